# Optimizing an MI355X kernel written in HIP

```python
import math
import jax, jax.numpy as jnp
from jax import lax
import numpy as np

D_MODEL = 2048
BATCH = 4
SEQ = 4096
DEPTH = 1
DEC_BATCH = 8
DEC_SEQ = 16
PAST_LEN = 4096

CHUNK = 64
N_HEADS = 8
HEAD_DIM = 128
ATTN_WIDTH = N_HEADS * HEAD_DIM
POOL_WINDOWS = (2, 4, 8, 16)
POOL_GROUPS = len(POOL_WINDOWS)
POOL_WIDTH = D_MODEL // 2
POOL_GROUP_WIDTH = POOL_WIDTH // POOL_GROUPS
POOL_HIST = max(POOL_WINDOWS) - 1
MIX_WIDTH = POOL_WIDTH + ATTN_WIDTH
IN_WIDTH = POOL_WIDTH + 3 * ATTN_WIDTH + 2 * D_MODEL
D_FF = int(math.ceil(8 * D_MODEL / 3 / 256) * 256)
Q_BLOCK = 128
EPS = 1e-6

kernel_name = "pool_stickbreak_gated_streaming_encoder"


def rmsnorm(x, g):
    xf = x.astype(jnp.float32)
    xf = xf * lax.rsqrt(jnp.mean(xf * xf, axis=-1, keepdims=True) + EPS)
    return (xf * g.astype(jnp.float32)).astype(x.dtype)


def multiscale_pool(u_hist, u, pos0, w_pool, s_pool):
    B, T, P = u.shape
    up = jnp.concatenate([u_hist.astype(u.dtype), u], axis=1)
    upf = up.astype(jnp.float32)
    cs = jnp.concatenate([jnp.zeros((B, 1, P), jnp.float32), jnp.cumsum(upf, axis=1)], axis=1)
    end = cs[:, POOL_HIST + 1:POOL_HIST + 1 + T]
    pos = pos0 + jnp.arange(T, dtype=jnp.int32)
    outs = []
    for gi, w in enumerate(POOL_WINDOWS):
        sl = slice(gi * POOL_GROUP_WIDTH, (gi + 1) * POOL_GROUP_WIDTH)
        start = cs[:, POOL_HIST + 1 - w:POOL_HIST + 1 - w + T, sl]
        cnt = jnp.minimum(pos + 1, w).astype(jnp.float32)[None, :, None]
        outs.append((end[..., sl] - start) / cnt)
    pooled = jnp.concatenate(outs, axis=-1)
    diff = (pooled - upf[:, POOL_HIST:]).reshape(B, T, POOL_GROUPS, POOL_GROUP_WIDTH)
    o = jnp.einsum('btgc,gce->btge', diff, w_pool.astype(jnp.float32)).reshape(B, T, P)
    o = o * s_pool.astype(jnp.float32)
    return o.astype(u.dtype), up[:, -POOL_HIST:]


def stick_breaking(q, k, v, q_pos, k_pos):
    z = jnp.einsum('bqhd,bkhd->bhqk', q, k).astype(jnp.float32) * (HEAD_DIM ** -0.5)
    mask = k_pos[None, :] < q_pos[:, None]
    log_1m = jnp.where(mask, jax.nn.log_sigmoid(-z), 0.0)
    suffix = lax.cumsum(log_1m, axis=3, reverse=True) - log_1m
    w = jnp.where(mask, jnp.exp(jax.nn.log_sigmoid(z) + suffix), 0.0)
    return jnp.einsum('bhqk,bkhd->bqhd', w.astype(v.dtype), v)


def layer(x, pool_hist, k_past, v_past, g_mix, w_in, w_pool, s_pool, w_branch, w_out,
          g_ffn, w_gate_up, w_down):
    B, T, _ = x.shape
    pos0 = 0 if k_past is None else k_past.shape[1]
    n = rmsnorm(x, g_mix)
    proj = n @ w_in
    c0 = POOL_WIDTH
    c1 = c0 + ATTN_WIDTH
    c2 = c1 + ATTN_WIDTH
    c3 = c2 + ATTN_WIDTH
    u = proj[..., :c0]
    q = proj[..., c0:c1].reshape(B, T, N_HEADS, HEAD_DIM)
    k = proj[..., c1:c2].reshape(B, T, N_HEADS, HEAD_DIM)
    v = proj[..., c2:c3].reshape(B, T, N_HEADS, HEAD_DIM)
    gate_logits = proj[..., c3:]

    o_a, new_pool = multiscale_pool(pool_hist, u, pos0, w_pool, s_pool)

    if k_past is None:
        k_all, v_all = k, v
    else:
        k_all = jnp.concatenate([k_past.astype(k.dtype), k], axis=1)
        v_all = jnp.concatenate([v_past.astype(v.dtype), v], axis=1)
    k_pos = jnp.arange(k_all.shape[1], dtype=jnp.int32)
    q_pos = pos0 + jnp.arange(T, dtype=jnp.int32)
    if T > Q_BLOCK:
        nb = T // Q_BLOCK
        qb = q.reshape(B, nb, Q_BLOCK, N_HEADS, HEAD_DIM).transpose(1, 0, 2, 3, 4)
        pb = q_pos.reshape(nb, Q_BLOCK)
        ob = lax.map(lambda a: stick_breaking(a[0], k_all, v_all, a[1], k_pos), (qb, pb))
        o_b = ob.transpose(1, 0, 2, 3, 4).reshape(B, T, ATTN_WIDTH)
    else:
        o_b = stick_breaking(q, k_all, v_all, q_pos, k_pos).reshape(B, T, ATTN_WIDTH)

    y_a = o_a @ w_branch[:POOL_WIDTH]
    y_b = o_b @ w_branch[POOL_WIDTH:]
    g = jax.nn.sigmoid(gate_logits.astype(jnp.float32))
    merged = g[..., :D_MODEL] * y_a.astype(jnp.float32) + g[..., D_MODEL:] * y_b.astype(jnp.float32)
    h = x + merged.astype(x.dtype) @ w_out

    n2 = rmsnorm(h, g_ffn)
    gu = n2 @ w_gate_up
    hid = jax.nn.silu(gu[..., :D_FF]) * gu[..., D_FF:]
    h = h + hid @ w_down
    return h, k, v, new_pool


def setup_inputs(seed: int = 0) -> dict:
    key = jax.random.key(seed)
    ks = jax.random.split(key, 16)
    f32 = jnp.float32
    nrm = lambda k, s, sc: jax.random.normal(k, s, f32) * sc
    return {
        "x_prompt": nrm(ks[0], (BATCH, SEQ, D_MODEL), 1.0),
        "x_sample": nrm(ks[1], (DEC_BATCH, DEC_SEQ, D_MODEL), 1.0),
        "cache_k": nrm(ks[2], (DEPTH, DEC_BATCH, PAST_LEN, N_HEADS, HEAD_DIM), 1.0),
        "cache_v": nrm(ks[3], (DEPTH, DEC_BATCH, PAST_LEN, N_HEADS, HEAD_DIM), 1.0),
        "state_pool": nrm(ks[4], (DEPTH, DEC_BATCH, POOL_HIST, POOL_WIDTH), 1.0),
        "g_mix": 1.0 + nrm(ks[5], (DEPTH, D_MODEL), 0.02),
        "w_in": nrm(ks[6], (DEPTH, D_MODEL, IN_WIDTH), D_MODEL ** -0.5),
        "w_pool": nrm(ks[7], (DEPTH, POOL_GROUPS, POOL_GROUP_WIDTH, POOL_GROUP_WIDTH), POOL_GROUP_WIDTH ** -0.5),
        "s_pool": 1.0 + nrm(ks[8], (DEPTH, POOL_WIDTH), 0.02),
        "w_branch": nrm(ks[9], (DEPTH, MIX_WIDTH, D_MODEL), POOL_WIDTH ** -0.5),
        "w_out": nrm(ks[10], (DEPTH, D_MODEL, D_MODEL), D_MODEL ** -0.5),
        "g_ffn": 1.0 + nrm(ks[11], (DEPTH, D_MODEL), 0.02),
        "w_gate_up": nrm(ks[12], (DEPTH, D_MODEL, 2 * D_FF), D_MODEL ** -0.5),
        "w_down": nrm(ks[13], (DEPTH, D_FF, D_MODEL), D_FF ** -0.5),
        "g_final": 1.0 + nrm(ks[14], (D_MODEL,), 0.02),
    }


def reference(x_prompt, x_sample, cache_k, cache_v, state_pool, g_mix, w_in, w_pool, s_pool,
              w_branch, w_out, g_ffn, w_gate_up, w_down, g_final):
    hp = x_prompt
    hs = x_sample
    kp_l, vp_l, pp_l, ks_l, vs_l, ps_l = [], [], [], [], [], []
    for l in range(DEPTH):
        params = (g_mix[l], w_in[l], w_pool[l], s_pool[l], w_branch[l], w_out[l],
                  g_ffn[l], w_gate_up[l], w_down[l])
        zero_hist = jnp.zeros((hp.shape[0], POOL_HIST, POOL_WIDTH), hp.dtype)
        hp, kp, vp, pp = layer(hp, zero_hist, None, None, *params)
        hs, ksm, vsm, psm = layer(hs, state_pool[l], cache_k[l], cache_v[l], *params)
        kp_l.append(kp); vp_l.append(vp); pp_l.append(pp)
        ks_l.append(ksm); vs_l.append(vsm); ps_l.append(psm)
    y_prompt = rmsnorm(hp, g_final)
    y_sample = rmsnorm(hs, g_final)
    return (y_prompt, y_sample, jnp.stack(kp_l), jnp.stack(vp_l), jnp.stack(pp_l),
            jnp.stack(ks_l), jnp.stack(vs_l), jnp.stack(ps_l))
```

```cpp
#include <hip/hip_runtime.h>
#include <hip/hip_cooperative_groups.h>
#include <cstdio>
#include <cstdint>
namespace cg = cooperative_groups;

#ifndef N_LAUNCH_MODE
#define N_LAUNCH_MODE 1
#endif

#define LAS __attribute__((address_space(3)))
typedef unsigned short bf16_t;
typedef short bf16x8 __attribute__((ext_vector_type(8)));
typedef short s16x4 __attribute__((ext_vector_type(4)));
typedef float f32x4 __attribute__((ext_vector_type(4)));
typedef float f32x16 __attribute__((ext_vector_type(16)));
typedef unsigned u32x4 __attribute__((ext_vector_type(4)));
typedef unsigned u32x2 __attribute__((ext_vector_type(2)));

constexpr int D = 2048, MP = 16384, MS = 128, MV = MP + MS, MT = 16640;
constexpr int SEQ = 4096, DSEQ = 16, PAST = 4096, NH = 8, HD = 128;
constexpr int NIN = 8192, FF = 5632, NGU = 2 * FF, AW = 1024;
constexpr float EPS = 1e-6f;
constexpr size_t OFF_Y = 0, OFF_KP = (size_t)MV * D, OFF_VP = OFF_KP + (size_t)MP * 1024, OFF_PP = OFF_VP + (size_t)MP * 1024,
                 OFF_KS = OFF_PP + 4 * 15 * 1024, OFF_VS = OFF_KS + (size_t)MS * 1024, OFF_PS = OFF_VS + (size_t)MS * 1024, OUT_TOTAL = OFF_PS + 8 * 15 * 1024;
constexpr size_t MiB = 1u << 20;
constexpr size_t WS_SSQ = 0, WS_WIN = 1 * MiB, WS_WBR = 33 * MiB, WS_WOUT = 41 * MiB, WS_WGU = 49 * MiB, WS_WDN = 93 * MiB, WS_XN = 115 * MiB,
                 WS_QKVU = 180 * MiB, WS_GATE = 310 * MiB, WS_AO = 440 * MiB, WS_END = 505 * MiB;
constexpr size_t WS_MERGED = WS_QKVU;
constexpr size_t WS_HID = WS_QKVU;
static_assert((size_t)MT * FF * 2 <= WS_AO - WS_QKVU, "hid overlay");
constexpr int LDS_BYTES = 147456;

typedef __bf16 bf16x2_t __attribute__((ext_vector_type(2)));
typedef float f32x2_t __attribute__((ext_vector_type(2)));
__device__ __forceinline__ unsigned cvt_pk_bf16(float lo, float hi) { const f32x2_t v = {lo, hi}; return __builtin_bit_cast(unsigned, __builtin_convertvector(v, bf16x2_t)); }
__device__ __forceinline__ float bf2f(unsigned short b) { return __uint_as_float(((unsigned)b) << 16); }
__device__ __forceinline__ float bflo(unsigned w) { return __uint_as_float(w << 16); }
__device__ __forceinline__ float bfhi(unsigned w) { return __uint_as_float(w & 0xffff0000u); }
__device__ __forceinline__ float fast_sigmoid(float x) { return __builtin_amdgcn_rcpf(1.0f + __expf(-x)); }
__device__ __forceinline__ float wave_sum(float v) {
#pragma unroll
    for (int o = 1; o < 64; o <<= 1) v += __shfl_xor(v, o);
    return v;
}

namespace pg8 {
constexpr int BM = 256, BK = 64, HALF = 128, HTB = HALF * BK * 2, STAGE_BYTES = 8 * HTB, NXCD = 8, WGM = 8;
__host__ __device__ __forceinline__ int lds_byte(int r, int c) { const int st = (r >> 4) * 2 + (c >> 5), rr = r & 15, cc = c & 31, ob = rr * 64 + cc * 2; return st * 1024 + (ob ^ (((ob >> 9) & 1) << 5)); }
__host__ __device__ __forceinline__ void stage_rc(int b, int& R, int& C) { const int st = b / 1024, sb = b % 1024, swz = sb ^ (((sb >> 9) & 1) << 5); R = (st >> 1) * 16 + swz / 64; C = (st & 1) * 32 + (swz % 64) / 2; }
__host__ __device__ __forceinline__ int perm32(int rho) { const int n = rho >> 4, i = rho & 15; return 8 * (i >> 2) + 4 * n + (i & 3); }

struct Unit { int pm, pn; };
struct Gemm { const bf16_t* A; const bf16_t* Bt; int lda, ldb, M, N, K; };

struct StaticOrder {
    int nM, nN, nwg, G, c;
    __device__ void init(int M, int N, int G_, int c_) { nM = M / BM; nN = N / BM; nwg = nM * nN; G = G_; c = c_; }
    __device__ bool next(int i, Unit& u) const {
        const long L = (long)i * G + c; if (L >= nwg) return false;
        int wgid = (int)L; { const int q = nwg / NXCD, r = nwg % NXCD, xcd = wgid % NXCD, off = wgid / NXCD; wgid = (xcd < r ? xcd * (q + 1) : r * (q + 1) + (xcd - r) * q) + off; }
        const int nig = WGM * nN, gid = wgid / nig, fm = gid * WGM, gsz = (nM - fm) < WGM ? (nM - fm) : WGM;
        u.pm = fm + ((wgid % nig) % gsz); u.pn = (wgid % nig) / gsz; return true;
    }
};

template <class Epi>
__device__ __forceinline__ void gemm_phase(LAS unsigned char* lds, const Gemm g, const StaticOrder& S, const Epi& E) {
    const int tid = threadIdx.x, wid = __builtin_amdgcn_readfirstlane(tid >> 6), lane = tid & 63, wr = wid >> 2, wc = wid & 3, fr = lane & 15, fq = lane >> 4;
    const int K = g.K, nt = K / BK;
    unsigned voffA[2], voffB[2];
#pragma unroll
    for (int i = 0; i < 2; ++i) { int R, C; stage_rc(tid * 16 + i * 8192, R, C); const int Rb = (R & ~31) + perm32(R & 31);
        voffA[i] = (unsigned)(R * g.lda + C) * 2u; voffB[i] = (unsigned)(Rb * g.ldb + C) * 2u; }
    const size_t kstep = (size_t)(BK * 2);
    const size_t hstepA = (size_t)HALF * g.lda * 2, hstepB = (size_t)HALF * g.ldb * 2;
    const size_t tstepA = 2 * hstepA, tstepB = 2 * hstepB;
    const unsigned ldsw = (unsigned)wid * 1024u;
    const int aoff = lds_byte(wr * 64 + fr, fq * 8), boff = lds_byte(wc * 32 + fr, fq * 8);
#define PG8_SA(b, h) (((b) * 2 + (h)) * HTB)
#define PG8_SB(b, h) ((4 + (b) * 2 + (h)) * HTB)
#define PG8_STAGE(bufoff, gbase, voff) do { _Pragma("unroll") for (int _i = 0; _i < 2; ++_i) \
        __builtin_amdgcn_global_load_lds((const unsigned*)((const char*)(gbase) + (voff)[_i]), (LAS unsigned*)(lds + (bufoff) + ldsw + _i * 8192), 16, 0, 0); } while (0)
#define PG8_LDA(dst, b, h) do { _Pragma("unroll") for (int m = 0; m < 4; ++m) _Pragma("unroll") for (int k = 0; k < 2; ++k) dst[m][k] = *(const LAS bf16x8*)(lds + PG8_SA(b, h) + aoff + m * 2048 + k * 1024); } while (0)
#define PG8_LDB(dst, b, h) do { _Pragma("unroll") for (int n = 0; n < 2; ++n) _Pragma("unroll") for (int k = 0; k < 2; ++k) dst[n][k] = *(const LAS bf16x8*)(lds + PG8_SB(b, h) + boff + n * 2048 + k * 1024); } while (0)
#define PG8_MMA(ai, bj, At, Bt) do { __builtin_amdgcn_s_setprio(1); _Pragma("unroll") for (int m = 0; m < 4; ++m) _Pragma("unroll") for (int n = 0; n < 2; ++n) _Pragma("unroll") for (int k = 0; k < 2; ++k) \
        acc[ai][bj][m][n] = __builtin_amdgcn_mfma_f32_16x16x32_bf16(Bt[n][k], At[m][k], acc[ai][bj][m][n], 0, 0, 0); __builtin_amdgcn_s_setprio(0); } while (0)
#define PG8_WAIT_V(n) asm volatile("s_waitcnt vmcnt(" #n ")" ::: "memory")
#define PG8_WAIT_L(n) asm volatile("s_waitcnt lgkmcnt(" #n ")" ::: "memory")
#define PG8_BAR __builtin_amdgcn_s_barrier()
#define PG8_SCHED __builtin_amdgcn_sched_barrier(0)
    Unit cur, nxt; int ui = 0;
    if (!S.next(0, cur)) return;
    f32x4 acc[2][2][4][2];
#pragma unroll
    for (int a = 0; a < 2; ++a)
#pragma unroll
        for (int b = 0; b < 2; ++b)
#pragma unroll
            for (int m = 0; m < 4; ++m)
#pragma unroll
                for (int n = 0; n < 2; ++n) acc[a][b][m][n] = (f32x4){0.f, 0.f, 0.f, 0.f};
    bf16x8 At[4][2], B0[2][2], B1[2][2];
    const char* cA = (const char*)g.A + (size_t)cur.pm * tstepA; const char* cB = (const char*)g.Bt + (size_t)cur.pn * tstepB;
    PG8_STAGE(PG8_SB(0, 0), cB, voffB); PG8_STAGE(PG8_SB(0, 1), cB + hstepB, voffB); PG8_STAGE(PG8_SA(0, 0), cA, voffA); PG8_STAGE(PG8_SA(0, 1), cA + hstepA, voffA);
    if (wr == 1) PG8_BAR;
    PG8_WAIT_V(2); PG8_BAR;
    PG8_STAGE(PG8_SB(1, 0), cB + kstep, voffB); PG8_STAGE(PG8_SA(1, 0), cA + kstep, voffA); PG8_STAGE(PG8_SB(1, 1), cB + hstepB + kstep, voffB);
    PG8_WAIT_V(6); PG8_BAR;
    for (;;) {
        const bool has_next = S.next(ui + 1, nxt);
        const char* nA = has_next ? (const char*)g.A + (size_t)nxt.pm * tstepA : cA; const char* nB = has_next ? (const char*)g.Bt + (size_t)nxt.pn * tstepB : cB;
        for (int t = 0; t < nt; t += 2) {
            const bool last = (t == nt - 2);
            const char* a1 = cA + (size_t)(t + 1) * kstep;
            const char* a2 = last ? nA : cA + (size_t)(t + 2) * kstep; const char* b2 = last ? nB : cB + (size_t)(t + 2) * kstep;
            const char* a3 = a2 + kstep; const char* b3 = b2 + kstep;
            PG8_LDB(B0, 0, 0); PG8_LDB(B1, 0, 1); PG8_SCHED; PG8_LDA(At, 0, 0); PG8_STAGE(PG8_SA(1, 1), a1 + hstepA, voffA);
            PG8_WAIT_V(8); PG8_WAIT_L(0); PG8_BAR; PG8_MMA(0, 0, At, B0); PG8_MMA(0, 1, At, B1); PG8_BAR; PG8_SCHED;
            PG8_LDA(At, 0, 1); PG8_STAGE(PG8_SB(0, 0), b2, voffB); PG8_STAGE(PG8_SB(0, 1), b2 + hstepB, voffB); PG8_STAGE(PG8_SA(0, 0), a2, voffA);
            PG8_WAIT_V(8); PG8_WAIT_L(0); PG8_BAR; PG8_MMA(1, 0, At, B0); PG8_MMA(1, 1, At, B1); PG8_BAR; PG8_SCHED;
            PG8_LDB(B0, 1, 0); PG8_LDB(B1, 1, 1); PG8_SCHED; PG8_LDA(At, 1, 0); PG8_STAGE(PG8_SA(0, 1), a2 + hstepA, voffA);
            PG8_WAIT_V(8); PG8_WAIT_L(0); PG8_BAR; PG8_MMA(0, 0, At, B0); PG8_MMA(0, 1, At, B1); PG8_BAR; PG8_SCHED;
            PG8_LDA(At, 1, 1); PG8_STAGE(PG8_SB(1, 0), b3, voffB); PG8_STAGE(PG8_SB(1, 1), b3 + hstepB, voffB); PG8_STAGE(PG8_SA(1, 0), a3, voffA);
            PG8_WAIT_V(8); PG8_WAIT_L(0); PG8_BAR; PG8_MMA(1, 0, At, B0); PG8_MMA(1, 1, At, B1); PG8_BAR; PG8_SCHED;
        }
        if (wr == 0) PG8_BAR;
        E(acc, cur, wr, wc, fr, fq);
        if (!has_next) break;
#pragma unroll
        for (int a = 0; a < 2; ++a)
#pragma unroll
            for (int b = 0; b < 2; ++b)
#pragma unroll
                for (int m = 0; m < 4; ++m)
#pragma unroll
                    for (int n = 0; n < 2; ++n) acc[a][b][m][n] = (f32x4){0.f, 0.f, 0.f, 0.f};
        cur = nxt; cA = nA; cB = nB; ++ui;
        if (wr == 1) PG8_BAR;
    }
    PG8_WAIT_V(0);
    PG8_BAR;
#undef PG8_SA
#undef PG8_SB
#undef PG8_STAGE
#undef PG8_LDA
#undef PG8_LDB
#undef PG8_MMA
#undef PG8_WAIT_V
#undef PG8_WAIT_L
#undef PG8_BAR
#undef PG8_SCHED
}
}
using pg8::Unit;

__device__ __forceinline__ u32x4 pack8(const f32x4& v0, const f32x4& v1) {
    u32x4 w; w.x = cvt_pk_bf16(v0[0], v0[1]); w.y = cvt_pk_bf16(v0[2], v0[3]); w.z = cvt_pk_bf16(v1[0], v1[1]); w.w = cvt_pk_bf16(v1[2], v1[3]); return w;
}
__device__ __forceinline__ void unpack8(const u32x4& w, f32x4& v0, f32x4& v1) {
    v0 = (f32x4){bflo(w.x), bfhi(w.x), bflo(w.y), bfhi(w.y)}; v1 = (f32x4){bflo(w.z), bfhi(w.z), bflo(w.w), bfhi(w.w)};
}

struct EpiIn {
    bf16_t* qkvu; bf16_t* gate; float* out;
    __device__ __forceinline__ void operator()(const f32x4 (&acc)[2][2][4][2], const Unit& u, int wr, int wc, int fr, int fq) const {
        const int row0 = u.pm * 256 + wr * 64 + fr, cw = wc * 32 + 8 * fq;
        if (u.pn >= 16) {
            bf16_t* base = gate + (size_t)row0 * 4096 + (u.pn - 16) * 256 + cw;
#pragma unroll
            for (int ai = 0; ai < 2; ++ai)
#pragma unroll
                for (int m = 0; m < 4; ++m) { bf16_t* rowp = base + (size_t)(ai * 128 + m * 16) * 4096;
#pragma unroll
                    for (int bj = 0; bj < 2; ++bj) { f32x4 v0 = acc[ai][bj][m][0], v1 = acc[ai][bj][m][1];
#pragma unroll
                        for (int j = 0; j < 4; ++j) { v0[j] = fast_sigmoid(v0[j]); v1[j] = fast_sigmoid(v1[j]); }
                        *(u32x4*)(rowp + bj * 128) = pack8(v0, v1); } }
        } else {
            const int sec = u.pn >> 2, cc = (u.pn & 3) * 256 + cw;
            bf16_t* base = qkvu + (size_t)sec * MT * 1024 + (size_t)row0 * 1024 + cc;
#pragma unroll
            for (int ai = 0; ai < 2; ++ai)
#pragma unroll
                for (int m = 0; m < 4; ++m) { bf16_t* rowp = base + (size_t)(ai * 128 + m * 16) * 1024;
#pragma unroll
                    for (int bj = 0; bj < 2; ++bj) *(u32x4*)(rowp + bj * 128) = pack8(acc[ai][bj][m][0], acc[ai][bj][m][1]); }
            if (sec >= 2) {
                const size_t offp = (sec == 2) ? OFF_KP : OFF_VP, offs = (sec == 2) ? OFF_KS : OFF_VS;
#pragma unroll
                for (int ai = 0; ai < 2; ++ai)
#pragma unroll
                    for (int m = 0; m < 4; ++m) { const int row = row0 + ai * 128 + m * 16;
                        if (row < MV) { float* o = out + (row < MP ? offp + (size_t)row * 1024 : offs + (size_t)(row - MP) * 1024) + cc;
#pragma unroll
                            for (int bj = 0; bj < 2; ++bj) { *(f32x4*)(o + bj * 128) = acc[ai][bj][m][0]; *(f32x4*)(o + bj * 128 + 4) = acc[ai][bj][m][1]; } } }
            } else if (sec == 0 && ((u.pm & 15) == 15 || u.pm == 64)) {
#pragma unroll
                for (int ai = 0; ai < 2; ++ai)
#pragma unroll
                    for (int m = 0; m < 4; ++m) { const int row = row0 + ai * 128 + m * 16; long off = -1;
                        if (row < MP) { const int t = row & (SEQ - 1); if (t >= SEQ - 15) off = (long)OFF_PP + ((long)(row >> 12) * 15 + (t - (SEQ - 15))) * 1024; }
                        else if (row < MV) { const int t = (row - MP) & 15, b = (row - MP) >> 4; if (t >= 1) off = (long)OFF_PS + ((long)b * 15 + (t - 1)) * 1024; }
                        if (off >= 0) { float* o = out + off + cc;
#pragma unroll
                            for (int bj = 0; bj < 2; ++bj) { *(f32x4*)(o + bj * 128) = acc[ai][bj][m][0]; *(f32x4*)(o + bj * 128 + 4) = acc[ai][bj][m][1]; } } }
            }
        }
    }
};
struct EpiBrA {
    const bf16_t* gate; float* tmp;
    __device__ __forceinline__ void operator()(const f32x4 (&acc)[2][2][4][2], const Unit& u, int wr, int wc, int fr, int fq) const {
        const int row0 = u.pm * 256 + wr * 64 + fr, cc = u.pn * 256 + wc * 32 + 8 * fq;
#pragma unroll
        for (int ai = 0; ai < 2; ++ai)
#pragma unroll
            for (int m = 0; m < 4; ++m) { const int row = row0 + ai * 128 + m * 16;
                if (row < MV) { const bf16_t* gp = gate + (size_t)row * 4096 + cc; float* o = tmp + (size_t)row * D + cc;
#pragma unroll
                    for (int bj = 0; bj < 2; ++bj) { const u32x4 gw = *(const u32x4*)(gp + bj * 128); f32x4 g0, g1; unpack8(gw, g0, g1);
                        *(f32x4*)(o + bj * 128) = acc[ai][bj][m][0] * g0; *(f32x4*)(o + bj * 128 + 4) = acc[ai][bj][m][1] * g1; } } }
    }
};
struct EpiBrB {
    const bf16_t* gate; const float* tmp; bf16_t* merged;
    __device__ __forceinline__ void operator()(const f32x4 (&acc)[2][2][4][2], const Unit& u, int wr, int wc, int fr, int fq) const {
        const int row0 = u.pm * 256 + wr * 64 + fr, cc = u.pn * 256 + wc * 32 + 8 * fq;
#pragma unroll
        for (int ai = 0; ai < 2; ++ai)
#pragma unroll
            for (int m = 0; m < 4; ++m) { const int row = row0 + ai * 128 + m * 16;
                const bf16_t* gp = gate + (size_t)row * 4096 + 2048 + cc; const float* tp = tmp + (size_t)row * D + cc; bf16_t* o = merged + (size_t)row * D + cc;
#pragma unroll
                for (int bj = 0; bj < 2; ++bj) { const u32x4 gw = *(const u32x4*)(gp + bj * 128); f32x4 g0, g1; unpack8(gw, g0, g1);
                    f32x4 t0 = (f32x4){0.f, 0.f, 0.f, 0.f}, t1 = t0;
                    if (row < MV) { t0 = *(const f32x4*)(tp + bj * 128); t1 = *(const f32x4*)(tp + bj * 128 + 4); }
                    *(u32x4*)(o + bj * 128) = pack8(t0 + acc[ai][bj][m][0] * g0, t1 + acc[ai][bj][m][1] * g1); } }
    }
};
struct EpiOut {
    const float* xp; const float* xs; float* y; bf16_t* hb; float* ssq;
    __device__ __forceinline__ void operator()(const f32x4 (&acc)[2][2][4][2], const Unit& u, int wr, int wc, int fr, int fq) const {
        const int row0 = u.pm * 256 + wr * 64 + fr, cc = u.pn * 256 + wc * 32 + 8 * fq;
#pragma unroll
        for (int ai = 0; ai < 2; ++ai)
#pragma unroll
            for (int m = 0; m < 4; ++m) { const int row = row0 + ai * 128 + m * 16; const bool ok = row < MV;
                const float* xr = (row < MP ? xp + (size_t)row * D : xs + (size_t)(row - MP) * D) + cc; float* o = y + (size_t)row * D + cc; bf16_t* ob = hb + (size_t)row * D + cc;
                float s = 0.f;
#pragma unroll
                for (int bj = 0; bj < 2; ++bj) { f32x4 h0 = acc[ai][bj][m][0], h1 = acc[ai][bj][m][1];
                    if (ok) { h0 += *(const f32x4*)(xr + bj * 128); h1 += *(const f32x4*)(xr + bj * 128 + 4); *(f32x4*)(o + bj * 128) = h0; *(f32x4*)(o + bj * 128 + 4) = h1; }
                    *(u32x4*)(ob + bj * 128) = pack8(h0, h1);
                    s += (h0[0] * h0[0] + h0[1] * h0[1]) + (h0[2] * h0[2] + h0[3] * h0[3]) + (h1[0] * h1[0] + h1[1] * h1[1]) + (h1[2] * h1[2] + h1[3] * h1[3]); }
                s += __shfl_xor(s, 16); s += __shfl_xor(s, 32);
                if (fq == 0) atomicAdd(ssq + row, s); }
    }
};
struct EpiGU {
    const float* ssq; bf16_t* hid;
    __device__ __forceinline__ void operator()(const f32x4 (&acc)[2][2][4][2], const Unit& u, int wr, int wc, int fr, int fq) const {
        const int row0 = u.pm * 256 + wr * 64 + fr, cc = u.pn * 128 + wc * 32 + 8 * fq;
#pragma unroll
        for (int ai = 0; ai < 2; ++ai)
#pragma unroll
            for (int m = 0; m < 4; ++m) { const int row = row0 + ai * 128 + m * 16;
                const float sc = __builtin_amdgcn_rsqf(ssq[row] * (1.0f / D) + EPS);
                f32x4 r0, r1;
#pragma unroll
                for (int j = 0; j < 4; ++j) { const float g0 = acc[ai][0][m][0][j] * sc, u0 = acc[ai][1][m][0][j] * sc, g1 = acc[ai][0][m][1][j] * sc, u1 = acc[ai][1][m][1][j] * sc;
                    r0[j] = g0 * fast_sigmoid(g0) * u0; r1[j] = g1 * fast_sigmoid(g1) * u1; }
                *(u32x4*)(hid + (size_t)row * FF + cc) = pack8(r0, r1); }
    }
};
struct EpiDown {
    float* y;
    __device__ __forceinline__ void operator()(const f32x4 (&acc)[2][2][4][2], const Unit& u, int wr, int wc, int fr, int fq) const {
        const int row0 = u.pm * 256 + wr * 64 + fr, cc = u.pn * 256 + wc * 32 + 8 * fq;
#pragma unroll
        for (int ai = 0; ai < 2; ++ai)
#pragma unroll
            for (int m = 0; m < 4; ++m) { const int row = row0 + ai * 128 + m * 16;
                if (row < MV) { float* o = y + (size_t)row * D + cc;
#pragma unroll
                    for (int bj = 0; bj < 2; ++bj) { *(f32x4*)(o + bj * 128) = *(const f32x4*)(o + bj * 128) + acc[ai][bj][m][0]; *(f32x4*)(o + bj * 128 + 4) = *(const f32x4*)(o + bj * 128 + 4) + acc[ai][bj][m][1]; } } }
    }
};

__device__ __forceinline__ void p0_item(const float* W, int N, int k0, int n0, const float* gsc, bf16_t* dst, int ldd, int drow0, int dcol0, LAS float* scr, int lane) {
#pragma unroll 8
    for (int i = 0; i < 32; ++i) { const int kk = 2 * i + (lane >> 5); float v = W[(size_t)(k0 + kk) * N + n0 + (lane & 31)]; if (gsc) v *= gsc[k0 + kk]; scr[kk * 33 + (lane & 31)] = v; }
    asm volatile("s_waitcnt lgkmcnt(0)" ::: "memory");
    const int c = lane & 7;
#pragma unroll
    for (int j = 0; j < 4; ++j) { const int n = (lane >> 3) + 8 * j; const LAS float* s = scr + (8 * c) * 33 + n;
        u32x4 o; o.x = cvt_pk_bf16(s[0 * 33], s[1 * 33]); o.y = cvt_pk_bf16(s[2 * 33], s[3 * 33]); o.z = cvt_pk_bf16(s[4 * 33], s[5 * 33]); o.w = cvt_pk_bf16(s[6 * 33], s[7 * 33]);
        *(u32x4*)(dst + (size_t)(drow0 + n) * ldd + dcol0 + k0 + 8 * c) = o; }
    asm volatile("s_waitcnt lgkmcnt(0)" ::: "memory");
}

struct Params {
    const float *x_prompt, *x_sample, *cache_k, *cache_v, *state_pool, *g_mix, *w_in, *w_pool, *s_pool, *w_branch, *w_out, *g_ffn, *w_gate_up, *w_down, *g_final;
    float* out; unsigned char* ws; int ph_lo, ph_hi;
};

__device__ __forceinline__ void phase0(const Params& p, LAS unsigned char* lds, int gw, int NGW, int wave, int lane) {
    LAS float* scr = (LAS float*)(lds + wave * 16384);
    bf16_t* Wt_in = (bf16_t*)(p.ws + WS_WIN); bf16_t* Wt_br = (bf16_t*)(p.ws + WS_WBR); bf16_t* Wt_out = (bf16_t*)(p.ws + WS_WOUT);
    bf16_t* Wt_gu = (bf16_t*)(p.ws + WS_WGU); bf16_t* Wt_dn = (bf16_t*)(p.ws + WS_WDN); bf16_t* XN = (bf16_t*)(p.ws + WS_XN);
    constexpr int I_IN = (D / 64) * (NIN / 32), I_BRB = (1024 / 64) * (D / 32), I_OUT = (D / 64) * (D / 32), I_GU = (D / 64) * (NGU / 32), I_DN = (FF / 64) * (D / 32);
    constexpr int NITEMS = I_IN + I_BRB + I_OUT + I_GU + I_DN;
    for (int it = gw; it < NITEMS; it += NGW) {
        int r = it;
        if (r < I_IN) { const int nb = NIN / 32; p0_item(p.w_in, NIN, 64 * (r / nb), 32 * (r % nb), p.g_mix, Wt_in, D, 32 * (r % nb), 0, scr, lane); continue; } r -= I_IN;
        if (r < I_BRB) { const int nb = D / 32; p0_item(p.w_branch + (size_t)1024 * D, D, 64 * (r / nb), 32 * (r % nb), nullptr, Wt_br, 2048, 32 * (r % nb), 1024, scr, lane); continue; } r -= I_BRB;
        if (r < I_OUT) { const int nb = D / 32; p0_item(p.w_out, D, 64 * (r / nb), 32 * (r % nb), nullptr, Wt_out, D, 32 * (r % nb), 0, scr, lane); continue; } r -= I_OUT;
        if (r < I_GU) { const int nb = NGU / 32; const int n0 = 32 * (r % nb); const int drow = n0 < FF ? (n0 / 128) * 256 + (n0 % 128) : ((n0 - FF) / 128) * 256 + 128 + ((n0 - FF) % 128);
            p0_item(p.w_gate_up, NGU, 64 * (r / nb), n0, p.g_ffn, Wt_gu, D, drow, 0, scr, lane); continue; } r -= I_GU;
        { const int nb = D / 32; p0_item(p.w_down, D, 64 * (r / nb), 32 * (r % nb), nullptr, Wt_dn, FF, 32 * (r % nb), 0, scr, lane); }
    }
    for (int it = gw; it < 128 * 32; it += NGW) {
        const int kb = it >> 5, nb = it & 31, g = kb >> 5, c0 = (kb & 31) * 8, n = nb * 64 + lane;
        const float* wp = p.w_pool + ((size_t)g * 256 + c0) * 256; const float* sp = p.s_pool + g * 256; const float* wb = p.w_branch + (size_t)g * 256 * D + n;
        float a[8];
#pragma unroll
        for (int e = 0; e < 8; ++e) a[e] = 0.f;
#pragma unroll 4
        for (int j = 0; j < 256; ++j) { const float b = sp[j] * wb[(size_t)j * D];
#pragma unroll
            for (int e = 0; e < 8; ++e) a[e] += wp[e * 256 + j] * b; }
        u32x4 o; o.x = cvt_pk_bf16(a[0], a[1]); o.y = cvt_pk_bf16(a[2], a[3]); o.z = cvt_pk_bf16(a[4], a[5]); o.w = cvt_pk_bf16(a[6], a[7]);
        *(u32x4*)(Wt_br + (size_t)n * 2048 + g * 256 + c0) = o;
    }
    for (int m = gw; m < MT; m += NGW) {
        u32x2* o8 = (u32x2*)(XN + (size_t)m * D) + lane;
        if (m >= MV) {
#pragma unroll
            for (int j = 0; j < 8; ++j) o8[64 * j] = (u32x2){0u, 0u};
            continue; }
        const f32x4* xr = (const f32x4*)(m < MP ? p.x_prompt + (size_t)m * D : p.x_sample + (size_t)(m - MP) * D) + lane;
        f32x4 v[8]; float s = 0.f;
#pragma unroll
        for (int j = 0; j < 8; ++j) { v[j] = xr[64 * j]; s += (v[j].x * v[j].x + v[j].y * v[j].y) + (v[j].z * v[j].z + v[j].w * v[j].w); }
        const float rs = __builtin_amdgcn_rsqf(wave_sum(s) * (1.0f / D) + EPS);
#pragma unroll
        for (int j = 0; j < 8; ++j) o8[64 * j] = (u32x2){cvt_pk_bf16(v[j].x * rs, v[j].y * rs), cvt_pk_bf16(v[j].z * rs, v[j].w * rs)};
    }
    float* ssq = (float*)(p.ws + WS_SSQ);
    for (int i = gw * 64 + lane; i < MT; i += NGW * 64) ssq[i] = 0.f;
}

constexpr int VROW = 320;
__device__ __forceinline__ s16x4 vtr(const LAS unsigned char* p) { typedef short v4i16_t __attribute__((ext_vector_type(4))); return __builtin_bit_cast(s16x4, __builtin_amdgcn_ds_read_tr16_b64_v4i16((LAS v4i16_t*)p)); }
__device__ __forceinline__ bf16x8 cvt8(const f32x4& a, const f32x4& b) { u32x4 w = pack8(a, b); return __builtin_bit_cast(bf16x8, w); }

__device__ __forceinline__ void attn_unit(const Params& p, LAS unsigned char* vl, int unit, int lane) {
    const bf16_t* Ub = (const bf16_t*)(p.ws + WS_QKVU);
    const bf16_t* Qb = Ub + (size_t)MT * 1024; const bf16_t* Kb = Qb + (size_t)MT * 1024; const bf16_t* Vb = Kb + (size_t)MT * 1024;
    bf16_t* AO = (bf16_t*)(p.ws + WS_AO);
    const int n = lane & 31, hh = lane >> 5;
    const bool sample = unit < 64;
    int b, h, qrow0, nblk;
    if (sample) { b = unit >> 3; h = unit & 7; qrow0 = MP + b * DSEQ; nblk = 1 + PAST / 32; }
    else { const int u2 = unit - 64; const int qb = u2 & 127; h = (u2 >> 7) & 7; b = u2 >> 10; qrow0 = b * SEQ + qb * 32; nblk = qb + 1; }
    bf16x8 qf[8];
    { const bf16_t* qp = Qb + (size_t)(qrow0 + n) * 1024 + h * HD + 64 * hh;
#pragma unroll
      for (int kk = 0; kk < 8; ++kk) qf[kk] = *(const bf16x8*)(qp + 8 * kk); }
    f32x16 o[4];
#pragma unroll
    for (int db = 0; db < 4; ++db)
#pragma unroll
        for (int r = 0; r < 16; ++r) o[db][r] = 0.f;
    float R = (sample && n >= DSEQ) ? -1e30f : 0.f;
    const float* ck = p.cache_k + (size_t)b * PAST * 1024 + h * HD; const float* cv = p.cache_v + (size_t)b * PAST * 1024 + h * HD;
    const int vaddr = (4 * hh + ((lane & 15) >> 2)) * VROW + (16 * ((lane >> 4) & 1) + 4 * (lane & 3)) * 2;
    for (int blk = 0; blk < nblk; ++blk) {
        bf16x8 kf[8];
        const bool diag = (blk == 0);
        if (!sample || blk == 0) {
            const int s0 = qrow0 - blk * 32;
            const bf16_t* kp = Kb + (size_t)(s0 + n) * 1024 + h * HD + 64 * hh;
#pragma unroll
            for (int kk = 0; kk < 8; ++kk) kf[kk] = *(const bf16x8*)(kp + 8 * kk);
            const bf16_t* vp = Vb + (size_t)(s0 + (lane >> 4)) * 1024 + h * HD + 8 * (lane & 15);
#pragma unroll
            for (int it = 0; it < 8; ++it) { const u32x4 w = *(const u32x4*)(vp + (size_t)(4 * it) * 1024); *(LAS u32x4*)(vl + (4 * it + (lane >> 4)) * VROW + 16 * (lane & 15)) = w; }
        } else {
            const int s0 = PAST - blk * 32;
            const float* kp = ck + (size_t)(s0 + n) * 1024 + 64 * hh;
#pragma unroll
            for (int kk = 0; kk < 8; ++kk) kf[kk] = cvt8(*(const f32x4*)(kp + 8 * kk), *(const f32x4*)(kp + 8 * kk + 4));
            const float* vp = cv + (size_t)(s0 + (lane >> 4)) * 1024 + 8 * (lane & 15);
#pragma unroll
            for (int it = 0; it < 8; ++it) { const f32x4 a = *(const f32x4*)(vp + (size_t)(4 * it) * 1024), c = *(const f32x4*)(vp + (size_t)(4 * it) * 1024 + 4);
                *(LAS u32x4*)(vl + (4 * it + (lane >> 4)) * VROW + 16 * (lane & 15)) = pack8(a, c); }
        }
        f32x16 st;
#pragma unroll
        for (int r = 0; r < 16; ++r) st[r] = 0.f;
#pragma unroll
        for (int kk = 0; kk < 8; ++kk) st = __builtin_amdgcn_mfma_f32_32x32x16_bf16(kf[kk], qf[kk], st, 0, 0, 0);
        float l1m[16], ls[16];
#pragma unroll
        for (int r = 0; r < 16; ++r) { const int i = (r & 3) + 8 * (r >> 2) + 4 * hh; const bool valid = !diag || (i < n);
            const float z = st[r] * 0.08838834764831845f; const float sp = fmaxf(z, 0.f) + __logf(1.0f + __expf(-fabsf(z)));
            l1m[r] = valid ? -sp : 0.f; ls[r] = valid ? (z - sp) : -1e30f; }
        float gown[4], goth[4];
#pragma unroll
        for (int a = 0; a < 4; ++a) { gown[a] = (l1m[4 * a] + l1m[4 * a + 1]) + (l1m[4 * a + 2] + l1m[4 * a + 3]); goth[a] = __shfl_xor(gown[a], 32); }
        float wv[16]; float tail = R;
#pragma unroll
        for (int a = 3; a >= 0; --a) { float sfx = tail + (hh == 0 ? goth[a] : 0.f);
#pragma unroll
            for (int rr = 3; rr >= 0; --rr) { wv[4 * a + rr] = __expf(ls[4 * a + rr] + sfx); sfx += l1m[4 * a + rr]; }
            tail += gown[a] + goth[a]; }
        R = tail;
        bf16x8 wb[2];
#pragma unroll
        for (int s = 0; s < 2; ++s) wb[s] = cvt8((f32x4){wv[8 * s], wv[8 * s + 1], wv[8 * s + 2], wv[8 * s + 3]}, (f32x4){wv[8 * s + 4], wv[8 * s + 5], wv[8 * s + 6], wv[8 * s + 7]});
        asm volatile("s_waitcnt lgkmcnt(0)" ::: "memory");
#pragma unroll
        for (int db = 0; db < 4; ++db)
#pragma unroll
            for (int s = 0; s < 2; ++s) { const s16x4 lo = vtr(vl + vaddr + (16 * s) * VROW + 64 * db), hi = vtr(vl + vaddr + (16 * s + 8) * VROW + 64 * db);
                const bf16x8 vf = (bf16x8){lo[0], lo[1], lo[2], lo[3], hi[0], hi[1], hi[2], hi[3]};
                o[db] = __builtin_amdgcn_mfma_f32_32x32x16_bf16(vf, wb[s], o[db], 0, 0, 0); }
        asm volatile("s_waitcnt lgkmcnt(0)" ::: "memory");
        if (__all(R < -104.0f)) break;
    }
    if (!sample || n < DSEQ) {
        bf16_t* op = AO + (size_t)(qrow0 + n) * 2048 + 1024 + h * HD + 4 * hh;
#pragma unroll
        for (int db = 0; db < 4; ++db)
#pragma unroll
            for (int a = 0; a < 4; ++a) *(u32x2*)(op + 32 * db + 8 * a) = (u32x2){cvt_pk_bf16(o[db][4 * a], o[db][4 * a + 1]), cvt_pk_bf16(o[db][4 * a + 2], o[db][4 * a + 3])};
    }
}

__device__ __forceinline__ void diff_items(const Params& p, int gtid, int nthreads) {
    const bf16_t* Ub = (const bf16_t*)(p.ws + WS_QKVU); bf16_t* AO = (bf16_t*)(p.ws + WS_AO);
    for (int it = gtid; it < MV * 128; it += nthreads) {
        const int m = it >> 7, cc = it & 127, g = cc >> 5, w = 2 << g;
        const bf16_t* up = Ub + (size_t)m * 1024 + cc * 8;
        f32x4 s0 = (f32x4){0.f, 0.f, 0.f, 0.f}, s1 = s0, u0, u1; float cnt;
        { const u32x4 v = *(const u32x4*)up; unpack8(v, u0, u1); s0 = u0; s1 = u1; }
        if (m < MP) { const int t = m & (SEQ - 1); const int jn = t < w - 1 ? t : w - 1; cnt = (float)(jn + 1);
            for (int j = 1; j <= jn; ++j) { const u32x4 v = *(const u32x4*)(up - (size_t)j * 1024); f32x4 a, c; unpack8(v, a, c); s0 += a; s1 += c; } }
        else { const int t = (m - MP) & 15, b = (m - MP) >> 4; cnt = (float)w;
            for (int j = 1; j < w; ++j) { const int tj = t - j;
                if (tj >= 0) { const u32x4 v = *(const u32x4*)(up - (size_t)j * 1024); f32x4 a, c; unpack8(v, a, c); s0 += a; s1 += c; }
                else { const float* hp = p.state_pool + ((size_t)b * 15 + (15 + tj)) * 1024 + cc * 8; s0 += *(const f32x4*)hp; s1 += *(const f32x4*)(hp + 4); } } }
        const float ic = 1.0f / cnt;
        *(u32x4*)(AO + (size_t)m * 2048 + cc * 8) = pack8(s0 * ic - u0, s1 * ic - u1);
    }
}

__global__ void __launch_bounds__(512, 2) fwd_megakernel(Params p) {
    extern __shared__ __attribute__((aligned(16))) unsigned char lds_raw[];
    LAS unsigned char* lds = (LAS unsigned char*)lds_raw;
    const int tid = threadIdx.x, lane = tid & 63, wave = __builtin_amdgcn_readfirstlane(tid >> 6);
    const int G = gridDim.x, bx = blockIdx.x;
    const int vcu = (G % 8 == 0) ? (bx % 8) * (G / 8) + bx / 8 : bx;
    const int gw = vcu * 8 + wave, NGW = G * 8;
    cg::grid_group grid = cg::this_grid();
#define IN(k) (p.ph_lo <= (k) && (k) < p.ph_hi)
#define SEAM(k) do { if (IN(k) && IN((k) + 1)) { __builtin_amdgcn_fence(__ATOMIC_RELEASE, "agent"); asm volatile("s_waitcnt vmcnt(0)" ::: "memory"); grid.sync(); __builtin_amdgcn_fence(__ATOMIC_ACQUIRE, "agent"); } } while (0)
    bf16_t* Wt_in = (bf16_t*)(p.ws + WS_WIN); bf16_t* Wt_br = (bf16_t*)(p.ws + WS_WBR); bf16_t* Wt_out = (bf16_t*)(p.ws + WS_WOUT);
    bf16_t* Wt_gu = (bf16_t*)(p.ws + WS_WGU); bf16_t* Wt_dn = (bf16_t*)(p.ws + WS_WDN); bf16_t* XN = (bf16_t*)(p.ws + WS_XN);
    bf16_t* QKVU = (bf16_t*)(p.ws + WS_QKVU); bf16_t* GATE = (bf16_t*)(p.ws + WS_GATE); bf16_t* AO = (bf16_t*)(p.ws + WS_AO);
    bf16_t* MERGED = (bf16_t*)(p.ws + WS_MERGED); bf16_t* HID = (bf16_t*)(p.ws + WS_HID); float* SSQ = (float*)(p.ws + WS_SSQ);
    float* Y = p.out + OFF_Y;

    if (IN(0)) { phase0(p, lds, gw, NGW, wave, lane); }
    SEAM(0);
    if (IN(1)) { pg8::Gemm g{XN, Wt_in, D, D, MT, NIN, D}; pg8::StaticOrder S; S.init(MT, NIN, G, bx); EpiIn E{QKVU, GATE, p.out}; pg8::gemm_phase(lds, g, S, E); }
    SEAM(1);
    if (IN(2)) {
        LAS unsigned char* vl = lds + wave * (32 * VROW);
#ifndef SKIP_ATTN
        for (int u = gw; u < 64 + 4096; u += NGW) attn_unit(p, vl, __builtin_amdgcn_readfirstlane(u), lane);
#else
        for (int it = gw * 64 + lane; it < MV * 128; it += NGW * 64) *(u32x4*)(AO + (size_t)(it >> 7) * 2048 + 1024 + (it & 127) * 8) = (u32x4){0u, 0u, 0u, 0u};
#endif
        diff_items(p, (NGW - 1 - gw) * 64 + lane, NGW * 64);
    }
    SEAM(2);
    if (IN(3)) {
        { pg8::Gemm g{AO, Wt_br, 2048, 2048, MT, D, 1024}; pg8::StaticOrder S; S.init(MT, D, G, bx); EpiBrA E{GATE, Y}; pg8::gemm_phase(lds, g, S, E); }
        { pg8::Gemm g{AO + 1024, Wt_br + 1024, 2048, 2048, MT, D, 1024}; pg8::StaticOrder S; S.init(MT, D, G, bx); EpiBrB E{GATE, Y, MERGED}; pg8::gemm_phase(lds, g, S, E); }
    }
    SEAM(3);
    if (IN(4)) { pg8::Gemm g{MERGED, Wt_out, D, D, MT, D, D}; pg8::StaticOrder S; S.init(MT, D, G, bx); EpiOut E{p.x_prompt, p.x_sample, Y, XN, SSQ}; pg8::gemm_phase(lds, g, S, E); }
    SEAM(4);
    if (IN(5)) { pg8::Gemm g{XN, Wt_gu, D, D, MT, NGU, D}; pg8::StaticOrder S; S.init(MT, NGU, G, bx); EpiGU E{SSQ, HID}; pg8::gemm_phase(lds, g, S, E); }
    SEAM(5);
    if (IN(6)) { pg8::Gemm g{HID, Wt_dn, FF, FF, MT, D, FF}; pg8::StaticOrder S; S.init(MT, D, G, bx); EpiDown E{Y}; pg8::gemm_phase(lds, g, S, E); }
    SEAM(6);
    if (IN(7)) {
        for (int m = gw; m < MV; m += NGW) {
            f32x4* yr = (f32x4*)(Y + (size_t)m * D) + lane; const f32x4* gf = (const f32x4*)p.g_final + lane;
            f32x4 v[8]; float s = 0.f;
#pragma unroll
            for (int j = 0; j < 8; ++j) { v[j] = yr[64 * j]; s += (v[j].x * v[j].x + v[j].y * v[j].y) + (v[j].z * v[j].z + v[j].w * v[j].w); }
            const float rs = __builtin_amdgcn_rsqf(wave_sum(s) * (1.0f / D) + EPS);
#pragma unroll
            for (int j = 0; j < 8; ++j) yr[64 * j] = v[j] * rs * gf[64 * j];
        }
    }
#undef IN
#undef SEAM
}

extern "C" void kernel_launch(void* const* d_in, const int* in_sizes, int n_in, void* d_out, int out_size, void* d_ws, size_t ws_size, hipStream_t stream) {
    static int grid = 0;
    if (grid == 0) {
        if (n_in != 15 || (size_t)out_size != OUT_TOTAL || ws_size < WS_END) { fprintf(stderr, "kernel_launch: unexpected shapes: n_in %d out %d ws %zu\n", n_in, out_size, ws_size); grid = -1; return; }
        int dev = 0, cus = 0, per_cu = 0;
        hipGetDevice(&dev); hipDeviceGetAttribute(&cus, hipDeviceAttributeMultiprocessorCount, dev);
        hipFuncSetAttribute((const void*)fwd_megakernel, hipFuncAttributeMaxDynamicSharedMemorySize, LDS_BYTES);
        hipOccupancyMaxActiveBlocksPerMultiprocessor(&per_cu, (const void*)fwd_megakernel, 512, LDS_BYTES);
        if (per_cu < 1) { fprintf(stderr, "kernel_launch: occupancy query says %d blocks per CU\n", per_cu); per_cu = 1; }
        (void)hipGetLastError();
        grid = cus;
    }
    if (grid < 0) return;
    Params p{};
    const float** pp = (const float**)&p;
    for (int i = 0; i < 15; ++i) pp[i] = (const float*)d_in[i];
    p.out = (float*)d_out; p.ws = (unsigned char*)d_ws;
#if N_LAUNCH_MODE == 1
    p.ph_lo = 0; p.ph_hi = 8;
    void* args[] = {&p};
    hipError_t e = hipLaunchCooperativeKernel((const void*)fwd_megakernel, dim3(grid), dim3(512), args, LDS_BYTES, stream);
    if (e != hipSuccess) fprintf(stderr, "cooperative launch failed: %s (grid %d)\n", hipGetErrorString(e), grid);
#else
    for (int ph = 0; ph < 8; ++ph) { p.ph_lo = ph; p.ph_hi = ph + 1; hipLaunchKernelGGL(fwd_megakernel, dim3(grid), dim3(512), LDS_BYTES, stream, p); }
#endif
}
```

```cpp
#include <hip/hip_runtime.h>
#include <hip/hip_cooperative_groups.h>
#include <cstdio>
#include <cstdint>
namespace cg = cooperative_groups;

#ifndef N_LAUNCH_MODE
#define N_LAUNCH_MODE 1
#endif

#define LAS __attribute__((address_space(3)))
typedef unsigned short bf16_t;
typedef short bf16x8 __attribute__((ext_vector_type(8)));
typedef short s16x4 __attribute__((ext_vector_type(4)));
typedef float f32x4 __attribute__((ext_vector_type(4)));
typedef float f32x16 __attribute__((ext_vector_type(16)));
typedef unsigned u32x4 __attribute__((ext_vector_type(4)));
typedef unsigned u32x2 __attribute__((ext_vector_type(2)));

constexpr int D = 2048, MP = 16384, MS = 128, MV = MP + MS, MT = 16640;
constexpr int SEQ = 4096, DSEQ = 16, PAST = 4096, NH = 8, HD = 128;
constexpr int NIN = 8192, FF = 5632, NGU = 2 * FF, AW = 1024;
constexpr float EPS = 1e-6f;
constexpr size_t OFF_Y = 0, OFF_KP = (size_t)MV * D, OFF_VP = OFF_KP + (size_t)MP * 1024, OFF_PP = OFF_VP + (size_t)MP * 1024,
                 OFF_KS = OFF_PP + 4 * 15 * 1024, OFF_VS = OFF_KS + (size_t)MS * 1024, OFF_PS = OFF_VS + (size_t)MS * 1024, OUT_TOTAL = OFF_PS + 8 * 15 * 1024;
constexpr size_t MiB = 1u << 20;
constexpr size_t WS_SSQ = 0, WS_WIN = 1 * MiB, WS_WBR = 33 * MiB, WS_WOUT = 41 * MiB, WS_WGU = 49 * MiB, WS_WDN = 93 * MiB, WS_XN = 115 * MiB,
                 WS_QKVU = 180 * MiB, WS_GATE = 310 * MiB, WS_AO = 440 * MiB, WS_TMPA = 505 * MiB, WS_WPB = 509 * MiB, WS_END = 510 * MiB;
constexpr size_t WS_MERGED = WS_QKVU;
constexpr size_t WS_HID = WS_QKVU;
static_assert((size_t)MT * FF * 2 <= WS_AO - WS_QKVU, "hid overlay");
constexpr int LDS_BYTES = 147456;

typedef __bf16 bf16x2_t __attribute__((ext_vector_type(2)));
typedef float f32x2_t __attribute__((ext_vector_type(2)));
__device__ __forceinline__ unsigned cvt_pk_bf16(float lo, float hi) { const f32x2_t v = {lo, hi}; return __builtin_bit_cast(unsigned, __builtin_convertvector(v, bf16x2_t)); }
__device__ __forceinline__ float bf2f(unsigned short b) { return __uint_as_float(((unsigned)b) << 16); }
__device__ __forceinline__ float bflo(unsigned w) { return __uint_as_float(w << 16); }
__device__ __forceinline__ float bfhi(unsigned w) { return __uint_as_float(w & 0xffff0000u); }
__device__ __forceinline__ float fast_sigmoid(float x) { return __builtin_amdgcn_rcpf(1.0f + __expf(-x)); }
__device__ __forceinline__ float wave_sum(float v) {
#pragma unroll
    for (int o = 1; o < 64; o <<= 1) v += __shfl_xor(v, o);
    return v;
}

namespace pg8 {
constexpr int BM = 256, BK = 64, HALF = 128, HTB = HALF * BK * 2, STAGE_BYTES = 8 * HTB, NXCD = 8, WGM = 8;
__host__ __device__ __forceinline__ int lds_byte(int r, int c) { const int st = (r >> 4) * 2 + (c >> 5), rr = r & 15, cc = c & 31, ob = rr * 64 + cc * 2; return st * 1024 + (ob ^ (((ob >> 9) & 1) << 5)); }
__host__ __device__ __forceinline__ void stage_rc(int b, int& R, int& C) { const int st = b / 1024, sb = b % 1024, swz = sb ^ (((sb >> 9) & 1) << 5); R = (st >> 1) * 16 + swz / 64; C = (st & 1) * 32 + (swz % 64) / 2; }
__host__ __device__ __forceinline__ int perm32(int rho) { const int n = rho >> 4, i = rho & 15; return 8 * (i >> 2) + 4 * n + (i & 3); }

struct Unit { int pm, pn, kt0, nkt, half; };
struct Gemm { const bf16_t* A; const bf16_t* Bt; int lda, ldb, M, N, K; };

struct StaticOrder {
    int nM, nN, nwg, G, c, ktfull, pmS, nS, ktS;
    __device__ void init(int nM_, int nN_, int ktfull_, int G_, int c_, int pmS_ = 0, int ksplit = 0) { nM = nM_; nN = nN_; nwg = nM * nN; G = G_; c = c_; ktfull = ktfull_; pmS = pmS_; nS = nN * ksplit; ktS = ksplit ? ktfull / ksplit : 0; }
    __device__ bool next(int i, Unit& u) const {
        const int L = i * G + c;
        if (L >= nwg) { const int t = L - nwg;
            if (t >= nS) return false;
            u.pm = pmS; u.pn = t % nN; u.kt0 = (t / nN) * ktS; u.nkt = ktS; u.half = 1; return true; }
        int wgid = L; { const int q = nwg / NXCD, r = nwg % NXCD, xcd = wgid % NXCD, off = wgid / NXCD; wgid = (xcd < r ? xcd * (q + 1) : r * (q + 1) + (xcd - r) * q) + off; }
        const int nig = WGM * nN, gid = wgid / nig, fm = gid * WGM, gsz = (nM - fm) < WGM ? (nM - fm) : WGM;
        u.pm = fm + ((wgid % nig) % gsz); u.pn = (wgid % nig) / gsz; u.kt0 = 0; u.nkt = ktfull; u.half = 0; return true;
    }
};

template <class Epi>
__device__ __forceinline__ void gemm_phase(LAS unsigned char* lds, const Gemm g, const StaticOrder& S, const Epi& E) {
    const int tid = threadIdx.x, wid = __builtin_amdgcn_readfirstlane(tid >> 6), lane = tid & 63, wr = wid >> 2, wc = wid & 3, fr = lane & 15, fq = lane >> 4;
    unsigned voffA[2], voffB[2];
#pragma unroll
    for (int i = 0; i < 2; ++i) { int R, C; stage_rc(tid * 16 + i * 8192, R, C); const int Rb = (R & ~31) + perm32(R & 31);
        voffA[i] = (unsigned)(R * g.lda + C) * 2u; voffB[i] = (unsigned)(Rb * g.ldb + C) * 2u; }
    const size_t kstep = (size_t)(BK * 2);
    const size_t hstepA = (size_t)HALF * g.lda * 2, hstepB = (size_t)HALF * g.ldb * 2;
    const size_t tstepA = 2 * hstepA, tstepB = 2 * hstepB;
    const unsigned ldsw = (unsigned)wid * 1024u;
    const int aoff = lds_byte(wr * 64 + fr, fq * 8), boff = lds_byte(wc * 32 + fr, fq * 8);
#define PG8_SA(b, h) (((b) * 2 + (h)) * HTB)
#define PG8_SB(b, h) ((4 + (b) * 2 + (h)) * HTB)
#define PG8_STAGE(bufoff, gbase, voff) do { _Pragma("unroll") for (int _i = 0; _i < 2; ++_i) \
        __builtin_amdgcn_global_load_lds((const unsigned*)((const char*)(gbase) + (voff)[_i]), (LAS unsigned*)(lds + (bufoff) + ldsw + _i * 8192), 16, 0, 0); } while (0)
#define PG8_LDA(dst, b, h) do { _Pragma("unroll") for (int m = 0; m < 4; ++m) _Pragma("unroll") for (int k = 0; k < 2; ++k) dst[m][k] = *(const LAS bf16x8*)(lds + PG8_SA(b, h) + aoff + m * 2048 + k * 1024); } while (0)
#define PG8_LDB(dst, b, h) do { _Pragma("unroll") for (int n = 0; n < 2; ++n) _Pragma("unroll") for (int k = 0; k < 2; ++k) dst[n][k] = *(const LAS bf16x8*)(lds + PG8_SB(b, h) + boff + n * 2048 + k * 1024); } while (0)
#define PG8_MMA(ai, bj, At, Bt) do { __builtin_amdgcn_s_setprio(1); _Pragma("unroll") for (int m = 0; m < 4; ++m) _Pragma("unroll") for (int n = 0; n < 2; ++n) _Pragma("unroll") for (int k = 0; k < 2; ++k) \
        acc[ai][bj][m][n] = __builtin_amdgcn_mfma_f32_16x16x32_bf16(Bt[n][k], At[m][k], acc[ai][bj][m][n], 0, 0, 0); __builtin_amdgcn_s_setprio(0); } while (0)
#define PG8_WAIT_V(n) asm volatile("s_waitcnt vmcnt(" #n ")" ::: "memory")
#define PG8_WAIT_L(n) asm volatile("s_waitcnt lgkmcnt(" #n ")" ::: "memory")
#define PG8_BAR __builtin_amdgcn_s_barrier()
#define PG8_SCHED __builtin_amdgcn_sched_barrier(0)
    Unit cur, nxt; int ui = 0;
    if (!S.next(0, cur)) return;
    f32x4 acc[2][2][4][2];
#pragma unroll
    for (int a = 0; a < 2; ++a)
#pragma unroll
        for (int b = 0; b < 2; ++b)
#pragma unroll
            for (int m = 0; m < 4; ++m)
#pragma unroll
                for (int n = 0; n < 2; ++n) acc[a][b][m][n] = (f32x4){0.f, 0.f, 0.f, 0.f};
    bf16x8 At[4][2], B0[2][2], B1[2][2];
    const char* cA = (const char*)g.A + (size_t)cur.pm * tstepA + (size_t)cur.kt0 * kstep; const char* cB = (const char*)g.Bt + (size_t)cur.pn * tstepB + (size_t)cur.kt0 * kstep;
    PG8_STAGE(PG8_SB(0, 0), cB, voffB); PG8_STAGE(PG8_SB(0, 1), cB + hstepB, voffB); PG8_STAGE(PG8_SA(0, 0), cA, voffA); PG8_STAGE(PG8_SA(0, 1), cA + hstepA, voffA);
    if (wr == 1) PG8_BAR;
    PG8_WAIT_V(2); PG8_BAR;
    PG8_STAGE(PG8_SB(1, 0), cB + kstep, voffB); PG8_STAGE(PG8_SA(1, 0), cA + kstep, voffA); PG8_STAGE(PG8_SB(1, 1), cB + hstepB + kstep, voffB);
    PG8_WAIT_V(6); PG8_BAR;
    for (;;) {
        const bool has_next = S.next(ui + 1, nxt);
        const char* nA = has_next ? (const char*)g.A + (size_t)nxt.pm * tstepA + (size_t)nxt.kt0 * kstep : cA; const char* nB = has_next ? (const char*)g.Bt + (size_t)nxt.pn * tstepB + (size_t)nxt.kt0 * kstep : cB;
        const int nt = cur.nkt; const bool full = !cur.half;
        for (int t = 0; t < nt; t += 2) {
            const bool last = (t == nt - 2);
            const char* a1 = cA + (size_t)(t + 1) * kstep;
            const char* a2 = last ? nA : cA + (size_t)(t + 2) * kstep; const char* b2 = last ? nB : cB + (size_t)(t + 2) * kstep;
            const char* a3 = a2 + kstep; const char* b3 = b2 + kstep;
            PG8_LDB(B0, 0, 0); PG8_LDB(B1, 0, 1); PG8_SCHED; PG8_LDA(At, 0, 0); PG8_STAGE(PG8_SA(1, 1), a1 + hstepA, voffA);
            PG8_WAIT_V(8); PG8_WAIT_L(0); PG8_BAR; PG8_MMA(0, 0, At, B0); PG8_MMA(0, 1, At, B1); PG8_BAR; PG8_SCHED;
            if (full) PG8_LDA(At, 0, 1); PG8_STAGE(PG8_SB(0, 0), b2, voffB); PG8_STAGE(PG8_SB(0, 1), b2 + hstepB, voffB); PG8_STAGE(PG8_SA(0, 0), a2, voffA);
            PG8_WAIT_V(8); PG8_WAIT_L(0); PG8_BAR; if (full) { PG8_MMA(1, 0, At, B0); PG8_MMA(1, 1, At, B1); } PG8_BAR; PG8_SCHED;
            PG8_LDB(B0, 1, 0); PG8_LDB(B1, 1, 1); PG8_SCHED; PG8_LDA(At, 1, 0); PG8_STAGE(PG8_SA(0, 1), a2 + hstepA, voffA);
            PG8_WAIT_V(8); PG8_WAIT_L(0); PG8_BAR; PG8_MMA(0, 0, At, B0); PG8_MMA(0, 1, At, B1); PG8_BAR; PG8_SCHED;
            if (full) PG8_LDA(At, 1, 1); PG8_STAGE(PG8_SB(1, 0), b3, voffB); PG8_STAGE(PG8_SB(1, 1), b3 + hstepB, voffB); PG8_STAGE(PG8_SA(1, 0), a3, voffA);
            PG8_WAIT_V(8); PG8_WAIT_L(0); PG8_BAR; if (full) { PG8_MMA(1, 0, At, B0); PG8_MMA(1, 1, At, B1); } PG8_BAR; PG8_SCHED;
        }
        if (wr == 0) PG8_BAR;
        E(acc, cur, wr, wc, fr, fq);
        if (!has_next) break;
#pragma unroll
        for (int a = 0; a < 2; ++a)
#pragma unroll
            for (int b = 0; b < 2; ++b)
#pragma unroll
                for (int m = 0; m < 4; ++m)
#pragma unroll
                    for (int n = 0; n < 2; ++n) acc[a][b][m][n] = (f32x4){0.f, 0.f, 0.f, 0.f};
        cur = nxt; cA = nA; cB = nB; ++ui;
        if (wr == 1) PG8_BAR;
    }
    PG8_WAIT_V(0);
    PG8_BAR;
#undef PG8_SA
#undef PG8_SB
#undef PG8_STAGE
#undef PG8_LDA
#undef PG8_LDB
#undef PG8_MMA
#undef PG8_WAIT_V
#undef PG8_WAIT_L
#undef PG8_BAR
#undef PG8_SCHED
}
}
using pg8::Unit;

__device__ __forceinline__ u32x4 pack8(const f32x4& v0, const f32x4& v1) {
    u32x4 w; w.x = cvt_pk_bf16(v0[0], v0[1]); w.y = cvt_pk_bf16(v0[2], v0[3]); w.z = cvt_pk_bf16(v1[0], v1[1]); w.w = cvt_pk_bf16(v1[2], v1[3]); return w;
}
__device__ __forceinline__ void unpack8(const u32x4& w, f32x4& v0, f32x4& v1) {
    v0 = (f32x4){bflo(w.x), bfhi(w.x), bflo(w.y), bfhi(w.y)}; v1 = (f32x4){bflo(w.z), bfhi(w.z), bflo(w.w), bfhi(w.w)};
}

struct EpiIn {
    bf16_t* qkvu; bf16_t* gate; float* out;
    __device__ __forceinline__ void operator()(const f32x4 (&acc)[2][2][4][2], const Unit& u, int wr, int wc, int fr, int fq) const {
        const int row0 = u.pm * 256 + wr * 64 + fr, cw = wc * 32 + 8 * fq;
        if (u.pn >= 16) {
            bf16_t* base = gate + (size_t)row0 * 4096 + (u.pn - 16) * 256 + cw;
#pragma unroll
            for (int ai = 0; ai < 2; ++ai)
#pragma unroll
                for (int m = 0; m < 4; ++m) { bf16_t* rowp = base + (size_t)(ai * 128 + m * 16) * 4096;
#pragma unroll
                    for (int bj = 0; bj < 2; ++bj) { f32x4 v0 = acc[ai][bj][m][0], v1 = acc[ai][bj][m][1];
#pragma unroll
                        for (int j = 0; j < 4; ++j) { v0[j] = fast_sigmoid(v0[j]); v1[j] = fast_sigmoid(v1[j]); }
                        *(u32x4*)(rowp + bj * 128) = pack8(v0, v1); } }
        } else {
            const int sec = u.pn >> 2, cc = (u.pn & 3) * 256 + cw;
            bf16_t* base = qkvu + (size_t)sec * MT * 1024 + (size_t)row0 * 1024 + cc;
#pragma unroll
            for (int ai = 0; ai < 2; ++ai)
#pragma unroll
                for (int m = 0; m < 4; ++m) { bf16_t* rowp = base + (size_t)(ai * 128 + m * 16) * 1024;
#pragma unroll
                    for (int bj = 0; bj < 2; ++bj) *(u32x4*)(rowp + bj * 128) = pack8(acc[ai][bj][m][0], acc[ai][bj][m][1]); }
            if (sec >= 2) {
                const size_t offp = (sec == 2) ? OFF_KP : OFF_VP, offs = (sec == 2) ? OFF_KS : OFF_VS;
#pragma unroll
                for (int ai = 0; ai < 2; ++ai)
#pragma unroll
                    for (int m = 0; m < 4; ++m) { const int row = row0 + ai * 128 + m * 16;
                        if (row < MV) { float* o = out + (row < MP ? offp + (size_t)row * 1024 : offs + (size_t)(row - MP) * 1024) + cc;
#pragma unroll
                            for (int bj = 0; bj < 2; ++bj) { *(f32x4*)(o + bj * 128) = acc[ai][bj][m][0]; *(f32x4*)(o + bj * 128 + 4) = acc[ai][bj][m][1]; } } }
            } else if (sec == 0 && ((u.pm & 15) == 15 || u.pm == 64)) {
#pragma unroll
                for (int ai = 0; ai < 2; ++ai)
#pragma unroll
                    for (int m = 0; m < 4; ++m) { const int row = row0 + ai * 128 + m * 16; long off = -1;
                        if (row < MP) { const int t = row & (SEQ - 1); if (t >= SEQ - 15) off = (long)OFF_PP + ((long)(row >> 12) * 15 + (t - (SEQ - 15))) * 1024; }
                        else if (row < MV) { const int t = (row - MP) & 15, b = (row - MP) >> 4; if (t >= 1) off = (long)OFF_PS + ((long)b * 15 + (t - 1)) * 1024; }
                        if (off >= 0) { float* o = out + off + cc;
#pragma unroll
                            for (int bj = 0; bj < 2; ++bj) { *(f32x4*)(o + bj * 128) = acc[ai][bj][m][0]; *(f32x4*)(o + bj * 128 + 4) = acc[ai][bj][m][1]; } } }
            }
        }
    }
};
struct EpiBrA {
    const bf16_t* gate; float* tmp;
    __device__ __forceinline__ void operator()(const f32x4 (&acc)[2][2][4][2], const Unit& u, int wr, int wc, int fr, int fq) const {
        const int row0 = u.pm * 256 + wr * 64 + fr, cc = u.pn * 256 + wc * 32 + 8 * fq;
#pragma unroll
        for (int ai = 0; ai < 2; ++ai)
#pragma unroll
            for (int m = 0; m < 4; ++m) { const int row = row0 + ai * 128 + m * 16;
                if (row < MV) { const bf16_t* gp = gate + (size_t)row * 4096 + cc; float* o = tmp + (size_t)row * D + cc;
#pragma unroll
                    for (int bj = 0; bj < 2; ++bj) { const u32x4 gw = *(const u32x4*)(gp + bj * 128); f32x4 g0, g1; unpack8(gw, g0, g1);
                        *(f32x4*)(o + bj * 128) = acc[ai][bj][m][0] * g0; *(f32x4*)(o + bj * 128 + 4) = acc[ai][bj][m][1] * g1; } } }
    }
};
struct EpiBrB {
    const bf16_t* gate; const float* tmp; bf16_t* merged;
    __device__ __forceinline__ void operator()(const f32x4 (&acc)[2][2][4][2], const Unit& u, int wr, int wc, int fr, int fq) const {
        const int row0 = u.pm * 256 + wr * 64 + fr, cc = u.pn * 256 + wc * 32 + 8 * fq;
#pragma unroll
        for (int ai = 0; ai < 2; ++ai)
#pragma unroll
            for (int m = 0; m < 4; ++m) { const int row = row0 + ai * 128 + m * 16;
                const bf16_t* gp = gate + (size_t)row * 4096 + 2048 + cc; const float* tp = tmp + (size_t)row * D + cc; bf16_t* o = merged + (size_t)row * D + cc;
#pragma unroll
                for (int bj = 0; bj < 2; ++bj) { const u32x4 gw = *(const u32x4*)(gp + bj * 128); f32x4 g0, g1; unpack8(gw, g0, g1);
                    f32x4 t0 = (f32x4){0.f, 0.f, 0.f, 0.f}, t1 = t0;
                    if (row < MV) { t0 = *(const f32x4*)(tp + bj * 128); t1 = *(const f32x4*)(tp + bj * 128 + 4); }
                    *(u32x4*)(o + bj * 128) = pack8(t0 + acc[ai][bj][m][0] * g0, t1 + acc[ai][bj][m][1] * g1); } }
    }
};
struct EpiOut {
    const float* xp; const float* xs; float* y; bf16_t* hb; float* ssq;
    __device__ __forceinline__ void operator()(const f32x4 (&acc)[2][2][4][2], const Unit& u, int wr, int wc, int fr, int fq) const {
        const int row0 = u.pm * 256 + wr * 64 + fr, cc = u.pn * 256 + wc * 32 + 8 * fq;
#pragma unroll
        for (int ai = 0; ai < 2; ++ai)
#pragma unroll
            for (int m = 0; m < 4; ++m) { const int row = row0 + ai * 128 + m * 16; const bool ok = row < MV;
                const float* xr = (row < MP ? xp + (size_t)row * D : xs + (size_t)(row - MP) * D) + cc; float* o = y + (size_t)row * D + cc; bf16_t* ob = hb + (size_t)row * D + cc;
                float s = 0.f;
#pragma unroll
                for (int bj = 0; bj < 2; ++bj) { f32x4 h0 = acc[ai][bj][m][0], h1 = acc[ai][bj][m][1];
                    if (ok) { h0 += *(const f32x4*)(xr + bj * 128); h1 += *(const f32x4*)(xr + bj * 128 + 4); *(f32x4*)(o + bj * 128) = h0; *(f32x4*)(o + bj * 128 + 4) = h1; }
                    *(u32x4*)(ob + bj * 128) = pack8(h0, h1);
                    s += (h0[0] * h0[0] + h0[1] * h0[1]) + (h0[2] * h0[2] + h0[3] * h0[3]) + (h1[0] * h1[0] + h1[1] * h1[1]) + (h1[2] * h1[2] + h1[3] * h1[3]); }
                s += __shfl_xor(s, 16); s += __shfl_xor(s, 32);
                if (fq == 0) atomicAdd(ssq + row, s); }
    }
};
struct EpiGU {
    const float* ssq; bf16_t* hid;
    __device__ __forceinline__ void operator()(const f32x4 (&acc)[2][2][4][2], const Unit& u, int wr, int wc, int fr, int fq) const {
        const int row0 = u.pm * 256 + wr * 64 + fr, cc = u.pn * 128 + wc * 32 + 8 * fq;
#pragma unroll
        for (int ai = 0; ai < 2; ++ai)
#pragma unroll
            for (int m = 0; m < 4; ++m) { const int row = row0 + ai * 128 + m * 16;
                const float sc = __builtin_amdgcn_rsqf(ssq[row] * (1.0f / D) + EPS);
                f32x4 r0, r1;
#pragma unroll
                for (int j = 0; j < 4; ++j) { const float g0 = acc[ai][0][m][0][j] * sc, u0 = acc[ai][1][m][0][j] * sc, g1 = acc[ai][0][m][1][j] * sc, u1 = acc[ai][1][m][1][j] * sc;
                    r0[j] = g0 * fast_sigmoid(g0) * u0; r1[j] = g1 * fast_sigmoid(g1) * u1; }
                *(u32x4*)(hid + (size_t)row * FF + cc) = pack8(r0, r1); }
    }
};
struct EpiDown {
    float* y;
    __device__ __forceinline__ void operator()(const f32x4 (&acc)[2][2][4][2], const Unit& u, int wr, int wc, int fr, int fq) const {
        const int row0 = u.pm * 256 + wr * 64 + fr, cc = u.pn * 256 + wc * 32 + 8 * fq;
#pragma unroll
        for (int ai = 0; ai < 2; ++ai)
#pragma unroll
            for (int m = 0; m < 4; ++m) { const int row = row0 + ai * 128 + m * 16;
                if (row < MV) { float* o = y + (size_t)row * D + cc;
                    if (u.half) {
#pragma unroll
                        for (int bj = 0; bj < 2; ++bj)
#pragma unroll
                            for (int n = 0; n < 2; ++n)
#pragma unroll
                                for (int j = 0; j < 4; ++j) __hip_atomic_fetch_add(o + bj * 128 + 4 * n + j, acc[ai][bj][m][n][j], __ATOMIC_RELAXED, __HIP_MEMORY_SCOPE_AGENT);
                    } else {
#pragma unroll
                    for (int bj = 0; bj < 2; ++bj) { *(f32x4*)(o + bj * 128) = *(const f32x4*)(o + bj * 128) + acc[ai][bj][m][0]; *(f32x4*)(o + bj * 128 + 4) = *(const f32x4*)(o + bj * 128 + 4) + acc[ai][bj][m][1]; } } } }
    }
};

struct EpiWA {
    bf16_t* dst;
    __device__ __forceinline__ void operator()(const f32x4 (&acc)[2][2][4][2], const Unit& u, int wr, int wc, int fr, int fq) const {
        const int row0 = u.pm * 256 + wr * 64 + fr, cc = wc * 32 + 8 * fq;
#pragma unroll
        for (int ai = 0; ai < 2; ++ai)
#pragma unroll
            for (int m = 0; m < 4; ++m) { bf16_t* o = dst + (size_t)(row0 + ai * 128 + m * 16) * 2048 + cc;
#pragma unroll
                for (int bj = 0; bj < 2; ++bj) *(u32x4*)(o + bj * 128) = pack8(acc[ai][bj][m][0], acc[ai][bj][m][1]); }
    }
};

__device__ __forceinline__ void p0_item(const float* W, int N, int k0, int n0, const float* gsc, bf16_t* dst, int ldd, int drow0, int dcol0, LAS float* scr, int lane) {
    const float* wp = W + (size_t)k0 * N + n0 + lane;
    float v[64];
#pragma unroll
    for (int i = 0; i < 64; ++i) v[i] = wp[(size_t)i * N];
    if (gsc) {
#pragma unroll
        for (int i = 0; i < 64; ++i) v[i] *= gsc[k0 + i]; }
#pragma unroll
    for (int i = 0; i < 64; ++i) scr[i * 65 + lane] = v[i];
    asm volatile("s_waitcnt lgkmcnt(0)" ::: "memory");
    const int c = lane & 7;
#pragma unroll
    for (int j = 0; j < 8; ++j) { const int n = (lane >> 3) + 8 * j; const LAS float* s = scr + (8 * c) * 65 + n;
        u32x4 o; o.x = cvt_pk_bf16(s[0 * 65], s[1 * 65]); o.y = cvt_pk_bf16(s[2 * 65], s[3 * 65]); o.z = cvt_pk_bf16(s[4 * 65], s[5 * 65]); o.w = cvt_pk_bf16(s[6 * 65], s[7 * 65]);
        *(u32x4*)(dst + (size_t)(drow0 + n) * ldd + dcol0 + k0 + 8 * c) = o; }
    asm volatile("s_waitcnt lgkmcnt(0)" ::: "memory");
}

struct Params {
    const float *x_prompt, *x_sample, *cache_k, *cache_v, *state_pool, *g_mix, *w_in, *w_pool, *s_pool, *w_branch, *w_out, *g_ffn, *w_gate_up, *w_down, *g_final;
    float* out; unsigned char* ws; int ph_lo, ph_hi;
};

__device__ __forceinline__ void phase0(const Params& p, LAS unsigned char* lds, int gw, int NGW, int wave, int lane) {
    LAS float* scr = (LAS float*)(lds + wave * 16640);
    bf16_t* Wt_in = (bf16_t*)(p.ws + WS_WIN); bf16_t* Wt_br = (bf16_t*)(p.ws + WS_WBR); bf16_t* Wt_out = (bf16_t*)(p.ws + WS_WOUT);
    bf16_t* Wt_gu = (bf16_t*)(p.ws + WS_WGU); bf16_t* Wt_dn = (bf16_t*)(p.ws + WS_WDN); bf16_t* XN = (bf16_t*)(p.ws + WS_XN);
    bf16_t* TMPA = (bf16_t*)(p.ws + WS_TMPA); bf16_t* WPB = (bf16_t*)(p.ws + WS_WPB);
    constexpr int I_IN = (D / 64) * (NIN / 64), I_BR = (D / 64) * (D / 64), I_OUT = (D / 64) * (D / 64), I_GU = (D / 64) * (NGU / 64), I_DN = (FF / 64) * (D / 64);
    constexpr int NITEMS = I_IN + I_BR + I_OUT + I_GU + I_DN;
    for (int it = gw; it < NITEMS; it += NGW) {
        int r = it;
        if (r < I_IN) { const int nb = NIN / 64; p0_item(p.w_in, NIN, 64 * (r / nb), 64 * (r % nb), p.g_mix, Wt_in, D, 64 * (r % nb), 0, scr, lane); continue; } r -= I_IN;
        if (r < I_BR) { const int nb = D / 64; const int k0 = 64 * (r / nb), n0 = 64 * (r % nb);
            if (k0 < 1024) p0_item(p.w_branch, D, k0, n0, p.s_pool, TMPA, 1024, n0, 0, scr, lane);
            else p0_item(p.w_branch, D, k0, n0, nullptr, Wt_br, 2048, n0, 0, scr, lane);
            continue; } r -= I_BR;
        if (r < I_OUT) { const int nb = D / 64; p0_item(p.w_out, D, 64 * (r / nb), 64 * (r % nb), nullptr, Wt_out, D, 64 * (r % nb), 0, scr, lane); continue; } r -= I_OUT;
        if (r < I_GU) { const int nb = NGU / 64; const int n0 = 64 * (r % nb); const int drow = n0 < FF ? (n0 / 128) * 256 + (n0 % 128) : ((n0 - FF) / 128) * 256 + 128 + ((n0 - FF) % 128);
            p0_item(p.w_gate_up, NGU, 64 * (r / nb), n0, p.g_ffn, Wt_gu, D, drow, 0, scr, lane); continue; } r -= I_GU;
        { const int nb = D / 64; p0_item(p.w_down, D, 64 * (r / nb), 64 * (r % nb), nullptr, Wt_dn, FF, 64 * (r % nb), 0, scr, lane); }
    }
    for (int i = gw * 64 + lane; i < 4 * 256 * 256 / 8; i += NGW * 64) { const f32x4 a = *(const f32x4*)(p.w_pool + (size_t)i * 8), b = *(const f32x4*)(p.w_pool + (size_t)i * 8 + 4); *(u32x4*)(WPB + (size_t)i * 8) = pack8(a, b); }
    for (int m = gw; m < MT; m += NGW) {
        u32x2* o8 = (u32x2*)(XN + (size_t)m * D) + lane;
        if (m >= MV) {
#pragma unroll
            for (int j = 0; j < 8; ++j) o8[64 * j] = (u32x2){0u, 0u};
            continue; }
        const f32x4* xr = (const f32x4*)(m < MP ? p.x_prompt + (size_t)m * D : p.x_sample + (size_t)(m - MP) * D) + lane;
        f32x4 v[8]; float s = 0.f;
#pragma unroll
        for (int j = 0; j < 8; ++j) { v[j] = xr[64 * j]; s += (v[j].x * v[j].x + v[j].y * v[j].y) + (v[j].z * v[j].z + v[j].w * v[j].w); }
        const float rs = __builtin_amdgcn_rsqf(wave_sum(s) * (1.0f / D) + EPS);
#pragma unroll
        for (int j = 0; j < 8; ++j) o8[64 * j] = (u32x2){cvt_pk_bf16(v[j].x * rs, v[j].y * rs), cvt_pk_bf16(v[j].z * rs, v[j].w * rs)};
    }
    float* ssq = (float*)(p.ws + WS_SSQ);
    for (int i = gw * 64 + lane; i < MT; i += NGW * 64) ssq[i] = 0.f;
}

constexpr int VROW = 320;
__device__ __forceinline__ s16x4 vtr(const LAS unsigned char* p) { typedef short v4i16_t __attribute__((ext_vector_type(4))); return __builtin_bit_cast(s16x4, __builtin_amdgcn_ds_read_tr16_b64_v4i16((LAS v4i16_t*)p)); }
__device__ __forceinline__ bf16x8 cvt8(const f32x4& a, const f32x4& b) { u32x4 w = pack8(a, b); return __builtin_bit_cast(bf16x8, w); }

__device__ __forceinline__ void attn_unit(const Params& p, LAS unsigned char* vl, int unit, int lane) {
    const bf16_t* Ub = (const bf16_t*)(p.ws + WS_QKVU);
    const bf16_t* Qb = Ub + (size_t)MT * 1024; const bf16_t* Kb = Qb + (size_t)MT * 1024; const bf16_t* Vb = Kb + (size_t)MT * 1024;
    bf16_t* AO = (bf16_t*)(p.ws + WS_AO);
    const int n = lane & 31, hh = lane >> 5;
    const bool sample = unit < 64;
    int b, h, qrow0, nblk;
    if (sample) { b = unit >> 3; h = unit & 7; qrow0 = MP + b * DSEQ; nblk = 1 + PAST / 32; }
    else { const int u2 = unit - 64; const int qb = u2 & 127; h = (u2 >> 7) & 7; b = u2 >> 10; qrow0 = b * SEQ + qb * 32; nblk = qb + 1; }
    bf16x8 qf[8];
    { const bf16_t* qp = Qb + (size_t)(qrow0 + n) * 1024 + h * HD + 64 * hh;
#pragma unroll
      for (int kk = 0; kk < 8; ++kk) qf[kk] = *(const bf16x8*)(qp + 8 * kk); }
    f32x16 o[4];
#pragma unroll
    for (int db = 0; db < 4; ++db)
#pragma unroll
        for (int r = 0; r < 16; ++r) o[db][r] = 0.f;
    float R = (sample && n >= DSEQ) ? -1e30f : 0.f;
    const float* ck = p.cache_k + (size_t)b * PAST * 1024 + h * HD; const float* cv = p.cache_v + (size_t)b * PAST * 1024 + h * HD;
    const int vaddr = (4 * hh + ((lane & 15) >> 2)) * VROW + (16 * ((lane >> 4) & 1) + 4 * (lane & 3)) * 2;
    for (int blk = 0; blk < nblk; ++blk) {
        bf16x8 kf[8];
        const bool diag = (blk == 0);
        if (!sample || blk == 0) {
            const int s0 = qrow0 - blk * 32;
            const bf16_t* kp = Kb + (size_t)(s0 + n) * 1024 + h * HD + 64 * hh;
#pragma unroll
            for (int kk = 0; kk < 8; ++kk) kf[kk] = *(const bf16x8*)(kp + 8 * kk);
            const bf16_t* vp = Vb + (size_t)(s0 + (lane >> 4)) * 1024 + h * HD + 8 * (lane & 15);
#pragma unroll
            for (int it = 0; it < 8; ++it) { const u32x4 w = *(const u32x4*)(vp + (size_t)(4 * it) * 1024); *(LAS u32x4*)(vl + (4 * it + (lane >> 4)) * VROW + 16 * (lane & 15)) = w; }
        } else {
            const int s0 = PAST - blk * 32;
            const float* kp = ck + (size_t)(s0 + n) * 1024 + 64 * hh;
#pragma unroll
            for (int kk = 0; kk < 8; ++kk) kf[kk] = cvt8(*(const f32x4*)(kp + 8 * kk), *(const f32x4*)(kp + 8 * kk + 4));
            const float* vp = cv + (size_t)(s0 + (lane >> 4)) * 1024 + 8 * (lane & 15);
#pragma unroll
            for (int it = 0; it < 8; ++it) { const f32x4 a = *(const f32x4*)(vp + (size_t)(4 * it) * 1024), c = *(const f32x4*)(vp + (size_t)(4 * it) * 1024 + 4);
                *(LAS u32x4*)(vl + (4 * it + (lane >> 4)) * VROW + 16 * (lane & 15)) = pack8(a, c); }
        }
        f32x16 st;
#pragma unroll
        for (int r = 0; r < 16; ++r) st[r] = 0.f;
#pragma unroll
        for (int kk = 0; kk < 8; ++kk) st = __builtin_amdgcn_mfma_f32_32x32x16_bf16(kf[kk], qf[kk], st, 0, 0, 0);
        float l1m[16], ls[16];
#pragma unroll
        for (int r = 0; r < 16; ++r) { const int i = (r & 3) + 8 * (r >> 2) + 4 * hh; const bool valid = !diag || (i < n);
            const float z = st[r] * 0.08838834764831845f; const float sp = fmaxf(z, 0.f) + __logf(1.0f + __expf(-fabsf(z)));
            l1m[r] = valid ? -sp : 0.f; ls[r] = valid ? (z - sp) : -1e30f; }
        float gown[4], goth[4];
#pragma unroll
        for (int a = 0; a < 4; ++a) { gown[a] = (l1m[4 * a] + l1m[4 * a + 1]) + (l1m[4 * a + 2] + l1m[4 * a + 3]); goth[a] = __shfl_xor(gown[a], 32); }
        float wv[16]; float tail = R;
#pragma unroll
        for (int a = 3; a >= 0; --a) { float sfx = tail + (hh == 0 ? goth[a] : 0.f);
#pragma unroll
            for (int rr = 3; rr >= 0; --rr) { wv[4 * a + rr] = __expf(ls[4 * a + rr] + sfx); sfx += l1m[4 * a + rr]; }
            tail += gown[a] + goth[a]; }
        R = tail;
        bf16x8 wb[2];
#pragma unroll
        for (int s = 0; s < 2; ++s) wb[s] = cvt8((f32x4){wv[8 * s], wv[8 * s + 1], wv[8 * s + 2], wv[8 * s + 3]}, (f32x4){wv[8 * s + 4], wv[8 * s + 5], wv[8 * s + 6], wv[8 * s + 7]});
        asm volatile("s_waitcnt lgkmcnt(0)" ::: "memory");
#pragma unroll
        for (int db = 0; db < 4; ++db)
#pragma unroll
            for (int s = 0; s < 2; ++s) { const s16x4 lo = vtr(vl + vaddr + (16 * s) * VROW + 64 * db), hi = vtr(vl + vaddr + (16 * s + 8) * VROW + 64 * db);
                const bf16x8 vf = (bf16x8){lo[0], lo[1], lo[2], lo[3], hi[0], hi[1], hi[2], hi[3]};
                o[db] = __builtin_amdgcn_mfma_f32_32x32x16_bf16(vf, wb[s], o[db], 0, 0, 0); }
        asm volatile("s_waitcnt lgkmcnt(0)" ::: "memory");
        if (__all(R < -104.0f)) break;
    }
    if (!sample || n < DSEQ) {
        bf16_t* op = AO + (size_t)(qrow0 + n) * 2048 + 1024 + h * HD + 4 * hh;
#pragma unroll
        for (int db = 0; db < 4; ++db)
#pragma unroll
            for (int a = 0; a < 4; ++a) *(u32x2*)(op + 32 * db + 8 * a) = (u32x2){cvt_pk_bf16(o[db][4 * a], o[db][4 * a + 1]), cvt_pk_bf16(o[db][4 * a + 2], o[db][4 * a + 3])};
    }
}

__device__ __forceinline__ void diff_items(const Params& p, int gtid, int nthreads) {
    const bf16_t* Ub = (const bf16_t*)(p.ws + WS_QKVU); bf16_t* AO = (bf16_t*)(p.ws + WS_AO);
    for (int it = gtid; it < MV * 128; it += nthreads) {
        const int m = it >> 7, cc = it & 127, g = cc >> 5, w = 2 << g;
        const bf16_t* up = Ub + (size_t)m * 1024 + cc * 8;
        f32x4 s0 = (f32x4){0.f, 0.f, 0.f, 0.f}, s1 = s0, u0, u1; float cnt;
        { const u32x4 v = *(const u32x4*)up; unpack8(v, u0, u1); s0 = u0; s1 = u1; }
        if (m < MP) { const int t = m & (SEQ - 1); const int jn = t < w - 1 ? t : w - 1; cnt = (float)(jn + 1);
            for (int j = 1; j <= jn; ++j) { const u32x4 v = *(const u32x4*)(up - (size_t)j * 1024); f32x4 a, c; unpack8(v, a, c); s0 += a; s1 += c; } }
        else { const int t = (m - MP) & 15, b = (m - MP) >> 4; cnt = (float)w;
            for (int j = 1; j < w; ++j) { const int tj = t - j;
                if (tj >= 0) { const u32x4 v = *(const u32x4*)(up - (size_t)j * 1024); f32x4 a, c; unpack8(v, a, c); s0 += a; s1 += c; }
                else { const float* hp = p.state_pool + ((size_t)b * 15 + (15 + tj)) * 1024 + cc * 8; s0 += *(const f32x4*)hp; s1 += *(const f32x4*)(hp + 4); } } }
        const float ic = 1.0f / cnt;
        *(u32x4*)(AO + (size_t)m * 2048 + cc * 8) = pack8(s0 * ic - u0, s1 * ic - u1);
    }
}

__global__ void __launch_bounds__(512, 2) fwd_megakernel(Params p) {
    extern __shared__ __attribute__((aligned(16))) unsigned char lds_raw[];
    LAS unsigned char* lds = (LAS unsigned char*)lds_raw;
    const int tid = threadIdx.x, lane = tid & 63, wave = __builtin_amdgcn_readfirstlane(tid >> 6);
    const int G = gridDim.x, bx = blockIdx.x;
    const int vcu = (G % 8 == 0) ? (bx % 8) * (G / 8) + bx / 8 : bx;
    const int gw = vcu * 8 + wave, NGW = G * 8;
    cg::grid_group grid = cg::this_grid();
#define IN(k) (p.ph_lo <= (k) && (k) < p.ph_hi)
#define SEAM(k) do { if (IN(k) && IN((k) + 1)) { __builtin_amdgcn_fence(__ATOMIC_RELEASE, "agent"); asm volatile("s_waitcnt vmcnt(0)" ::: "memory"); grid.sync(); __builtin_amdgcn_fence(__ATOMIC_ACQUIRE, "agent"); } } while (0)
    bf16_t* Wt_in = (bf16_t*)(p.ws + WS_WIN); bf16_t* Wt_br = (bf16_t*)(p.ws + WS_WBR); bf16_t* Wt_out = (bf16_t*)(p.ws + WS_WOUT);
    bf16_t* Wt_gu = (bf16_t*)(p.ws + WS_WGU); bf16_t* Wt_dn = (bf16_t*)(p.ws + WS_WDN); bf16_t* XN = (bf16_t*)(p.ws + WS_XN);
    bf16_t* QKVU = (bf16_t*)(p.ws + WS_QKVU); bf16_t* GATE = (bf16_t*)(p.ws + WS_GATE); bf16_t* AO = (bf16_t*)(p.ws + WS_AO);
    bf16_t* MERGED = (bf16_t*)(p.ws + WS_MERGED); bf16_t* HID = (bf16_t*)(p.ws + WS_HID); float* SSQ = (float*)(p.ws + WS_SSQ);
    float* Y = p.out + OFF_Y;

    if (IN(0)) { phase0(p, lds, gw, NGW, wave, lane);
#ifdef PROBE_P0
        __syncthreads(); phase0(p, lds, gw, NGW, wave, lane);
#endif
    }
    SEAM(0);
    if (IN(1)) { pg8::Gemm g{XN, Wt_in, D, D, MT, NIN, D}; pg8::StaticOrder S; S.init(64, NIN / 256, D / 64, G, bx, 64, 1); EpiIn E{QKVU, GATE, p.out}; pg8::gemm_phase(lds, g, S, E); }
    SEAM(1);
    if (IN(2)) {
        LAS unsigned char* vl = lds + wave * (32 * VROW);
#ifndef SKIP_ATTN
        for (int u = gw; u < 64 + 4096; u += NGW) attn_unit(p, vl, __builtin_amdgcn_readfirstlane(u), lane);
#else
        for (int it = gw * 64 + lane; it < MV * 128; it += NGW * 64) *(u32x4*)(AO + (size_t)(it >> 7) * 2048 + 1024 + (it & 127) * 8) = (u32x4){0u, 0u, 0u, 0u};
#endif
        diff_items(p, (NGW - 1 - gw) * 64 + lane, NGW * 64);
        __syncthreads();
        for (int gq = 0; gq < 4; ++gq) { pg8::Gemm g{(const bf16_t*)(p.ws + WS_TMPA) + gq * 256, (const bf16_t*)(p.ws + WS_WPB) + gq * 65536, 1024, 256, 2048, 256, 256};
            pg8::StaticOrder S; S.init(8, 1, 4, G, (bx + G - 8 * gq) % G); EpiWA E{Wt_br + gq * 256}; pg8::gemm_phase(lds, g, S, E); }
    }
    SEAM(2);
    if (IN(3)) {
        { pg8::Gemm g{AO, Wt_br, 2048, 2048, MT, D, 1024}; pg8::StaticOrder S; S.init(64, 8, 16, G, bx, 64, 1); EpiBrA E{GATE, Y}; pg8::gemm_phase(lds, g, S, E); }
        { pg8::Gemm g{AO + 1024, Wt_br + 1024, 2048, 2048, MT, D, 1024}; pg8::StaticOrder S; S.init(64, 8, 16, G, bx, 64, 1); EpiBrB E{GATE, Y, MERGED}; pg8::gemm_phase(lds, g, S, E); }
    }
    SEAM(3);
    if (IN(4)) { pg8::Gemm g{MERGED, Wt_out, D, D, MT, D, D}; pg8::StaticOrder S; S.init(64, 8, 32, G, bx, 64, 1); EpiOut E{p.x_prompt, p.x_sample, Y, XN, SSQ}; pg8::gemm_phase(lds, g, S, E); }
    SEAM(4);
    if (IN(5)) { pg8::Gemm g{XN, Wt_gu, D, D, MT, NGU, D}; pg8::StaticOrder S; S.init(64, NGU / 256, 32, G, bx, 64, 1); EpiGU E{SSQ, HID}; pg8::gemm_phase(lds, g, S, E); }
    SEAM(5);
    if (IN(6)) { pg8::Gemm g{HID, Wt_dn, FF, FF, MT, D, FF}; pg8::StaticOrder S; S.init(64, 8, FF / 64, G, bx, 64, 11); EpiDown E{Y}; pg8::gemm_phase(lds, g, S, E); }
    SEAM(6);
    if (IN(7)) {
        for (int m = gw; m < MV; m += NGW) {
            f32x4* yr = (f32x4*)(Y + (size_t)m * D) + lane; const f32x4* gf = (const f32x4*)p.g_final + lane;
            f32x4 v[8]; float s = 0.f;
#pragma unroll
            for (int j = 0; j < 8; ++j) { v[j] = yr[64 * j]; s += (v[j].x * v[j].x + v[j].y * v[j].y) + (v[j].z * v[j].z + v[j].w * v[j].w); }
            const float rs = __builtin_amdgcn_rsqf(wave_sum(s) * (1.0f / D) + EPS);
#pragma unroll
            for (int j = 0; j < 8; ++j) yr[64 * j] = v[j] * rs * gf[64 * j];
        }
    }
#undef IN
#undef SEAM
}

extern "C" void kernel_launch(void* const* d_in, const int* in_sizes, int n_in, void* d_out, int out_size, void* d_ws, size_t ws_size, hipStream_t stream) {
    static int grid = 0;
    if (grid == 0) {
        if (n_in != 15 || (size_t)out_size != OUT_TOTAL || ws_size < WS_END) { fprintf(stderr, "kernel_launch: unexpected shapes: n_in %d out %d ws %zu\n", n_in, out_size, ws_size); grid = -1; return; }
        int dev = 0, cus = 0, per_cu = 0;
        hipGetDevice(&dev); hipDeviceGetAttribute(&cus, hipDeviceAttributeMultiprocessorCount, dev);
        hipFuncSetAttribute((const void*)fwd_megakernel, hipFuncAttributeMaxDynamicSharedMemorySize, LDS_BYTES);
        hipOccupancyMaxActiveBlocksPerMultiprocessor(&per_cu, (const void*)fwd_megakernel, 512, LDS_BYTES);
        if (per_cu < 1) { fprintf(stderr, "kernel_launch: occupancy query says %d blocks per CU\n", per_cu); per_cu = 1; }
        (void)hipGetLastError();
        grid = cus;
    }
    if (grid < 0) return;
    Params p{};
    const float** pp = (const float**)&p;
    for (int i = 0; i < 15; ++i) pp[i] = (const float*)d_in[i];
    p.out = (float*)d_out; p.ws = (unsigned char*)d_ws;
#if N_LAUNCH_MODE == 1
    p.ph_lo = 0; p.ph_hi = 8;
    void* args[] = {&p};
    hipError_t e = hipLaunchCooperativeKernel((const void*)fwd_megakernel, dim3(grid), dim3(512), args, LDS_BYTES, stream);
    if (e != hipSuccess) fprintf(stderr, "cooperative launch failed: %s (grid %d)\n", hipGetErrorString(e), grid);
#else
    for (int ph = 0; ph < 8; ++ph) { p.ph_lo = ph; p.ph_hi = ph + 1; hipLaunchKernelGGL(fwd_megakernel, dim3(grid), dim3(512), LDS_BYTES, stream, p); }
#endif
}
```

```cpp
#include <hip/hip_runtime.h>
#include <hip/hip_cooperative_groups.h>
#include <cstdio>
#include <cstdint>
namespace cg = cooperative_groups;

#define PROBE_A 1
#define PROBE_B 0
#ifndef N_LAUNCH_MODE
#define N_LAUNCH_MODE 1
#endif

#define LAS __attribute__((address_space(3)))
typedef unsigned short bf16_t;
typedef short bf16x8 __attribute__((ext_vector_type(8)));
typedef short s16x4 __attribute__((ext_vector_type(4)));
typedef float f32x4 __attribute__((ext_vector_type(4)));
typedef float f32x16 __attribute__((ext_vector_type(16)));
typedef unsigned u32x4 __attribute__((ext_vector_type(4)));
typedef unsigned u32x2 __attribute__((ext_vector_type(2)));

constexpr int D = 2048, MP = 16384, MS = 128, MV = MP + MS, MT = 16640;
constexpr int SEQ = 4096, DSEQ = 16, PAST = 4096, NH = 8, HD = 128;
constexpr int NIN = 8192, FF = 5632, NGU = 2 * FF, AW = 1024;
constexpr float EPS = 1e-6f;
constexpr size_t OFF_Y = 0, OFF_KP = (size_t)MV * D, OFF_VP = OFF_KP + (size_t)MP * 1024, OFF_PP = OFF_VP + (size_t)MP * 1024,
                 OFF_KS = OFF_PP + 4 * 15 * 1024, OFF_VS = OFF_KS + (size_t)MS * 1024, OFF_PS = OFF_VS + (size_t)MS * 1024, OUT_TOTAL = OFF_PS + 8 * 15 * 1024;
constexpr size_t MiB = 1u << 20;
constexpr size_t WS_SSQ = 0, WS_WIN = 1 * MiB, WS_WBR = 33 * MiB, WS_WOUT = 41 * MiB, WS_WGU = 49 * MiB, WS_WDN = 93 * MiB, WS_XN = 115 * MiB,
                 WS_QKVU = 180 * MiB, WS_GATE = 310 * MiB, WS_AO = 440 * MiB, WS_TMPA = 505 * MiB, WS_WPB = 509 * MiB, WS_END = 510 * MiB;
constexpr size_t WS_BAR = 768 * 1024, WS_BAR_BYTES = 16384;
constexpr size_t WS_MERGED = WS_QKVU;
constexpr size_t WS_HID = WS_QKVU;
static_assert((size_t)MT * FF * 2 <= WS_AO - WS_QKVU, "hid overlay");
constexpr int LDS_BYTES = 147456;

typedef __bf16 bf16x2_t __attribute__((ext_vector_type(2)));
typedef float f32x2_t __attribute__((ext_vector_type(2)));
__device__ __forceinline__ unsigned cvt_pk_bf16(float lo, float hi) { const f32x2_t v = {lo, hi}; return __builtin_bit_cast(unsigned, __builtin_convertvector(v, bf16x2_t)); }
__device__ __forceinline__ float bf2f(unsigned short b) { return __uint_as_float(((unsigned)b) << 16); }
__device__ __forceinline__ float bflo(unsigned w) { return __uint_as_float(w << 16); }
__device__ __forceinline__ float bfhi(unsigned w) { return __uint_as_float(w & 0xffff0000u); }
__device__ __forceinline__ float fast_sigmoid(float x) { return __builtin_amdgcn_rcpf(1.0f + __expf(-x)); }
__device__ __forceinline__ float wave_sum(float v) {
#pragma unroll
    for (int o = 1; o < 64; o <<= 1) v += __shfl_xor(v, o);
    return v;
}

#define XB_TMO      128
#define XB_XCNT(j)  (256  + 64 * (j))
#define XB_XSUB(j)  (1280 + 64 * (j))
#define XB_XGEN(j)  (2304 + 64 * (j))
#define XB_TOP      3328
#define XB_TOPGEN   3392
#define XCD_BAR_WORDS 3456
#define XB_SPIN_CAP (1u << 18)

__device__ __forceinline__ unsigned xb_ld(unsigned* p)              { return __hip_atomic_load(p, __ATOMIC_RELAXED, __HIP_MEMORY_SCOPE_AGENT); }
__device__ __forceinline__ unsigned xb_add(unsigned* p, unsigned v) { return __hip_atomic_fetch_add(p, v, __ATOMIC_RELAXED, __HIP_MEMORY_SCOPE_AGENT); }
__device__ __forceinline__ unsigned xb_xcc_id() { return (unsigned)__builtin_amdgcn_s_getreg((3 << 11) | 20) & 0xFu; }
#define XB_SPIN(cond, bar) do { unsigned _sp = 0; while (cond) { __builtin_amdgcn_s_sleep(1); \
    if ((++_sp & 255u) == 0u) { if (xb_ld(&(bar)[XB_TMO])) break; if (_sp > XB_SPIN_CAP) { atomicAdd(&(bar)[XB_TMO], 1u); break; } } } } while (0)

struct XcdBarrier {
    unsigned* bar; unsigned x;
    volatile LAS unsigned* st;
};

__device__ __forceinline__ XcdBarrier xcd_barrier_post(unsigned* bar, volatile LAS unsigned* st) {
    XcdBarrier b; b.bar = bar; b.x = xb_xcc_id(); b.st = st;
    if (threadIdx.x == 0) (void)xb_add(&bar[XB_XCNT(b.x)], 1u);
    return b;
}
__device__ __forceinline__ void xcd_barrier_complete(unsigned* bar, unsigned x, unsigned& nloc, unsigned& nx) {
    const unsigned G = gridDim.x * gridDim.y * gridDim.z;
    unsigned sum, cnt, mine, sp = 0u;
    for (;;) {
        sum = 0u; cnt = 0u; mine = 0u;
#pragma unroll
        for (unsigned j = 0; j < 16; ++j) { const unsigned c = xb_ld(&bar[XB_XCNT(j)]); sum += c; cnt += (c > 0u) ? 1u : 0u; mine = (j == x) ? c : mine; }
        if (sum == G) break;
        __builtin_amdgcn_s_sleep(1);
        if ((++sp & 255u) == 0u) { if (xb_ld(&bar[XB_TMO])) break; if (sp > XB_SPIN_CAP) { atomicAdd(&bar[XB_TMO], 1u); break; } }
    }
    nloc = mine > 0u ? mine : 1u; nx = cnt > 0u ? cnt : 1u;
}

__device__ __forceinline__ void xcd_barrier(const XcdBarrier& b) {
    asm volatile("s_waitcnt vmcnt(0)" ::: "memory");
    __syncthreads();
    if (threadIdx.x == 0) {
        unsigned* bar = b.bar;
        __builtin_amdgcn_s_waitcnt(0);
        unsigned nloc = b.st[0], nx = b.st[1];
        if (nloc == 0u) { xcd_barrier_complete(bar, b.x, nloc, nx); b.st[0] = nloc; b.st[1] = nx; }
        const unsigned old = xb_add(&bar[XB_XSUB(b.x)], 1u);
        const unsigned gen = old / nloc;
        if (old + 1u == (gen + 1u) * nloc) {
            __builtin_amdgcn_fence(__ATOMIC_RELEASE, "agent");
            asm volatile("s_waitcnt vmcnt(0)" ::: "memory");
            const unsigned og = xb_add(&bar[XB_TOP], 1u);
            const unsigned tg = og / nx;
            if (og + 1u == (tg + 1u) * nx) xb_add(&bar[XB_TOPGEN], 1u);
            else XB_SPIN(xb_ld(&bar[XB_TOPGEN]) == tg, bar);
            __builtin_amdgcn_fence(__ATOMIC_ACQUIRE, "agent");
            xb_add(&bar[XB_XGEN(b.x)], 1u);
            asm volatile("s_waitcnt vmcnt(0)" ::: "memory");
        } else {
            XB_SPIN(xb_ld(&bar[XB_XGEN(b.x)]) == gen, bar);
            __builtin_amdgcn_fence(__ATOMIC_ACQUIRE, "agent");
            asm volatile("s_waitcnt vmcnt(0)" ::: "memory");
        }
    }
    __syncthreads();
}

namespace pg8 {
constexpr int BM = 256, BK = 64, HALF = 128, HTB = HALF * BK * 2, STAGE_BYTES = 8 * HTB, NXCD = 8, WGM = 8;
__host__ __device__ __forceinline__ int lds_byte(int r, int c) { const int st = (r >> 4) * 2 + (c >> 5), rr = r & 15, cc = c & 31, ob = rr * 64 + cc * 2; return st * 1024 + (ob ^ (((ob >> 9) & 1) << 5)); }
__host__ __device__ __forceinline__ void stage_rc(int b, int& R, int& C) { const int st = b / 1024, sb = b % 1024, swz = sb ^ (((sb >> 9) & 1) << 5); R = (st >> 1) * 16 + swz / 64; C = (st & 1) * 32 + (swz % 64) / 2; }
__host__ __device__ __forceinline__ int perm32(int rho) { const int n = rho >> 4, i = rho & 15; return 8 * (i >> 2) + 4 * n + (i & 3); }

struct Unit { int pm, pn, kt0, nkt, half; };
struct Gemm { const bf16_t* A; const bf16_t* Bt; int lda, ldb, M, N, K; };

struct StaticOrder {
    int nM, nN, nwg, G, c, ktfull, pmS, nS, ktS;
    __device__ void init(int nM_, int nN_, int ktfull_, int G_, int c_, int pmS_ = 0, int ksplit = 0) { nM = nM_; nN = nN_; nwg = nM * nN; G = G_; c = c_; ktfull = ktfull_; pmS = pmS_; nS = nN * ksplit; ktS = ksplit ? ktfull / ksplit : 0; }
    __device__ bool next(int i, Unit& u) const {
        const int L = i * G + c;
        if (L >= nwg) { const int t = L - nwg;
            if (t >= nS) return false;
            u.pm = pmS; u.pn = t % nN; u.kt0 = (t / nN) * ktS; u.nkt = ktS; u.half = 1; return true; }
        int wgid = L; { const int q = nwg / NXCD, r = nwg % NXCD, xcd = wgid % NXCD, off = wgid / NXCD; wgid = (xcd < r ? xcd * (q + 1) : r * (q + 1) + (xcd - r) * q) + off; }
        const int nig = WGM * nN, gid = wgid / nig, fm = gid * WGM, gsz = (nM - fm) < WGM ? (nM - fm) : WGM;
        u.pm = fm + ((wgid % nig) % gsz); u.pn = (wgid % nig) / gsz; u.kt0 = 0; u.nkt = ktfull; u.half = 0; return true;
    }
};

template <class Epi>
__device__ __forceinline__ void gemm_phase(LAS unsigned char* lds, const Gemm g, const StaticOrder& S, const Epi& E) {
    const int tid = threadIdx.x, wid = __builtin_amdgcn_readfirstlane(tid >> 6), lane = tid & 63, wr = wid >> 2, wc = wid & 3, fr = lane & 15, fq = lane >> 4;
    unsigned voffA[2], voffB[2];
#pragma unroll
    for (int i = 0; i < 2; ++i) { int R, C; stage_rc(tid * 16 + i * 8192, R, C); const int Rb = (R & ~31) + perm32(R & 31);
        voffA[i] = (unsigned)(R * g.lda + C) * 2u; voffB[i] = (unsigned)(Rb * g.ldb + C) * 2u; }
    const size_t kstep = (size_t)(BK * 2);
    const size_t hstepA = (size_t)HALF * g.lda * 2, hstepB = (size_t)HALF * g.ldb * 2;
    const size_t tstepA = 2 * hstepA, tstepB = 2 * hstepB;
    const unsigned ldsw = (unsigned)wid * 1024u;
    const int aoff = lds_byte(wr * 64 + fr, fq * 8), boff = lds_byte(wc * 32 + fr, fq * 8);
#define PG8_SA(b, h) (((b) * 2 + (h)) * HTB)
#define PG8_SB(b, h) ((4 + (b) * 2 + (h)) * HTB)
#define PG8_STAGE(bufoff, gbase, voff) do { _Pragma("unroll") for (int _i = 0; _i < 2; ++_i) \
        __builtin_amdgcn_global_load_lds((const unsigned*)((const char*)(gbase) + (voff)[_i]), (LAS unsigned*)(lds + (bufoff) + ldsw + _i * 8192), 16, 0, 0); } while (0)
#define PG8_LDA(dst, b, h) do { _Pragma("unroll") for (int m = 0; m < 4; ++m) _Pragma("unroll") for (int k = 0; k < 2; ++k) dst[m][k] = *(const LAS bf16x8*)(lds + PG8_SA(b, h) + aoff + m * 2048 + k * 1024); } while (0)
#define PG8_LDB(dst, b, h) do { _Pragma("unroll") for (int n = 0; n < 2; ++n) _Pragma("unroll") for (int k = 0; k < 2; ++k) dst[n][k] = *(const LAS bf16x8*)(lds + PG8_SB(b, h) + boff + n * 2048 + k * 1024); } while (0)
#define PG8_MMA(ai, bj, At, Bt) do { __builtin_amdgcn_s_setprio(1); _Pragma("unroll") for (int m = 0; m < 4; ++m) _Pragma("unroll") for (int n = 0; n < 2; ++n) _Pragma("unroll") for (int k = 0; k < 2; ++k) \
        acc[ai][bj][m][n] = __builtin_amdgcn_mfma_f32_16x16x32_bf16(Bt[n][k], At[m][k], acc[ai][bj][m][n], 0, 0, 0); __builtin_amdgcn_s_setprio(0); } while (0)
#define PG8_WAIT_V(n) asm volatile("s_waitcnt vmcnt(" #n ")" ::: "memory")
#define PG8_WAIT_L(n) asm volatile("s_waitcnt lgkmcnt(" #n ")" ::: "memory")
#define PG8_BAR __builtin_amdgcn_s_barrier()
#define PG8_SCHED __builtin_amdgcn_sched_barrier(0)
    Unit cur, nxt; int ui = 0;
    if (!S.next(0, cur)) return;
    f32x4 acc[2][2][4][2];
#pragma unroll
    for (int a = 0; a < 2; ++a)
#pragma unroll
        for (int b = 0; b < 2; ++b)
#pragma unroll
            for (int m = 0; m < 4; ++m)
#pragma unroll
                for (int n = 0; n < 2; ++n) acc[a][b][m][n] = (f32x4){0.f, 0.f, 0.f, 0.f};
    bf16x8 At[4][2], B0[2][2], B1[2][2];
    const char* cA = (const char*)g.A + (size_t)cur.pm * tstepA + (size_t)cur.kt0 * kstep; const char* cB = (const char*)g.Bt + (size_t)cur.pn * tstepB + (size_t)cur.kt0 * kstep;
    PG8_STAGE(PG8_SB(0, 0), cB, voffB); PG8_STAGE(PG8_SB(0, 1), cB + hstepB, voffB); PG8_STAGE(PG8_SA(0, 0), cA, voffA); PG8_STAGE(PG8_SA(0, 1), cA + hstepA, voffA);
    if (wr == 1) PG8_BAR;
    PG8_WAIT_V(2); PG8_BAR;
    PG8_STAGE(PG8_SB(1, 0), cB + kstep, voffB); PG8_STAGE(PG8_SA(1, 0), cA + kstep, voffA); PG8_STAGE(PG8_SB(1, 1), cB + hstepB + kstep, voffB);
    PG8_WAIT_V(6); PG8_BAR;
    for (;;) {
        const bool has_next = S.next(ui + 1, nxt);
        const char* nA = has_next ? (const char*)g.A + (size_t)nxt.pm * tstepA + (size_t)nxt.kt0 * kstep : cA; const char* nB = has_next ? (const char*)g.Bt + (size_t)nxt.pn * tstepB + (size_t)nxt.kt0 * kstep : cB;
        const int nt = cur.nkt; const bool full = !cur.half;
        for (int t = 0; t < nt; t += 2) {
            const bool last = (t == nt - 2);
            const char* a1 = cA + (size_t)(t + 1) * kstep;
            const char* a2 = last ? nA : cA + (size_t)(t + 2) * kstep; const char* b2 = last ? nB : cB + (size_t)(t + 2) * kstep;
            const char* a3 = a2 + kstep; const char* b3 = b2 + kstep;
            PG8_LDB(B0, 0, 0); PG8_LDB(B1, 0, 1); PG8_SCHED; PG8_LDA(At, 0, 0); PG8_STAGE(PG8_SA(1, 1), a1 + hstepA, voffA);
            PG8_WAIT_V(8); PG8_WAIT_L(0); PG8_BAR; PG8_MMA(0, 0, At, B0); PG8_MMA(0, 1, At, B1); PG8_BAR; PG8_SCHED;
            if (full) PG8_LDA(At, 0, 1); PG8_STAGE(PG8_SB(0, 0), b2, voffB); PG8_STAGE(PG8_SB(0, 1), b2 + hstepB, voffB); PG8_STAGE(PG8_SA(0, 0), a2, voffA);
            PG8_WAIT_V(8); PG8_WAIT_L(0); PG8_BAR; if (full) { PG8_MMA(1, 0, At, B0); PG8_MMA(1, 1, At, B1); } PG8_BAR; PG8_SCHED;
            PG8_LDB(B0, 1, 0); PG8_LDB(B1, 1, 1); PG8_SCHED; PG8_LDA(At, 1, 0); PG8_STAGE(PG8_SA(0, 1), a2 + hstepA, voffA);
            PG8_WAIT_V(8); PG8_WAIT_L(0); PG8_BAR; PG8_MMA(0, 0, At, B0); PG8_MMA(0, 1, At, B1); PG8_BAR; PG8_SCHED;
            if (full) PG8_LDA(At, 1, 1); PG8_STAGE(PG8_SB(1, 0), b3, voffB); PG8_STAGE(PG8_SB(1, 1), b3 + hstepB, voffB); PG8_STAGE(PG8_SA(1, 0), a3, voffA);
            PG8_WAIT_V(8); PG8_WAIT_L(0); PG8_BAR; if (full) { PG8_MMA(1, 0, At, B0); PG8_MMA(1, 1, At, B1); } PG8_BAR; PG8_SCHED;
        }
        if (wr == 0) PG8_BAR;
        E(acc, cur, wr, wc, fr, fq);
        if (!has_next) break;
#pragma unroll
        for (int a = 0; a < 2; ++a)
#pragma unroll
            for (int b = 0; b < 2; ++b)
#pragma unroll
                for (int m = 0; m < 4; ++m)
#pragma unroll
                    for (int n = 0; n < 2; ++n) acc[a][b][m][n] = (f32x4){0.f, 0.f, 0.f, 0.f};
        cur = nxt; cA = nA; cB = nB; ++ui;
        if (wr == 1) PG8_BAR;
    }
    PG8_WAIT_V(0);
    PG8_BAR;
#undef PG8_SA
#undef PG8_SB
#undef PG8_STAGE
#undef PG8_LDA
#undef PG8_LDB
#undef PG8_MMA
#undef PG8_WAIT_V
#undef PG8_WAIT_L
#undef PG8_BAR
#undef PG8_SCHED
}
}
using pg8::Unit;

__device__ __forceinline__ u32x4 pack8(const f32x4& v0, const f32x4& v1) {
    u32x4 w; w.x = cvt_pk_bf16(v0[0], v0[1]); w.y = cvt_pk_bf16(v0[2], v0[3]); w.z = cvt_pk_bf16(v1[0], v1[1]); w.w = cvt_pk_bf16(v1[2], v1[3]); return w;
}
__device__ __forceinline__ void unpack8(const u32x4& w, f32x4& v0, f32x4& v1) {
    v0 = (f32x4){bflo(w.x), bfhi(w.x), bflo(w.y), bfhi(w.y)}; v1 = (f32x4){bflo(w.z), bfhi(w.z), bflo(w.w), bfhi(w.w)};
}

struct EpiIn {
    bf16_t* qkvu; bf16_t* gate; float* out;
    __device__ __forceinline__ void operator()(const f32x4 (&acc)[2][2][4][2], const Unit& u, int wr, int wc, int fr, int fq) const {
        const int row0 = u.pm * 256 + wr * 64 + fr, cw = wc * 32 + 8 * fq;
        if (u.pn >= 16) {
            bf16_t* base = gate + (size_t)row0 * 4096 + (u.pn - 16) * 256 + cw;
#pragma unroll
            for (int ai = 0; ai < 2; ++ai)
#pragma unroll
                for (int m = 0; m < 4; ++m) { bf16_t* rowp = base + (size_t)(ai * 128 + m * 16) * 4096;
#pragma unroll
                    for (int bj = 0; bj < 2; ++bj) { f32x4 v0 = acc[ai][bj][m][0], v1 = acc[ai][bj][m][1];
#pragma unroll
                        for (int j = 0; j < 4; ++j) { v0[j] = fast_sigmoid(v0[j]); v1[j] = fast_sigmoid(v1[j]); }
                        *(u32x4*)(rowp + bj * 128) = pack8(v0, v1); } }
        } else {
            const int sec = u.pn >> 2, cc = (u.pn & 3) * 256 + cw;
            bf16_t* base = qkvu + (size_t)sec * MT * 1024 + (size_t)row0 * 1024 + cc;
#pragma unroll
            for (int ai = 0; ai < 2; ++ai)
#pragma unroll
                for (int m = 0; m < 4; ++m) { bf16_t* rowp = base + (size_t)(ai * 128 + m * 16) * 1024;
#pragma unroll
                    for (int bj = 0; bj < 2; ++bj) *(u32x4*)(rowp + bj * 128) = pack8(acc[ai][bj][m][0], acc[ai][bj][m][1]); }
            if (sec >= 2) {
                const size_t offp = (sec == 2) ? OFF_KP : OFF_VP, offs = (sec == 2) ? OFF_KS : OFF_VS;
#pragma unroll
                for (int ai = 0; ai < 2; ++ai)
#pragma unroll
                    for (int m = 0; m < 4; ++m) { const int row = row0 + ai * 128 + m * 16;
                        if (row < MV) { float* o = out + (row < MP ? offp + (size_t)row * 1024 : offs + (size_t)(row - MP) * 1024) + cc;
#pragma unroll
                            for (int bj = 0; bj < 2; ++bj) { *(f32x4*)(o + bj * 128) = acc[ai][bj][m][0]; *(f32x4*)(o + bj * 128 + 4) = acc[ai][bj][m][1]; } } }
            } else if (sec == 0 && ((u.pm & 15) == 15 || u.pm == 64)) {
#pragma unroll
                for (int ai = 0; ai < 2; ++ai)
#pragma unroll
                    for (int m = 0; m < 4; ++m) { const int row = row0 + ai * 128 + m * 16; long off = -1;
                        if (row < MP) { const int t = row & (SEQ - 1); if (t >= SEQ - 15) off = (long)OFF_PP + ((long)(row >> 12) * 15 + (t - (SEQ - 15))) * 1024; }
                        else if (row < MV) { const int t = (row - MP) & 15, b = (row - MP) >> 4; if (t >= 1) off = (long)OFF_PS + ((long)b * 15 + (t - 1)) * 1024; }
                        if (off >= 0) { float* o = out + off + cc;
#pragma unroll
                            for (int bj = 0; bj < 2; ++bj) { *(f32x4*)(o + bj * 128) = acc[ai][bj][m][0]; *(f32x4*)(o + bj * 128 + 4) = acc[ai][bj][m][1]; } } }
            }
        }
    }
};
struct EpiBrA {
    const bf16_t* gate; float* tmp;
    __device__ __forceinline__ void operator()(const f32x4 (&acc)[2][2][4][2], const Unit& u, int wr, int wc, int fr, int fq) const {
        const int row0 = u.pm * 256 + wr * 64 + fr, cc = u.pn * 256 + wc * 32 + 8 * fq;
#pragma unroll
        for (int ai = 0; ai < 2; ++ai)
#pragma unroll
            for (int m = 0; m < 4; ++m) { const int row = row0 + ai * 128 + m * 16;
                if (row < MV) { const bf16_t* gp = gate + (size_t)row * 4096 + cc; float* o = tmp + (size_t)row * D + cc;
#pragma unroll
                    for (int bj = 0; bj < 2; ++bj) { const u32x4 gw = *(const u32x4*)(gp + bj * 128); f32x4 g0, g1; unpack8(gw, g0, g1);
                        *(f32x4*)(o + bj * 128) = acc[ai][bj][m][0] * g0; *(f32x4*)(o + bj * 128 + 4) = acc[ai][bj][m][1] * g1; } } }
    }
};
struct EpiBrB {
    const bf16_t* gate; const float* tmp; bf16_t* merged;
    __device__ __forceinline__ void operator()(const f32x4 (&acc)[2][2][4][2], const Unit& u, int wr, int wc, int fr, int fq) const {
        const int row0 = u.pm * 256 + wr * 64 + fr, cc = u.pn * 256 + wc * 32 + 8 * fq;
#pragma unroll
        for (int ai = 0; ai < 2; ++ai)
#pragma unroll
            for (int m = 0; m < 4; ++m) { const int row = row0 + ai * 128 + m * 16;
                const bf16_t* gp = gate + (size_t)row * 4096 + 2048 + cc; const float* tp = tmp + (size_t)row * D + cc; bf16_t* o = merged + (size_t)row * D + cc;
#pragma unroll
                for (int bj = 0; bj < 2; ++bj) { const u32x4 gw = *(const u32x4*)(gp + bj * 128); f32x4 g0, g1; unpack8(gw, g0, g1);
                    f32x4 t0 = (f32x4){0.f, 0.f, 0.f, 0.f}, t1 = t0;
                    if (row < MV) { t0 = *(const f32x4*)(tp + bj * 128); t1 = *(const f32x4*)(tp + bj * 128 + 4); }
                    *(u32x4*)(o + bj * 128) = pack8(t0 + acc[ai][bj][m][0] * g0, t1 + acc[ai][bj][m][1] * g1); } }
    }
};
struct EpiOut {
    const float* xp; const float* xs; float* y; bf16_t* hb; float* ssq;
    __device__ __forceinline__ void operator()(const f32x4 (&acc)[2][2][4][2], const Unit& u, int wr, int wc, int fr, int fq) const {
        const int row0 = u.pm * 256 + wr * 64 + fr, cc = u.pn * 256 + wc * 32 + 8 * fq;
#pragma unroll
        for (int ai = 0; ai < 2; ++ai)
#pragma unroll
            for (int m = 0; m < 4; ++m) { const int row = row0 + ai * 128 + m * 16; const bool ok = row < MV;
                const float* xr = (row < MP ? xp + (size_t)row * D : xs + (size_t)(row - MP) * D) + cc; float* o = y + (size_t)row * D + cc; bf16_t* ob = hb + (size_t)row * D + cc;
                float s = 0.f;
#pragma unroll
                for (int bj = 0; bj < 2; ++bj) { f32x4 h0 = acc[ai][bj][m][0], h1 = acc[ai][bj][m][1];
                    if (ok) { h0 += *(const f32x4*)(xr + bj * 128); h1 += *(const f32x4*)(xr + bj * 128 + 4); *(f32x4*)(o + bj * 128) = h0; *(f32x4*)(o + bj * 128 + 4) = h1; }
                    *(u32x4*)(ob + bj * 128) = pack8(h0, h1);
                    s += (h0[0] * h0[0] + h0[1] * h0[1]) + (h0[2] * h0[2] + h0[3] * h0[3]) + (h1[0] * h1[0] + h1[1] * h1[1]) + (h1[2] * h1[2] + h1[3] * h1[3]); }
                s += __shfl_xor(s, 16); s += __shfl_xor(s, 32);
                if (fq == 0) atomicAdd(ssq + row, s); }
    }
};
struct EpiGU {
    const float* ssq; bf16_t* hid;
    __device__ __forceinline__ void operator()(const f32x4 (&acc)[2][2][4][2], const Unit& u, int wr, int wc, int fr, int fq) const {
        const int row0 = u.pm * 256 + wr * 64 + fr, cc = u.pn * 128 + wc * 32 + 8 * fq;
#pragma unroll
        for (int ai = 0; ai < 2; ++ai)
#pragma unroll
            for (int m = 0; m < 4; ++m) { const int row = row0 + ai * 128 + m * 16;
                const float sc = __builtin_amdgcn_rsqf(ssq[row] * (1.0f / D) + EPS);
                f32x4 r0, r1;
#pragma unroll
                for (int j = 0; j < 4; ++j) { const float g0 = acc[ai][0][m][0][j] * sc, u0 = acc[ai][1][m][0][j] * sc, g1 = acc[ai][0][m][1][j] * sc, u1 = acc[ai][1][m][1][j] * sc;
                    r0[j] = g0 * fast_sigmoid(g0) * u0; r1[j] = g1 * fast_sigmoid(g1) * u1; }
                *(u32x4*)(hid + (size_t)row * FF + cc) = pack8(r0, r1); }
    }
};
struct EpiDown {
    float* y;
    __device__ __forceinline__ void operator()(const f32x4 (&acc)[2][2][4][2], const Unit& u, int wr, int wc, int fr, int fq) const {
        const int row0 = u.pm * 256 + wr * 64 + fr, cc = u.pn * 256 + wc * 32 + 8 * fq;
#pragma unroll
        for (int ai = 0; ai < 2; ++ai)
#pragma unroll
            for (int m = 0; m < 4; ++m) { const int row = row0 + ai * 128 + m * 16;
                if (row < MV) { float* o = y + (size_t)row * D + cc;
                    if (u.half) {
#pragma unroll
                        for (int bj = 0; bj < 2; ++bj)
#pragma unroll
                            for (int n = 0; n < 2; ++n)
#pragma unroll
                                for (int j = 0; j < 4; ++j) __hip_atomic_fetch_add(o + bj * 128 + 4 * n + j, acc[ai][bj][m][n][j], __ATOMIC_RELAXED, __HIP_MEMORY_SCOPE_AGENT);
                    } else {
#pragma unroll
                    for (int bj = 0; bj < 2; ++bj) { *(f32x4*)(o + bj * 128) = *(const f32x4*)(o + bj * 128) + acc[ai][bj][m][0]; *(f32x4*)(o + bj * 128 + 4) = *(const f32x4*)(o + bj * 128 + 4) + acc[ai][bj][m][1]; } } } }
    }
};

struct EpiWA {
    bf16_t* dst;
    __device__ __forceinline__ void operator()(const f32x4 (&acc)[2][2][4][2], const Unit& u, int wr, int wc, int fr, int fq) const {
        const int row0 = u.pm * 256 + wr * 64 + fr, cc = wc * 32 + 8 * fq;
#pragma unroll
        for (int ai = 0; ai < 2; ++ai)
#pragma unroll
            for (int m = 0; m < 4; ++m) { bf16_t* o = dst + (size_t)(row0 + ai * 128 + m * 16) * 2048 + cc;
#pragma unroll
                for (int bj = 0; bj < 2; ++bj) *(u32x4*)(o + bj * 128) = pack8(acc[ai][bj][m][0], acc[ai][bj][m][1]); }
    }
};

__device__ __forceinline__ void p0_item(const float* W, int N, int k0, int n0, const float* gsc, bf16_t* dst, int ldd, int drow0, int dcol0, LAS float* scr, int lane) {
    const float* wp = W + (size_t)k0 * N + n0 + lane;
    float v[64];
#pragma unroll
    for (int i = 0; i < 64; ++i) v[i] = wp[(size_t)i * N];
    if (gsc) {
#pragma unroll
        for (int i = 0; i < 64; ++i) v[i] *= gsc[k0 + i]; }
#pragma unroll
    for (int i = 0; i < 64; ++i) scr[i * 65 + lane] = v[i];
    asm volatile("s_waitcnt lgkmcnt(0)" ::: "memory");
    const int c = lane & 7;
#pragma unroll
    for (int j = 0; j < 8; ++j) { const int n = (lane >> 3) + 8 * j; const LAS float* s = scr + (8 * c) * 65 + n;
        u32x4 o; o.x = cvt_pk_bf16(s[0 * 65], s[1 * 65]); o.y = cvt_pk_bf16(s[2 * 65], s[3 * 65]); o.z = cvt_pk_bf16(s[4 * 65], s[5 * 65]); o.w = cvt_pk_bf16(s[6 * 65], s[7 * 65]);
        *(u32x4*)(dst + (size_t)(drow0 + n) * ldd + dcol0 + k0 + 8 * c) = o; }
    asm volatile("s_waitcnt lgkmcnt(0)" ::: "memory");
}

struct Params {
    const float *x_prompt, *x_sample, *cache_k, *cache_v, *state_pool, *g_mix, *w_in, *w_pool, *s_pool, *w_branch, *w_out, *g_ffn, *w_gate_up, *w_down, *g_final;
    float* out; unsigned char* ws; int ph_lo, ph_hi;
};

__device__ __forceinline__ void phase0(const Params& p, LAS unsigned char* lds, int gw, int NGW, int wave, int lane) {
    LAS float* scr = (LAS float*)(lds + wave * 16640);
    bf16_t* Wt_in = (bf16_t*)(p.ws + WS_WIN); bf16_t* Wt_br = (bf16_t*)(p.ws + WS_WBR); bf16_t* Wt_out = (bf16_t*)(p.ws + WS_WOUT);
    bf16_t* Wt_gu = (bf16_t*)(p.ws + WS_WGU); bf16_t* Wt_dn = (bf16_t*)(p.ws + WS_WDN); bf16_t* XN = (bf16_t*)(p.ws + WS_XN);
    bf16_t* TMPA = (bf16_t*)(p.ws + WS_TMPA); bf16_t* WPB = (bf16_t*)(p.ws + WS_WPB);
    constexpr int I_IN = (D / 64) * (NIN / 64), I_BR = (D / 64) * (D / 64), I_OUT = (D / 64) * (D / 64), I_GU = (D / 64) * (NGU / 64), I_DN = (FF / 64) * (D / 64);
    constexpr int NITEMS = I_IN + I_BR + I_OUT + I_GU + I_DN;
    for (int it = gw; it < NITEMS; it += NGW) {
        int r = it;
        if (r < I_IN) { const int nb = NIN / 64; p0_item(p.w_in, NIN, 64 * (r / nb), 64 * (r % nb), p.g_mix, Wt_in, D, 64 * (r % nb), 0, scr, lane); continue; } r -= I_IN;
        if (r < I_BR) { const int nb = D / 64; const int k0 = 64 * (r / nb), n0 = 64 * (r % nb);
            if (k0 < 1024) p0_item(p.w_branch, D, k0, n0, p.s_pool, TMPA, 1024, n0, 0, scr, lane);
            else p0_item(p.w_branch, D, k0, n0, nullptr, Wt_br, 2048, n0, 0, scr, lane);
            continue; } r -= I_BR;
        if (r < I_OUT) { const int nb = D / 64; p0_item(p.w_out, D, 64 * (r / nb), 64 * (r % nb), nullptr, Wt_out, D, 64 * (r % nb), 0, scr, lane); continue; } r -= I_OUT;
        if (r < I_GU) { const int nb = NGU / 64; const int n0 = 64 * (r % nb); const int drow = n0 < FF ? (n0 / 128) * 256 + (n0 % 128) : ((n0 - FF) / 128) * 256 + 128 + ((n0 - FF) % 128);
            p0_item(p.w_gate_up, NGU, 64 * (r / nb), n0, p.g_ffn, Wt_gu, D, drow, 0, scr, lane); continue; } r -= I_GU;
        { const int nb = D / 64; p0_item(p.w_down, D, 64 * (r / nb), 64 * (r % nb), nullptr, Wt_dn, FF, 64 * (r % nb), 0, scr, lane); }
    }
}
__device__ __forceinline__ void phase0b(const Params& p, int gw, int NGW, int lane) {
    bf16_t* XN = (bf16_t*)(p.ws + WS_XN); bf16_t* WPB = (bf16_t*)(p.ws + WS_WPB);
    for (int i = gw * 64 + lane; i < 4 * 256 * 256 / 8; i += NGW * 64) { const f32x4 a = *(const f32x4*)(p.w_pool + (size_t)i * 8), b = *(const f32x4*)(p.w_pool + (size_t)i * 8 + 4); *(u32x4*)(WPB + (size_t)i * 8) = pack8(a, b); }
    for (int m = gw; m < MT; m += NGW) {
        u32x2* o8 = (u32x2*)(XN + (size_t)m * D) + lane;
        if (m >= MV) {
#pragma unroll
            for (int j = 0; j < 8; ++j) o8[64 * j] = (u32x2){0u, 0u};
            continue; }
        const f32x4* xr = (const f32x4*)(m < MP ? p.x_prompt + (size_t)m * D : p.x_sample + (size_t)(m - MP) * D) + lane;
        f32x4 v[8]; float s = 0.f;
#pragma unroll
        for (int j = 0; j < 8; ++j) { v[j] = xr[64 * j]; s += (v[j].x * v[j].x + v[j].y * v[j].y) + (v[j].z * v[j].z + v[j].w * v[j].w); }
        const float rs = __builtin_amdgcn_rsqf(wave_sum(s) * (1.0f / D) + EPS);
#pragma unroll
        for (int j = 0; j < 8; ++j) o8[64 * j] = (u32x2){cvt_pk_bf16(v[j].x * rs, v[j].y * rs), cvt_pk_bf16(v[j].z * rs, v[j].w * rs)};
    }
    float* ssq = (float*)(p.ws + WS_SSQ);
    for (int i = gw * 64 + lane; i < MT; i += NGW * 64) ssq[i] = 0.f;
}

constexpr int VROW = 320;
__device__ __forceinline__ s16x4 vtr(const LAS unsigned char* p) { typedef short v4i16_t __attribute__((ext_vector_type(4))); return __builtin_bit_cast(s16x4, __builtin_amdgcn_ds_read_tr16_b64_v4i16((LAS v4i16_t*)p)); }
__device__ __forceinline__ bf16x8 cvt8(const f32x4& a, const f32x4& b) { u32x4 w = pack8(a, b); return __builtin_bit_cast(bf16x8, w); }

__device__ __forceinline__ void attn_unit(const Params& p, LAS unsigned char* vl, int unit, int lane) {
    const bf16_t* Ub = (const bf16_t*)(p.ws + WS_QKVU);
    const bf16_t* Qb = Ub + (size_t)MT * 1024; const bf16_t* Kb = Qb + (size_t)MT * 1024; const bf16_t* Vb = Kb + (size_t)MT * 1024;
    bf16_t* AO = (bf16_t*)(p.ws + WS_AO);
    const int n = lane & 31, hh = lane >> 5;
    const bool sample = unit < 64;
    int b, h, qrow0, nblk;
    if (sample) { b = unit >> 3; h = unit & 7; qrow0 = MP + b * DSEQ; nblk = 1 + PAST / 32; }
    else { const int u2 = unit - 64; const int qb = u2 & 127; h = (u2 >> 7) & 7; b = u2 >> 10; qrow0 = b * SEQ + qb * 32; nblk = qb + 1; }
    bf16x8 qf[8];
    { const bf16_t* qp = Qb + (size_t)(qrow0 + n) * 1024 + h * HD + 64 * hh;
#pragma unroll
      for (int kk = 0; kk < 8; ++kk) qf[kk] = *(const bf16x8*)(qp + 8 * kk); }
    f32x16 o[4];
#pragma unroll
    for (int db = 0; db < 4; ++db)
#pragma unroll
        for (int r = 0; r < 16; ++r) o[db][r] = 0.f;
    float R = (sample && n >= DSEQ) ? -1e30f : 0.f;
    const float* ck = p.cache_k + (size_t)b * PAST * 1024 + h * HD; const float* cv = p.cache_v + (size_t)b * PAST * 1024 + h * HD;
    const int vaddr = (4 * hh + ((lane & 15) >> 2)) * VROW + (16 * ((lane >> 4) & 1) + 4 * (lane & 3)) * 2;
    for (int blk = 0; blk < nblk; ++blk) {
        bf16x8 kf[8];
        const bool diag = (blk == 0);
        if (!sample || blk == 0) {
            const int s0 = qrow0 - blk * 32;
            const bf16_t* kp = Kb + (size_t)(s0 + n) * 1024 + h * HD + 64 * hh;
#pragma unroll
            for (int kk = 0; kk < 8; ++kk) kf[kk] = *(const bf16x8*)(kp + 8 * kk);
            const bf16_t* vp = Vb + (size_t)(s0 + (lane >> 4)) * 1024 + h * HD + 8 * (lane & 15);
#pragma unroll
            for (int it = 0; it < 8; ++it) { const u32x4 w = *(const u32x4*)(vp + (size_t)(4 * it) * 1024); *(LAS u32x4*)(vl + (4 * it + (lane >> 4)) * VROW + 16 * (lane & 15)) = w; }
        } else {
            const int s0 = PAST - blk * 32;
            const float* kp = ck + (size_t)(s0 + n) * 1024 + 64 * hh;
#pragma unroll
            for (int kk = 0; kk < 8; ++kk) kf[kk] = cvt8(*(const f32x4*)(kp + 8 * kk), *(const f32x4*)(kp + 8 * kk + 4));
            const float* vp = cv + (size_t)(s0 + (lane >> 4)) * 1024 + 8 * (lane & 15);
#pragma unroll
            for (int it = 0; it < 8; ++it) { const f32x4 a = *(const f32x4*)(vp + (size_t)(4 * it) * 1024), c = *(const f32x4*)(vp + (size_t)(4 * it) * 1024 + 4);
                *(LAS u32x4*)(vl + (4 * it + (lane >> 4)) * VROW + 16 * (lane & 15)) = pack8(a, c); }
        }
        f32x16 st;
#pragma unroll
        for (int r = 0; r < 16; ++r) st[r] = 0.f;
#pragma unroll
        for (int kk = 0; kk < 8; ++kk) st = __builtin_amdgcn_mfma_f32_32x32x16_bf16(kf[kk], qf[kk], st, 0, 0, 0);
        float l1m[16], ls[16];
#pragma unroll
        for (int r = 0; r < 16; ++r) { const int i = (r & 3) + 8 * (r >> 2) + 4 * hh; const bool valid = !diag || (i < n);
            const float z = st[r] * 0.08838834764831845f; const float sp = fmaxf(z, 0.f) + __logf(1.0f + __expf(-fabsf(z)));
            l1m[r] = valid ? -sp : 0.f; ls[r] = valid ? (z - sp) : -1e30f; }
        float gown[4], goth[4];
#pragma unroll
        for (int a = 0; a < 4; ++a) { gown[a] = (l1m[4 * a] + l1m[4 * a + 1]) + (l1m[4 * a + 2] + l1m[4 * a + 3]); goth[a] = __shfl_xor(gown[a], 32); }
        float wv[16]; float tail = R;
#pragma unroll
        for (int a = 3; a >= 0; --a) { float sfx = tail + (hh == 0 ? goth[a] : 0.f);
#pragma unroll
            for (int rr = 3; rr >= 0; --rr) { wv[4 * a + rr] = __expf(ls[4 * a + rr] + sfx); sfx += l1m[4 * a + rr]; }
            tail += gown[a] + goth[a]; }
        R = tail;
        bf16x8 wb[2];
#pragma unroll
        for (int s = 0; s < 2; ++s) wb[s] = cvt8((f32x4){wv[8 * s], wv[8 * s + 1], wv[8 * s + 2], wv[8 * s + 3]}, (f32x4){wv[8 * s + 4], wv[8 * s + 5], wv[8 * s + 6], wv[8 * s + 7]});
        asm volatile("s_waitcnt lgkmcnt(0)" ::: "memory");
#pragma unroll
        for (int db = 0; db < 4; ++db)
#pragma unroll
            for (int s = 0; s < 2; ++s) { const s16x4 lo = vtr(vl + vaddr + (16 * s) * VROW + 64 * db), hi = vtr(vl + vaddr + (16 * s + 8) * VROW + 64 * db);
                const bf16x8 vf = (bf16x8){lo[0], lo[1], lo[2], lo[3], hi[0], hi[1], hi[2], hi[3]};
                o[db] = __builtin_amdgcn_mfma_f32_32x32x16_bf16(vf, wb[s], o[db], 0, 0, 0); }
        asm volatile("s_waitcnt lgkmcnt(0)" ::: "memory");
        if (__all(R < -104.0f)) break;
    }
    if (!sample || n < DSEQ) {
        bf16_t* op = AO + (size_t)(qrow0 + n) * 2048 + 1024 + h * HD + 4 * hh;
#pragma unroll
        for (int db = 0; db < 4; ++db)
#pragma unroll
            for (int a = 0; a < 4; ++a) *(u32x2*)(op + 32 * db + 8 * a) = (u32x2){cvt_pk_bf16(o[db][4 * a], o[db][4 * a + 1]), cvt_pk_bf16(o[db][4 * a + 2], o[db][4 * a + 3])};
    }
}

__device__ __forceinline__ void diff_items(const Params& p, int gtid, int nthreads) {
    const bf16_t* Ub = (const bf16_t*)(p.ws + WS_QKVU); bf16_t* AO = (bf16_t*)(p.ws + WS_AO);
    for (int it = gtid; it < MV * 128; it += nthreads) {
        const int m = it >> 7, cc = it & 127, g = cc >> 5, w = 2 << g;
        const bf16_t* up = Ub + (size_t)m * 1024 + cc * 8;
        f32x4 s0 = (f32x4){0.f, 0.f, 0.f, 0.f}, s1 = s0, u0, u1; float cnt;
        { const u32x4 v = *(const u32x4*)up; unpack8(v, u0, u1); s0 = u0; s1 = u1; }
        if (m < MP) { const int t = m & (SEQ - 1); const int jn = t < w - 1 ? t : w - 1; cnt = (float)(jn + 1);
            for (int j = 1; j <= jn; ++j) { const u32x4 v = *(const u32x4*)(up - (size_t)j * 1024); f32x4 a, c; unpack8(v, a, c); s0 += a; s1 += c; } }
        else { const int t = (m - MP) & 15, b = (m - MP) >> 4; cnt = (float)w;
            for (int j = 1; j < w; ++j) { const int tj = t - j;
                if (tj >= 0) { const u32x4 v = *(const u32x4*)(up - (size_t)j * 1024); f32x4 a, c; unpack8(v, a, c); s0 += a; s1 += c; }
                else { const float* hp = p.state_pool + ((size_t)b * 15 + (15 + tj)) * 1024 + cc * 8; s0 += *(const f32x4*)hp; s1 += *(const f32x4*)(hp + 4); } } }
        const float ic = 1.0f / cnt;
        *(u32x4*)(AO + (size_t)m * 2048 + cc * 8) = pack8(s0 * ic - u0, s1 * ic - u1);
    }
}

__global__ void __launch_bounds__(512, 2) fwd_megakernel(Params p) {
    extern __shared__ __attribute__((aligned(16))) unsigned char lds_raw[];
    LAS unsigned char* lds = (LAS unsigned char*)lds_raw;
    const int tid = threadIdx.x, lane = tid & 63, wave = __builtin_amdgcn_readfirstlane(tid >> 6);
    const int G = gridDim.x, bx = blockIdx.x;
    const int vcu = (G % 8 == 0) ? (bx % 8) * (G / 8) + bx / 8 : bx;
    const int gw = vcu * 8 + wave, NGW = G * 8;
    cg::grid_group grid = cg::this_grid();
    volatile LAS unsigned* xst = (volatile LAS unsigned*)(lds + LDS_BYTES - 64);
    if (tid < 2) xst[tid] = 0u;
    __syncthreads();
    XcdBarrier xbar = xcd_barrier_post((unsigned*)(p.ws + WS_BAR), xst);
#define IN(k) (p.ph_lo <= (k) && (k) < p.ph_hi)
#define SEAM(k) do { if (IN(k) && IN((k) + 1)) { if (p.ph_hi > 64) grid.sync();   xcd_barrier(xbar); } STAMP(); } while (0)
    bf16_t* Wt_in = (bf16_t*)(p.ws + WS_WIN); bf16_t* Wt_br = (bf16_t*)(p.ws + WS_WBR); bf16_t* Wt_out = (bf16_t*)(p.ws + WS_WOUT);
    bf16_t* Wt_gu = (bf16_t*)(p.ws + WS_WGU); bf16_t* Wt_dn = (bf16_t*)(p.ws + WS_WDN); bf16_t* XN = (bf16_t*)(p.ws + WS_XN);
    bf16_t* QKVU = (bf16_t*)(p.ws + WS_QKVU); bf16_t* GATE = (bf16_t*)(p.ws + WS_GATE); bf16_t* AO = (bf16_t*)(p.ws + WS_AO);
    bf16_t* MERGED = (bf16_t*)(p.ws + WS_MERGED); bf16_t* HID = (bf16_t*)(p.ws + WS_HID); float* SSQ = (float*)(p.ws + WS_SSQ);
    float* Y = p.out + OFF_Y;
#ifdef PROBE_T
    unsigned long long tstamp[10]; int nst = 0;
#define STAMP() do { tstamp[nst++] = __builtin_amdgcn_s_memrealtime(); } while (0)
#else
#define STAMP() do {} while (0)
#endif
    STAMP();

    if (IN(0)) { phase0(p, lds, gw, NGW, wave, lane);
#ifdef PROBE_T
#endif
        phase0b(p, gw, NGW, lane);
#ifdef PROBE_T
        asm volatile("s_waitcnt vmcnt(0)" ::: "memory");
        if (lane == 0) atomicMax((long long*)(p.ws + WS_SSQ + 512 * 1024), (long long)__builtin_amdgcn_s_memrealtime());
#endif
    }
    SEAM(0);
    if (IN(1)) { pg8::Gemm g{XN, Wt_in, D, D, MT, NIN, D}; pg8::StaticOrder S; S.init(64, NIN / 256, D / 64, G, bx, 64, 1); EpiIn E{QKVU, GATE, p.out}; pg8::gemm_phase(lds, g, S, E); }
    SEAM(1);
    if (IN(2)) {
        LAS unsigned char* vl = lds + wave * (32 * VROW);
#ifndef SKIP_ATTN
        for (int u = gw; u < 64 + 4096; u += NGW) attn_unit(p, vl, __builtin_amdgcn_readfirstlane(u), lane);
#else
        for (int it = gw * 64 + lane; it < MV * 128; it += NGW * 64) *(u32x4*)(AO + (size_t)(it >> 7) * 2048 + 1024 + (it & 127) * 8) = (u32x4){0u, 0u, 0u, 0u};
#endif
        diff_items(p, (NGW - 1 - gw) * 64 + lane, NGW * 64);
        __syncthreads();
        for (int gq = 0; gq < 4; ++gq) { pg8::Gemm g{(const bf16_t*)(p.ws + WS_TMPA) + gq * 256, (const bf16_t*)(p.ws + WS_WPB) + gq * 65536, 1024, 256, 2048, 256, 256};
            pg8::StaticOrder S; S.init(8, 1, 4, G, (bx + G - 8 * gq) % G); EpiWA E{Wt_br + gq * 256}; pg8::gemm_phase(lds, g, S, E); }
    }
    SEAM(2);
    if (IN(3)) {
        { pg8::Gemm g{AO, Wt_br, 2048, 2048, MT, D, 1024}; pg8::StaticOrder S; S.init(64, 8, 16, G, bx, 64, 1); EpiBrA E{GATE, Y}; pg8::gemm_phase(lds, g, S, E); }
        { pg8::Gemm g{AO + 1024, Wt_br + 1024, 2048, 2048, MT, D, 1024}; pg8::StaticOrder S; S.init(64, 8, 16, G, bx, 64, 1); EpiBrB E{GATE, Y, MERGED}; pg8::gemm_phase(lds, g, S, E); }
    }
    SEAM(3);
    if (IN(4)) { pg8::Gemm g{MERGED, Wt_out, D, D, MT, D, D}; pg8::StaticOrder S; S.init(64, 8, 32, G, bx, 64, 1); EpiOut E{p.x_prompt, p.x_sample, Y, XN, SSQ}; pg8::gemm_phase(lds, g, S, E); }
    SEAM(4);
    if (IN(5)) { pg8::Gemm g{XN, Wt_gu, D, D, MT, NGU, D}; pg8::StaticOrder S; S.init(64, NGU / 256, 32, G, bx, 64, 1); EpiGU E{SSQ, HID}; pg8::gemm_phase(lds, g, S, E); }
    SEAM(5);
    if (IN(6)) { pg8::Gemm g{HID, Wt_dn, FF, FF, MT, D, FF}; pg8::StaticOrder S; S.init(64, 8, FF / 64, G, bx, 64, 11); EpiDown E{Y}; pg8::gemm_phase(lds, g, S, E); }
    SEAM(6);
    if (IN(7)) {
        for (int m = gw; m < MV; m += NGW) {
            f32x4* yr = (f32x4*)(Y + (size_t)m * D) + lane; const f32x4* gf = (const f32x4*)p.g_final + lane;
            f32x4 v[8]; float s = 0.f;
#pragma unroll
            for (int j = 0; j < 8; ++j) { v[j] = yr[64 * j]; s += (v[j].x * v[j].x + v[j].y * v[j].y) + (v[j].z * v[j].z + v[j].w * v[j].w); }
            const float rs = __builtin_amdgcn_rsqf(wave_sum(s) * (1.0f / D) + EPS);
#pragma unroll
            for (int j = 0; j < 8; ++j) yr[64 * j] = v[j] * rs * gf[64 * j];
        }
    }
#ifdef PROBE_T
    if (bx == 0 && tid == 0) { tstamp[8] = (unsigned long long)__hip_atomic_load((long long*)(p.ws + WS_SSQ + 512 * 1024), __ATOMIC_RELAXED, __HIP_MEMORY_SCOPE_AGENT);
        const float ta = (float)(tstamp[8] - tstamp[0]) * 0.01f, tb = (float)(tstamp[PROBE_B + 1] - tstamp[PROBE_B]) * 0.01f;
        asm volatile("s_waitcnt vmcnt(0)" ::: "memory");
        atomicAdd(Y, 4.0f + ta * (1.0f / 256.0f)); atomicAdd(p.out + OFF_PP, 1.5f + tb * (1.0f / 500.0f));
    }
#endif
#undef IN
#undef SEAM
}

extern "C" void kernel_launch(void* const* d_in, const int* in_sizes, int n_in, void* d_out, int out_size, void* d_ws, size_t ws_size, hipStream_t stream) {
    static int grid = 0;
    if (grid == 0) {
        if (n_in != 15 || (size_t)out_size != OUT_TOTAL || ws_size < WS_END) { fprintf(stderr, "kernel_launch: unexpected shapes: n_in %d out %d ws %zu\n", n_in, out_size, ws_size); grid = -1; return; }
        int dev = 0, cus = 0, per_cu = 0;
        hipGetDevice(&dev); hipDeviceGetAttribute(&cus, hipDeviceAttributeMultiprocessorCount, dev);
        hipFuncSetAttribute((const void*)fwd_megakernel, hipFuncAttributeMaxDynamicSharedMemorySize, LDS_BYTES);
        hipOccupancyMaxActiveBlocksPerMultiprocessor(&per_cu, (const void*)fwd_megakernel, 512, LDS_BYTES);
        if (per_cu < 1) { fprintf(stderr, "kernel_launch: occupancy query says %d blocks per CU\n", per_cu); per_cu = 1; }
        (void)hipGetLastError();
        grid = cus;
    }
    if (grid < 0) return;
    Params p{};
    const float** pp = (const float**)&p;
    for (int i = 0; i < 15; ++i) pp[i] = (const float*)d_in[i];
    p.out = (float*)d_out; p.ws = (unsigned char*)d_ws;
#if N_LAUNCH_MODE == 1
    p.ph_lo = 0; p.ph_hi = 8;
    void* args[] = {&p};
    if (hipMemsetAsync((char*)d_ws + WS_BAR, 0, WS_BAR_BYTES, stream) != hipSuccess) fprintf(stderr, "kernel_launch: memset of the barrier words failed\n");
    hipError_t e = hipLaunchCooperativeKernel((const void*)fwd_megakernel, dim3(grid), dim3(512), args, LDS_BYTES, stream);
    if (e != hipSuccess) fprintf(stderr, "cooperative launch failed: %s (grid %d)\n", hipGetErrorString(e), grid);
#else
    for (int ph = 0; ph < 8; ++ph) { p.ph_lo = ph; p.ph_hi = ph + 1; hipLaunchKernelGGL(fwd_megakernel, dim3(grid), dim3(512), LDS_BYTES, stream, p); }
#endif
}
```

```cpp
#include <hip/hip_runtime.h>
#include <hip/hip_cooperative_groups.h>
#include <cstdio>
#include <cstdint>
namespace cg = cooperative_groups;

#define PROBE_A 3
#define PROBE_B 2
#ifndef N_LAUNCH_MODE
#define N_LAUNCH_MODE 1
#endif

#define LAS __attribute__((address_space(3)))
typedef unsigned short bf16_t;
typedef short bf16x8 __attribute__((ext_vector_type(8)));
typedef short s16x4 __attribute__((ext_vector_type(4)));
typedef float f32x4 __attribute__((ext_vector_type(4)));
typedef float f32x16 __attribute__((ext_vector_type(16)));
typedef unsigned u32x4 __attribute__((ext_vector_type(4)));
typedef unsigned u32x2 __attribute__((ext_vector_type(2)));

constexpr int D = 2048, MP = 16384, MS = 128, MV = MP + MS, MT = 16640;
constexpr int SEQ = 4096, DSEQ = 16, PAST = 4096, NH = 8, HD = 128;
constexpr int NIN = 8192, FF = 5632, NGU = 2 * FF, AW = 1024;
constexpr float EPS = 1e-6f;
constexpr size_t OFF_Y = 0, OFF_KP = (size_t)MV * D, OFF_VP = OFF_KP + (size_t)MP * 1024, OFF_PP = OFF_VP + (size_t)MP * 1024,
                 OFF_KS = OFF_PP + 4 * 15 * 1024, OFF_VS = OFF_KS + (size_t)MS * 1024, OFF_PS = OFF_VS + (size_t)MS * 1024, OUT_TOTAL = OFF_PS + 8 * 15 * 1024;
constexpr size_t MiB = 1u << 20;
constexpr size_t WS_SSQ = 0, WS_WIN = 1 * MiB, WS_WBR = 33 * MiB, WS_WOUT = 41 * MiB, WS_WGU = 49 * MiB, WS_WDN = 93 * MiB, WS_XN = 115 * MiB,
                 WS_QKVU = 180 * MiB, WS_GATE = 310 * MiB, WS_AO = 440 * MiB, WS_TMPA = 505 * MiB, WS_WPB = 509 * MiB, WS_END = 510 * MiB;
constexpr size_t WS_BAR = 768 * 1024, WS_BAR_BYTES = 16384;
constexpr size_t WS_MERGED = WS_QKVU;
constexpr size_t WS_HID = WS_QKVU;
static_assert((size_t)MT * FF * 2 <= WS_AO - WS_QKVU, "hid overlay");
constexpr int LDS_BYTES = 147456;

typedef __bf16 bf16x2_t __attribute__((ext_vector_type(2)));
typedef float f32x2_t __attribute__((ext_vector_type(2)));
__device__ __forceinline__ unsigned cvt_pk_bf16(float lo, float hi) { const f32x2_t v = {lo, hi}; return __builtin_bit_cast(unsigned, __builtin_convertvector(v, bf16x2_t)); }
__device__ __forceinline__ float bf2f(unsigned short b) { return __uint_as_float(((unsigned)b) << 16); }
__device__ __forceinline__ float bflo(unsigned w) { return __uint_as_float(w << 16); }
__device__ __forceinline__ float bfhi(unsigned w) { return __uint_as_float(w & 0xffff0000u); }
__device__ __forceinline__ float fast_sigmoid(float x) { return __builtin_amdgcn_rcpf(1.0f + __expf(-x)); }
__device__ __forceinline__ float wave_sum(float v) {
#pragma unroll
    for (int o = 1; o < 64; o <<= 1) v += __shfl_xor(v, o);
    return v;
}

#define XB_TMO      128
#define XB_XCNT(j)  (256  + 64 * (j))
#define XB_XSUB(j)  (1280 + 64 * (j))
#define XB_XGEN(j)  (2304 + 64 * (j))
#define XB_TOP      3328
#define XB_TOPGEN   3392
#define XCD_BAR_WORDS 3456
#define XB_SPIN_CAP (1u << 18)

__device__ __forceinline__ unsigned xb_ld(unsigned* p)              { return __hip_atomic_load(p, __ATOMIC_RELAXED, __HIP_MEMORY_SCOPE_AGENT); }
__device__ __forceinline__ unsigned xb_add(unsigned* p, unsigned v) { return __hip_atomic_fetch_add(p, v, __ATOMIC_RELAXED, __HIP_MEMORY_SCOPE_AGENT); }
__device__ __forceinline__ unsigned xb_xcc_id() { return (unsigned)__builtin_amdgcn_s_getreg((3 << 11) | 20) & 0xFu; }
#define XB_SPIN(cond, bar) do { unsigned _sp = 0; while (cond) { __builtin_amdgcn_s_sleep(1); \
    if ((++_sp & 255u) == 0u) { if (xb_ld(&(bar)[XB_TMO])) break; if (_sp > XB_SPIN_CAP) { atomicAdd(&(bar)[XB_TMO], 1u); break; } } } } while (0)

struct XcdBarrier {
    unsigned* bar; unsigned x;
    volatile LAS unsigned* st;
};

__device__ __forceinline__ XcdBarrier xcd_barrier_post(unsigned* bar, volatile LAS unsigned* st) {
    XcdBarrier b; b.bar = bar; b.x = xb_xcc_id(); b.st = st;
    if (threadIdx.x == 0) (void)xb_add(&bar[XB_XCNT(b.x)], 1u);
    return b;
}
__device__ __forceinline__ void xcd_barrier_complete(unsigned* bar, unsigned x, unsigned& nloc, unsigned& nx) {
    const unsigned G = gridDim.x * gridDim.y * gridDim.z;
    unsigned sum, cnt, mine, sp = 0u;
    for (;;) {
        sum = 0u; cnt = 0u; mine = 0u;
#pragma unroll
        for (unsigned j = 0; j < 16; ++j) { const unsigned c = xb_ld(&bar[XB_XCNT(j)]); sum += c; cnt += (c > 0u) ? 1u : 0u; mine = (j == x) ? c : mine; }
        if (sum == G) break;
        __builtin_amdgcn_s_sleep(1);
        if ((++sp & 255u) == 0u) { if (xb_ld(&bar[XB_TMO])) break; if (sp > XB_SPIN_CAP) { atomicAdd(&bar[XB_TMO], 1u); break; } }
    }
    nloc = mine > 0u ? mine : 1u; nx = cnt > 0u ? cnt : 1u;
}

__device__ __forceinline__ void xcd_barrier(const XcdBarrier& b) {
    asm volatile("s_waitcnt vmcnt(0)" ::: "memory");
    __syncthreads();
    if (threadIdx.x == 0) {
        unsigned* bar = b.bar;
        __builtin_amdgcn_s_waitcnt(0);
        unsigned nloc = b.st[0], nx = b.st[1];
        if (nloc == 0u) { xcd_barrier_complete(bar, b.x, nloc, nx); b.st[0] = nloc; b.st[1] = nx; }
        const unsigned old = xb_add(&bar[XB_XSUB(b.x)], 1u);
        const unsigned gen = old / nloc;
        if (old + 1u == (gen + 1u) * nloc) {
            __builtin_amdgcn_fence(__ATOMIC_RELEASE, "agent");
            asm volatile("s_waitcnt vmcnt(0)" ::: "memory");
            const unsigned og = xb_add(&bar[XB_TOP], 1u);
            const unsigned tg = og / nx;
            if (og + 1u == (tg + 1u) * nx) xb_add(&bar[XB_TOPGEN], 1u);
            else XB_SPIN(xb_ld(&bar[XB_TOPGEN]) == tg, bar);
            __builtin_amdgcn_fence(__ATOMIC_ACQUIRE, "agent");
            xb_add(&bar[XB_XGEN(b.x)], 1u);
            asm volatile("s_waitcnt vmcnt(0)" ::: "memory");
        } else {
            XB_SPIN(xb_ld(&bar[XB_XGEN(b.x)]) == gen, bar);
            __builtin_amdgcn_fence(__ATOMIC_ACQUIRE, "agent");
            asm volatile("s_waitcnt vmcnt(0)" ::: "memory");
        }
    }
    __syncthreads();
}

namespace pg8 {
constexpr int BM = 256, BK = 64, HALF = 128, HTB = HALF * BK * 2, STAGE_BYTES = 8 * HTB, NXCD = 8, WGM = 8;
__host__ __device__ __forceinline__ int lds_byte(int r, int c) { const int st = (r >> 4) * 2 + (c >> 5), rr = r & 15, cc = c & 31, ob = rr * 64 + cc * 2; return st * 1024 + (ob ^ (((ob >> 9) & 1) << 5)); }
__host__ __device__ __forceinline__ void stage_rc(int b, int& R, int& C) { const int st = b / 1024, sb = b % 1024, swz = sb ^ (((sb >> 9) & 1) << 5); R = (st >> 1) * 16 + swz / 64; C = (st & 1) * 32 + (swz % 64) / 2; }
__host__ __device__ __forceinline__ int perm32(int rho) { const int n = rho >> 4, i = rho & 15; return 8 * (i >> 2) + 4 * n + (i & 3); }

struct Unit { int pm, pn, kt0, nkt, half; };
struct Gemm { const bf16_t* A; const bf16_t* Bt; int lda, ldb, M, N, K; };

struct StaticOrder {
    int nM, nN, nwg, G, c, ktfull, pmS, nS, ktS;
    __device__ void init(int nM_, int nN_, int ktfull_, int G_, int c_, int pmS_ = 0, int ksplit = 0) { nM = nM_; nN = nN_; nwg = nM * nN; G = G_; c = c_; ktfull = ktfull_; pmS = pmS_; nS = nN * ksplit; ktS = ksplit ? ktfull / ksplit : 0; }
    __device__ bool next(int i, Unit& u) const {
        const int L = i * G + c;
        if (L >= nwg) { const int t = L - nwg;
            if (t >= nS) return false;
            u.pm = pmS; u.pn = t % nN; u.kt0 = (t / nN) * ktS; u.nkt = ktS; u.half = 1; return true; }
        int wgid = L; { const int q = nwg / NXCD, r = nwg % NXCD, xcd = wgid % NXCD, off = wgid / NXCD; wgid = (xcd < r ? xcd * (q + 1) : r * (q + 1) + (xcd - r) * q) + off; }
        const int nig = WGM * nN, gid = wgid / nig, fm = gid * WGM, gsz = (nM - fm) < WGM ? (nM - fm) : WGM;
        u.pm = fm + ((wgid % nig) % gsz); u.pn = (wgid % nig) / gsz; u.kt0 = 0; u.nkt = ktfull; u.half = 0; return true;
    }
};

template <class Epi>
__device__ __forceinline__ void gemm_phase(LAS unsigned char* lds, const Gemm g, const StaticOrder& S, const Epi& E) {
    int tid_ = threadIdx.x; asm volatile("" : "+v"(tid_));
    const int tid = tid_, wid = __builtin_amdgcn_readfirstlane(tid >> 6), lane = tid & 63, wr = wid >> 2, wc = wid & 3, fr = lane & 15, fq = lane >> 4;
    unsigned voffA[2], voffB[2];
#pragma unroll
    for (int i = 0; i < 2; ++i) { int R, C; stage_rc(tid * 16 + i * 8192, R, C); const int Rb = (R & ~31) + perm32(R & 31);
        voffA[i] = (unsigned)(R * g.lda + C) * 2u; voffB[i] = (unsigned)(Rb * g.ldb + C) * 2u; }
    const size_t kstep = (size_t)(BK * 2);
    const size_t hstepA = (size_t)HALF * g.lda * 2, hstepB = (size_t)HALF * g.ldb * 2;
    const size_t tstepA = 2 * hstepA, tstepB = 2 * hstepB;
    const unsigned ldsw = (unsigned)wid * 1024u;
    const int aoff = lds_byte(wr * 64 + fr, fq * 8), boff = lds_byte(wc * 32 + fr, fq * 8);
#define PG8_SA(b, h) (((b) * 2 + (h)) * HTB)
#define PG8_SB(b, h) ((4 + (b) * 2 + (h)) * HTB)
#define PG8_STAGE(bufoff, gbase, voff) do { _Pragma("unroll") for (int _i = 0; _i < 2; ++_i) \
        __builtin_amdgcn_global_load_lds((const unsigned*)((const char*)(gbase) + (voff)[_i]), (LAS unsigned*)(lds + (bufoff) + ldsw + _i * 8192), 16, 0, 0); } while (0)
#define PG8_LDA(dst, b, h) do { _Pragma("unroll") for (int m = 0; m < 4; ++m) _Pragma("unroll") for (int k = 0; k < 2; ++k) dst[m][k] = *(const LAS bf16x8*)(lds + PG8_SA(b, h) + aoff + m * 2048 + k * 1024); } while (0)
#define PG8_LDB(dst, b, h) do { _Pragma("unroll") for (int n = 0; n < 2; ++n) _Pragma("unroll") for (int k = 0; k < 2; ++k) dst[n][k] = *(const LAS bf16x8*)(lds + PG8_SB(b, h) + boff + n * 2048 + k * 1024); } while (0)
#define PG8_MMA(ai, bj, At, Bt) do { __builtin_amdgcn_s_setprio(1); _Pragma("unroll") for (int m = 0; m < 4; ++m) _Pragma("unroll") for (int n = 0; n < 2; ++n) _Pragma("unroll") for (int k = 0; k < 2; ++k) \
        acc[ai][bj][m][n] = __builtin_amdgcn_mfma_f32_16x16x32_bf16(Bt[n][k], At[m][k], acc[ai][bj][m][n], 0, 0, 0); __builtin_amdgcn_s_setprio(0); } while (0)
#define PG8_WAIT_V(n) asm volatile("s_waitcnt vmcnt(" #n ")" ::: "memory")
#define PG8_WAIT_L(n) asm volatile("s_waitcnt lgkmcnt(" #n ")" ::: "memory")
#define PG8_BAR __builtin_amdgcn_s_barrier()
#define PG8_SCHED __builtin_amdgcn_sched_barrier(0)
    Unit cur, nxt; int ui = 0;
    if (!S.next(0, cur)) return;
    f32x4 acc[2][2][4][2];
#pragma unroll
    for (int a = 0; a < 2; ++a)
#pragma unroll
        for (int b = 0; b < 2; ++b)
#pragma unroll
            for (int m = 0; m < 4; ++m)
#pragma unroll
                for (int n = 0; n < 2; ++n) acc[a][b][m][n] = (f32x4){0.f, 0.f, 0.f, 0.f};
    bf16x8 At[4][2], B0[2][2], B1[2][2];
    const char* cA = (const char*)g.A + (size_t)cur.pm * tstepA + (size_t)cur.kt0 * kstep; const char* cB = (const char*)g.Bt + (size_t)cur.pn * tstepB + (size_t)cur.kt0 * kstep;
    PG8_STAGE(PG8_SB(0, 0), cB, voffB); PG8_STAGE(PG8_SB(0, 1), cB + hstepB, voffB); PG8_STAGE(PG8_SA(0, 0), cA, voffA); PG8_STAGE(PG8_SA(0, 1), cA + hstepA, voffA);
    if (wr == 1) PG8_BAR;
    PG8_WAIT_V(2); PG8_BAR;
    PG8_STAGE(PG8_SB(1, 0), cB + kstep, voffB); PG8_STAGE(PG8_SA(1, 0), cA + kstep, voffA); PG8_STAGE(PG8_SB(1, 1), cB + hstepB + kstep, voffB);
    PG8_WAIT_V(6); PG8_BAR;
    for (;;) {
        const bool has_next = S.next(ui + 1, nxt);
        const char* nA = has_next ? (const char*)g.A + (size_t)nxt.pm * tstepA + (size_t)nxt.kt0 * kstep : cA; const char* nB = has_next ? (const char*)g.Bt + (size_t)nxt.pn * tstepB + (size_t)nxt.kt0 * kstep : cB;
        const int nt = cur.nkt; const bool full = !cur.half;
        for (int t = 0; t < nt; t += 2) {
            const bool last = (t == nt - 2);
            if constexpr (Epi::HAS_MID) { if (t == (nt >> 1)) E.mid(acc, cur, wr, wc, fr, fq); }
            const char* a1 = cA + (size_t)(t + 1) * kstep;
            const char* a2 = last ? nA : cA + (size_t)(t + 2) * kstep; const char* b2 = last ? nB : cB + (size_t)(t + 2) * kstep;
            const char* a3 = a2 + kstep; const char* b3 = b2 + kstep;
            PG8_LDB(B0, 0, 0); PG8_LDB(B1, 0, 1); PG8_SCHED; PG8_LDA(At, 0, 0); PG8_STAGE(PG8_SA(1, 1), a1 + hstepA, voffA);
            PG8_WAIT_V(8); PG8_WAIT_L(0); PG8_BAR; PG8_MMA(0, 0, At, B0); PG8_MMA(0, 1, At, B1); PG8_BAR; PG8_SCHED;
            if (full) PG8_LDA(At, 0, 1); PG8_STAGE(PG8_SB(0, 0), b2, voffB); PG8_STAGE(PG8_SB(0, 1), b2 + hstepB, voffB); PG8_STAGE(PG8_SA(0, 0), a2, voffA);
            PG8_WAIT_V(8); PG8_WAIT_L(0); PG8_BAR; if (full) { PG8_MMA(1, 0, At, B0); PG8_MMA(1, 1, At, B1); } PG8_BAR; PG8_SCHED;
            PG8_LDB(B0, 1, 0); PG8_LDB(B1, 1, 1); PG8_SCHED; PG8_LDA(At, 1, 0); PG8_STAGE(PG8_SA(0, 1), a2 + hstepA, voffA);
            PG8_WAIT_V(8); PG8_WAIT_L(0); PG8_BAR; PG8_MMA(0, 0, At, B0); PG8_MMA(0, 1, At, B1); PG8_BAR; PG8_SCHED;
            if (full) PG8_LDA(At, 1, 1); PG8_STAGE(PG8_SB(1, 0), b3, voffB); PG8_STAGE(PG8_SB(1, 1), b3 + hstepB, voffB); PG8_STAGE(PG8_SA(1, 0), a3, voffA);
            PG8_WAIT_V(8); PG8_WAIT_L(0); PG8_BAR; if (full) { PG8_MMA(1, 0, At, B0); PG8_MMA(1, 1, At, B1); } PG8_BAR; PG8_SCHED;
        }
        if (wr == 0) PG8_BAR;
        E(acc, cur, wr, wc, fr, fq);
        if (!has_next) break;
#pragma unroll
        for (int a = 0; a < 2; ++a)
#pragma unroll
            for (int b = 0; b < 2; ++b)
#pragma unroll
                for (int m = 0; m < 4; ++m)
#pragma unroll
                    for (int n = 0; n < 2; ++n) acc[a][b][m][n] = (f32x4){0.f, 0.f, 0.f, 0.f};
        cur = nxt; cA = nA; cB = nB; ++ui;
        if (wr == 1) PG8_BAR;
    }
    PG8_WAIT_V(0);
    PG8_BAR;
#undef PG8_SA
#undef PG8_SB
#undef PG8_STAGE
#undef PG8_LDA
#undef PG8_LDB
#undef PG8_MMA
#undef PG8_WAIT_V
#undef PG8_WAIT_L
#undef PG8_BAR
#undef PG8_SCHED
}
}
using pg8::Unit;

__device__ __forceinline__ u32x4 pack8(const f32x4& v0, const f32x4& v1) {
    u32x4 w; w.x = cvt_pk_bf16(v0[0], v0[1]); w.y = cvt_pk_bf16(v0[2], v0[3]); w.z = cvt_pk_bf16(v1[0], v1[1]); w.w = cvt_pk_bf16(v1[2], v1[3]); return w;
}
__device__ __forceinline__ void unpack8(const u32x4& w, f32x4& v0, f32x4& v1) {
    v0 = (f32x4){bflo(w.x), bfhi(w.x), bflo(w.y), bfhi(w.y)}; v1 = (f32x4){bflo(w.z), bfhi(w.z), bflo(w.w), bfhi(w.w)};
}

struct EpiIn {
    static constexpr bool HAS_MID = false;
    bf16_t* qkvu; bf16_t* gate; float* out;
    __device__ __forceinline__ void operator()(const f32x4 (&acc)[2][2][4][2], const Unit& u, int wr, int wc, int fr, int fq) const {
        const int row0 = u.pm * 256 + wr * 64 + fr, cw = wc * 32 + 8 * fq;
        if (u.pn >= 16) {
            bf16_t* base = gate + (size_t)row0 * 4096 + (u.pn - 16) * 128 + cw;
#pragma unroll
            for (int ai = 0; ai < 2; ++ai)
#pragma unroll
                for (int m = 0; m < 4; ++m) { bf16_t* rowp = base + (size_t)(ai * 128 + m * 16) * 4096;
                    f32x4 r0, r1, b0, b1;
#pragma unroll
                    for (int j = 0; j < 4; ++j) { b0[j] = fmaxf(fast_sigmoid(acc[ai][1][m][0][j]), 1e-30f); b1[j] = fmaxf(fast_sigmoid(acc[ai][1][m][1][j]), 1e-30f);
                        r0[j] = fast_sigmoid(acc[ai][0][m][0][j]) * __builtin_amdgcn_rcpf(b0[j]); r1[j] = fast_sigmoid(acc[ai][0][m][1][j]) * __builtin_amdgcn_rcpf(b1[j]); }
                    *(u32x4*)rowp = pack8(r0, r1); *(u32x4*)(rowp + 2048) = pack8(b0, b1); }
        } else {
            const int sec = u.pn >> 2, cc = (u.pn & 3) * 256 + cw;
            bf16_t* base = qkvu + (size_t)sec * MT * 1024 + (size_t)row0 * 1024 + cc;
#pragma unroll
            for (int ai = 0; ai < 2; ++ai)
#pragma unroll
                for (int m = 0; m < 4; ++m) { bf16_t* rowp = base + (size_t)(ai * 128 + m * 16) * 1024;
#pragma unroll
                    for (int bj = 0; bj < 2; ++bj) *(u32x4*)(rowp + bj * 128) = pack8(acc[ai][bj][m][0], acc[ai][bj][m][1]); }
            if (sec >= 2) {
                const size_t offp = (sec == 2) ? OFF_KP : OFF_VP, offs = (sec == 2) ? OFF_KS : OFF_VS;
#pragma unroll
                for (int ai = 0; ai < 2; ++ai)
#pragma unroll
                    for (int m = 0; m < 4; ++m) { const int row = row0 + ai * 128 + m * 16;
                        if (row < MV) { float* o = out + (row < MP ? offp + (size_t)row * 1024 : offs + (size_t)(row - MP) * 1024) + cc;
#pragma unroll
                            for (int bj = 0; bj < 2; ++bj) { *(f32x4*)(o + bj * 128) = acc[ai][bj][m][0]; *(f32x4*)(o + bj * 128 + 4) = acc[ai][bj][m][1]; } } }
            } else if (sec == 0 && ((u.pm & 15) == 15 || u.pm == 64)) {
#pragma unroll
                for (int ai = 0; ai < 2; ++ai)
#pragma unroll
                    for (int m = 0; m < 4; ++m) { const int row = row0 + ai * 128 + m * 16; long off = -1;
                        if (row < MP) { const int t = row & (SEQ - 1); if (t >= SEQ - 15) off = (long)OFF_PP + ((long)(row >> 12) * 15 + (t - (SEQ - 15))) * 1024; }
                        else if (row < MV) { const int t = (row - MP) & 15, b = (row - MP) >> 4; if (t >= 1) off = (long)OFF_PS + ((long)b * 15 + (t - 1)) * 1024; }
                        if (off >= 0) { float* o = out + off + cc;
#pragma unroll
                            for (int bj = 0; bj < 2; ++bj) { *(f32x4*)(o + bj * 128) = acc[ai][bj][m][0]; *(f32x4*)(o + bj * 128 + 4) = acc[ai][bj][m][1]; } } }
            }
        }
    }
};
struct EpiMerged {
    static constexpr bool HAS_MID = true;
    const bf16_t* gate; bf16_t* merged;
    __device__ __forceinline__ void mid(f32x4 (&acc)[2][2][4][2], const Unit& u, int wr, int wc, int fr, int fq) const {
        int zoff = 0; asm volatile("" : "+v"(zoff));
        const int row0 = u.pm * 256 + wr * 64 + fr + zoff, cc = u.pn * 256 + wc * 32 + 8 * fq;
#pragma unroll
        for (int ai = 0; ai < 2; ++ai) {
            if (ai == 1 && u.half) break;
            u32x4 rw[4][2];
#pragma unroll
            for (int m = 0; m < 4; ++m)
#pragma unroll
                for (int bj = 0; bj < 2; ++bj) rw[m][bj] = *(const u32x4*)(gate + (size_t)(row0 + ai * 128 + m * 16) * 4096 + cc + bj * 128);
#pragma unroll
            for (int m = 0; m < 4; ++m)
#pragma unroll
                for (int bj = 0; bj < 2; ++bj) { f32x4 a0, a1; unpack8(rw[m][bj], a0, a1); acc[ai][bj][m][0] *= a0; acc[ai][bj][m][1] *= a1; }
            __builtin_amdgcn_sched_barrier(0);
        }
    }
    __device__ __forceinline__ void operator()(const f32x4 (&acc)[2][2][4][2], const Unit& u, int wr, int wc, int fr, int fq) const {
        const int row0 = u.pm * 256 + wr * 64 + fr, cc = u.pn * 256 + wc * 32 + 8 * fq;
#pragma unroll
        for (int ai = 0; ai < 2; ++ai)
#pragma unroll
            for (int m = 0; m < 4; ++m) { const int row = row0 + ai * 128 + m * 16;
                const bf16_t* gp = gate + (size_t)row * 4096 + 2048 + cc; bf16_t* o = merged + (size_t)row * D + cc;
#pragma unroll
                for (int bj = 0; bj < 2; ++bj) { const u32x4 gw = *(const u32x4*)(gp + bj * 128); f32x4 g0, g1; unpack8(gw, g0, g1);
                    *(u32x4*)(o + bj * 128) = pack8(acc[ai][bj][m][0] * g0, acc[ai][bj][m][1] * g1); } }
    }
};
struct EpiOut {
    static constexpr bool HAS_MID = false;
    const float* xp; const float* xs; float* y; bf16_t* hb; float* ssq;
    __device__ __forceinline__ void operator()(const f32x4 (&acc)[2][2][4][2], const Unit& u, int wr, int wc, int fr, int fq) const {
        const int row0 = u.pm * 256 + wr * 64 + fr, cc = u.pn * 256 + wc * 32 + 8 * fq;
#pragma unroll
        for (int ai = 0; ai < 2; ++ai)
#pragma unroll
            for (int m = 0; m < 4; ++m) { const int row = row0 + ai * 128 + m * 16; const bool ok = row < MV;
                const float* xr = (row < MP ? xp + (size_t)row * D : xs + (size_t)(row - MP) * D) + cc; float* o = y + (size_t)row * D + cc; bf16_t* ob = hb + (size_t)row * D + cc;
                float s = 0.f;
#pragma unroll
                for (int bj = 0; bj < 2; ++bj) { f32x4 h0 = acc[ai][bj][m][0], h1 = acc[ai][bj][m][1];
                    if (ok) { h0 += *(const f32x4*)(xr + bj * 128); h1 += *(const f32x4*)(xr + bj * 128 + 4); *(f32x4*)(o + bj * 128) = h0; *(f32x4*)(o + bj * 128 + 4) = h1; }
                    *(u32x4*)(ob + bj * 128) = pack8(h0, h1);
                    s += (h0[0] * h0[0] + h0[1] * h0[1]) + (h0[2] * h0[2] + h0[3] * h0[3]) + (h1[0] * h1[0] + h1[1] * h1[1]) + (h1[2] * h1[2] + h1[3] * h1[3]); }
                s += __shfl_xor(s, 16); s += __shfl_xor(s, 32);
                if (fq == 0) atomicAdd(ssq + row, s); }
    }
};
struct EpiGU {
    static constexpr bool HAS_MID = false;
    const float* ssq; bf16_t* hid;
    __device__ __forceinline__ void operator()(const f32x4 (&acc)[2][2][4][2], const Unit& u, int wr, int wc, int fr, int fq) const {
        const int row0 = u.pm * 256 + wr * 64 + fr, cc = u.pn * 128 + wc * 32 + 8 * fq;
#pragma unroll
        for (int ai = 0; ai < 2; ++ai)
#pragma unroll
            for (int m = 0; m < 4; ++m) { const int row = row0 + ai * 128 + m * 16;
                const float sc = __builtin_amdgcn_rsqf(ssq[row] * (1.0f / D) + EPS);
                f32x4 r0, r1;
#pragma unroll
                for (int j = 0; j < 4; ++j) { const float g0 = acc[ai][0][m][0][j] * sc, u0 = acc[ai][1][m][0][j] * sc, g1 = acc[ai][0][m][1][j] * sc, u1 = acc[ai][1][m][1][j] * sc;
                    r0[j] = g0 * fast_sigmoid(g0) * u0; r1[j] = g1 * fast_sigmoid(g1) * u1; }
                *(u32x4*)(hid + (size_t)row * FF + cc) = pack8(r0, r1); }
    }
};
constexpr int DN_SPLIT = 11, DN_KT = (FF / 64) / DN_SPLIT;
struct EpiDown {
    static constexpr bool HAS_MID = false;
    float* y; float* part;
    __device__ __forceinline__ void operator()(const f32x4 (&acc)[2][2][4][2], const Unit& u, int wr, int wc, int fr, int fq) const {
        const int row0 = u.pm * 256 + wr * 64 + fr, cc = u.pn * 256 + wc * 32 + 8 * fq;
#pragma unroll
        for (int ai = 0; ai < 2; ++ai)
#pragma unroll
            for (int m = 0; m < 4; ++m) { const int row = row0 + ai * 128 + m * 16;
                if (row < MV) { float* o = y + (size_t)row * D + cc;
                    if (u.half) {
                        float* ps = part + ((size_t)(u.kt0 / DN_KT) * MS + (row - MP)) * D + cc;
#pragma unroll
                        for (int bj = 0; bj < 2; ++bj) { *(f32x4*)(ps + bj * 128) = acc[ai][bj][m][0]; *(f32x4*)(ps + bj * 128 + 4) = acc[ai][bj][m][1]; }
                    } else {
#pragma unroll
                    for (int bj = 0; bj < 2; ++bj) { *(f32x4*)(o + bj * 128) = *(const f32x4*)(o + bj * 128) + acc[ai][bj][m][0]; *(f32x4*)(o + bj * 128 + 4) = *(const f32x4*)(o + bj * 128 + 4) + acc[ai][bj][m][1]; } } } }
    }
};

struct EpiWA {
    static constexpr bool HAS_MID = false;
    bf16_t* dst;
    __device__ __forceinline__ void operator()(const f32x4 (&acc)[2][2][4][2], const Unit& u, int wr, int wc, int fr, int fq) const {
        const int row0 = u.pm * 256 + wr * 64 + fr, cc = wc * 32 + 8 * fq;
#pragma unroll
        for (int ai = 0; ai < 2; ++ai)
#pragma unroll
            for (int m = 0; m < 4; ++m) { bf16_t* o = dst + (size_t)(row0 + ai * 128 + m * 16) * 2048 + cc;
#pragma unroll
                for (int bj = 0; bj < 2; ++bj) *(u32x4*)(o + bj * 128) = pack8(acc[ai][bj][m][0], acc[ai][bj][m][1]); }
    }
};

__device__ __forceinline__ void p0_item(const float* W, int N, int k0, int n0, const float* gsc, bf16_t* dst, int ldd, int drow0, int dcol0, LAS float* scr, int lane) {
    const float* wp = W + (size_t)k0 * N + n0 + lane;
    float v[64];
#pragma unroll
    for (int i = 0; i < 64; ++i) v[i] = wp[(size_t)i * N];
    if (gsc) {
#pragma unroll
        for (int i = 0; i < 64; ++i) v[i] *= gsc[k0 + i]; }
#pragma unroll
    for (int i = 0; i < 64; ++i) scr[i * 65 + lane] = v[i];
    asm volatile("s_waitcnt lgkmcnt(0)" ::: "memory");
    const int c = lane & 7;
#pragma unroll
    for (int j = 0; j < 8; ++j) { const int n = (lane >> 3) + 8 * j; const LAS float* s = scr + (8 * c) * 65 + n;
        u32x4 o; o.x = cvt_pk_bf16(s[0 * 65], s[1 * 65]); o.y = cvt_pk_bf16(s[2 * 65], s[3 * 65]); o.z = cvt_pk_bf16(s[4 * 65], s[5 * 65]); o.w = cvt_pk_bf16(s[6 * 65], s[7 * 65]);
        *(u32x4*)(dst + (size_t)(drow0 + n) * ldd + dcol0 + k0 + 8 * c) = o; }
    asm volatile("s_waitcnt lgkmcnt(0)" ::: "memory");
}

struct Params {
    const float *x_prompt, *x_sample, *cache_k, *cache_v, *state_pool, *g_mix, *w_in, *w_pool, *s_pool, *w_branch, *w_out, *g_ffn, *w_gate_up, *w_down, *g_final;
    float* out; unsigned char* ws; int ph_lo, ph_hi;
};

__device__ __forceinline__ void phase0(const Params& p, LAS unsigned char* lds, int gw, int NGW, int wave, int lane) {
    LAS float* scr = (LAS float*)(lds + wave * 16640);
    bf16_t* Wt_in = (bf16_t*)(p.ws + WS_WIN); bf16_t* Wt_br = (bf16_t*)(p.ws + WS_WBR); bf16_t* Wt_out = (bf16_t*)(p.ws + WS_WOUT);
    bf16_t* Wt_gu = (bf16_t*)(p.ws + WS_WGU); bf16_t* Wt_dn = (bf16_t*)(p.ws + WS_WDN); bf16_t* XN = (bf16_t*)(p.ws + WS_XN);
    bf16_t* TMPA = (bf16_t*)(p.ws + WS_TMPA); bf16_t* WPB = (bf16_t*)(p.ws + WS_WPB);
    constexpr int I_IN = (D / 64) * (NIN / 64), I_BR = (D / 64) * (D / 64), I_OUT = (D / 64) * (D / 64), I_GU = (D / 64) * (NGU / 64), I_DN = (FF / 64) * (D / 64);
    constexpr int NITEMS = I_IN + I_BR + I_OUT + I_GU + I_DN;
    for (int it = gw; it < NITEMS; it += NGW) {
        int r = it;
        if (r < I_IN) { const int nb = NIN / 64; const int n0 = 64 * (r % nb); int drow = n0;
            if (n0 >= 4096) { const int q = n0 - 4096; drow = q < 2048 ? 4096 + (q / 128) * 256 + (q % 128) : 4096 + ((q - 2048) / 128) * 256 + 128 + ((q - 2048) % 128); }
            p0_item(p.w_in, NIN, 64 * (r / nb), n0, p.g_mix, Wt_in, D, drow, 0, scr, lane); continue; } r -= I_IN;
        if (r < I_BR) { const int nb = D / 64; const int k0 = 64 * (r / nb), n0 = 64 * (r % nb);
            if (k0 < 1024) p0_item(p.w_branch, D, k0, n0, p.s_pool, TMPA, 1024, n0, 0, scr, lane);
            else p0_item(p.w_branch, D, k0, n0, nullptr, Wt_br, 2048, n0, 0, scr, lane);
            continue; } r -= I_BR;
        if (r < I_OUT) { const int nb = D / 64; p0_item(p.w_out, D, 64 * (r / nb), 64 * (r % nb), nullptr, Wt_out, D, 64 * (r % nb), 0, scr, lane); continue; } r -= I_OUT;
        if (r < I_GU) { const int nb = NGU / 64; const int n0 = 64 * (r % nb); const int drow = n0 < FF ? (n0 / 128) * 256 + (n0 % 128) : ((n0 - FF) / 128) * 256 + 128 + ((n0 - FF) % 128);
            p0_item(p.w_gate_up, NGU, 64 * (r / nb), n0, p.g_ffn, Wt_gu, D, drow, 0, scr, lane); continue; } r -= I_GU;
        { const int nb = D / 64; p0_item(p.w_down, D, 64 * (r / nb), 64 * (r % nb), nullptr, Wt_dn, FF, 64 * (r % nb), 0, scr, lane); }
    }
}
__device__ __forceinline__ void phase0b(const Params& p, int gw, int NGW, int lane) {
    bf16_t* XN = (bf16_t*)(p.ws + WS_XN); bf16_t* WPB = (bf16_t*)(p.ws + WS_WPB);
    for (int i = gw * 64 + lane; i < 4 * 256 * 256 / 8; i += NGW * 64) { const f32x4 a = *(const f32x4*)(p.w_pool + (size_t)i * 8), b = *(const f32x4*)(p.w_pool + (size_t)i * 8 + 4); *(u32x4*)(WPB + (size_t)i * 8) = pack8(a, b); }
    for (int m = gw; m < MT; m += NGW) {
        u32x2* o8 = (u32x2*)(XN + (size_t)m * D) + lane;
        if (m >= MV) {
#pragma unroll
            for (int j = 0; j < 8; ++j) o8[64 * j] = (u32x2){0u, 0u};
            continue; }
        const f32x4* xr = (const f32x4*)(m < MP ? p.x_prompt + (size_t)m * D : p.x_sample + (size_t)(m - MP) * D) + lane;
        f32x4 v[8]; float s = 0.f;
#pragma unroll
        for (int j = 0; j < 8; ++j) { v[j] = xr[64 * j]; s += (v[j].x * v[j].x + v[j].y * v[j].y) + (v[j].z * v[j].z + v[j].w * v[j].w); }
        const float rs = __builtin_amdgcn_rsqf(wave_sum(s) * (1.0f / D) + EPS);
#pragma unroll
        for (int j = 0; j < 8; ++j) o8[64 * j] = (u32x2){cvt_pk_bf16(v[j].x * rs, v[j].y * rs), cvt_pk_bf16(v[j].z * rs, v[j].w * rs)};
    }
    float* ssq = (float*)(p.ws + WS_SSQ);
    for (int i = gw * 64 + lane; i < MT; i += NGW * 64) ssq[i] = 0.f;
}

constexpr int VROW = 320;
__device__ __forceinline__ s16x4 vtr(const LAS unsigned char* p) { typedef short v4i16_t __attribute__((ext_vector_type(4))); return __builtin_bit_cast(s16x4, __builtin_amdgcn_ds_read_tr16_b64_v4i16((LAS v4i16_t*)p)); }
__device__ __forceinline__ bf16x8 cvt8(const f32x4& a, const f32x4& b) { u32x4 w = pack8(a, b); return __builtin_bit_cast(bf16x8, w); }

__device__ __forceinline__ void attn_unit(const Params& p, LAS unsigned char* vl, int unit, int lane) {
    const bf16_t* Ub = (const bf16_t*)(p.ws + WS_QKVU);
    const bf16_t* Qb = Ub + (size_t)MT * 1024; const bf16_t* Kb = Qb + (size_t)MT * 1024; const bf16_t* Vb = Kb + (size_t)MT * 1024;
    bf16_t* AO = (bf16_t*)(p.ws + WS_AO);
    const int n = lane & 31, hh = lane >> 5;
    const bool sample = unit < 64;
    int b, h, qrow0, nblk;
    if (sample) { b = unit >> 3; h = unit & 7; qrow0 = MP + b * DSEQ; nblk = 1 + PAST / 32; }
    else { const int u2 = unit - 64; const int qb = u2 & 127; h = (u2 >> 7) & 7; b = u2 >> 10; qrow0 = b * SEQ + qb * 32; nblk = qb + 1; }
    bf16x8 qf[8];
    { const bf16_t* qp = Qb + (size_t)(qrow0 + n) * 1024 + h * HD + 64 * hh;
#pragma unroll
      for (int kk = 0; kk < 8; ++kk) qf[kk] = *(const bf16x8*)(qp + 8 * kk); }
    f32x16 o[4];
#pragma unroll
    for (int db = 0; db < 4; ++db)
#pragma unroll
        for (int r = 0; r < 16; ++r) o[db][r] = 0.f;
    float R = (sample && n >= DSEQ) ? -1e30f : 0.f;
    const float* ck = p.cache_k + (size_t)b * PAST * 1024 + h * HD; const float* cv = p.cache_v + (size_t)b * PAST * 1024 + h * HD;
    const int vaddr = (4 * hh + ((lane & 15) >> 2)) * VROW + (16 * ((lane >> 4) & 1) + 4 * (lane & 3)) * 2;
    for (int blk = 0; blk < nblk; ++blk) {
        bf16x8 kf[8];
        const bool diag = (blk == 0);
        if (!sample || blk == 0) {
            const int s0 = qrow0 - blk * 32;
            const bf16_t* kp = Kb + (size_t)(s0 + n) * 1024 + h * HD + 64 * hh;
#pragma unroll
            for (int kk = 0; kk < 8; ++kk) kf[kk] = *(const bf16x8*)(kp + 8 * kk);
            const bf16_t* vp = Vb + (size_t)(s0 + (lane >> 4)) * 1024 + h * HD + 8 * (lane & 15);
#pragma unroll
            for (int it = 0; it < 8; ++it) { const u32x4 w = *(const u32x4*)(vp + (size_t)(4 * it) * 1024); *(LAS u32x4*)(vl + (4 * it + (lane >> 4)) * VROW + 16 * (lane & 15)) = w; }
        } else {
            const int s0 = PAST - blk * 32;
            const float* kp = ck + (size_t)(s0 + n) * 1024 + 64 * hh;
#pragma unroll
            for (int kk = 0; kk < 8; ++kk) kf[kk] = cvt8(*(const f32x4*)(kp + 8 * kk), *(const f32x4*)(kp + 8 * kk + 4));
            const float* vp = cv + (size_t)(s0 + (lane >> 4)) * 1024 + 8 * (lane & 15);
#pragma unroll
            for (int it = 0; it < 8; ++it) { const f32x4 a = *(const f32x4*)(vp + (size_t)(4 * it) * 1024), c = *(const f32x4*)(vp + (size_t)(4 * it) * 1024 + 4);
                *(LAS u32x4*)(vl + (4 * it + (lane >> 4)) * VROW + 16 * (lane & 15)) = pack8(a, c); }
        }
        f32x16 st;
#pragma unroll
        for (int r = 0; r < 16; ++r) st[r] = 0.f;
#pragma unroll
        for (int kk = 0; kk < 8; ++kk) st = __builtin_amdgcn_mfma_f32_32x32x16_bf16(kf[kk], qf[kk], st, 0, 0, 0);
        float l1m[16], ls[16];
#pragma unroll
        for (int r = 0; r < 16; ++r) { const int i = (r & 3) + 8 * (r >> 2) + 4 * hh; const bool valid = !diag || (i < n);
            const float z = st[r] * 0.08838834764831845f; const float sp = fmaxf(z, 0.f) + __logf(1.0f + __expf(-fabsf(z)));
            l1m[r] = valid ? -sp : 0.f; ls[r] = valid ? (z - sp) : -1e30f; }
        float gown[4], goth[4];
#pragma unroll
        for (int a = 0; a < 4; ++a) { gown[a] = (l1m[4 * a] + l1m[4 * a + 1]) + (l1m[4 * a + 2] + l1m[4 * a + 3]); goth[a] = __shfl_xor(gown[a], 32); }
        float wv[16]; float tail = R;
#pragma unroll
        for (int a = 3; a >= 0; --a) { float sfx = tail + (hh == 0 ? goth[a] : 0.f);
#pragma unroll
            for (int rr = 3; rr >= 0; --rr) { wv[4 * a + rr] = __expf(ls[4 * a + rr] + sfx); sfx += l1m[4 * a + rr]; }
            tail += gown[a] + goth[a]; }
        R = tail;
        bf16x8 wb[2];
#pragma unroll
        for (int s = 0; s < 2; ++s) wb[s] = cvt8((f32x4){wv[8 * s], wv[8 * s + 1], wv[8 * s + 2], wv[8 * s + 3]}, (f32x4){wv[8 * s + 4], wv[8 * s + 5], wv[8 * s + 6], wv[8 * s + 7]});
        asm volatile("s_waitcnt lgkmcnt(0)" ::: "memory");
#pragma unroll
        for (int db = 0; db < 4; ++db)
#pragma unroll
            for (int s = 0; s < 2; ++s) { const s16x4 lo = vtr(vl + vaddr + (16 * s) * VROW + 64 * db), hi = vtr(vl + vaddr + (16 * s + 8) * VROW + 64 * db);
                const bf16x8 vf = (bf16x8){lo[0], lo[1], lo[2], lo[3], hi[0], hi[1], hi[2], hi[3]};
                o[db] = __builtin_amdgcn_mfma_f32_32x32x16_bf16(vf, wb[s], o[db], 0, 0, 0); }
        asm volatile("s_waitcnt lgkmcnt(0)" ::: "memory");
        if (__all(R < -104.0f)) break;
    }
    if (!sample || n < DSEQ) {
        bf16_t* op = AO + (size_t)(qrow0 + n) * 2048 + 1024 + h * HD + 4 * hh;
#pragma unroll
        for (int db = 0; db < 4; ++db)
#pragma unroll
            for (int a = 0; a < 4; ++a) *(u32x2*)(op + 32 * db + 8 * a) = (u32x2){cvt_pk_bf16(o[db][4 * a], o[db][4 * a + 1]), cvt_pk_bf16(o[db][4 * a + 2], o[db][4 * a + 3])};
    }
}

template <int W>
__device__ __forceinline__ void diff_chunk(const Params& p, int ch, int cc) {
    const bf16_t* Ub = (const bf16_t*)(p.ws + WS_QKVU); bf16_t* AO = (bf16_t*)(p.ws + WS_AO);
    const int m0 = ch * 16; const bool prompt = m0 < MP; const int t0 = prompt ? (m0 & (SEQ - 1)) : PAST;
    const bf16_t* up = Ub + (size_t)m0 * 1024 + cc * 8;
    u32x4 raw[15 + W];
#pragma unroll
    for (int r = 0; r < 16; ++r) raw[W - 1 + r] = *(const u32x4*)(up + (size_t)r * 1024);
    if (prompt) {
#pragma unroll
        for (int j = 1; j < W; ++j) { const u32x4 v = *(const u32x4*)(t0 > 0 ? up - (size_t)j * 1024 : up); raw[W - 1 - j] = (t0 > 0) ? v : (u32x4){0u, 0u, 0u, 0u}; }
    } else { const float* hp = p.state_pool + (size_t)((m0 - MP) >> 4) * 15 * 1024 + cc * 8;
#pragma unroll
        for (int j = 1; j < W; ++j) raw[W - 1 - j] = pack8(*(const f32x4*)(hp + (size_t)(15 - j) * 1024), *(const f32x4*)(hp + (size_t)(15 - j) * 1024 + 4)); }
    f32x4 s0 = (f32x4){0.f, 0.f, 0.f, 0.f}, s1 = s0;
#pragma unroll
    for (int j = 1; j < W; ++j) { f32x4 a, c; unpack8(raw[W - 1 - j], a, c); s0 += a; s1 += c; }
#pragma unroll
    for (int r = 0; r < 16; ++r) { f32x4 a, c; unpack8(raw[W - 1 + r], a, c); s0 += a; s1 += c;
        const int t = t0 + r; const float ic = 1.0f / (float)(t + 1 < W ? t + 1 : W);
        *(u32x4*)(AO + (size_t)(m0 + r) * 2048 + cc * 8) = pack8(s0 * ic - a, s1 * ic - c);
        f32x4 da, dc; unpack8(raw[r], da, dc); s0 -= da; s1 -= dc; }
}
constexpr int N_ATT_UNITS = 64 + 4096, N_DIFF_ITEMS = (MV / 32) * 4, N_P2_ITEMS = N_ATT_UNITS + N_DIFF_ITEMS;
__device__ __forceinline__ void diff_item(const Params& p, int wi, int lane) {
    const int g = wi & 3, ch = 2 * (wi >> 2) + (lane >> 5), cc = 32 * g + (lane & 31);
    if (g == 0) diff_chunk<2>(p, ch, cc); else if (g == 1) diff_chunk<4>(p, ch, cc); else if (g == 2) diff_chunk<8>(p, ch, cc); else diff_chunk<16>(p, ch, cc);
}

__global__ void __launch_bounds__(512, 2) fwd_megakernel(Params p) {
    extern __shared__ __attribute__((aligned(16))) unsigned char lds_raw[];
    LAS unsigned char* lds = (LAS unsigned char*)lds_raw;
    const int tid = threadIdx.x, lane = tid & 63, wave = __builtin_amdgcn_readfirstlane(tid >> 6);
    const int G = gridDim.x, bx = blockIdx.x;
    const int vcu = (G % 8 == 0) ? (bx % 8) * (G / 8) + bx / 8 : bx;
    const int gw = vcu * 8 + wave, NGW = G * 8;
    cg::grid_group grid = cg::this_grid();
    volatile LAS unsigned* xst = (volatile LAS unsigned*)(lds + LDS_BYTES - 64);
    if (tid < 2) xst[tid] = 0u;
    __syncthreads();
    XcdBarrier xbar = xcd_barrier_post((unsigned*)(p.ws + WS_BAR), xst);
#define IN(k) (p.ph_lo <= (k) && (k) < p.ph_hi)
#define SEAM(k) do { if (IN(k) && IN((k) + 1)) { if (p.ph_hi > 64) grid.sync();   xcd_barrier(xbar); } STAMP(); } while (0)
    bf16_t* Wt_in = (bf16_t*)(p.ws + WS_WIN); bf16_t* Wt_br = (bf16_t*)(p.ws + WS_WBR); bf16_t* Wt_out = (bf16_t*)(p.ws + WS_WOUT);
    bf16_t* Wt_gu = (bf16_t*)(p.ws + WS_WGU); bf16_t* Wt_dn = (bf16_t*)(p.ws + WS_WDN); bf16_t* XN = (bf16_t*)(p.ws + WS_XN);
    bf16_t* QKVU = (bf16_t*)(p.ws + WS_QKVU); bf16_t* GATE = (bf16_t*)(p.ws + WS_GATE); bf16_t* AO = (bf16_t*)(p.ws + WS_AO);
    bf16_t* MERGED = (bf16_t*)(p.ws + WS_MERGED); bf16_t* HID = (bf16_t*)(p.ws + WS_HID); float* SSQ = (float*)(p.ws + WS_SSQ);
    float* Y = p.out + OFF_Y;
#ifdef PROBE_T
    unsigned long long tstamp[10]; int nst = 0;
#define STAMP() do { tstamp[nst++] = __builtin_amdgcn_s_memrealtime(); } while (0)
#else
#define STAMP() do {} while (0)
#endif
    STAMP();

    if (IN(0)) { phase0(p, lds, gw, NGW, wave, lane);
#ifdef PROBE_T
#endif
        phase0b(p, gw, NGW, lane);
    }
    SEAM(0);
    if (IN(1)) { pg8::Gemm g{XN, Wt_in, D, D, MT, NIN, D}; pg8::StaticOrder S; S.init(64, NIN / 256, D / 64, G, bx, 64, 1); EpiIn E{QKVU, GATE, p.out}; pg8::gemm_phase(lds, g, S, E); }
    SEAM(1);
    if (IN(2)) {
        LAS unsigned char* vl = lds + wave * (32 * VROW);
        unsigned* ctr = (unsigned*)(p.ws + WS_BAR) + 3584;
        int item = gw;
        while (item < N_P2_ITEMS) {
            if (item < N_ATT_UNITS) attn_unit(p, vl, item, lane); else diff_item(p, item - N_ATT_UNITS, lane);
            unsigned nx = 0; if (lane == 0) nx = __hip_atomic_fetch_add(ctr, 1u, __ATOMIC_RELAXED, __HIP_MEMORY_SCOPE_AGENT);
            item = NGW + (int)__builtin_amdgcn_readfirstlane(nx);
        }
        __syncthreads();
        for (int gq = 0; gq < 4; ++gq) { pg8::Gemm g{(const bf16_t*)(p.ws + WS_TMPA) + gq * 256, (const bf16_t*)(p.ws + WS_WPB) + gq * 65536, 1024, 256, 2048, 256, 256};
            pg8::StaticOrder S; S.init(8, 1, 4, G, (bx + G - 8 * gq) % G); EpiWA E{Wt_br + gq * 256}; pg8::gemm_phase(lds, g, S, E); }
    }
    SEAM(2);
    if (IN(3)) {
        { pg8::Gemm g{AO, Wt_br, 2048, 2048, MT, D, 2048}; pg8::StaticOrder S; S.init(64, 8, 32, G, bx, 64, 1); EpiMerged E{GATE, MERGED}; pg8::gemm_phase(lds, g, S, E); }
    }
    SEAM(3);
    if (IN(4)) { pg8::Gemm g{MERGED, Wt_out, D, D, MT, D, D}; pg8::StaticOrder S; S.init(64, 8, 32, G, bx, 64, 1); EpiOut E{p.x_prompt, p.x_sample, Y, XN, SSQ}; pg8::gemm_phase(lds, g, S, E); }
    SEAM(4);
    if (IN(5)) { pg8::Gemm g{XN, Wt_gu, D, D, MT, NGU, D}; pg8::StaticOrder S; S.init(64, NGU / 256, 32, G, bx, 64, 1); EpiGU E{SSQ, HID}; pg8::gemm_phase(lds, g, S, E); }
    SEAM(5);
    if (IN(6)) { pg8::Gemm g{HID, Wt_dn, FF, FF, MT, D, FF}; pg8::StaticOrder S; S.init(64, 8, FF / 64, G, bx, 64, DN_SPLIT); EpiDown E{Y, (float*)(p.ws + WS_AO)}; pg8::gemm_phase(lds, g, S, E); }
    SEAM(6);
    if (IN(7)) {
        for (int m = gw; m < MV; m += NGW) {
            f32x4* yr = (f32x4*)(Y + (size_t)m * D) + lane; const f32x4* gf = (const f32x4*)p.g_final + lane;
            f32x4 v[8]; float s = 0.f;
#pragma unroll
            for (int j = 0; j < 8; ++j) v[j] = yr[64 * j];
            if (m >= MP) { const f32x4* pr = (const f32x4*)((const float*)(p.ws + WS_AO) + (size_t)(m - MP) * D) + lane;
                for (int c = 0; c < DN_SPLIT; ++c)
#pragma unroll
                    for (int j = 0; j < 8; ++j) v[j] += pr[(size_t)c * MS * D / 4 + 64 * j]; }
#pragma unroll
            for (int j = 0; j < 8; ++j) s += (v[j].x * v[j].x + v[j].y * v[j].y) + (v[j].z * v[j].z + v[j].w * v[j].w);
            const float rs = __builtin_amdgcn_rsqf(wave_sum(s) * (1.0f / D) + EPS);
#pragma unroll
            for (int j = 0; j < 8; ++j) yr[64 * j] = v[j] * rs * gf[64 * j];
        }
    }
#ifdef PROBE_T
    STAMP();
    if (bx == 0 && tid == 0) {
        const unsigned long long e1 = (unsigned long long)__hip_atomic_load((long long*)(p.ws + WS_SSQ + 512 * 1024), __ATOMIC_RELAXED, __HIP_MEMORY_SCOPE_AGENT);
        const unsigned long long e2 = (unsigned long long)__hip_atomic_load((long long*)(p.ws + WS_SSQ + 512 * 1024 + 256), __ATOMIC_RELAXED, __HIP_MEMORY_SCOPE_AGENT);
        const float ta = (float)(e1 - tstamp[2]) * 0.01f, tb = (float)(e2 - tstamp[2]) * 0.01f;
        asm volatile("s_waitcnt vmcnt(0)" ::: "memory");
        atomicAdd(Y, 4.0f + ta * (1.0f / 256.0f)); atomicAdd(p.out + OFF_PP, 1.5f + tb * (1.0f / 500.0f));
    }
#endif
#undef IN
#undef SEAM
}

extern "C" void kernel_launch(void* const* d_in, const int* in_sizes, int n_in, void* d_out, int out_size, void* d_ws, size_t ws_size, hipStream_t stream) {
    static int grid = 0;
    if (grid == 0) {
        if (n_in != 15 || (size_t)out_size != OUT_TOTAL || ws_size < WS_END) { fprintf(stderr, "kernel_launch: unexpected shapes: n_in %d out %d ws %zu\n", n_in, out_size, ws_size); grid = -1; return; }
        int dev = 0, cus = 0, per_cu = 0;
        hipGetDevice(&dev); hipDeviceGetAttribute(&cus, hipDeviceAttributeMultiprocessorCount, dev);
        hipFuncSetAttribute((const void*)fwd_megakernel, hipFuncAttributeMaxDynamicSharedMemorySize, LDS_BYTES);
        hipOccupancyMaxActiveBlocksPerMultiprocessor(&per_cu, (const void*)fwd_megakernel, 512, LDS_BYTES);
        if (per_cu < 1) { fprintf(stderr, "kernel_launch: occupancy query says %d blocks per CU\n", per_cu); per_cu = 1; }
        (void)hipGetLastError();
        grid = cus;
    }
    if (grid < 0) return;
    Params p{};
    const float** pp = (const float**)&p;
    for (int i = 0; i < 15; ++i) pp[i] = (const float*)d_in[i];
    p.out = (float*)d_out; p.ws = (unsigned char*)d_ws;
#if N_LAUNCH_MODE == 1
    p.ph_lo = 0; p.ph_hi = 8;
    void* args[] = {&p};
    if (hipMemsetAsync((char*)d_ws + WS_BAR, 0, WS_BAR_BYTES, stream) != hipSuccess) fprintf(stderr, "kernel_launch: memset of the barrier words failed\n");
    hipError_t e = hipLaunchCooperativeKernel((const void*)fwd_megakernel, dim3(grid), dim3(512), args, LDS_BYTES, stream);
    if (e != hipSuccess) fprintf(stderr, "cooperative launch failed: %s (grid %d)\n", hipGetErrorString(e), grid);
#else
    for (int ph = 0; ph < 8; ++ph) { p.ph_lo = ph; p.ph_hi = ph + 1; hipLaunchKernelGGL(fwd_megakernel, dim3(grid), dim3(512), LDS_BYTES, stream, p); }
#endif
}
```

```cpp
#include <hip/hip_runtime.h>
#include <hip/hip_cooperative_groups.h>
#include <cstdio>
#include <cstdint>
namespace cg = cooperative_groups;

#define PROBE_A 6
#define PROBE_B 4
#ifndef N_LAUNCH_MODE
#define N_LAUNCH_MODE 1
#endif

#define LAS __attribute__((address_space(3)))
typedef unsigned short bf16_t;
typedef short bf16x8 __attribute__((ext_vector_type(8)));
typedef short s16x4 __attribute__((ext_vector_type(4)));
typedef float f32x4 __attribute__((ext_vector_type(4)));
typedef float f32x16 __attribute__((ext_vector_type(16)));
typedef unsigned u32x4 __attribute__((ext_vector_type(4)));
typedef unsigned u32x2 __attribute__((ext_vector_type(2)));

constexpr int D = 2048, MP = 16384, MS = 128, MV = MP + MS, MT = 16640;
constexpr int SEQ = 4096, DSEQ = 16, PAST = 4096, NH = 8, HD = 128;
constexpr int NIN = 8192, FF = 5632, NGU = 2 * FF, AW = 1024;
constexpr float EPS = 1e-6f;
constexpr size_t OFF_Y = 0, OFF_KP = (size_t)MV * D, OFF_VP = OFF_KP + (size_t)MP * 1024, OFF_PP = OFF_VP + (size_t)MP * 1024,
                 OFF_KS = OFF_PP + 4 * 15 * 1024, OFF_VS = OFF_KS + (size_t)MS * 1024, OFF_PS = OFF_VS + (size_t)MS * 1024, OUT_TOTAL = OFF_PS + 8 * 15 * 1024;
constexpr size_t MiB = 1u << 20;
constexpr size_t WS_SSQ = 0, WS_WIN = 1 * MiB, WS_WBR = 33 * MiB, WS_WOUT = 41 * MiB, WS_WGU = 49 * MiB, WS_WDN = 93 * MiB, WS_XN = 115 * MiB,
                 WS_QKVU = 180 * MiB, WS_GATE = 310 * MiB, WS_AO = 440 * MiB, WS_TMPA = 505 * MiB, WS_WPB = 509 * MiB, WS_SSQP = 510 * MiB, WS_END = 513 * MiB;
constexpr size_t WS_BAR = 768 * 1024, WS_BAR_BYTES = 32768;
constexpr size_t WS_MERGED = WS_QKVU;
constexpr size_t WS_HID = WS_QKVU;
static_assert((size_t)MT * FF * 2 <= WS_AO - WS_QKVU, "hid overlay");
constexpr int LDS_BYTES = 147456;

typedef __bf16 bf16x2_t __attribute__((ext_vector_type(2)));
typedef float f32x2_t __attribute__((ext_vector_type(2)));
__device__ __forceinline__ unsigned cvt_pk_bf16(float lo, float hi) { const f32x2_t v = {lo, hi}; return __builtin_bit_cast(unsigned, __builtin_convertvector(v, bf16x2_t)); }
__device__ __forceinline__ float bf2f(unsigned short b) { return __uint_as_float(((unsigned)b) << 16); }
__device__ __forceinline__ float bflo(unsigned w) { return __uint_as_float(w << 16); }
__device__ __forceinline__ float bfhi(unsigned w) { return __uint_as_float(w & 0xffff0000u); }
__device__ __forceinline__ float fast_sigmoid(float x) { return __builtin_amdgcn_rcpf(1.0f + __expf(-x)); }
__device__ __forceinline__ float wave_sum(float v) {
#pragma unroll
    for (int o = 1; o < 64; o <<= 1) v += __shfl_xor(v, o);
    return v;
}

#define XB_TMO      128
#define XB_XCNT(j)  (256  + 64 * (j))
#define XB_XSUB(j)  (1280 + 64 * (j))
#define XB_XGEN(j)  (2304 + 64 * (j))
#define XB_TOP      3328
#define XB_TOPGEN   3392
#define XCD_BAR_WORDS 3456
#define XB_SPIN_CAP (1u << 18)

__device__ __forceinline__ unsigned xb_ld(unsigned* p)              { return __hip_atomic_load(p, __ATOMIC_RELAXED, __HIP_MEMORY_SCOPE_AGENT); }
__device__ __forceinline__ unsigned xb_add(unsigned* p, unsigned v) { return __hip_atomic_fetch_add(p, v, __ATOMIC_RELAXED, __HIP_MEMORY_SCOPE_AGENT); }
__device__ __forceinline__ unsigned xb_xcc_id() { return (unsigned)__builtin_amdgcn_s_getreg((3 << 11) | 20) & 0xFu; }
#define XB_SPIN(cond, bar) do { unsigned _sp = 0; while (cond) { __builtin_amdgcn_s_sleep(1); \
    if ((++_sp & 255u) == 0u) { if (xb_ld(&(bar)[XB_TMO])) break; if (_sp > XB_SPIN_CAP) { atomicAdd(&(bar)[XB_TMO], 1u); break; } } } } while (0)

struct XcdBarrier {
    unsigned* bar; unsigned x;
    volatile LAS unsigned* st;
};

__device__ __forceinline__ XcdBarrier xcd_barrier_post(unsigned* bar, volatile LAS unsigned* st) {
    XcdBarrier b; b.bar = bar; b.x = xb_xcc_id(); b.st = st;
    if (threadIdx.x == 0) (void)xb_add(&bar[XB_XCNT(b.x)], 1u);
    return b;
}
__device__ __forceinline__ void xcd_barrier_complete(unsigned* bar, unsigned x, unsigned& nloc, unsigned& nx) {
    const unsigned G = gridDim.x * gridDim.y * gridDim.z;
    unsigned sum, cnt, mine, sp = 0u;
    for (;;) {
        sum = 0u; cnt = 0u; mine = 0u;
#pragma unroll
        for (unsigned j = 0; j < 16; ++j) { const unsigned c = xb_ld(&bar[XB_XCNT(j)]); sum += c; cnt += (c > 0u) ? 1u : 0u; mine = (j == x) ? c : mine; }
        if (sum == G) break;
        __builtin_amdgcn_s_sleep(1);
        if ((++sp & 255u) == 0u) { if (xb_ld(&bar[XB_TMO])) break; if (sp > XB_SPIN_CAP) { atomicAdd(&bar[XB_TMO], 1u); break; } }
    }
    nloc = mine > 0u ? mine : 1u; nx = cnt > 0u ? cnt : 1u;
}

__device__ __forceinline__ void xcd_barrier(const XcdBarrier& b) {
    asm volatile("s_waitcnt vmcnt(0)" ::: "memory");
    __syncthreads();
    if (threadIdx.x == 0) {
        unsigned* bar = b.bar;
        __builtin_amdgcn_s_waitcnt(0);
        unsigned nloc = b.st[0], nx = b.st[1];
        if (nloc == 0u) { xcd_barrier_complete(bar, b.x, nloc, nx); b.st[0] = nloc; b.st[1] = nx; }
        const unsigned old = xb_add(&bar[XB_XSUB(b.x)], 1u);
        const unsigned gen = old / nloc;
        if (old + 1u == (gen + 1u) * nloc) {
            __builtin_amdgcn_fence(__ATOMIC_RELEASE, "agent");
            asm volatile("s_waitcnt vmcnt(0)" ::: "memory");
            const unsigned og = xb_add(&bar[XB_TOP], 1u);
            const unsigned tg = og / nx;
            if (og + 1u == (tg + 1u) * nx) xb_add(&bar[XB_TOPGEN], 1u);
            else XB_SPIN(xb_ld(&bar[XB_TOPGEN]) == tg, bar);
            __builtin_amdgcn_fence(__ATOMIC_ACQUIRE, "agent");
            xb_add(&bar[XB_XGEN(b.x)], 1u);
            asm volatile("s_waitcnt vmcnt(0)" ::: "memory");
        } else {
            XB_SPIN(xb_ld(&bar[XB_XGEN(b.x)]) == gen, bar);
            __builtin_amdgcn_fence(__ATOMIC_ACQUIRE, "agent");
            asm volatile("s_waitcnt vmcnt(0)" ::: "memory");
        }
    }
    __syncthreads();
}

namespace pg8 {
constexpr int BM = 256, BK = 64, HALF = 128, HTB = HALF * BK * 2, STAGE_BYTES = 8 * HTB, NXCD = 8, WGM = 8;
__host__ __device__ __forceinline__ int lds_byte(int r, int c) { const int st = (r >> 4) * 2 + (c >> 5), rr = r & 15, cc = c & 31, ob = rr * 64 + cc * 2; return st * 1024 + (ob ^ (((ob >> 9) & 1) << 5)); }
__host__ __device__ __forceinline__ void stage_rc(int b, int& R, int& C) { const int st = b / 1024, sb = b % 1024, swz = sb ^ (((sb >> 9) & 1) << 5); R = (st >> 1) * 16 + swz / 64; C = (st & 1) * 32 + (swz % 64) / 2; }
__host__ __device__ __forceinline__ int perm32(int rho) { const int n = rho >> 4, i = rho & 15; return 8 * (i >> 2) + 4 * n + (i & 3); }

struct Unit { int pm, pn, kt0, nkt, half; };
struct Gemm { const bf16_t* A; const bf16_t* Bt; int lda, ldb, M, N, K; };

struct StaticOrder {
    int nM, nN, nwg, G, c, ktfull, pmS, nS, ktS;
    __device__ void init(int nM_, int nN_, int ktfull_, int G_, int c_, int pmS_ = 0, int ksplit = 0) { nM = nM_; nN = nN_; nwg = nM * nN; G = G_; c = c_; ktfull = ktfull_; pmS = pmS_; nS = nN * ksplit; ktS = ksplit ? ktfull / ksplit : 0; }
    __device__ bool next(int i, Unit& u) const {
        const int L = i * G + c;
        if (L >= nwg) { const int t = L - nwg;
            if (t >= nS) return false;
            u.pm = pmS; u.pn = t % nN; u.kt0 = (t / nN) * ktS; u.nkt = ktS; u.half = 1; return true; }
        int wgid = L; { const int q = nwg / NXCD, r = nwg % NXCD, xcd = wgid % NXCD, off = wgid / NXCD; wgid = (xcd < r ? xcd * (q + 1) : r * (q + 1) + (xcd - r) * q) + off; }
        const int nig = WGM * nN, gid = wgid / nig, fm = gid * WGM, gsz = (nM - fm) < WGM ? (nM - fm) : WGM;
        u.pm = fm + ((wgid % nig) % gsz); u.pn = (wgid % nig) / gsz; u.kt0 = 0; u.nkt = ktfull; u.half = 0; return true;
    }
};

template <class Epi>
__device__ __forceinline__ void gemm_phase(LAS unsigned char* lds, const Gemm g, const StaticOrder& S, const Epi& E) {
    int tid_ = threadIdx.x; asm volatile("" : "+v"(tid_));
    const int tid = tid_, wid = __builtin_amdgcn_readfirstlane(tid >> 6), lane = tid & 63, wr = wid >> 2, wc = wid & 3, fr = lane & 15, fq = lane >> 4;
    unsigned voffA[2], voffB[2];
#pragma unroll
    for (int i = 0; i < 2; ++i) { int R, C; stage_rc(tid * 16 + i * 8192, R, C); const int Rb = (R & ~31) + perm32(R & 31);
        voffA[i] = (unsigned)(R * g.lda + C) * 2u; voffB[i] = (unsigned)(Rb * g.ldb + C) * 2u; }
    const size_t kstep = (size_t)(BK * 2);
    const size_t hstepA = (size_t)HALF * g.lda * 2, hstepB = (size_t)HALF * g.ldb * 2;
    const size_t tstepA = 2 * hstepA, tstepB = 2 * hstepB;
    const unsigned ldsw = (unsigned)wid * 1024u;
    const int aoff = lds_byte(wr * 64 + fr, fq * 8), boff = lds_byte(wc * 32 + fr, fq * 8);
#define PG8_SA(b, h) (((b) * 2 + (h)) * HTB)
#define PG8_SB(b, h) ((4 + (b) * 2 + (h)) * HTB)
#define PG8_STAGE(bufoff, gbase, voff) do { _Pragma("unroll") for (int _i = 0; _i < 2; ++_i) \
        __builtin_amdgcn_global_load_lds((const unsigned*)((const char*)(gbase) + (voff)[_i]), (LAS unsigned*)(lds + (bufoff) + ldsw + _i * 8192), 16, 0, 0); } while (0)
#define PG8_LDA(dst, b, h) do { _Pragma("unroll") for (int m = 0; m < 4; ++m) _Pragma("unroll") for (int k = 0; k < 2; ++k) dst[m][k] = *(const LAS bf16x8*)(lds + PG8_SA(b, h) + aoff + m * 2048 + k * 1024); } while (0)
#define PG8_LDB(dst, b, h) do { _Pragma("unroll") for (int n = 0; n < 2; ++n) _Pragma("unroll") for (int k = 0; k < 2; ++k) dst[n][k] = *(const LAS bf16x8*)(lds + PG8_SB(b, h) + boff + n * 2048 + k * 1024); } while (0)
#define PG8_MMA(ai, bj, At, Bt) do { __builtin_amdgcn_s_setprio(1); _Pragma("unroll") for (int m = 0; m < 4; ++m) _Pragma("unroll") for (int n = 0; n < 2; ++n) _Pragma("unroll") for (int k = 0; k < 2; ++k) \
        acc[ai][bj][m][n] = __builtin_amdgcn_mfma_f32_16x16x32_bf16(Bt[n][k], At[m][k], acc[ai][bj][m][n], 0, 0, 0); __builtin_amdgcn_s_setprio(0); } while (0)
#define PG8_WAIT_V(n) asm volatile("s_waitcnt vmcnt(" #n ")" ::: "memory")
#define PG8_WAIT_L(n) asm volatile("s_waitcnt lgkmcnt(" #n ")" ::: "memory")
#define PG8_BAR __builtin_amdgcn_s_barrier()
#define PG8_SCHED __builtin_amdgcn_sched_barrier(0)
    Unit cur, nxt; int ui = 0;
    if (!S.next(0, cur)) return;
    f32x4 acc[2][2][4][2];
#pragma unroll
    for (int a = 0; a < 2; ++a)
#pragma unroll
        for (int b = 0; b < 2; ++b)
#pragma unroll
            for (int m = 0; m < 4; ++m)
#pragma unroll
                for (int n = 0; n < 2; ++n) acc[a][b][m][n] = (f32x4){0.f, 0.f, 0.f, 0.f};
    bf16x8 At[4][2], B0[2][2], B1[2][2];
    const char* cA = (const char*)g.A + (size_t)cur.pm * tstepA + (size_t)cur.kt0 * kstep; const char* cB = (const char*)g.Bt + (size_t)cur.pn * tstepB + (size_t)cur.kt0 * kstep;
    PG8_STAGE(PG8_SB(0, 0), cB, voffB); PG8_STAGE(PG8_SB(0, 1), cB + hstepB, voffB); PG8_STAGE(PG8_SA(0, 0), cA, voffA); PG8_STAGE(PG8_SA(0, 1), cA + hstepA, voffA);
    if (wr == 1) PG8_BAR;
    PG8_WAIT_V(2); PG8_BAR;
    PG8_STAGE(PG8_SB(1, 0), cB + kstep, voffB); PG8_STAGE(PG8_SA(1, 0), cA + kstep, voffA); PG8_STAGE(PG8_SB(1, 1), cB + hstepB + kstep, voffB);
    PG8_WAIT_V(6); PG8_BAR;
    for (;;) {
        const bool has_next = S.next(ui + 1, nxt);
        const char* nA = has_next ? (const char*)g.A + (size_t)nxt.pm * tstepA + (size_t)nxt.kt0 * kstep : cA; const char* nB = has_next ? (const char*)g.Bt + (size_t)nxt.pn * tstepB + (size_t)nxt.kt0 * kstep : cB;
        const int nt = cur.nkt; const bool full = !cur.half;
        for (int t = 0; t < nt; t += 2) {
            const bool last = (t == nt - 2);
            if constexpr (Epi::HAS_MID) { if (t == (nt >> 1)) E.mid(acc, cur, wr, wc, fr, fq); }
            const char* a1 = cA + (size_t)(t + 1) * kstep;
            const char* a2 = last ? nA : cA + (size_t)(t + 2) * kstep; const char* b2 = last ? nB : cB + (size_t)(t + 2) * kstep;
            const char* a3 = a2 + kstep; const char* b3 = b2 + kstep;
            PG8_LDB(B0, 0, 0); PG8_LDB(B1, 0, 1); PG8_SCHED; PG8_LDA(At, 0, 0); PG8_STAGE(PG8_SA(1, 1), a1 + hstepA, voffA);
            PG8_WAIT_V(8); PG8_WAIT_L(0); PG8_BAR; PG8_MMA(0, 0, At, B0); PG8_MMA(0, 1, At, B1); PG8_BAR; PG8_SCHED;
            if (full) PG8_LDA(At, 0, 1); PG8_STAGE(PG8_SB(0, 0), b2, voffB); PG8_STAGE(PG8_SB(0, 1), b2 + hstepB, voffB); PG8_STAGE(PG8_SA(0, 0), a2, voffA);
            PG8_WAIT_V(8); PG8_WAIT_L(0); PG8_BAR; if (full) { PG8_MMA(1, 0, At, B0); PG8_MMA(1, 1, At, B1); } PG8_BAR; PG8_SCHED;
            PG8_LDB(B0, 1, 0); PG8_LDB(B1, 1, 1); PG8_SCHED; PG8_LDA(At, 1, 0); PG8_STAGE(PG8_SA(0, 1), a2 + hstepA, voffA);
            PG8_WAIT_V(8); PG8_WAIT_L(0); PG8_BAR; PG8_MMA(0, 0, At, B0); PG8_MMA(0, 1, At, B1); PG8_BAR; PG8_SCHED;
            if (full) PG8_LDA(At, 1, 1); PG8_STAGE(PG8_SB(1, 0), b3, voffB); PG8_STAGE(PG8_SB(1, 1), b3 + hstepB, voffB); PG8_STAGE(PG8_SA(1, 0), a3, voffA);
            PG8_WAIT_V(8); PG8_WAIT_L(0); PG8_BAR; if (full) { PG8_MMA(1, 0, At, B0); PG8_MMA(1, 1, At, B1); } PG8_BAR; PG8_SCHED;
        }
        if (wr == 0) PG8_BAR;
        E(acc, cur, wr, wc, fr, fq);
        if (!has_next) break;
#pragma unroll
        for (int a = 0; a < 2; ++a)
#pragma unroll
            for (int b = 0; b < 2; ++b)
#pragma unroll
                for (int m = 0; m < 4; ++m)
#pragma unroll
                    for (int n = 0; n < 2; ++n) acc[a][b][m][n] = (f32x4){0.f, 0.f, 0.f, 0.f};
        cur = nxt; cA = nA; cB = nB; ++ui;
        if (wr == 1) PG8_BAR;
    }
    PG8_WAIT_V(0);
    PG8_BAR;
#undef PG8_SA
#undef PG8_SB
#undef PG8_STAGE
#undef PG8_LDA
#undef PG8_LDB
#undef PG8_MMA
#undef PG8_WAIT_V
#undef PG8_WAIT_L
#undef PG8_BAR
#undef PG8_SCHED
}
}
using pg8::Unit;

__device__ __forceinline__ u32x4 pack8(const f32x4& v0, const f32x4& v1) {
    u32x4 w; w.x = cvt_pk_bf16(v0[0], v0[1]); w.y = cvt_pk_bf16(v0[2], v0[3]); w.z = cvt_pk_bf16(v1[0], v1[1]); w.w = cvt_pk_bf16(v1[2], v1[3]); return w;
}
__device__ __forceinline__ void unpack8(const u32x4& w, f32x4& v0, f32x4& v1) {
    v0 = (f32x4){bflo(w.x), bfhi(w.x), bflo(w.y), bfhi(w.y)}; v1 = (f32x4){bflo(w.z), bfhi(w.z), bflo(w.w), bfhi(w.w)};
}

struct EpiIn {
    static constexpr bool HAS_MID = false;
    bf16_t* qkvu; bf16_t* gate; float* out;
    __device__ __forceinline__ void operator()(const f32x4 (&acc)[2][2][4][2], const Unit& u, int wr, int wc, int fr, int fq) const {
        const int row0 = u.pm * 256 + wr * 64 + fr, cw = wc * 32 + 8 * fq;
        if (u.pn >= 16) {
            bf16_t* base = gate + (size_t)row0 * 4096 + (u.pn - 16) * 128 + cw;
#pragma unroll
            for (int ai = 0; ai < 2; ++ai)
#pragma unroll
                for (int m = 0; m < 4; ++m) { bf16_t* rowp = base + (size_t)(ai * 128 + m * 16) * 4096;
                    f32x4 r0, r1, b0, b1;
#pragma unroll
                    for (int j = 0; j < 4; ++j) { b0[j] = fmaxf(fast_sigmoid(acc[ai][1][m][0][j]), 1e-30f); b1[j] = fmaxf(fast_sigmoid(acc[ai][1][m][1][j]), 1e-30f);
                        r0[j] = fast_sigmoid(acc[ai][0][m][0][j]) * __builtin_amdgcn_rcpf(b0[j]); r1[j] = fast_sigmoid(acc[ai][0][m][1][j]) * __builtin_amdgcn_rcpf(b1[j]); }
                    *(u32x4*)rowp = pack8(r0, r1); *(u32x4*)(rowp + 2048) = pack8(b0, b1); }
        } else {
            const int sec = u.pn >> 2, cc = (u.pn & 3) * 256 + cw;
            bf16_t* base = qkvu + (size_t)sec * MT * 1024 + (size_t)row0 * 1024 + cc;
#pragma unroll
            for (int ai = 0; ai < 2; ++ai)
#pragma unroll
                for (int m = 0; m < 4; ++m) { bf16_t* rowp = base + (size_t)(ai * 128 + m * 16) * 1024;
#pragma unroll
                    for (int bj = 0; bj < 2; ++bj) *(u32x4*)(rowp + bj * 128) = pack8(acc[ai][bj][m][0], acc[ai][bj][m][1]); }
            if (sec >= 2) {
                const size_t offp = (sec == 2) ? OFF_KP : OFF_VP, offs = (sec == 2) ? OFF_KS : OFF_VS;
#pragma unroll
                for (int ai = 0; ai < 2; ++ai)
#pragma unroll
                    for (int m = 0; m < 4; ++m) { const int row = row0 + ai * 128 + m * 16;
                        if (row < MV) { float* o = out + (row < MP ? offp + (size_t)row * 1024 : offs + (size_t)(row - MP) * 1024) + cc;
#pragma unroll
                            for (int bj = 0; bj < 2; ++bj) { *(f32x4*)(o + bj * 128) = acc[ai][bj][m][0]; *(f32x4*)(o + bj * 128 + 4) = acc[ai][bj][m][1]; } } }
            } else if (sec == 0 && ((u.pm & 15) == 15 || u.pm == 64)) {
#pragma unroll
                for (int ai = 0; ai < 2; ++ai)
#pragma unroll
                    for (int m = 0; m < 4; ++m) { const int row = row0 + ai * 128 + m * 16; long off = -1;
                        if (row < MP) { const int t = row & (SEQ - 1); if (t >= SEQ - 15) off = (long)OFF_PP + ((long)(row >> 12) * 15 + (t - (SEQ - 15))) * 1024; }
                        else if (row < MV) { const int t = (row - MP) & 15, b = (row - MP) >> 4; if (t >= 1) off = (long)OFF_PS + ((long)b * 15 + (t - 1)) * 1024; }
                        if (off >= 0) { float* o = out + off + cc;
#pragma unroll
                            for (int bj = 0; bj < 2; ++bj) { *(f32x4*)(o + bj * 128) = acc[ai][bj][m][0]; *(f32x4*)(o + bj * 128 + 4) = acc[ai][bj][m][1]; } } }
            }
        }
    }
};
struct EpiMerged {
    static constexpr bool HAS_MID = true;
    const bf16_t* gate; bf16_t* merged;
    __device__ __forceinline__ void mid(f32x4 (&acc)[2][2][4][2], const Unit& u, int wr, int wc, int fr, int fq) const {
        int zoff = 0; asm volatile("" : "+v"(zoff));
        const int row0 = u.pm * 256 + wr * 64 + fr + zoff, cc = u.pn * 256 + wc * 32 + 8 * fq;
#pragma unroll
        for (int ai = 0; ai < 2; ++ai) {
            if (ai == 1 && u.half) break;
            u32x4 rw[4][2];
#pragma unroll
            for (int m = 0; m < 4; ++m)
#pragma unroll
                for (int bj = 0; bj < 2; ++bj) rw[m][bj] = *(const u32x4*)(gate + (size_t)(row0 + ai * 128 + m * 16) * 4096 + cc + bj * 128);
#pragma unroll
            for (int m = 0; m < 4; ++m)
#pragma unroll
                for (int bj = 0; bj < 2; ++bj) { f32x4 a0, a1; unpack8(rw[m][bj], a0, a1); acc[ai][bj][m][0] *= a0; acc[ai][bj][m][1] *= a1; }
            __builtin_amdgcn_sched_barrier(0);
        }
    }
    __device__ __forceinline__ void operator()(const f32x4 (&acc)[2][2][4][2], const Unit& u, int wr, int wc, int fr, int fq) const {
        const int row0 = u.pm * 256 + wr * 64 + fr, cc = u.pn * 256 + wc * 32 + 8 * fq;
#pragma unroll
        for (int ai = 0; ai < 2; ++ai)
#pragma unroll
            for (int m = 0; m < 4; ++m) { const int row = row0 + ai * 128 + m * 16;
                const bf16_t* gp = gate + (size_t)row * 4096 + 2048 + cc; bf16_t* o = merged + (size_t)row * D + cc;
#pragma unroll
                for (int bj = 0; bj < 2; ++bj) { const u32x4 gw = *(const u32x4*)(gp + bj * 128); f32x4 g0, g1; unpack8(gw, g0, g1);
                    *(u32x4*)(o + bj * 128) = pack8(acc[ai][bj][m][0] * g0, acc[ai][bj][m][1] * g1); } }
    }
};
struct EpiOut {
    static constexpr bool HAS_MID = false;
    const float* xp; const float* xs; float* y; bf16_t* hb; float* ssq;
    __device__ __forceinline__ void operator()(const f32x4 (&acc)[2][2][4][2], const Unit& u, int wr, int wc, int fr, int fq) const {
        int zoff = 0; asm volatile("" : "+v"(zoff));
        const int row0 = u.pm * 256 + wr * 64 + fr + zoff, cc = u.pn * 256 + wc * 32 + 8 * fq;
#pragma unroll
        for (int ai = 0; ai < 2; ++ai) {
            if (ai == 1 && u.half) break;
            f32x4 xv[4][2][2];
#pragma unroll
            for (int m = 0; m < 4; ++m) { const int row = row0 + ai * 128 + m * 16; const bool ok = row < MV;
                const float* xr = (row < MP ? xp + (size_t)row * D : xs + (size_t)(ok ? row - MP : 0) * D) + cc;
#pragma unroll
                for (int bj = 0; bj < 2; ++bj) { xv[m][bj][0] = *(const f32x4*)(xr + bj * 128); xv[m][bj][1] = *(const f32x4*)(xr + bj * 128 + 4); } }
            __builtin_amdgcn_sched_barrier(0);
#pragma unroll
            for (int m = 0; m < 4; ++m) { const int row = row0 + ai * 128 + m * 16; const bool ok = row < MV;
                float* o = y + (size_t)row * D + cc; bf16_t* ob = hb + (size_t)row * D + cc;
                float s = 0.f;
#pragma unroll
                for (int bj = 0; bj < 2; ++bj) { f32x4 h0 = acc[ai][bj][m][0], h1 = acc[ai][bj][m][1];
                    if (ok) { h0 += xv[m][bj][0]; h1 += xv[m][bj][1]; *(f32x4*)(o + bj * 128) = h0; *(f32x4*)(o + bj * 128 + 4) = h1; }
                    *(u32x4*)(ob + bj * 128) = pack8(h0, h1);
                    s += (h0[0] * h0[0] + h0[1] * h0[1]) + (h0[2] * h0[2] + h0[3] * h0[3]) + (h1[0] * h1[0] + h1[1] * h1[1]) + (h1[2] * h1[2] + h1[3] * h1[3]); }
                s += __shfl_xor(s, 16); s += __shfl_xor(s, 32);
                if (fq == 0) ssq[(size_t)(u.pn * 4 + wc) * MT + row] = s; }
            __builtin_amdgcn_sched_barrier(0);
        }
    }
};
struct EpiGU {
    static constexpr bool HAS_MID = false;
    const LAS float* tab; bf16_t* hid;
    __device__ __forceinline__ void operator()(const f32x4 (&acc)[2][2][4][2], const Unit& u, int wr, int wc, int fr, int fq) const {
        const int row0 = u.pm * 256 + wr * 64 + fr, cc = u.pn * 128 + wc * 32 + 8 * fq;
#pragma unroll
        for (int ai = 0; ai < 2; ++ai)
#pragma unroll
            for (int m = 0; m < 4; ++m) { const int row = row0 + ai * 128 + m * 16;
                const float sc = tab[(u.half ? 256 : 0) + ((ai * 128 + wr * 64 + m * 16 + fr) & (u.half ? 127 : 255))];
                f32x4 r0, r1;
#pragma unroll
                for (int j = 0; j < 4; ++j) { const float g0 = acc[ai][0][m][0][j] * sc, u0 = acc[ai][1][m][0][j] * sc, g1 = acc[ai][0][m][1][j] * sc, u1 = acc[ai][1][m][1][j] * sc;
                    r0[j] = g0 * fast_sigmoid(g0) * u0; r1[j] = g1 * fast_sigmoid(g1) * u1; }
                *(u32x4*)(hid + (size_t)row * FF + cc) = pack8(r0, r1); }
    }
};
constexpr int DN_SPLIT = 11, DN_KT = (FF / 64) / DN_SPLIT;
struct EpiDown {
    static constexpr bool HAS_MID = false;
    float* y; float* part;
    __device__ __forceinline__ void operator()(const f32x4 (&acc)[2][2][4][2], const Unit& u, int wr, int wc, int fr, int fq) const {
        const int row0 = u.pm * 256 + wr * 64 + fr, cc = u.pn * 256 + wc * 32 + 8 * fq;
#pragma unroll
        for (int ai = 0; ai < 2; ++ai)
#pragma unroll
            for (int m = 0; m < 4; ++m) { const int row = row0 + ai * 128 + m * 16;
                if (row < MV) { float* o = y + (size_t)row * D + cc;
                    if (u.half) {
                        float* ps = part + ((size_t)(u.kt0 / DN_KT) * MS + (row - MP)) * D + cc;
#pragma unroll
                        for (int bj = 0; bj < 2; ++bj) { *(f32x4*)(ps + bj * 128) = acc[ai][bj][m][0]; *(f32x4*)(ps + bj * 128 + 4) = acc[ai][bj][m][1]; }
                    } else {
#pragma unroll
                    for (int bj = 0; bj < 2; ++bj) { *(f32x4*)(o + bj * 128) = *(const f32x4*)(o + bj * 128) + acc[ai][bj][m][0]; *(f32x4*)(o + bj * 128 + 4) = *(const f32x4*)(o + bj * 128 + 4) + acc[ai][bj][m][1]; } } } }
    }
};

struct EpiWA {
    static constexpr bool HAS_MID = false;
    bf16_t* dst;
    __device__ __forceinline__ void operator()(const f32x4 (&acc)[2][2][4][2], const Unit& u, int wr, int wc, int fr, int fq) const {
        const int row0 = u.pm * 256 + wr * 64 + fr, cc = wc * 32 + 8 * fq;
#pragma unroll
        for (int ai = 0; ai < 2; ++ai)
#pragma unroll
            for (int m = 0; m < 4; ++m) { bf16_t* o = dst + (size_t)(row0 + ai * 128 + m * 16) * 2048 + cc;
#pragma unroll
                for (int bj = 0; bj < 2; ++bj) *(u32x4*)(o + bj * 128) = pack8(acc[ai][bj][m][0], acc[ai][bj][m][1]); }
    }
};

__device__ __forceinline__ void p0_item(const float* W, int N, int k0, int n0, const float* gsc, bf16_t* dst, int ldd, int drow0, int dcol0, LAS float* scr, int lane) {
    const float* wp = W + (size_t)k0 * N + n0 + lane;
    float v[64];
#pragma unroll
    for (int i = 0; i < 64; ++i) v[i] = wp[(size_t)i * N];
    if (gsc) {
#pragma unroll
        for (int i = 0; i < 64; ++i) v[i] *= gsc[k0 + i]; }
#pragma unroll
    for (int i = 0; i < 64; ++i) scr[i * 65 + lane] = v[i];
    asm volatile("s_waitcnt lgkmcnt(0)" ::: "memory");
    const int c = lane & 7;
#pragma unroll
    for (int j = 0; j < 8; ++j) { const int n = (lane >> 3) + 8 * j; const LAS float* s = scr + (8 * c) * 65 + n;
        u32x4 o; o.x = cvt_pk_bf16(s[0 * 65], s[1 * 65]); o.y = cvt_pk_bf16(s[2 * 65], s[3 * 65]); o.z = cvt_pk_bf16(s[4 * 65], s[5 * 65]); o.w = cvt_pk_bf16(s[6 * 65], s[7 * 65]);
        *(u32x4*)(dst + (size_t)(drow0 + n) * ldd + dcol0 + k0 + 8 * c) = o; }
    asm volatile("s_waitcnt lgkmcnt(0)" ::: "memory");
}

struct Params {
    const float *x_prompt, *x_sample, *cache_k, *cache_v, *state_pool, *g_mix, *w_in, *w_pool, *s_pool, *w_branch, *w_out, *g_ffn, *w_gate_up, *w_down, *g_final;
    float* out; unsigned char* ws; int ph_lo, ph_hi;
};

__device__ __forceinline__ void xn_row(const Params& p, int m, int lane);
__device__ __forceinline__ void phase0(const Params& p, LAS unsigned char* lds, int gw, int NGW, int wave, int lane, unsigned xcc) {
    LAS float* scr = (LAS float*)(lds + wave * 16640);
    bf16_t* Wt_in = (bf16_t*)(p.ws + WS_WIN); bf16_t* Wt_br = (bf16_t*)(p.ws + WS_WBR); bf16_t* Wt_out = (bf16_t*)(p.ws + WS_WOUT);
    bf16_t* Wt_gu = (bf16_t*)(p.ws + WS_WGU); bf16_t* Wt_dn = (bf16_t*)(p.ws + WS_WDN); bf16_t* XN = (bf16_t*)(p.ws + WS_XN);
    bf16_t* TMPA = (bf16_t*)(p.ws + WS_TMPA); bf16_t* WPB = (bf16_t*)(p.ws + WS_WPB);
    constexpr int I_IN = (D / 64) * (NIN / 64), I_BR = (D / 64) * (D / 64), I_OUT = (D / 64) * (D / 64), I_GU = (D / 64) * (NGU / 64), I_DN = (FF / 64) * (D / 64);
    constexpr int NITEMS = I_IN + I_BR + I_OUT + I_GU + I_DN;
    unsigned* ctr = (unsigned*)(p.ws + WS_BAR) + 3648 + 64 * (xcc & 7);
    constexpr int NXN = MT / 2;
    for (;;) {
        unsigned kq = 0; if (lane == 0) kq = __hip_atomic_fetch_add(ctr, 1u, __ATOMIC_RELAXED, __HIP_MEMORY_SCOPE_AGENT);
        const int it = 8 * (int)__builtin_amdgcn_readfirstlane(kq) + (int)(xcc & 7);
        if (it >= NITEMS + NXN) break;
        if (it >= NITEMS) { xn_row(p, 2 * (it - NITEMS), lane); xn_row(p, 2 * (it - NITEMS) + 1, lane); continue; }
        int r = it;
        if (r < I_IN) { const int nb = NIN / 64; const int n0 = 64 * (r % nb); int drow = n0;
            if (n0 >= 4096) { const int q = n0 - 4096; drow = q < 2048 ? 4096 + (q / 128) * 256 + (q % 128) : 4096 + ((q - 2048) / 128) * 256 + 128 + ((q - 2048) % 128); }
            p0_item(p.w_in, NIN, 64 * (r / nb), n0, p.g_mix, Wt_in, D, drow, 0, scr, lane); continue; } r -= I_IN;
        if (r < I_BR) { const int nb = D / 64; const int k0 = 64 * (r / nb), n0 = 64 * (r % nb);
            if (k0 < 1024) p0_item(p.w_branch, D, k0, n0, p.s_pool, TMPA, 1024, n0, 0, scr, lane);
            else p0_item(p.w_branch, D, k0, n0, nullptr, Wt_br, 2048, n0, 0, scr, lane);
            continue; } r -= I_BR;
        if (r < I_OUT) { const int nb = D / 64; p0_item(p.w_out, D, 64 * (r / nb), 64 * (r % nb), nullptr, Wt_out, D, 64 * (r % nb), 0, scr, lane); continue; } r -= I_OUT;
        if (r < I_GU) { const int nb = NGU / 64; const int n0 = 64 * (r % nb); const int drow = n0 < FF ? (n0 / 128) * 256 + (n0 % 128) : ((n0 - FF) / 128) * 256 + 128 + ((n0 - FF) % 128);
            p0_item(p.w_gate_up, NGU, 64 * (r / nb), n0, p.g_ffn, Wt_gu, D, drow, 0, scr, lane); continue; } r -= I_GU;
        { const int nb = D / 64; p0_item(p.w_down, D, 64 * (r / nb), 64 * (r % nb), nullptr, Wt_dn, FF, 64 * (r % nb), 0, scr, lane); }
    }
}
__device__ __forceinline__ void xn_row(const Params& p, int m, int lane) {
    bf16_t* XN = (bf16_t*)(p.ws + WS_XN);
    u32x2* o8 = (u32x2*)(XN + (size_t)m * D) + lane;
    if (m >= MV) {
#pragma unroll
        for (int j = 0; j < 8; ++j) o8[64 * j] = (u32x2){0u, 0u};
        return; }
    const f32x4* xr = (const f32x4*)(m < MP ? p.x_prompt + (size_t)m * D : p.x_sample + (size_t)(m - MP) * D) + lane;
    f32x4 v[8]; float s = 0.f;
#pragma unroll
    for (int j = 0; j < 8; ++j) { v[j] = xr[64 * j]; s += (v[j].x * v[j].x + v[j].y * v[j].y) + (v[j].z * v[j].z + v[j].w * v[j].w); }
    const float rs = __builtin_amdgcn_rsqf(wave_sum(s) * (1.0f / D) + EPS);
#pragma unroll
    for (int j = 0; j < 8; ++j) o8[64 * j] = (u32x2){cvt_pk_bf16(v[j].x * rs, v[j].y * rs), cvt_pk_bf16(v[j].z * rs, v[j].w * rs)};
}
__device__ __forceinline__ void phase0b(const Params& p, int gw, int NGW, int lane) {
    bf16_t* WPB = (bf16_t*)(p.ws + WS_WPB);
    for (int i = gw * 64 + lane; i < 4 * 256 * 256 / 8; i += NGW * 64) { const f32x4 a = *(const f32x4*)(p.w_pool + (size_t)i * 8), b = *(const f32x4*)(p.w_pool + (size_t)i * 8 + 4); *(u32x4*)(WPB + (size_t)i * 8) = pack8(a, b); }
    float* ssq = (float*)(p.ws + WS_SSQ);
    for (int i = gw * 64 + lane; i < MT; i += NGW * 64) ssq[i] = 0.f;
}

constexpr int VROW = 320;
__device__ __forceinline__ s16x4 vtr(const LAS unsigned char* p) { typedef short v4i16_t __attribute__((ext_vector_type(4))); return __builtin_bit_cast(s16x4, __builtin_amdgcn_ds_read_tr16_b64_v4i16((LAS v4i16_t*)p)); }
__device__ __forceinline__ bf16x8 cvt8(const f32x4& a, const f32x4& b) { u32x4 w = pack8(a, b); return __builtin_bit_cast(bf16x8, w); }

__device__ __forceinline__ void attn_unit(const Params& p, LAS unsigned char* vl, int unit, int lane) {
    const bf16_t* Ub = (const bf16_t*)(p.ws + WS_QKVU);
    const bf16_t* Qb = Ub + (size_t)MT * 1024; const bf16_t* Kb = Qb + (size_t)MT * 1024; const bf16_t* Vb = Kb + (size_t)MT * 1024;
    bf16_t* AO = (bf16_t*)(p.ws + WS_AO);
    const int n = lane & 31, hh = lane >> 5;
    const bool sample = unit < 64;
    int b, h, qrow0, nblk;
    if (sample) { b = unit >> 3; h = unit & 7; qrow0 = MP + b * DSEQ; nblk = 1 + PAST / 32; }
    else { const int u2 = unit - 64; const int qb = u2 & 127; h = (u2 >> 7) & 7; b = u2 >> 10; qrow0 = b * SEQ + qb * 32; nblk = qb + 1; }
    bf16x8 qf[8];
    { const bf16_t* qp = Qb + (size_t)(qrow0 + n) * 1024 + h * HD + 64 * hh;
#pragma unroll
      for (int kk = 0; kk < 8; ++kk) qf[kk] = *(const bf16x8*)(qp + 8 * kk); }
    f32x16 o[4];
#pragma unroll
    for (int db = 0; db < 4; ++db)
#pragma unroll
        for (int r = 0; r < 16; ++r) o[db][r] = 0.f;
    float R = (sample && n >= DSEQ) ? -1e30f : 0.f;
    const float* ck = p.cache_k + (size_t)b * PAST * 1024 + h * HD; const float* cv = p.cache_v + (size_t)b * PAST * 1024 + h * HD;
    const int vaddr = (4 * hh + ((lane & 15) >> 2)) * VROW + (16 * ((lane >> 4) & 1) + 4 * (lane & 3)) * 2;
    for (int blk = 0; blk < nblk; ++blk) {
        bf16x8 kf[8];
        const bool diag = (blk == 0);
        if (!sample || blk == 0) {
            const int s0 = qrow0 - blk * 32;
            const bf16_t* kp = Kb + (size_t)(s0 + n) * 1024 + h * HD + 64 * hh;
#pragma unroll
            for (int kk = 0; kk < 8; ++kk) kf[kk] = *(const bf16x8*)(kp + 8 * kk);
            const bf16_t* vp = Vb + (size_t)(s0 + (lane >> 4)) * 1024 + h * HD + 8 * (lane & 15);
#pragma unroll
            for (int it = 0; it < 8; ++it) { const u32x4 w = *(const u32x4*)(vp + (size_t)(4 * it) * 1024); *(LAS u32x4*)(vl + (4 * it + (lane >> 4)) * VROW + 16 * (lane & 15)) = w; }
        } else {
            const int s0 = PAST - blk * 32;
            const float* kp = ck + (size_t)(s0 + n) * 1024 + 64 * hh;
#pragma unroll
            for (int kk = 0; kk < 8; ++kk) kf[kk] = cvt8(*(const f32x4*)(kp + 8 * kk), *(const f32x4*)(kp + 8 * kk + 4));
            const float* vp = cv + (size_t)(s0 + (lane >> 4)) * 1024 + 8 * (lane & 15);
#pragma unroll
            for (int it = 0; it < 8; ++it) { const f32x4 a = *(const f32x4*)(vp + (size_t)(4 * it) * 1024), c = *(const f32x4*)(vp + (size_t)(4 * it) * 1024 + 4);
                *(LAS u32x4*)(vl + (4 * it + (lane >> 4)) * VROW + 16 * (lane & 15)) = pack8(a, c); }
        }
        f32x16 st;
#pragma unroll
        for (int r = 0; r < 16; ++r) st[r] = 0.f;
#pragma unroll
        for (int kk = 0; kk < 8; ++kk) st = __builtin_amdgcn_mfma_f32_32x32x16_bf16(kf[kk], qf[kk], st, 0, 0, 0);
        float l1m[16], ls[16];
#pragma unroll
        for (int r = 0; r < 16; ++r) { const int i = (r & 3) + 8 * (r >> 2) + 4 * hh; const bool valid = !diag || (i < n);
            const float z = st[r] * 0.08838834764831845f; const float sp = fmaxf(z, 0.f) + __logf(1.0f + __expf(-fabsf(z)));
            l1m[r] = valid ? -sp : 0.f; ls[r] = valid ? (z - sp) : -1e30f; }
        float gown[4], goth[4];
#pragma unroll
        for (int a = 0; a < 4; ++a) { gown[a] = (l1m[4 * a] + l1m[4 * a + 1]) + (l1m[4 * a + 2] + l1m[4 * a + 3]); goth[a] = __shfl_xor(gown[a], 32); }
        float wv[16]; float tail = R;
#pragma unroll
        for (int a = 3; a >= 0; --a) { float sfx = tail + (hh == 0 ? goth[a] : 0.f);
#pragma unroll
            for (int rr = 3; rr >= 0; --rr) { wv[4 * a + rr] = __expf(ls[4 * a + rr] + sfx); sfx += l1m[4 * a + rr]; }
            tail += gown[a] + goth[a]; }
        R = tail;
        bf16x8 wb[2];
#pragma unroll
        for (int s = 0; s < 2; ++s) wb[s] = cvt8((f32x4){wv[8 * s], wv[8 * s + 1], wv[8 * s + 2], wv[8 * s + 3]}, (f32x4){wv[8 * s + 4], wv[8 * s + 5], wv[8 * s + 6], wv[8 * s + 7]});
        asm volatile("s_waitcnt lgkmcnt(0)" ::: "memory");
#pragma unroll
        for (int db = 0; db < 4; ++db)
#pragma unroll
            for (int s = 0; s < 2; ++s) { const s16x4 lo = vtr(vl + vaddr + (16 * s) * VROW + 64 * db), hi = vtr(vl + vaddr + (16 * s + 8) * VROW + 64 * db);
                const bf16x8 vf = (bf16x8){lo[0], lo[1], lo[2], lo[3], hi[0], hi[1], hi[2], hi[3]};
                o[db] = __builtin_amdgcn_mfma_f32_32x32x16_bf16(vf, wb[s], o[db], 0, 0, 0); }
        asm volatile("s_waitcnt lgkmcnt(0)" ::: "memory");
        if (__all(R < -104.0f)) break;
    }
    if (!sample || n < DSEQ) {
        bf16_t* op = AO + (size_t)(qrow0 + n) * 2048 + 1024 + h * HD + 4 * hh;
#pragma unroll
        for (int db = 0; db < 4; ++db)
#pragma unroll
            for (int a = 0; a < 4; ++a) *(u32x2*)(op + 32 * db + 8 * a) = (u32x2){cvt_pk_bf16(o[db][4 * a], o[db][4 * a + 1]), cvt_pk_bf16(o[db][4 * a + 2], o[db][4 * a + 3])};
    }
}

template <int W>
__device__ __forceinline__ void diff_chunk(const Params& p, int ch, int cc) {
    const bf16_t* Ub = (const bf16_t*)(p.ws + WS_QKVU); bf16_t* AO = (bf16_t*)(p.ws + WS_AO);
    const int m0 = ch * 16; const bool prompt = m0 < MP; const int t0 = prompt ? (m0 & (SEQ - 1)) : PAST;
    const bf16_t* up = Ub + (size_t)m0 * 1024 + cc * 8;
    u32x4 raw[15 + W];
#pragma unroll
    for (int r = 0; r < 16; ++r) raw[W - 1 + r] = *(const u32x4*)(up + (size_t)r * 1024);
    if (prompt) {
#pragma unroll
        for (int j = 1; j < W; ++j) { const u32x4 v = *(const u32x4*)(t0 > 0 ? up - (size_t)j * 1024 : up); raw[W - 1 - j] = (t0 > 0) ? v : (u32x4){0u, 0u, 0u, 0u}; }
    } else { const float* hp = p.state_pool + (size_t)((m0 - MP) >> 4) * 15 * 1024 + cc * 8;
#pragma unroll
        for (int j = 1; j < W; ++j) raw[W - 1 - j] = pack8(*(const f32x4*)(hp + (size_t)(15 - j) * 1024), *(const f32x4*)(hp + (size_t)(15 - j) * 1024 + 4)); }
    f32x4 s0 = (f32x4){0.f, 0.f, 0.f, 0.f}, s1 = s0;
#pragma unroll
    for (int j = 1; j < W; ++j) { f32x4 a, c; unpack8(raw[W - 1 - j], a, c); s0 += a; s1 += c; }
#pragma unroll
    for (int r = 0; r < 16; ++r) { f32x4 a, c; unpack8(raw[W - 1 + r], a, c); s0 += a; s1 += c;
        const int t = t0 + r; const float ic = 1.0f / (float)(t + 1 < W ? t + 1 : W);
        *(u32x4*)(AO + (size_t)(m0 + r) * 2048 + cc * 8) = pack8(s0 * ic - a, s1 * ic - c);
        f32x4 da, dc; unpack8(raw[r], da, dc); s0 -= da; s1 -= dc; }
}
constexpr int N_ATT_UNITS = 64 + 4096, N_DIFF_ITEMS = (MV / 32) * 4, N_P2_ITEMS = N_ATT_UNITS + N_DIFF_ITEMS;
__device__ __forceinline__ void diff_item(const Params& p, int wi, int lane) {
    const int g = wi & 3, ch = 2 * (wi >> 2) + (lane >> 5), cc = 32 * g + (lane & 31);
    if (g == 0) diff_chunk<2>(p, ch, cc); else if (g == 1) diff_chunk<4>(p, ch, cc); else if (g == 2) diff_chunk<8>(p, ch, cc); else diff_chunk<16>(p, ch, cc);
}

__global__ void __launch_bounds__(512, 2) fwd_megakernel(Params p) {
    extern __shared__ __attribute__((aligned(16))) unsigned char lds_raw[];
    LAS unsigned char* lds = (LAS unsigned char*)lds_raw;
    const int tid = threadIdx.x, lane = tid & 63, wave = __builtin_amdgcn_readfirstlane(tid >> 6);
    const int G = gridDim.x, bx = blockIdx.x;
    const int vcu = (G % 8 == 0) ? (bx % 8) * (G / 8) + bx / 8 : bx;
    const int gw = vcu * 8 + wave, NGW = G * 8;
    cg::grid_group grid = cg::this_grid();
    volatile LAS unsigned* xst = (volatile LAS unsigned*)(lds + LDS_BYTES - 64);
    if (tid < 2) xst[tid] = 0u;
    __syncthreads();
    XcdBarrier xbar = xcd_barrier_post((unsigned*)(p.ws + WS_BAR), xst);
#define IN(k) (p.ph_lo <= (k) && (k) < p.ph_hi)
#define SEAM(k) do { if (IN(k) && IN((k) + 1)) { if (p.ph_hi > 64) grid.sync();   xcd_barrier(xbar); } STAMP(); } while (0)
    bf16_t* Wt_in = (bf16_t*)(p.ws + WS_WIN); bf16_t* Wt_br = (bf16_t*)(p.ws + WS_WBR); bf16_t* Wt_out = (bf16_t*)(p.ws + WS_WOUT);
    bf16_t* Wt_gu = (bf16_t*)(p.ws + WS_WGU); bf16_t* Wt_dn = (bf16_t*)(p.ws + WS_WDN); bf16_t* XN = (bf16_t*)(p.ws + WS_XN);
    bf16_t* QKVU = (bf16_t*)(p.ws + WS_QKVU); bf16_t* GATE = (bf16_t*)(p.ws + WS_GATE); bf16_t* AO = (bf16_t*)(p.ws + WS_AO);
    bf16_t* MERGED = (bf16_t*)(p.ws + WS_MERGED); bf16_t* HID = (bf16_t*)(p.ws + WS_HID); float* SSQ = (float*)(p.ws + WS_SSQ);
    float* Y = p.out + OFF_Y;
#ifdef PROBE_T
    unsigned long long tstamp[10]; int nst = 0;
#define STAMP() do { tstamp[nst++] = __builtin_amdgcn_s_memrealtime(); } while (0)
#else
#define STAMP() do {} while (0)
#endif
    STAMP();

    if (IN(0)) { phase0(p, lds, gw, NGW, wave, lane, xbar.x);
#ifdef PROBE_T
#endif
        phase0b(p, gw, NGW, lane);
    }
    SEAM(0);
    if (IN(1)) { pg8::Gemm g{XN, Wt_in, D, D, MT, NIN, D}; pg8::StaticOrder S; S.init(64, NIN / 256, D / 64, G, bx, 64, 1); EpiIn E{QKVU, GATE, p.out}; pg8::gemm_phase(lds, g, S, E); }
    SEAM(1);
    if (IN(2)) {
        LAS unsigned char* vl = lds + wave * (32 * VROW);
        unsigned* ctr = (unsigned*)(p.ws + WS_BAR) + 3584;
        int item = gw;
        while (item < N_P2_ITEMS) {
            if (item < N_ATT_UNITS) attn_unit(p, vl, item, lane); else diff_item(p, item - N_ATT_UNITS, lane);
            unsigned nx = 0; if (lane == 0) nx = __hip_atomic_fetch_add(ctr, 1u, __ATOMIC_RELAXED, __HIP_MEMORY_SCOPE_AGENT);
            item = NGW + (int)__builtin_amdgcn_readfirstlane(nx);
        }
        __syncthreads();
        for (int gq = 0; gq < 4; ++gq) { pg8::Gemm g{(const bf16_t*)(p.ws + WS_TMPA) + gq * 256, (const bf16_t*)(p.ws + WS_WPB) + gq * 65536, 1024, 256, 2048, 256, 256};
            pg8::StaticOrder S; S.init(8, 1, 4, G, (bx + G - 8 * gq) % G); EpiWA E{Wt_br + gq * 256}; pg8::gemm_phase(lds, g, S, E); }
    }
    SEAM(2);
    if (IN(3)) {
        { pg8::Gemm g{AO, Wt_br, 2048, 2048, MT, D, 2048}; pg8::StaticOrder S; S.init(64, 8, 32, G, bx, 64, 1); EpiMerged E{GATE, MERGED}; pg8::gemm_phase(lds, g, S, E); }
    }
    SEAM(3);
    if (IN(4)) { pg8::Gemm g{MERGED, Wt_out, D, D, MT, D, D}; pg8::StaticOrder S; S.init(64, 8, 32, G, bx, 64, 1); EpiOut E{p.x_prompt, p.x_sample, Y, XN, (float*)(p.ws + WS_SSQP)}; pg8::gemm_phase(lds, g, S, E); }
    SEAM(4);
    if (IN(5)) { pg8::Gemm g{XN, Wt_gu, D, D, MT, NGU, D}; pg8::StaticOrder S; S.init(64, NGU / 256, 32, G, bx, 64, 1);
        LAS float* tab = (LAS float*)(lds + 131072);
        { pg8::Unit u0; S.next(0, u0); const float* sp = (const float*)(p.ws + WS_SSQP);
          if (tid < 384) { const int row = tid < 256 ? u0.pm * 256 + tid : MP + (tid - 256); float a = 0.f;
#pragma unroll 8
              for (int k = 0; k < 32; ++k) a += sp[(size_t)k * MT + row];
              tab[tid] = __builtin_amdgcn_rsqf(a * (1.0f / D) + EPS); }
          __syncthreads(); }
        EpiGU E{tab, HID}; pg8::gemm_phase(lds, g, S, E); }
    SEAM(5);
    if (IN(6)) { pg8::Gemm g{HID, Wt_dn, FF, FF, MT, D, FF}; pg8::StaticOrder S; S.init(64, 8, FF / 64, G, bx, 64, DN_SPLIT); EpiDown E{Y, (float*)(p.ws + WS_AO)}; pg8::gemm_phase(lds, g, S, E); }
    SEAM(6);
    if (IN(7)) {
        for (int m = gw; m < MV; m += NGW) {
            f32x4* yr = (f32x4*)(Y + (size_t)m * D) + lane; const f32x4* gf = (const f32x4*)p.g_final + lane;
            f32x4 v[8]; float s = 0.f;
#pragma unroll
            for (int j = 0; j < 8; ++j) v[j] = yr[64 * j];
            if (m >= MP) { const f32x4* pr = (const f32x4*)((const float*)(p.ws + WS_AO) + (size_t)(m - MP) * D) + lane;
                for (int c = 0; c < DN_SPLIT; ++c)
#pragma unroll
                    for (int j = 0; j < 8; ++j) v[j] += pr[(size_t)c * MS * D / 4 + 64 * j]; }
#pragma unroll
            for (int j = 0; j < 8; ++j) s += (v[j].x * v[j].x + v[j].y * v[j].y) + (v[j].z * v[j].z + v[j].w * v[j].w);
            const float rs = __builtin_amdgcn_rsqf(wave_sum(s) * (1.0f / D) + EPS);
#pragma unroll
            for (int j = 0; j < 8; ++j) yr[64 * j] = v[j] * rs * gf[64 * j];
        }
    }
#ifdef PROBE_T
    STAMP();
    if (bx == 0 && tid == 0) {
        const unsigned long long e1 = (unsigned long long)__hip_atomic_load((long long*)(p.ws + WS_SSQ + 512 * 1024), __ATOMIC_RELAXED, __HIP_MEMORY_SCOPE_AGENT);
        const unsigned long long e2 = (unsigned long long)__hip_atomic_load((long long*)(p.ws + WS_SSQ + 512 * 1024 + 256), __ATOMIC_RELAXED, __HIP_MEMORY_SCOPE_AGENT);
        (void)e1; (void)e2;
        const float ta = (float)(tstamp[PROBE_A + 1] - tstamp[PROBE_A]) * 0.01f, tb = (float)(tstamp[PROBE_B + 1] - tstamp[PROBE_B]) * 0.01f;
        asm volatile("s_waitcnt vmcnt(0)" ::: "memory");
        atomicAdd(Y, 4.0f + ta * (1.0f / 256.0f)); atomicAdd(p.out + OFF_PP, 1.5f + tb * (1.0f / 500.0f));
    }
#endif
#undef IN
#undef SEAM
}

extern "C" void kernel_launch(void* const* d_in, const int* in_sizes, int n_in, void* d_out, int out_size, void* d_ws, size_t ws_size, hipStream_t stream) {
    static int grid = 0;
    if (grid == 0) {
        if (n_in != 15 || (size_t)out_size != OUT_TOTAL || ws_size < WS_END) { fprintf(stderr, "kernel_launch: unexpected shapes: n_in %d out %d ws %zu\n", n_in, out_size, ws_size); grid = -1; return; }
        int dev = 0, cus = 0, per_cu = 0;
        hipGetDevice(&dev); hipDeviceGetAttribute(&cus, hipDeviceAttributeMultiprocessorCount, dev);
        hipFuncSetAttribute((const void*)fwd_megakernel, hipFuncAttributeMaxDynamicSharedMemorySize, LDS_BYTES);
        hipOccupancyMaxActiveBlocksPerMultiprocessor(&per_cu, (const void*)fwd_megakernel, 512, LDS_BYTES);
        if (per_cu < 1) { fprintf(stderr, "kernel_launch: occupancy query says %d blocks per CU\n", per_cu); per_cu = 1; }
        (void)hipGetLastError();
        grid = cus;
    }
    if (grid < 0) return;
    Params p{};
    const float** pp = (const float**)&p;
    for (int i = 0; i < 15; ++i) pp[i] = (const float*)d_in[i];
    p.out = (float*)d_out; p.ws = (unsigned char*)d_ws;
#if N_LAUNCH_MODE == 1
    p.ph_lo = 0; p.ph_hi = 8;
    void* args[] = {&p};
    if (hipMemsetAsync((char*)d_ws + WS_BAR, 0, WS_BAR_BYTES, stream) != hipSuccess) fprintf(stderr, "kernel_launch: memset of the barrier words failed\n");
    hipError_t e = hipLaunchCooperativeKernel((const void*)fwd_megakernel, dim3(grid), dim3(512), args, LDS_BYTES, stream);
    if (e != hipSuccess) fprintf(stderr, "cooperative launch failed: %s (grid %d)\n", hipGetErrorString(e), grid);
#else
    for (int ph = 0; ph < 8; ++ph) { p.ph_lo = ph; p.ph_hi = ph + 1; hipLaunchKernelGGL(fwd_megakernel, dim3(grid), dim3(512), LDS_BYTES, stream, p); }
#endif
}
```

```cpp
#include <hip/hip_runtime.h>
#include <hip/hip_cooperative_groups.h>
#include <cstdio>
#include <cstdint>
namespace cg = cooperative_groups;

#define PROBE_A 6
#define PROBE_B 4
#ifndef N_LAUNCH_MODE
#define N_LAUNCH_MODE 1
#endif

#define LAS __attribute__((address_space(3)))
typedef unsigned short bf16_t;
typedef short bf16x8 __attribute__((ext_vector_type(8)));
typedef short s16x4 __attribute__((ext_vector_type(4)));
typedef float f32x4 __attribute__((ext_vector_type(4)));
typedef float f32x16 __attribute__((ext_vector_type(16)));
typedef unsigned u32x4 __attribute__((ext_vector_type(4)));
typedef unsigned u32x2 __attribute__((ext_vector_type(2)));

constexpr int D = 2048, MP = 16384, MS = 128, MV = MP + MS, MT = 16640;
constexpr int SEQ = 4096, DSEQ = 16, PAST = 4096, NH = 8, HD = 128;
constexpr int NIN = 8192, FF = 5632, NGU = 2 * FF, AW = 1024;
constexpr float EPS = 1e-6f;
constexpr size_t OFF_Y = 0, OFF_KP = (size_t)MV * D, OFF_VP = OFF_KP + (size_t)MP * 1024, OFF_PP = OFF_VP + (size_t)MP * 1024,
                 OFF_KS = OFF_PP + 4 * 15 * 1024, OFF_VS = OFF_KS + (size_t)MS * 1024, OFF_PS = OFF_VS + (size_t)MS * 1024, OUT_TOTAL = OFF_PS + 8 * 15 * 1024;
constexpr size_t MiB = 1u << 20;
constexpr size_t WS_SSQ = 0, WS_WIN = 1 * MiB, WS_WBR = 33 * MiB, WS_WOUT = 41 * MiB, WS_WGU = 49 * MiB, WS_WDN = 93 * MiB, WS_XN = 115 * MiB,
                 WS_QKVU = 180 * MiB, WS_GATE = 310 * MiB, WS_AO = 440 * MiB, WS_TMPA = 505 * MiB, WS_WPB = 509 * MiB, WS_SSQP = 510 * MiB, WS_END = 513 * MiB;
constexpr size_t WS_BAR = 768 * 1024, WS_BAR_BYTES = 32768;
constexpr size_t WS_MERGED = WS_QKVU;
constexpr size_t WS_HID = WS_QKVU;
static_assert((size_t)MT * FF * 2 <= WS_AO - WS_QKVU, "hid overlay");
constexpr int LDS_BYTES = 147456;

typedef __bf16 bf16x2_t __attribute__((ext_vector_type(2)));
typedef float f32x2_t __attribute__((ext_vector_type(2)));
__device__ __forceinline__ unsigned cvt_pk_bf16(float lo, float hi) { const f32x2_t v = {lo, hi}; return __builtin_bit_cast(unsigned, __builtin_convertvector(v, bf16x2_t)); }
__device__ __forceinline__ float bf2f(unsigned short b) { return __uint_as_float(((unsigned)b) << 16); }
__device__ __forceinline__ float bflo(unsigned w) { return __uint_as_float(w << 16); }
__device__ __forceinline__ float bfhi(unsigned w) { return __uint_as_float(w & 0xffff0000u); }
__device__ __forceinline__ float fast_sigmoid(float x) { return __builtin_amdgcn_rcpf(1.0f + __expf(-x)); }
__device__ __forceinline__ float wave_sum(float v) {
#pragma unroll
    for (int o = 1; o < 64; o <<= 1) v += __shfl_xor(v, o);
    return v;
}

#define XB_TMO      128
#define XB_XCNT(j)  (256  + 64 * (j))
#define XB_XSUB(j)  (1280 + 64 * (j))
#define XB_XGEN(j)  (2304 + 64 * (j))
#define XB_TOP      3328
#define XB_TOPGEN   3392
#define XCD_BAR_WORDS 3456
#define XB_SPIN_CAP (1u << 18)

__device__ __forceinline__ unsigned xb_ld(unsigned* p)              { return __hip_atomic_load(p, __ATOMIC_RELAXED, __HIP_MEMORY_SCOPE_AGENT); }
__device__ __forceinline__ unsigned xb_add(unsigned* p, unsigned v) { return __hip_atomic_fetch_add(p, v, __ATOMIC_RELAXED, __HIP_MEMORY_SCOPE_AGENT); }
__device__ __forceinline__ unsigned xb_xcc_id() { return (unsigned)__builtin_amdgcn_s_getreg((3 << 11) | 20) & 0xFu; }
#define XB_SPIN(cond, bar) do { unsigned _sp = 0; while (cond) { __builtin_amdgcn_s_sleep(1); \
    if ((++_sp & 255u) == 0u) { if (xb_ld(&(bar)[XB_TMO])) break; if (_sp > XB_SPIN_CAP) { atomicAdd(&(bar)[XB_TMO], 1u); break; } } } } while (0)

struct XcdBarrier {
    unsigned* bar; unsigned x;
    volatile LAS unsigned* st;
};

__device__ __forceinline__ XcdBarrier xcd_barrier_post(unsigned* bar, volatile LAS unsigned* st) {
    XcdBarrier b; b.bar = bar; b.x = xb_xcc_id(); b.st = st;
    if (threadIdx.x == 0) (void)xb_add(&bar[XB_XCNT(b.x)], 1u);
    return b;
}
__device__ __forceinline__ void xcd_barrier_complete(unsigned* bar, unsigned x, unsigned& nloc, unsigned& nx) {
    const unsigned G = gridDim.x * gridDim.y * gridDim.z;
    unsigned sum, cnt, mine, sp = 0u;
    for (;;) {
        sum = 0u; cnt = 0u; mine = 0u;
#pragma unroll
        for (unsigned j = 0; j < 16; ++j) { const unsigned c = xb_ld(&bar[XB_XCNT(j)]); sum += c; cnt += (c > 0u) ? 1u : 0u; mine = (j == x) ? c : mine; }
        if (sum == G) break;
        __builtin_amdgcn_s_sleep(1);
        if ((++sp & 255u) == 0u) { if (xb_ld(&bar[XB_TMO])) break; if (sp > XB_SPIN_CAP) { atomicAdd(&bar[XB_TMO], 1u); break; } }
    }
    nloc = mine > 0u ? mine : 1u; nx = cnt > 0u ? cnt : 1u;
}

__device__ __forceinline__ void xcd_barrier(const XcdBarrier& b) {
    asm volatile("s_waitcnt vmcnt(0)" ::: "memory");
    __syncthreads();
    if (threadIdx.x == 0) {
        unsigned* bar = b.bar;
        __builtin_amdgcn_s_waitcnt(0);
        unsigned nloc = b.st[0], nx = b.st[1];
        if (nloc == 0u) { xcd_barrier_complete(bar, b.x, nloc, nx); b.st[0] = nloc; b.st[1] = nx; }
        const unsigned old = xb_add(&bar[XB_XSUB(b.x)], 1u);
        const unsigned gen = old / nloc;
        if (old + 1u == (gen + 1u) * nloc) {
            __builtin_amdgcn_fence(__ATOMIC_RELEASE, "agent");
            asm volatile("s_waitcnt vmcnt(0)" ::: "memory");
            const unsigned og = xb_add(&bar[XB_TOP], 1u);
            const unsigned tg = og / nx;
            if (og + 1u == (tg + 1u) * nx) xb_add(&bar[XB_TOPGEN], 1u);
            else XB_SPIN(xb_ld(&bar[XB_TOPGEN]) == tg, bar);
            __builtin_amdgcn_fence(__ATOMIC_ACQUIRE, "agent");
            xb_add(&bar[XB_XGEN(b.x)], 1u);
            asm volatile("s_waitcnt vmcnt(0)" ::: "memory");
        } else {
            XB_SPIN(xb_ld(&bar[XB_XGEN(b.x)]) == gen, bar);
            __builtin_amdgcn_fence(__ATOMIC_ACQUIRE, "agent");
            asm volatile("s_waitcnt vmcnt(0)" ::: "memory");
        }
    }
    __syncthreads();
}

namespace pg8 {
constexpr int BM = 256, BK = 64, HALF = 128, HTB = HALF * BK * 2, STAGE_BYTES = 8 * HTB, NXCD = 8, WGM = 8;
__host__ __device__ __forceinline__ int lds_byte(int r, int c) { const int st = (r >> 4) * 2 + (c >> 5), rr = r & 15, cc = c & 31, ob = rr * 64 + cc * 2; return st * 1024 + (ob ^ (((ob >> 9) & 1) << 5)); }
__host__ __device__ __forceinline__ void stage_rc(int b, int& R, int& C) { const int st = b / 1024, sb = b % 1024, swz = sb ^ (((sb >> 9) & 1) << 5); R = (st >> 1) * 16 + swz / 64; C = (st & 1) * 32 + (swz % 64) / 2; }
__host__ __device__ __forceinline__ int perm32(int rho) { const int n = rho >> 4, i = rho & 15; return 8 * (i >> 2) + 4 * n + (i & 3); }

struct Unit { int pm, pn, kt0, nkt, half; };
struct Gemm { const bf16_t* A; const bf16_t* Bt; int lda, ldb, M, N, K; };

struct StaticOrder {
    int nM, nN, nwg, G, c, ktfull, pmS, nS, ktS;
    __device__ void init(int nM_, int nN_, int ktfull_, int G_, int c_, int pmS_ = 0, int ksplit = 0) { nM = nM_; nN = nN_; nwg = nM * nN; G = G_; c = c_; ktfull = ktfull_; pmS = pmS_; nS = nN * ksplit; ktS = ksplit ? ktfull / ksplit : 0; }
    __device__ bool next(int i, Unit& u) const {
        const int L = i * G + c;
        if (L >= nwg) { const int t = L - nwg;
            if (t >= nS) return false;
            u.pm = pmS; u.pn = t % nN; u.kt0 = (t / nN) * ktS; u.nkt = ktS; u.half = 1; return true; }
        int wgid = L; { const int q = nwg / NXCD, r = nwg % NXCD, xcd = wgid % NXCD, off = wgid / NXCD; wgid = (xcd < r ? xcd * (q + 1) : r * (q + 1) + (xcd - r) * q) + off; }
        const int nig = WGM * nN, gid = wgid / nig, fm = gid * WGM, gsz = (nM - fm) < WGM ? (nM - fm) : WGM;
        u.pm = fm + ((wgid % nig) % gsz); u.pn = (wgid % nig) / gsz; u.kt0 = 0; u.nkt = ktfull; u.half = 0; return true;
    }
};

template <class Epi>
__device__ __forceinline__ void gemm_phase(LAS unsigned char* lds, const Gemm g, const StaticOrder& S, const Epi& E) {
    int tid_ = threadIdx.x; asm volatile("" : "+v"(tid_));
    const int tid = tid_, wid = __builtin_amdgcn_readfirstlane(tid >> 6), lane = tid & 63, wr = wid >> 2, wc = wid & 3, fr = lane & 15, fq = lane >> 4;
    unsigned voffA[2], voffB[2];
#pragma unroll
    for (int i = 0; i < 2; ++i) { int R, C; stage_rc(tid * 16 + i * 8192, R, C); const int Rb = (R & ~31) + perm32(R & 31);
        voffA[i] = (unsigned)(R * g.lda + C) * 2u; voffB[i] = (unsigned)(Rb * g.ldb + C) * 2u; }
    const size_t kstep = (size_t)(BK * 2);
    const size_t hstepA = (size_t)HALF * g.lda * 2, hstepB = (size_t)HALF * g.ldb * 2;
    const size_t tstepA = 2 * hstepA, tstepB = 2 * hstepB;
    const unsigned ldsw = (unsigned)wid * 1024u;
    const int aoff = lds_byte(wr * 64 + fr, fq * 8), boff = lds_byte(wc * 32 + fr, fq * 8);
#define PG8_SA(b, h) (((b) * 2 + (h)) * HTB)
#define PG8_SB(b, h) ((4 + (b) * 2 + (h)) * HTB)
#define PG8_STAGE(bufoff, gbase, voff) do { _Pragma("unroll") for (int _i = 0; _i < 2; ++_i) \
        __builtin_amdgcn_global_load_lds((const unsigned*)((const char*)(gbase) + (voff)[_i]), (LAS unsigned*)(lds + (bufoff) + ldsw + _i * 8192), 16, 0, 0); } while (0)
#define PG8_LDA(dst, b, h) do { _Pragma("unroll") for (int m = 0; m < 4; ++m) _Pragma("unroll") for (int k = 0; k < 2; ++k) dst[m][k] = *(const LAS bf16x8*)(lds + PG8_SA(b, h) + aoff + m * 2048 + k * 1024); } while (0)
#define PG8_LDB(dst, b, h) do { _Pragma("unroll") for (int n = 0; n < 2; ++n) _Pragma("unroll") for (int k = 0; k < 2; ++k) dst[n][k] = *(const LAS bf16x8*)(lds + PG8_SB(b, h) + boff + n * 2048 + k * 1024); } while (0)
#define PG8_MMA(ai, bj, At, Bt) do { __builtin_amdgcn_s_setprio(1); _Pragma("unroll") for (int m = 0; m < 4; ++m) _Pragma("unroll") for (int n = 0; n < 2; ++n) _Pragma("unroll") for (int k = 0; k < 2; ++k) \
        acc[ai][bj][m][n] = __builtin_amdgcn_mfma_f32_16x16x32_bf16(Bt[n][k], At[m][k], acc[ai][bj][m][n], 0, 0, 0); __builtin_amdgcn_s_setprio(0); } while (0)
#define PG8_WAIT_V(n) asm volatile("s_waitcnt vmcnt(" #n ")" ::: "memory")
#define PG8_WAIT_L(n) asm volatile("s_waitcnt lgkmcnt(" #n ")" ::: "memory")
#define PG8_BAR __builtin_amdgcn_s_barrier()
#define PG8_SCHED __builtin_amdgcn_sched_barrier(0)
    Unit cur, nxt; int ui = 0;
    if (!S.next(0, cur)) return;
    f32x4 acc[2][2][4][2];
#pragma unroll
    for (int a = 0; a < 2; ++a)
#pragma unroll
        for (int b = 0; b < 2; ++b)
#pragma unroll
            for (int m = 0; m < 4; ++m)
#pragma unroll
                for (int n = 0; n < 2; ++n) acc[a][b][m][n] = (f32x4){0.f, 0.f, 0.f, 0.f};
    bf16x8 At[4][2], B0[2][2], B1[2][2];
    const char* cA = (const char*)g.A + (size_t)cur.pm * tstepA + (size_t)cur.kt0 * kstep; const char* cB = (const char*)g.Bt + (size_t)cur.pn * tstepB + (size_t)cur.kt0 * kstep;
    PG8_STAGE(PG8_SB(0, 0), cB, voffB); PG8_STAGE(PG8_SB(0, 1), cB + hstepB, voffB); PG8_STAGE(PG8_SA(0, 0), cA, voffA); PG8_STAGE(PG8_SA(0, 1), cA + hstepA, voffA);
    if (wr == 1) PG8_BAR;
    PG8_WAIT_V(2); PG8_BAR;
    PG8_STAGE(PG8_SB(1, 0), cB + kstep, voffB); PG8_STAGE(PG8_SA(1, 0), cA + kstep, voffA); PG8_STAGE(PG8_SB(1, 1), cB + hstepB + kstep, voffB);
    PG8_WAIT_V(6); PG8_BAR;
    for (;;) {
        const bool has_next = S.next(ui + 1, nxt);
        const char* nA = has_next ? (const char*)g.A + (size_t)nxt.pm * tstepA + (size_t)nxt.kt0 * kstep : cA; const char* nB = has_next ? (const char*)g.Bt + (size_t)nxt.pn * tstepB + (size_t)nxt.kt0 * kstep : cB;
        const int nt = cur.nkt; const bool full = !cur.half;
        for (int t = 0; t < nt; t += 2) {
            const bool last = (t == nt - 2);
            if constexpr (Epi::HAS_MID) { if (t == (nt >> 1)) E.mid(acc, cur, wr, wc, fr, fq); }
            const char* a1 = cA + (size_t)(t + 1) * kstep;
            const char* a2 = last ? nA : cA + (size_t)(t + 2) * kstep; const char* b2 = last ? nB : cB + (size_t)(t + 2) * kstep;
            const char* a3 = a2 + kstep; const char* b3 = b2 + kstep;
            PG8_LDB(B0, 0, 0); PG8_LDB(B1, 0, 1); PG8_SCHED; PG8_LDA(At, 0, 0); PG8_STAGE(PG8_SA(1, 1), a1 + hstepA, voffA);
            PG8_WAIT_V(8); PG8_WAIT_L(0); PG8_BAR; PG8_MMA(0, 0, At, B0); PG8_MMA(0, 1, At, B1); PG8_BAR; PG8_SCHED;
            if (full) PG8_LDA(At, 0, 1); PG8_STAGE(PG8_SB(0, 0), b2, voffB); PG8_STAGE(PG8_SB(0, 1), b2 + hstepB, voffB); PG8_STAGE(PG8_SA(0, 0), a2, voffA);
            PG8_WAIT_V(8); PG8_WAIT_L(0); PG8_BAR; if (full) { PG8_MMA(1, 0, At, B0); PG8_MMA(1, 1, At, B1); } PG8_BAR; PG8_SCHED;
            PG8_LDB(B0, 1, 0); PG8_LDB(B1, 1, 1); PG8_SCHED; PG8_LDA(At, 1, 0); PG8_STAGE(PG8_SA(0, 1), a2 + hstepA, voffA);
            PG8_WAIT_V(8); PG8_WAIT_L(0); PG8_BAR; PG8_MMA(0, 0, At, B0); PG8_MMA(0, 1, At, B1); PG8_BAR; PG8_SCHED;
            if (full) PG8_LDA(At, 1, 1); PG8_STAGE(PG8_SB(1, 0), b3, voffB); PG8_STAGE(PG8_SB(1, 1), b3 + hstepB, voffB); PG8_STAGE(PG8_SA(1, 0), a3, voffA);
            PG8_WAIT_V(8); PG8_WAIT_L(0); PG8_BAR; if (full) { PG8_MMA(1, 0, At, B0); PG8_MMA(1, 1, At, B1); } PG8_BAR; PG8_SCHED;
        }
        if (wr == 0) PG8_BAR;
        E(acc, cur, wr, wc, fr, fq);
        if (!has_next) break;
#pragma unroll
        for (int a = 0; a < 2; ++a)
#pragma unroll
            for (int b = 0; b < 2; ++b)
#pragma unroll
                for (int m = 0; m < 4; ++m)
#pragma unroll
                    for (int n = 0; n < 2; ++n) acc[a][b][m][n] = (f32x4){0.f, 0.f, 0.f, 0.f};
        cur = nxt; cA = nA; cB = nB; ++ui;
        if (wr == 1) PG8_BAR;
    }
    PG8_WAIT_V(0);
    PG8_BAR;
#undef PG8_SA
#undef PG8_SB
#undef PG8_STAGE
#undef PG8_LDA
#undef PG8_LDB
#undef PG8_MMA
#undef PG8_WAIT_V
#undef PG8_WAIT_L
#undef PG8_BAR
#undef PG8_SCHED
}
}
using pg8::Unit;

__device__ __forceinline__ u32x4 pack8(const f32x4& v0, const f32x4& v1) {
    u32x4 w; w.x = cvt_pk_bf16(v0[0], v0[1]); w.y = cvt_pk_bf16(v0[2], v0[3]); w.z = cvt_pk_bf16(v1[0], v1[1]); w.w = cvt_pk_bf16(v1[2], v1[3]); return w;
}
__device__ __forceinline__ void unpack8(const u32x4& w, f32x4& v0, f32x4& v1) {
    v0 = (f32x4){bflo(w.x), bfhi(w.x), bflo(w.y), bfhi(w.y)}; v1 = (f32x4){bflo(w.z), bfhi(w.z), bflo(w.w), bfhi(w.w)};
}

struct EpiIn {
    static constexpr bool HAS_MID = false;
    bf16_t* qkvu; bf16_t* gate; float* out;
    __device__ __forceinline__ void operator()(const f32x4 (&acc)[2][2][4][2], const Unit& u, int wr, int wc, int fr, int fq) const {
        const int row0 = u.pm * 256 + wr * 64 + fr, cw = wc * 32 + 8 * fq;
        if (u.pn >= 16) {
            bf16_t* base = gate + (size_t)row0 * 4096 + (u.pn - 16) * 128 + cw;
#pragma unroll
            for (int ai = 0; ai < 2; ++ai)
#pragma unroll
                for (int m = 0; m < 4; ++m) { bf16_t* rowp = base + (size_t)(ai * 128 + m * 16) * 4096;
                    f32x4 r0, r1, b0, b1;
#pragma unroll
                    for (int j = 0; j < 4; ++j) { b0[j] = fmaxf(fast_sigmoid(acc[ai][1][m][0][j]), 1e-30f); b1[j] = fmaxf(fast_sigmoid(acc[ai][1][m][1][j]), 1e-30f);
                        r0[j] = fast_sigmoid(acc[ai][0][m][0][j]) * __builtin_amdgcn_rcpf(b0[j]); r1[j] = fast_sigmoid(acc[ai][0][m][1][j]) * __builtin_amdgcn_rcpf(b1[j]); }
                    *(u32x4*)rowp = pack8(r0, r1); *(u32x4*)(rowp + 2048) = pack8(b0, b1); }
        } else {
            const int sec = u.pn >> 2, cc = (u.pn & 3) * 256 + cw;
            bf16_t* base = qkvu + (size_t)sec * MT * 1024 + (size_t)row0 * 1024 + cc;
#pragma unroll
            for (int ai = 0; ai < 2; ++ai)
#pragma unroll
                for (int m = 0; m < 4; ++m) { bf16_t* rowp = base + (size_t)(ai * 128 + m * 16) * 1024;
#pragma unroll
                    for (int bj = 0; bj < 2; ++bj) *(u32x4*)(rowp + bj * 128) = pack8(acc[ai][bj][m][0], acc[ai][bj][m][1]); }
            if (sec >= 2) {
                const size_t offp = (sec == 2) ? OFF_KP : OFF_VP, offs = (sec == 2) ? OFF_KS : OFF_VS;
#pragma unroll
                for (int ai = 0; ai < 2; ++ai)
#pragma unroll
                    for (int m = 0; m < 4; ++m) { const int row = row0 + ai * 128 + m * 16;
                        if (row < MV) { float* o = out + (row < MP ? offp + (size_t)row * 1024 : offs + (size_t)(row - MP) * 1024) + cc;
#pragma unroll
                            for (int bj = 0; bj < 2; ++bj) { *(f32x4*)(o + bj * 128) = acc[ai][bj][m][0]; *(f32x4*)(o + bj * 128 + 4) = acc[ai][bj][m][1]; } } }
            } else if (sec == 0 && ((u.pm & 15) == 15 || u.pm == 64)) {
#pragma unroll
                for (int ai = 0; ai < 2; ++ai)
#pragma unroll
                    for (int m = 0; m < 4; ++m) { const int row = row0 + ai * 128 + m * 16; long off = -1;
                        if (row < MP) { const int t = row & (SEQ - 1); if (t >= SEQ - 15) off = (long)OFF_PP + ((long)(row >> 12) * 15 + (t - (SEQ - 15))) * 1024; }
                        else if (row < MV) { const int t = (row - MP) & 15, b = (row - MP) >> 4; if (t >= 1) off = (long)OFF_PS + ((long)b * 15 + (t - 1)) * 1024; }
                        if (off >= 0) { float* o = out + off + cc;
#pragma unroll
                            for (int bj = 0; bj < 2; ++bj) { *(f32x4*)(o + bj * 128) = acc[ai][bj][m][0]; *(f32x4*)(o + bj * 128 + 4) = acc[ai][bj][m][1]; } } }
            }
        }
    }
};
struct EpiMerged {
    static constexpr bool HAS_MID = true;
    const bf16_t* gate; bf16_t* merged;
    __device__ __forceinline__ void mid(f32x4 (&acc)[2][2][4][2], const Unit& u, int wr, int wc, int fr, int fq) const {
        int zoff = 0; asm volatile("" : "+v"(zoff));
        const int row0 = u.pm * 256 + wr * 64 + fr + zoff, cc = u.pn * 256 + wc * 32 + 8 * fq;
#pragma unroll
        for (int ai = 0; ai < 2; ++ai) {
            if (ai == 1 && u.half) break;
            u32x4 rw[4][2];
#pragma unroll
            for (int m = 0; m < 4; ++m)
#pragma unroll
                for (int bj = 0; bj < 2; ++bj) rw[m][bj] = *(const u32x4*)(gate + (size_t)(row0 + ai * 128 + m * 16) * 4096 + cc + bj * 128);
#pragma unroll
            for (int m = 0; m < 4; ++m)
#pragma unroll
                for (int bj = 0; bj < 2; ++bj) { f32x4 a0, a1; unpack8(rw[m][bj], a0, a1); acc[ai][bj][m][0] *= a0; acc[ai][bj][m][1] *= a1; }
            __builtin_amdgcn_sched_barrier(0);
        }
    }
    __device__ __forceinline__ void operator()(const f32x4 (&acc)[2][2][4][2], const Unit& u, int wr, int wc, int fr, int fq) const {
        const int row0 = u.pm * 256 + wr * 64 + fr, cc = u.pn * 256 + wc * 32 + 8 * fq;
#pragma unroll
        for (int ai = 0; ai < 2; ++ai)
#pragma unroll
            for (int m = 0; m < 4; ++m) { const int row = row0 + ai * 128 + m * 16;
                const bf16_t* gp = gate + (size_t)row * 4096 + 2048 + cc; bf16_t* o = merged + (size_t)row * D + cc;
#pragma unroll
                for (int bj = 0; bj < 2; ++bj) { const u32x4 gw = *(const u32x4*)(gp + bj * 128); f32x4 g0, g1; unpack8(gw, g0, g1);
                    *(u32x4*)(o + bj * 128) = pack8(acc[ai][bj][m][0] * g0, acc[ai][bj][m][1] * g1); } }
    }
};
struct EpiOut {
    static constexpr bool HAS_MID = false;
    const float* xp; const float* xs; float* y; bf16_t* hb; float* ssq;
    __device__ __forceinline__ void operator()(const f32x4 (&acc)[2][2][4][2], const Unit& u, int wr, int wc, int fr, int fq) const {
        int zoff = 0; asm volatile("" : "+v"(zoff));
        const int row0 = u.pm * 256 + wr * 64 + fr + zoff, cc = u.pn * 256 + wc * 32 + 8 * fq;
#pragma unroll
        for (int ai = 0; ai < 2; ++ai) {
            if (ai == 1 && u.half) break;
            f32x4 xv[4][2][2];
#pragma unroll
            for (int m = 0; m < 4; ++m) { const int row = row0 + ai * 128 + m * 16; const bool ok = row < MV;
                const float* xr = (row < MP ? xp + (size_t)row * D : xs + (size_t)(ok ? row - MP : 0) * D) + cc;
#pragma unroll
                for (int bj = 0; bj < 2; ++bj) { xv[m][bj][0] = *(const f32x4*)(xr + bj * 128); xv[m][bj][1] = *(const f32x4*)(xr + bj * 128 + 4); } }
            __builtin_amdgcn_sched_barrier(0);
#pragma unroll
            for (int m = 0; m < 4; ++m) { const int row = row0 + ai * 128 + m * 16; const bool ok = row < MV;
                bf16_t* ob = hb + (size_t)row * D + cc;
                float s = 0.f;
#pragma unroll
                for (int bj = 0; bj < 2; ++bj) { f32x4 h0 = acc[ai][bj][m][0], h1 = acc[ai][bj][m][1];
                    if (ok) { h0 += xv[m][bj][0]; h1 += xv[m][bj][1]; }
                    *(u32x4*)(ob + bj * 128) = pack8(h0, h1);
                    s += (h0[0] * h0[0] + h0[1] * h0[1]) + (h0[2] * h0[2] + h0[3] * h0[3]) + (h1[0] * h1[0] + h1[1] * h1[1]) + (h1[2] * h1[2] + h1[3] * h1[3]); }
                s += __shfl_xor(s, 16); s += __shfl_xor(s, 32);
                if (fq == 0) ssq[(size_t)(u.pn * 4 + wc) * MT + row] = s; }
            __builtin_amdgcn_sched_barrier(0);
        }
    }
};
struct EpiGU {
    static constexpr bool HAS_MID = false;
    const LAS float* tab; bf16_t* hid;
    __device__ __forceinline__ void operator()(const f32x4 (&acc)[2][2][4][2], const Unit& u, int wr, int wc, int fr, int fq) const {
        const int row0 = u.pm * 256 + wr * 64 + fr, cc = u.pn * 128 + wc * 32 + 8 * fq;
#pragma unroll
        for (int ai = 0; ai < 2; ++ai)
#pragma unroll
            for (int m = 0; m < 4; ++m) { const int row = row0 + ai * 128 + m * 16;
                const float sc = tab[(u.half ? 256 : 0) + ((ai * 128 + wr * 64 + m * 16 + fr) & (u.half ? 127 : 255))];
                f32x4 r0, r1;
#pragma unroll
                for (int j = 0; j < 4; ++j) { const float g0 = acc[ai][0][m][0][j] * sc, u0 = acc[ai][1][m][0][j] * sc, g1 = acc[ai][0][m][1][j] * sc, u1 = acc[ai][1][m][1][j] * sc;
                    r0[j] = g0 * fast_sigmoid(g0) * u0; r1[j] = g1 * fast_sigmoid(g1) * u1; }
                *(u32x4*)(hid + (size_t)row * FF + cc) = pack8(r0, r1); }
    }
};
constexpr int DN_SPLIT = 11, DN_KT = (FF / 64) / DN_SPLIT;
struct EpiDown {
    static constexpr bool HAS_MID = false;
    float* y; float* part; const bf16_t* hb;
    __device__ __forceinline__ void operator()(const f32x4 (&acc)[2][2][4][2], const Unit& u, int wr, int wc, int fr, int fq) const {
        const int row0 = u.pm * 256 + wr * 64 + fr, cc = u.pn * 256 + wc * 32 + 8 * fq;
#pragma unroll
        for (int ai = 0; ai < 2; ++ai)
#pragma unroll
            for (int m = 0; m < 4; ++m) { const int row = row0 + ai * 128 + m * 16;
                if (row < MV) { float* o = y + (size_t)row * D + cc;
                    if (u.half) {
                        float* ps = part + ((size_t)(u.kt0 / DN_KT) * MS + (row - MP)) * D + cc;
#pragma unroll
                        for (int bj = 0; bj < 2; ++bj) { *(f32x4*)(ps + bj * 128) = acc[ai][bj][m][0]; *(f32x4*)(ps + bj * 128 + 4) = acc[ai][bj][m][1]; }
                    } else {
#pragma unroll
                    for (int bj = 0; bj < 2; ++bj) { const u32x4 hw = *(const u32x4*)(hb + (size_t)row * D + cc + bj * 128); f32x4 h0, h1; unpack8(hw, h0, h1);
                        *(f32x4*)(o + bj * 128) = h0 + acc[ai][bj][m][0]; *(f32x4*)(o + bj * 128 + 4) = h1 + acc[ai][bj][m][1]; } } } }
    }
};

struct EpiWA {
    static constexpr bool HAS_MID = false;
    bf16_t* dst;
    __device__ __forceinline__ void operator()(const f32x4 (&acc)[2][2][4][2], const Unit& u, int wr, int wc, int fr, int fq) const {
        const int row0 = u.pm * 256 + wr * 64 + fr, cc = wc * 32 + 8 * fq;
#pragma unroll
        for (int ai = 0; ai < 2; ++ai)
#pragma unroll
            for (int m = 0; m < 4; ++m) { bf16_t* o = dst + (size_t)(row0 + ai * 128 + m * 16) * 2048 + cc;
#pragma unroll
                for (int bj = 0; bj < 2; ++bj) *(u32x4*)(o + bj * 128) = pack8(acc[ai][bj][m][0], acc[ai][bj][m][1]); }
    }
};

__device__ __forceinline__ void p0_item(const float* W, int N, int k0, int n0, const float* gsc, bf16_t* dst, int ldd, int drow0, int dcol0, LAS float* scr, int lane) {
    const float* wp = W + (size_t)k0 * N + n0 + lane;
    float v[64];
#pragma unroll
    for (int i = 0; i < 64; ++i) v[i] = wp[(size_t)i * N];
    if (gsc) {
#pragma unroll
        for (int i = 0; i < 64; ++i) v[i] *= gsc[k0 + i]; }
#pragma unroll
    for (int i = 0; i < 64; ++i) scr[i * 65 + lane] = v[i];
    asm volatile("s_waitcnt lgkmcnt(0)" ::: "memory");
    const int c = lane & 7;
#pragma unroll
    for (int j = 0; j < 8; ++j) { const int n = (lane >> 3) + 8 * j; const LAS float* s = scr + (8 * c) * 65 + n;
        u32x4 o; o.x = cvt_pk_bf16(s[0 * 65], s[1 * 65]); o.y = cvt_pk_bf16(s[2 * 65], s[3 * 65]); o.z = cvt_pk_bf16(s[4 * 65], s[5 * 65]); o.w = cvt_pk_bf16(s[6 * 65], s[7 * 65]);
        *(u32x4*)(dst + (size_t)(drow0 + n) * ldd + dcol0 + k0 + 8 * c) = o; }
    asm volatile("s_waitcnt lgkmcnt(0)" ::: "memory");
}

struct Params {
    const float *x_prompt, *x_sample, *cache_k, *cache_v, *state_pool, *g_mix, *w_in, *w_pool, *s_pool, *w_branch, *w_out, *g_ffn, *w_gate_up, *w_down, *g_final;
    float* out; unsigned char* ws; int ph_lo, ph_hi;
};

__device__ __forceinline__ void xn_row(const Params& p, int m, int lane);
__device__ __forceinline__ void phase0(const Params& p, LAS unsigned char* lds, int gw, int NGW, int wave, int lane, unsigned xcc) {
    LAS float* scr = (LAS float*)(lds + wave * 16640);
    bf16_t* Wt_in = (bf16_t*)(p.ws + WS_WIN); bf16_t* Wt_br = (bf16_t*)(p.ws + WS_WBR); bf16_t* Wt_out = (bf16_t*)(p.ws + WS_WOUT);
    bf16_t* Wt_gu = (bf16_t*)(p.ws + WS_WGU); bf16_t* Wt_dn = (bf16_t*)(p.ws + WS_WDN); bf16_t* XN = (bf16_t*)(p.ws + WS_XN);
    bf16_t* TMPA = (bf16_t*)(p.ws + WS_TMPA); bf16_t* WPB = (bf16_t*)(p.ws + WS_WPB);
    constexpr int I_IN = (D / 64) * (NIN / 64), I_BR = (D / 64) * (D / 64), I_OUT = (D / 64) * (D / 64), I_GU = (D / 64) * (NGU / 64), I_DN = (FF / 64) * (D / 64);
    constexpr int NITEMS = I_IN + I_BR + I_OUT + I_GU + I_DN;
    unsigned* ctr = (unsigned*)(p.ws + WS_BAR) + 3648 + 64 * (xcc & 7);
    constexpr int NXN = MT / 2;
    for (;;) {
        unsigned kq = 0; if (lane == 0) kq = __hip_atomic_fetch_add(ctr, 1u, __ATOMIC_RELAXED, __HIP_MEMORY_SCOPE_AGENT);
        const int it = 8 * (int)__builtin_amdgcn_readfirstlane(kq) + (int)(xcc & 7);
        if (it >= NITEMS + NXN) break;
        if (it >= NITEMS) { xn_row(p, 2 * (it - NITEMS), lane); xn_row(p, 2 * (it - NITEMS) + 1, lane); continue; }
        int r = it;
        if (r < I_IN) { const int nb = NIN / 64; const int n0 = 64 * (r % nb); int drow = n0;
            if (n0 >= 4096) { const int q = n0 - 4096; drow = q < 2048 ? 4096 + (q / 128) * 256 + (q % 128) : 4096 + ((q - 2048) / 128) * 256 + 128 + ((q - 2048) % 128); }
            p0_item(p.w_in, NIN, 64 * (r / nb), n0, p.g_mix, Wt_in, D, drow, 0, scr, lane); continue; } r -= I_IN;
        if (r < I_BR) { const int nb = D / 64; const int k0 = 64 * (r / nb), n0 = 64 * (r % nb);
            if (k0 < 1024) p0_item(p.w_branch, D, k0, n0, p.s_pool, TMPA, 1024, n0, 0, scr, lane);
            else p0_item(p.w_branch, D, k0, n0, nullptr, Wt_br, 2048, n0, 0, scr, lane);
            continue; } r -= I_BR;
        if (r < I_OUT) { const int nb = D / 64; p0_item(p.w_out, D, 64 * (r / nb), 64 * (r % nb), nullptr, Wt_out, D, 64 * (r % nb), 0, scr, lane); continue; } r -= I_OUT;
        if (r < I_GU) { const int nb = NGU / 64; const int n0 = 64 * (r % nb); const int drow = n0 < FF ? (n0 / 128) * 256 + (n0 % 128) : ((n0 - FF) / 128) * 256 + 128 + ((n0 - FF) % 128);
            p0_item(p.w_gate_up, NGU, 64 * (r / nb), n0, p.g_ffn, Wt_gu, D, drow, 0, scr, lane); continue; } r -= I_GU;
        { const int nb = D / 64; p0_item(p.w_down, D, 64 * (r / nb), 64 * (r % nb), nullptr, Wt_dn, FF, 64 * (r % nb), 0, scr, lane); }
    }
}
__device__ __forceinline__ void xn_row(const Params& p, int m, int lane) {
    bf16_t* XN = (bf16_t*)(p.ws + WS_XN);
    u32x2* o8 = (u32x2*)(XN + (size_t)m * D) + lane;
    if (m >= MV) {
#pragma unroll
        for (int j = 0; j < 8; ++j) o8[64 * j] = (u32x2){0u, 0u};
        return; }
    const f32x4* xr = (const f32x4*)(m < MP ? p.x_prompt + (size_t)m * D : p.x_sample + (size_t)(m - MP) * D) + lane;
    f32x4 v[8]; float s = 0.f;
#pragma unroll
    for (int j = 0; j < 8; ++j) { v[j] = xr[64 * j]; s += (v[j].x * v[j].x + v[j].y * v[j].y) + (v[j].z * v[j].z + v[j].w * v[j].w); }
    const float rs = __builtin_amdgcn_rsqf(wave_sum(s) * (1.0f / D) + EPS);
#pragma unroll
    for (int j = 0; j < 8; ++j) o8[64 * j] = (u32x2){cvt_pk_bf16(v[j].x * rs, v[j].y * rs), cvt_pk_bf16(v[j].z * rs, v[j].w * rs)};
}
__device__ __forceinline__ void phase0b(const Params& p, int gw, int NGW, int lane) {
    bf16_t* WPB = (bf16_t*)(p.ws + WS_WPB);
    for (int i = gw * 64 + lane; i < 4 * 256 * 256 / 8; i += NGW * 64) { const f32x4 a = *(const f32x4*)(p.w_pool + (size_t)i * 8), b = *(const f32x4*)(p.w_pool + (size_t)i * 8 + 4); *(u32x4*)(WPB + (size_t)i * 8) = pack8(a, b); }
    float* ssq = (float*)(p.ws + WS_SSQ);
    for (int i = gw * 64 + lane; i < MT; i += NGW * 64) ssq[i] = 0.f;
}

constexpr int VROW = 320;
__device__ __forceinline__ s16x4 vtr(const LAS unsigned char* p) { typedef short v4i16_t __attribute__((ext_vector_type(4))); return __builtin_bit_cast(s16x4, __builtin_amdgcn_ds_read_tr16_b64_v4i16((LAS v4i16_t*)p)); }
__device__ __forceinline__ bf16x8 cvt8(const f32x4& a, const f32x4& b) { u32x4 w = pack8(a, b); return __builtin_bit_cast(bf16x8, w); }

__device__ __forceinline__ void attn_unit(const Params& p, LAS unsigned char* vl, int unit, int lane) {
    const bf16_t* Ub = (const bf16_t*)(p.ws + WS_QKVU);
    const bf16_t* Qb = Ub + (size_t)MT * 1024; const bf16_t* Kb = Qb + (size_t)MT * 1024; const bf16_t* Vb = Kb + (size_t)MT * 1024;
    bf16_t* AO = (bf16_t*)(p.ws + WS_AO);
    const int n = lane & 31, hh = lane >> 5;
    const bool sample = unit < 64;
    int b, h, qrow0, nblk;
    if (sample) { b = unit >> 3; h = unit & 7; qrow0 = MP + b * DSEQ; nblk = 1 + PAST / 32; }
    else { const int u2 = unit - 64; const int qb = u2 & 127; h = (u2 >> 7) & 7; b = u2 >> 10; qrow0 = b * SEQ + qb * 32; nblk = qb + 1; }
    bf16x8 qf[8];
    { const bf16_t* qp = Qb + (size_t)(qrow0 + n) * 1024 + h * HD + 64 * hh;
#pragma unroll
      for (int kk = 0; kk < 8; ++kk) qf[kk] = *(const bf16x8*)(qp + 8 * kk); }
    f32x16 o[4];
#pragma unroll
    for (int db = 0; db < 4; ++db)
#pragma unroll
        for (int r = 0; r < 16; ++r) o[db][r] = 0.f;
    float R = (sample && n >= DSEQ) ? -1e30f : 0.f;
    const float* ck = p.cache_k + (size_t)b * PAST * 1024 + h * HD; const float* cv = p.cache_v + (size_t)b * PAST * 1024 + h * HD;
    const int vaddr = (4 * hh + ((lane & 15) >> 2)) * VROW + (16 * ((lane >> 4) & 1) + 4 * (lane & 3)) * 2;
    for (int blk = 0; blk < nblk; ++blk) {
        bf16x8 kf[8];
        const bool diag = (blk == 0);
        if (!sample || blk == 0) {
            const int s0 = qrow0 - blk * 32;
            const bf16_t* kp = Kb + (size_t)(s0 + n) * 1024 + h * HD + 64 * hh;
#pragma unroll
            for (int kk = 0; kk < 8; ++kk) kf[kk] = *(const bf16x8*)(kp + 8 * kk);
            const bf16_t* vp = Vb + (size_t)(s0 + (lane >> 4)) * 1024 + h * HD + 8 * (lane & 15);
#pragma unroll
            for (int it = 0; it < 8; ++it) { const u32x4 w = *(const u32x4*)(vp + (size_t)(4 * it) * 1024); *(LAS u32x4*)(vl + (4 * it + (lane >> 4)) * VROW + 16 * (lane & 15)) = w; }
        } else {
            const int s0 = PAST - blk * 32;
            const float* kp = ck + (size_t)(s0 + n) * 1024 + 64 * hh;
#pragma unroll
            for (int kk = 0; kk < 8; ++kk) kf[kk] = cvt8(*(const f32x4*)(kp + 8 * kk), *(const f32x4*)(kp + 8 * kk + 4));
            const float* vp = cv + (size_t)(s0 + (lane >> 4)) * 1024 + 8 * (lane & 15);
#pragma unroll
            for (int it = 0; it < 8; ++it) { const f32x4 a = *(const f32x4*)(vp + (size_t)(4 * it) * 1024), c = *(const f32x4*)(vp + (size_t)(4 * it) * 1024 + 4);
                *(LAS u32x4*)(vl + (4 * it + (lane >> 4)) * VROW + 16 * (lane & 15)) = pack8(a, c); }
        }
        f32x16 st;
#pragma unroll
        for (int r = 0; r < 16; ++r) st[r] = 0.f;
#pragma unroll
        for (int kk = 0; kk < 8; ++kk) st = __builtin_amdgcn_mfma_f32_32x32x16_bf16(kf[kk], qf[kk], st, 0, 0, 0);
        float l1m[16], ls[16];
#pragma unroll
        for (int r = 0; r < 16; ++r) { const int i = (r & 3) + 8 * (r >> 2) + 4 * hh; const bool valid = !diag || (i < n);
            const float z = st[r] * 0.08838834764831845f; const float sp = fmaxf(z, 0.f) + __logf(1.0f + __expf(-fabsf(z)));
            l1m[r] = valid ? -sp : 0.f; ls[r] = valid ? (z - sp) : -1e30f; }
        float gown[4], goth[4];
#pragma unroll
        for (int a = 0; a < 4; ++a) { gown[a] = (l1m[4 * a] + l1m[4 * a + 1]) + (l1m[4 * a + 2] + l1m[4 * a + 3]); goth[a] = __shfl_xor(gown[a], 32); }
        float wv[16]; float tail = R;
#pragma unroll
        for (int a = 3; a >= 0; --a) { float sfx = tail + (hh == 0 ? goth[a] : 0.f);
#pragma unroll
            for (int rr = 3; rr >= 0; --rr) { wv[4 * a + rr] = __expf(ls[4 * a + rr] + sfx); sfx += l1m[4 * a + rr]; }
            tail += gown[a] + goth[a]; }
        R = tail;
        bf16x8 wb[2];
#pragma unroll
        for (int s = 0; s < 2; ++s) wb[s] = cvt8((f32x4){wv[8 * s], wv[8 * s + 1], wv[8 * s + 2], wv[8 * s + 3]}, (f32x4){wv[8 * s + 4], wv[8 * s + 5], wv[8 * s + 6], wv[8 * s + 7]});
        asm volatile("s_waitcnt lgkmcnt(0)" ::: "memory");
#pragma unroll
        for (int db = 0; db < 4; ++db)
#pragma unroll
            for (int s = 0; s < 2; ++s) { const s16x4 lo = vtr(vl + vaddr + (16 * s) * VROW + 64 * db), hi = vtr(vl + vaddr + (16 * s + 8) * VROW + 64 * db);
                const bf16x8 vf = (bf16x8){lo[0], lo[1], lo[2], lo[3], hi[0], hi[1], hi[2], hi[3]};
                o[db] = __builtin_amdgcn_mfma_f32_32x32x16_bf16(vf, wb[s], o[db], 0, 0, 0); }
        asm volatile("s_waitcnt lgkmcnt(0)" ::: "memory");
        if (__all(R < -104.0f)) break;
    }
    if (!sample || n < DSEQ) {
        bf16_t* op = AO + (size_t)(qrow0 + n) * 2048 + 1024 + h * HD + 4 * hh;
#pragma unroll
        for (int db = 0; db < 4; ++db)
#pragma unroll
            for (int a = 0; a < 4; ++a) *(u32x2*)(op + 32 * db + 8 * a) = (u32x2){cvt_pk_bf16(o[db][4 * a], o[db][4 * a + 1]), cvt_pk_bf16(o[db][4 * a + 2], o[db][4 * a + 3])};
    }
}

template <int W>
__device__ __forceinline__ void diff_chunk(const Params& p, int ch, int cc) {
    const bf16_t* Ub = (const bf16_t*)(p.ws + WS_QKVU); bf16_t* AO = (bf16_t*)(p.ws + WS_AO);
    const int m0 = ch * 16; const bool prompt = m0 < MP; const int t0 = prompt ? (m0 & (SEQ - 1)) : PAST;
    const bf16_t* up = Ub + (size_t)m0 * 1024 + cc * 8;
    u32x4 raw[15 + W];
#pragma unroll
    for (int r = 0; r < 16; ++r) raw[W - 1 + r] = *(const u32x4*)(up + (size_t)r * 1024);
    if (prompt) {
#pragma unroll
        for (int j = 1; j < W; ++j) { const u32x4 v = *(const u32x4*)(t0 > 0 ? up - (size_t)j * 1024 : up); raw[W - 1 - j] = (t0 > 0) ? v : (u32x4){0u, 0u, 0u, 0u}; }
    } else { const float* hp = p.state_pool + (size_t)((m0 - MP) >> 4) * 15 * 1024 + cc * 8;
#pragma unroll
        for (int j = 1; j < W; ++j) raw[W - 1 - j] = pack8(*(const f32x4*)(hp + (size_t)(15 - j) * 1024), *(const f32x4*)(hp + (size_t)(15 - j) * 1024 + 4)); }
    f32x4 s0 = (f32x4){0.f, 0.f, 0.f, 0.f}, s1 = s0;
#pragma unroll
    for (int j = 1; j < W; ++j) { f32x4 a, c; unpack8(raw[W - 1 - j], a, c); s0 += a; s1 += c; }
#pragma unroll
    for (int r = 0; r < 16; ++r) { f32x4 a, c; unpack8(raw[W - 1 + r], a, c); s0 += a; s1 += c;
        const int t = t0 + r; const float ic = 1.0f / (float)(t + 1 < W ? t + 1 : W);
        *(u32x4*)(AO + (size_t)(m0 + r) * 2048 + cc * 8) = pack8(s0 * ic - a, s1 * ic - c);
        f32x4 da, dc; unpack8(raw[r], da, dc); s0 -= da; s1 -= dc; }
}
constexpr int N_ATT_UNITS = 64 + 4096, N_DIFF_ITEMS = (MV / 32) * 4, N_P2_ITEMS = N_ATT_UNITS + N_DIFF_ITEMS;
__device__ __forceinline__ void diff_item(const Params& p, int wi, int lane) {
    const int g = wi & 3, ch = 2 * (wi >> 2) + (lane >> 5), cc = 32 * g + (lane & 31);
    if (g == 0) diff_chunk<2>(p, ch, cc); else if (g == 1) diff_chunk<4>(p, ch, cc); else if (g == 2) diff_chunk<8>(p, ch, cc); else diff_chunk<16>(p, ch, cc);
}

__global__ void __launch_bounds__(512, 2) fwd_megakernel(Params p) {
    extern __shared__ __attribute__((aligned(16))) unsigned char lds_raw[];
    LAS unsigned char* lds = (LAS unsigned char*)lds_raw;
    const int tid = threadIdx.x, lane = tid & 63, wave = __builtin_amdgcn_readfirstlane(tid >> 6);
    const int G = gridDim.x, bx = blockIdx.x;
    const int vcu = (G % 8 == 0) ? (bx % 8) * (G / 8) + bx / 8 : bx;
    const int gw = vcu * 8 + wave, NGW = G * 8;
    cg::grid_group grid = cg::this_grid();
    volatile LAS unsigned* xst = (volatile LAS unsigned*)(lds + LDS_BYTES - 64);
    if (tid < 2) xst[tid] = 0u;
    __syncthreads();
    XcdBarrier xbar = xcd_barrier_post((unsigned*)(p.ws + WS_BAR), xst);
#define IN(k) (p.ph_lo <= (k) && (k) < p.ph_hi)
#define SEAM(k) do { if (IN(k) && IN((k) + 1)) { if (p.ph_hi > 64) grid.sync();   xcd_barrier(xbar); } STAMP(); } while (0)
    bf16_t* Wt_in = (bf16_t*)(p.ws + WS_WIN); bf16_t* Wt_br = (bf16_t*)(p.ws + WS_WBR); bf16_t* Wt_out = (bf16_t*)(p.ws + WS_WOUT);
    bf16_t* Wt_gu = (bf16_t*)(p.ws + WS_WGU); bf16_t* Wt_dn = (bf16_t*)(p.ws + WS_WDN); bf16_t* XN = (bf16_t*)(p.ws + WS_XN);
    bf16_t* QKVU = (bf16_t*)(p.ws + WS_QKVU); bf16_t* GATE = (bf16_t*)(p.ws + WS_GATE); bf16_t* AO = (bf16_t*)(p.ws + WS_AO);
    bf16_t* MERGED = (bf16_t*)(p.ws + WS_MERGED); bf16_t* HID = (bf16_t*)(p.ws + WS_HID); float* SSQ = (float*)(p.ws + WS_SSQ);
    float* Y = p.out + OFF_Y;
#ifdef PROBE_T
    unsigned long long tstamp[10]; int nst = 0;
#define STAMP() do { tstamp[nst++] = __builtin_amdgcn_s_memrealtime(); } while (0)
#else
#define STAMP() do {} while (0)
#endif
    STAMP();

    if (IN(0)) { phase0(p, lds, gw, NGW, wave, lane, xbar.x);
#ifdef PROBE_T
#endif
        phase0b(p, gw, NGW, lane);
    }
    SEAM(0);
    if (IN(1)) { pg8::Gemm g{XN, Wt_in, D, D, MT, NIN, D}; pg8::StaticOrder S; S.init(64, NIN / 256, D / 64, G, bx, 64, 1); EpiIn E{QKVU, GATE, p.out}; pg8::gemm_phase(lds, g, S, E); }
    SEAM(1);
    if (IN(2)) {
        LAS unsigned char* vl = lds + wave * (32 * VROW);
        unsigned* ctr = (unsigned*)(p.ws + WS_BAR) + 3584;
        int item = gw;
        while (item < N_P2_ITEMS) {
            if (item < N_ATT_UNITS) attn_unit(p, vl, item, lane); else diff_item(p, item - N_ATT_UNITS, lane);
            unsigned nx = 0; if (lane == 0) nx = __hip_atomic_fetch_add(ctr, 1u, __ATOMIC_RELAXED, __HIP_MEMORY_SCOPE_AGENT);
            item = NGW + (int)__builtin_amdgcn_readfirstlane(nx);
        }
        __syncthreads();
        for (int gq = 0; gq < 4; ++gq) { pg8::Gemm g{(const bf16_t*)(p.ws + WS_TMPA) + gq * 256, (const bf16_t*)(p.ws + WS_WPB) + gq * 65536, 1024, 256, 2048, 256, 256};
            pg8::StaticOrder S; S.init(8, 1, 4, G, (bx + G - 8 * gq) % G); EpiWA E{Wt_br + gq * 256}; pg8::gemm_phase(lds, g, S, E); }
    }
    SEAM(2);
    if (IN(3)) {
        { pg8::Gemm g{AO, Wt_br, 2048, 2048, MT, D, 2048}; pg8::StaticOrder S; S.init(64, 8, 32, G, bx, 64, 1); EpiMerged E{GATE, MERGED}; pg8::gemm_phase(lds, g, S, E); }
    }
    SEAM(3);
    if (IN(4)) { pg8::Gemm g{MERGED, Wt_out, D, D, MT, D, D}; pg8::StaticOrder S; S.init(64, 8, 32, G, bx, 64, 1); EpiOut E{p.x_prompt, p.x_sample, Y, XN, (float*)(p.ws + WS_SSQP)}; pg8::gemm_phase(lds, g, S, E); }
    SEAM(4);
    if (IN(5)) { pg8::Gemm g{XN, Wt_gu, D, D, MT, NGU, D}; pg8::StaticOrder S; S.init(64, NGU / 256, 32, G, bx, 64, 1);
        LAS float* tab = (LAS float*)(lds + 131072);
        { pg8::Unit u0; S.next(0, u0); const float* sp = (const float*)(p.ws + WS_SSQP);
          if (tid < 384) { const int row = tid < 256 ? u0.pm * 256 + tid : MP + (tid - 256); float a = 0.f;
#pragma unroll 8
              for (int k = 0; k < 32; ++k) a += sp[(size_t)k * MT + row];
              tab[tid] = __builtin_amdgcn_rsqf(a * (1.0f / D) + EPS); }
          __syncthreads(); }
        EpiGU E{tab, HID}; pg8::gemm_phase(lds, g, S, E); }
    SEAM(5);
    if (IN(6)) { pg8::Gemm g{HID, Wt_dn, FF, FF, MT, D, FF}; pg8::StaticOrder S; S.init(64, 8, FF / 64, G, bx, 64, DN_SPLIT); EpiDown E{Y, (float*)(p.ws + WS_AO), XN}; pg8::gemm_phase(lds, g, S, E); }
    SEAM(6);
    if (IN(7)) {
        for (int m = gw; m < MV; m += NGW) {
            f32x4* yr = (f32x4*)(Y + (size_t)m * D) + lane; const f32x4* gf = (const f32x4*)p.g_final + lane;
            f32x4 v[8]; float s = 0.f;
            if (m < MP) {
#pragma unroll
                for (int j = 0; j < 8; ++j) v[j] = yr[64 * j];
            } else {
                const u32x2* hr = (const u32x2*)(XN + (size_t)m * D) + lane;
#pragma unroll
                for (int j = 0; j < 8; ++j) { const u32x2 w2 = hr[64 * j]; v[j] = (f32x4){bflo(w2.x), bfhi(w2.x), bflo(w2.y), bfhi(w2.y)}; } }
            if (m >= MP) { const f32x4* pr = (const f32x4*)((const float*)(p.ws + WS_AO) + (size_t)(m - MP) * D) + lane;
                for (int c = 0; c < DN_SPLIT; ++c)
#pragma unroll
                    for (int j = 0; j < 8; ++j) v[j] += pr[(size_t)c * MS * D / 4 + 64 * j]; }
#pragma unroll
            for (int j = 0; j < 8; ++j) s += (v[j].x * v[j].x + v[j].y * v[j].y) + (v[j].z * v[j].z + v[j].w * v[j].w);
            const float rs = __builtin_amdgcn_rsqf(wave_sum(s) * (1.0f / D) + EPS);
#pragma unroll
            for (int j = 0; j < 8; ++j) yr[64 * j] = v[j] * rs * gf[64 * j];
        }
    }
#ifdef PROBE_T
    STAMP();
    if (bx == 0 && tid == 0) {
        const unsigned long long e1 = (unsigned long long)__hip_atomic_load((long long*)(p.ws + WS_SSQ + 512 * 1024), __ATOMIC_RELAXED, __HIP_MEMORY_SCOPE_AGENT);
        const unsigned long long e2 = (unsigned long long)__hip_atomic_load((long long*)(p.ws + WS_SSQ + 512 * 1024 + 256), __ATOMIC_RELAXED, __HIP_MEMORY_SCOPE_AGENT);
        (void)e1; (void)e2;
        const float ta = (float)(tstamp[PROBE_A + 1] - tstamp[PROBE_A]) * 0.01f, tb = (float)(tstamp[PROBE_B + 1] - tstamp[PROBE_B]) * 0.01f;
        asm volatile("s_waitcnt vmcnt(0)" ::: "memory");
        atomicAdd(Y, 4.0f + ta * (1.0f / 256.0f)); atomicAdd(p.out + OFF_PP, 1.5f + tb * (1.0f / 500.0f));
    }
#endif
#undef IN
#undef SEAM
}

extern "C" void kernel_launch(void* const* d_in, const int* in_sizes, int n_in, void* d_out, int out_size, void* d_ws, size_t ws_size, hipStream_t stream) {
    static int grid = 0;
    if (grid == 0) {
        if (n_in != 15 || (size_t)out_size != OUT_TOTAL || ws_size < WS_END) { fprintf(stderr, "kernel_launch: unexpected shapes: n_in %d out %d ws %zu\n", n_in, out_size, ws_size); grid = -1; return; }
        int dev = 0, cus = 0, per_cu = 0;
        hipGetDevice(&dev); hipDeviceGetAttribute(&cus, hipDeviceAttributeMultiprocessorCount, dev);
        hipFuncSetAttribute((const void*)fwd_megakernel, hipFuncAttributeMaxDynamicSharedMemorySize, LDS_BYTES);
        hipOccupancyMaxActiveBlocksPerMultiprocessor(&per_cu, (const void*)fwd_megakernel, 512, LDS_BYTES);
        if (per_cu < 1) { fprintf(stderr, "kernel_launch: occupancy query says %d blocks per CU\n", per_cu); per_cu = 1; }
        (void)hipGetLastError();
        grid = cus;
    }
    if (grid < 0) return;
    Params p{};
    const float** pp = (const float**)&p;
    for (int i = 0; i < 15; ++i) pp[i] = (const float*)d_in[i];
    p.out = (float*)d_out; p.ws = (unsigned char*)d_ws;
#if N_LAUNCH_MODE == 1
    p.ph_lo = 0; p.ph_hi = 8;
    void* args[] = {&p};
    if (hipMemsetAsync((char*)d_ws + WS_BAR, 0, WS_BAR_BYTES, stream) != hipSuccess) fprintf(stderr, "kernel_launch: memset of the barrier words failed\n");
    hipError_t e = hipLaunchCooperativeKernel((const void*)fwd_megakernel, dim3(grid), dim3(512), args, LDS_BYTES, stream);
    if (e != hipSuccess) fprintf(stderr, "cooperative launch failed: %s (grid %d)\n", hipGetErrorString(e), grid);
#else
    for (int ph = 0; ph < 8; ++ph) { p.ph_lo = ph; p.ph_hi = ph + 1; hipLaunchKernelGGL(fwd_megakernel, dim3(grid), dim3(512), LDS_BYTES, stream, p); }
#endif
}
```

```cpp
#include <hip/hip_runtime.h>
#include <hip/hip_cooperative_groups.h>
#include <cstdio>
#include <cstdint>
namespace cg = cooperative_groups;

#define PROBE_A 6
#define PROBE_B 4
#ifndef N_LAUNCH_MODE
#define N_LAUNCH_MODE 1
#endif

#define LAS __attribute__((address_space(3)))
typedef unsigned short bf16_t;
typedef short bf16x8 __attribute__((ext_vector_type(8)));
typedef short s16x4 __attribute__((ext_vector_type(4)));
typedef float f32x4 __attribute__((ext_vector_type(4)));
typedef float f32x16 __attribute__((ext_vector_type(16)));
typedef unsigned u32x4 __attribute__((ext_vector_type(4)));
typedef unsigned u32x2 __attribute__((ext_vector_type(2)));

constexpr int D = 2048, MP = 16384, MS = 128, MV = MP + MS, MT = 16640;
constexpr int SEQ = 4096, DSEQ = 16, PAST = 4096, NH = 8, HD = 128;
constexpr int NIN = 8192, FF = 5632, NGU = 2 * FF, AW = 1024;
constexpr float EPS = 1e-6f;
constexpr size_t OFF_Y = 0, OFF_KP = (size_t)MV * D, OFF_VP = OFF_KP + (size_t)MP * 1024, OFF_PP = OFF_VP + (size_t)MP * 1024,
                 OFF_KS = OFF_PP + 4 * 15 * 1024, OFF_VS = OFF_KS + (size_t)MS * 1024, OFF_PS = OFF_VS + (size_t)MS * 1024, OUT_TOTAL = OFF_PS + 8 * 15 * 1024;
constexpr size_t MiB = 1u << 20;
constexpr size_t WS_SSQ = 0, WS_WIN = 1 * MiB, WS_WBR = 33 * MiB, WS_WOUT = 41 * MiB, WS_WGU = 49 * MiB, WS_WDN = 93 * MiB, WS_XN = 115 * MiB,
                 WS_QKVU = 180 * MiB, WS_GATE = 310 * MiB, WS_AO = 440 * MiB, WS_TMPA = 505 * MiB, WS_WPB = 509 * MiB, WS_SSQP = 510 * MiB, WS_END = 513 * MiB;
constexpr size_t WS_BAR = 768 * 1024, WS_BAR_BYTES = 32768;
constexpr size_t WS_MERGED = WS_QKVU;
constexpr size_t WS_HID = WS_QKVU;
static_assert((size_t)MT * FF * 2 <= WS_AO - WS_QKVU, "hid overlay");
constexpr int LDS_BYTES = 147456;

typedef __bf16 bf16x2_t __attribute__((ext_vector_type(2)));
typedef float f32x2_t __attribute__((ext_vector_type(2)));
__device__ __forceinline__ unsigned cvt_pk_bf16(float lo, float hi) { const f32x2_t v = {lo, hi}; return __builtin_bit_cast(unsigned, __builtin_convertvector(v, bf16x2_t)); }
__device__ __forceinline__ float bf2f(unsigned short b) { return __uint_as_float(((unsigned)b) << 16); }
__device__ __forceinline__ float bflo(unsigned w) { return __uint_as_float(w << 16); }
__device__ __forceinline__ float bfhi(unsigned w) { return __uint_as_float(w & 0xffff0000u); }
__device__ __forceinline__ float fast_sigmoid(float x) { return __builtin_amdgcn_rcpf(1.0f + __expf(-x)); }
__device__ __forceinline__ float wave_sum(float v) {
#pragma unroll
    for (int o = 1; o < 64; o <<= 1) v += __shfl_xor(v, o);
    return v;
}

#define XB_TMO      128
#define XB_XCNT(j)  (256  + 64 * (j))
#define XB_XSUB(j)  (1280 + 64 * (j))
#define XB_XGEN(j)  (2304 + 64 * (j))
#define XB_TOP      3328
#define XB_TOPGEN   3392
#define XCD_BAR_WORDS 3456
#define XB_SPIN_CAP (1u << 18)

__device__ __forceinline__ unsigned xb_ld(unsigned* p)              { return __hip_atomic_load(p, __ATOMIC_RELAXED, __HIP_MEMORY_SCOPE_AGENT); }
__device__ __forceinline__ unsigned xb_add(unsigned* p, unsigned v) { return __hip_atomic_fetch_add(p, v, __ATOMIC_RELAXED, __HIP_MEMORY_SCOPE_AGENT); }
__device__ __forceinline__ unsigned xb_xcc_id() { return (unsigned)__builtin_amdgcn_s_getreg((3 << 11) | 20) & 0xFu; }
#define XB_SPIN(cond, bar) do { unsigned _sp = 0; while (cond) { __builtin_amdgcn_s_sleep(1); \
    if ((++_sp & 255u) == 0u) { if (xb_ld(&(bar)[XB_TMO])) break; if (_sp > XB_SPIN_CAP) { atomicAdd(&(bar)[XB_TMO], 1u); break; } } } } while (0)

struct XcdBarrier {
    unsigned* bar; unsigned x;
    volatile LAS unsigned* st;
};

__device__ __forceinline__ XcdBarrier xcd_barrier_post(unsigned* bar, volatile LAS unsigned* st) {
    XcdBarrier b; b.bar = bar; b.x = xb_xcc_id(); b.st = st;
    if (threadIdx.x == 0) (void)xb_add(&bar[XB_XCNT(b.x)], 1u);
    return b;
}
__device__ __forceinline__ void xcd_barrier_complete(unsigned* bar, unsigned x, unsigned& nloc, unsigned& nx) {
    const unsigned G = gridDim.x * gridDim.y * gridDim.z;
    unsigned sum, cnt, mine, sp = 0u;
    for (;;) {
        sum = 0u; cnt = 0u; mine = 0u;
#pragma unroll
        for (unsigned j = 0; j < 16; ++j) { const unsigned c = xb_ld(&bar[XB_XCNT(j)]); sum += c; cnt += (c > 0u) ? 1u : 0u; mine = (j == x) ? c : mine; }
        if (sum == G) break;
        __builtin_amdgcn_s_sleep(1);
        if ((++sp & 255u) == 0u) { if (xb_ld(&bar[XB_TMO])) break; if (sp > XB_SPIN_CAP) { atomicAdd(&bar[XB_TMO], 1u); break; } }
    }
    nloc = mine > 0u ? mine : 1u; nx = cnt > 0u ? cnt : 1u;
}

__device__ __forceinline__ void xcd_barrier(const XcdBarrier& b) {
    asm volatile("s_waitcnt vmcnt(0)" ::: "memory");
    __syncthreads();
    if (threadIdx.x == 0) {
        unsigned* bar = b.bar;
        __builtin_amdgcn_s_waitcnt(0);
        unsigned nloc = b.st[0], nx = b.st[1];
        if (nloc == 0u) { xcd_barrier_complete(bar, b.x, nloc, nx); b.st[0] = nloc; b.st[1] = nx; }
        const unsigned old = xb_add(&bar[XB_XSUB(b.x)], 1u);
        const unsigned gen = old / nloc;
        if (old + 1u == (gen + 1u) * nloc) {
            __builtin_amdgcn_fence(__ATOMIC_RELEASE, "agent");
            asm volatile("s_waitcnt vmcnt(0)" ::: "memory");
            const unsigned og = xb_add(&bar[XB_TOP], 1u);
            const unsigned tg = og / nx;
            if (og + 1u == (tg + 1u) * nx) xb_add(&bar[XB_TOPGEN], 1u);
            else XB_SPIN(xb_ld(&bar[XB_TOPGEN]) == tg, bar);
            __builtin_amdgcn_fence(__ATOMIC_ACQUIRE, "agent");
            xb_add(&bar[XB_XGEN(b.x)], 1u);
            asm volatile("s_waitcnt vmcnt(0)" ::: "memory");
        } else {
            XB_SPIN(xb_ld(&bar[XB_XGEN(b.x)]) == gen, bar);
            __builtin_amdgcn_fence(__ATOMIC_ACQUIRE, "agent");
            asm volatile("s_waitcnt vmcnt(0)" ::: "memory");
        }
    }
    __syncthreads();
}

namespace pg8 {
constexpr int BM = 256, BK = 64, HALF = 128, HTB = HALF * BK * 2, STAGE_BYTES = 8 * HTB, NXCD = 8, WGM = 8;
__host__ __device__ __forceinline__ int lds_byte(int r, int c) { const int st = (r >> 4) * 2 + (c >> 5), rr = r & 15, cc = c & 31, ob = rr * 64 + cc * 2; return st * 1024 + (ob ^ (((ob >> 9) & 1) << 5)); }
__host__ __device__ __forceinline__ void stage_rc(int b, int& R, int& C) { const int st = b / 1024, sb = b % 1024, swz = sb ^ (((sb >> 9) & 1) << 5); R = (st >> 1) * 16 + swz / 64; C = (st & 1) * 32 + (swz % 64) / 2; }
__host__ __device__ __forceinline__ int perm32(int rho) { const int n = rho >> 4, i = rho & 15; return 8 * (i >> 2) + 4 * n + (i & 3); }

struct Unit { int pm, pn, kt0, nkt, half; };
struct Gemm { const bf16_t* A; const bf16_t* Bt; int lda, ldb, M, N, K; };

struct StaticOrder {
    int nM, nN, nwg, G, c, ktfull, pmS, nS, ktS;
    __device__ void init(int nM_, int nN_, int ktfull_, int G_, int c_, int pmS_ = 0, int ksplit = 0) { nM = nM_; nN = nN_; nwg = nM * nN; G = G_; c = c_; ktfull = ktfull_; pmS = pmS_; nS = nN * ksplit; ktS = ksplit ? ktfull / ksplit : 0; }
    __device__ bool next(int i, Unit& u) const {
        const int L = i * G + c;
        if (L >= nwg) { const int t = L - nwg;
            if (t >= nS) return false;
            u.pm = pmS; u.pn = t % nN; u.kt0 = (t / nN) * ktS; u.nkt = ktS; u.half = 1; return true; }
        int wgid = L; { const int q = nwg / NXCD, r = nwg % NXCD, xcd = wgid % NXCD, off = wgid / NXCD; wgid = (xcd < r ? xcd * (q + 1) : r * (q + 1) + (xcd - r) * q) + off; }
        const int nig = WGM * nN, gid = wgid / nig, fm = gid * WGM, gsz = (nM - fm) < WGM ? (nM - fm) : WGM;
        u.pm = fm + ((wgid % nig) % gsz); u.pn = (wgid % nig) / gsz; u.kt0 = 0; u.nkt = ktfull; u.half = 0; return true;
    }
};

template <class Epi>
__device__ __forceinline__ void gemm_phase(LAS unsigned char* lds, const Gemm g, const StaticOrder& S, const Epi& E) {
    int tid_ = threadIdx.x; asm volatile("" : "+v"(tid_));
    const int tid = tid_, wid = __builtin_amdgcn_readfirstlane(tid >> 6), lane = tid & 63, wr = wid >> 2, wc = wid & 3, fr = lane & 15, fq = lane >> 4;
    unsigned voffA[2], voffB[2];
#pragma unroll
    for (int i = 0; i < 2; ++i) { int R, C; stage_rc(tid * 16 + i * 8192, R, C); const int Rb = (R & ~31) + perm32(R & 31);
        voffA[i] = (unsigned)(R * g.lda + C) * 2u; voffB[i] = (unsigned)(Rb * g.ldb + C) * 2u; }
    const size_t kstep = (size_t)(BK * 2);
    const size_t hstepA = (size_t)HALF * g.lda * 2, hstepB = (size_t)HALF * g.ldb * 2;
    const size_t tstepA = 2 * hstepA, tstepB = 2 * hstepB;
    const unsigned ldsw = (unsigned)wid * 1024u;
    const int aoff = lds_byte(wr * 64 + fr, fq * 8), boff = lds_byte(wc * 32 + fr, fq * 8);
#define PG8_SA(b, h) (((b) * 2 + (h)) * HTB)
#define PG8_SB(b, h) ((4 + (b) * 2 + (h)) * HTB)
#define PG8_STAGE(bufoff, gbase, voff) do { _Pragma("unroll") for (int _i = 0; _i < 2; ++_i) \
        __builtin_amdgcn_global_load_lds((const unsigned*)((const char*)(gbase) + (voff)[_i]), (LAS unsigned*)(lds + (bufoff) + ldsw + _i * 8192), 16, 0, 0); } while (0)
#define PG8_LDA(dst, b, h) do { _Pragma("unroll") for (int m = 0; m < 4; ++m) _Pragma("unroll") for (int k = 0; k < 2; ++k) dst[m][k] = *(const LAS bf16x8*)(lds + PG8_SA(b, h) + aoff + m * 2048 + k * 1024); } while (0)
#define PG8_LDB(dst, b, h) do { _Pragma("unroll") for (int n = 0; n < 2; ++n) _Pragma("unroll") for (int k = 0; k < 2; ++k) dst[n][k] = *(const LAS bf16x8*)(lds + PG8_SB(b, h) + boff + n * 2048 + k * 1024); } while (0)
#define PG8_MMA(ai, bj, At, Bt) do { __builtin_amdgcn_s_setprio(1); _Pragma("unroll") for (int m = 0; m < 4; ++m) _Pragma("unroll") for (int n = 0; n < 2; ++n) _Pragma("unroll") for (int k = 0; k < 2; ++k) \
        acc[ai][bj][m][n] = __builtin_amdgcn_mfma_f32_16x16x32_bf16(Bt[n][k], At[m][k], acc[ai][bj][m][n], 0, 0, 0); __builtin_amdgcn_s_setprio(0); } while (0)
#define PG8_WAIT_V(n) asm volatile("s_waitcnt vmcnt(" #n ")" ::: "memory")
#define PG8_WAIT_L(n) asm volatile("s_waitcnt lgkmcnt(" #n ")" ::: "memory")
#define PG8_BAR __builtin_amdgcn_s_barrier()
#define PG8_SCHED __builtin_amdgcn_sched_barrier(0)
    Unit cur, nxt; int ui = 0;
    if (!S.next(0, cur)) return;
    f32x4 acc[2][2][4][2];
#pragma unroll
    for (int a = 0; a < 2; ++a)
#pragma unroll
        for (int b = 0; b < 2; ++b)
#pragma unroll
            for (int m = 0; m < 4; ++m)
#pragma unroll
                for (int n = 0; n < 2; ++n) acc[a][b][m][n] = (f32x4){0.f, 0.f, 0.f, 0.f};
    bf16x8 At[4][2], B0[2][2], B1[2][2];
    const char* cA = (const char*)g.A + (size_t)cur.pm * tstepA + (size_t)cur.kt0 * kstep; const char* cB = (const char*)g.Bt + (size_t)cur.pn * tstepB + (size_t)cur.kt0 * kstep;
    PG8_STAGE(PG8_SB(0, 0), cB, voffB); PG8_STAGE(PG8_SB(0, 1), cB + hstepB, voffB); PG8_STAGE(PG8_SA(0, 0), cA, voffA); PG8_STAGE(PG8_SA(0, 1), cA + hstepA, voffA);
    if (wr == 1) PG8_BAR;
    PG8_WAIT_V(2); PG8_BAR;
    PG8_STAGE(PG8_SB(1, 0), cB + kstep, voffB); PG8_STAGE(PG8_SA(1, 0), cA + kstep, voffA); PG8_STAGE(PG8_SB(1, 1), cB + hstepB + kstep, voffB);
    PG8_WAIT_V(6); PG8_BAR;
    for (;;) {
        const bool has_next = S.next(ui + 1, nxt);
        const char* nA = has_next ? (const char*)g.A + (size_t)nxt.pm * tstepA + (size_t)nxt.kt0 * kstep : cA; const char* nB = has_next ? (const char*)g.Bt + (size_t)nxt.pn * tstepB + (size_t)nxt.kt0 * kstep : cB;
        const int nt = cur.nkt; const bool full = !cur.half;
        for (int t = 0; t < nt; t += 2) {
            const bool last = (t == nt - 2);
            if constexpr (Epi::HAS_MID) { if (t == (nt >> 1)) E.mid(acc, cur, wr, wc, fr, fq); }
            const char* a1 = cA + (size_t)(t + 1) * kstep;
            const char* a2 = last ? nA : cA + (size_t)(t + 2) * kstep; const char* b2 = last ? nB : cB + (size_t)(t + 2) * kstep;
            const char* a3 = a2 + kstep; const char* b3 = b2 + kstep;
            PG8_LDB(B0, 0, 0); PG8_LDB(B1, 0, 1); PG8_SCHED; PG8_LDA(At, 0, 0); PG8_STAGE(PG8_SA(1, 1), a1 + hstepA, voffA);
            PG8_WAIT_V(8); PG8_WAIT_L(0); PG8_BAR; PG8_MMA(0, 0, At, B0); PG8_MMA(0, 1, At, B1); PG8_BAR; PG8_SCHED;
            if (full) PG8_LDA(At, 0, 1); PG8_STAGE(PG8_SB(0, 0), b2, voffB); PG8_STAGE(PG8_SB(0, 1), b2 + hstepB, voffB); PG8_STAGE(PG8_SA(0, 0), a2, voffA);
            PG8_WAIT_V(8); PG8_WAIT_L(0); PG8_BAR; if (full) { PG8_MMA(1, 0, At, B0); PG8_MMA(1, 1, At, B1); } PG8_BAR; PG8_SCHED;
            PG8_LDB(B0, 1, 0); PG8_LDB(B1, 1, 1); PG8_SCHED; PG8_LDA(At, 1, 0); PG8_STAGE(PG8_SA(0, 1), a2 + hstepA, voffA);
            PG8_WAIT_V(8); PG8_WAIT_L(0); PG8_BAR; PG8_MMA(0, 0, At, B0); PG8_MMA(0, 1, At, B1); PG8_BAR; PG8_SCHED;
            if (full) PG8_LDA(At, 1, 1); PG8_STAGE(PG8_SB(1, 0), b3, voffB); PG8_STAGE(PG8_SB(1, 1), b3 + hstepB, voffB); PG8_STAGE(PG8_SA(1, 0), a3, voffA);
            PG8_WAIT_V(8); PG8_WAIT_L(0); PG8_BAR; if (full) { PG8_MMA(1, 0, At, B0); PG8_MMA(1, 1, At, B1); } PG8_BAR; PG8_SCHED;
        }
        if (wr == 0) PG8_BAR;
        E(acc, cur, wr, wc, fr, fq);
        if (!has_next) break;
#pragma unroll
        for (int a = 0; a < 2; ++a)
#pragma unroll
            for (int b = 0; b < 2; ++b)
#pragma unroll
                for (int m = 0; m < 4; ++m)
#pragma unroll
                    for (int n = 0; n < 2; ++n) acc[a][b][m][n] = (f32x4){0.f, 0.f, 0.f, 0.f};
        cur = nxt; cA = nA; cB = nB; ++ui;
        if (wr == 1) PG8_BAR;
    }
    PG8_WAIT_V(0);
    PG8_BAR;
#undef PG8_SA
#undef PG8_SB
#undef PG8_STAGE
#undef PG8_LDA
#undef PG8_LDB
#undef PG8_MMA
#undef PG8_WAIT_V
#undef PG8_WAIT_L
#undef PG8_BAR
#undef PG8_SCHED
}
}
using pg8::Unit;

__device__ __forceinline__ u32x4 pack8(const f32x4& v0, const f32x4& v1) {
    u32x4 w; w.x = cvt_pk_bf16(v0[0], v0[1]); w.y = cvt_pk_bf16(v0[2], v0[3]); w.z = cvt_pk_bf16(v1[0], v1[1]); w.w = cvt_pk_bf16(v1[2], v1[3]); return w;
}
__device__ __forceinline__ void unpack8(const u32x4& w, f32x4& v0, f32x4& v1) {
    v0 = (f32x4){bflo(w.x), bfhi(w.x), bflo(w.y), bfhi(w.y)}; v1 = (f32x4){bflo(w.z), bfhi(w.z), bflo(w.w), bfhi(w.w)};
}

struct EpiIn {
    static constexpr bool HAS_MID = false;
    bf16_t* qkvu; bf16_t* gate; float* out;
    __device__ __forceinline__ void operator()(const f32x4 (&acc)[2][2][4][2], const Unit& u, int wr, int wc, int fr, int fq) const {
        const int row0 = u.pm * 256 + wr * 64 + fr, cw = wc * 32 + 8 * fq;
        if (u.pn >= 16) {
            bf16_t* base = gate + (size_t)row0 * 4096 + (u.pn - 16) * 128 + cw;
#pragma unroll
            for (int ai = 0; ai < 2; ++ai)
#pragma unroll
                for (int m = 0; m < 4; ++m) { bf16_t* rowp = base + (size_t)(ai * 128 + m * 16) * 4096;
                    f32x4 r0, r1, b0, b1;
#pragma unroll
                    for (int j = 0; j < 4; ++j) { b0[j] = fmaxf(fast_sigmoid(acc[ai][1][m][0][j]), 1e-30f); b1[j] = fmaxf(fast_sigmoid(acc[ai][1][m][1][j]), 1e-30f);
                        r0[j] = fast_sigmoid(acc[ai][0][m][0][j]) * __builtin_amdgcn_rcpf(b0[j]); r1[j] = fast_sigmoid(acc[ai][0][m][1][j]) * __builtin_amdgcn_rcpf(b1[j]); }
                    *(u32x4*)rowp = pack8(r0, r1); *(u32x4*)(rowp + 2048) = pack8(b0, b1); }
        } else {
            const int sec = u.pn >> 2, cc = (u.pn & 3) * 256 + cw;
            bf16_t* base = qkvu + (size_t)sec * MT * 1024 + (size_t)row0 * 1024 + cc;
#pragma unroll
            for (int ai = 0; ai < 2; ++ai)
#pragma unroll
                for (int m = 0; m < 4; ++m) { bf16_t* rowp = base + (size_t)(ai * 128 + m * 16) * 1024;
#pragma unroll
                    for (int bj = 0; bj < 2; ++bj) *(u32x4*)(rowp + bj * 128) = pack8(acc[ai][bj][m][0], acc[ai][bj][m][1]); }
            if (sec >= 2) {
                const size_t offp = (sec == 2) ? OFF_KP : OFF_VP, offs = (sec == 2) ? OFF_KS : OFF_VS;
#pragma unroll
                for (int ai = 0; ai < 2; ++ai)
#pragma unroll
                    for (int m = 0; m < 4; ++m) { const int row = row0 + ai * 128 + m * 16;
                        if (row < MV) { float* o = out + (row < MP ? offp + (size_t)row * 1024 : offs + (size_t)(row - MP) * 1024) + cc;
#pragma unroll
                            for (int bj = 0; bj < 2; ++bj) { *(f32x4*)(o + bj * 128) = acc[ai][bj][m][0]; *(f32x4*)(o + bj * 128 + 4) = acc[ai][bj][m][1]; } } }
            } else if (sec == 0 && ((u.pm & 15) == 15 || u.pm == 64)) {
#pragma unroll
                for (int ai = 0; ai < 2; ++ai)
#pragma unroll
                    for (int m = 0; m < 4; ++m) { const int row = row0 + ai * 128 + m * 16; long off = -1;
                        if (row < MP) { const int t = row & (SEQ - 1); if (t >= SEQ - 15) off = (long)OFF_PP + ((long)(row >> 12) * 15 + (t - (SEQ - 15))) * 1024; }
                        else if (row < MV) { const int t = (row - MP) & 15, b = (row - MP) >> 4; if (t >= 1) off = (long)OFF_PS + ((long)b * 15 + (t - 1)) * 1024; }
                        if (off >= 0) { float* o = out + off + cc;
#pragma unroll
                            for (int bj = 0; bj < 2; ++bj) { *(f32x4*)(o + bj * 128) = acc[ai][bj][m][0]; *(f32x4*)(o + bj * 128 + 4) = acc[ai][bj][m][1]; } } }
            }
        }
    }
};
struct EpiMerged {
    static constexpr bool HAS_MID = true;
    const bf16_t* gate; bf16_t* merged;
    __device__ __forceinline__ void mid(f32x4 (&acc)[2][2][4][2], const Unit& u, int wr, int wc, int fr, int fq) const {
        int zoff = 0; asm volatile("" : "+v"(zoff));
        const int row0 = u.pm * 256 + wr * 64 + fr + zoff, cc = u.pn * 256 + wc * 32 + 8 * fq;
#pragma unroll
        for (int ai = 0; ai < 2; ++ai) {
            if (ai == 1 && u.half) break;
            u32x4 rw[4][2];
#pragma unroll
            for (int m = 0; m < 4; ++m)
#pragma unroll
                for (int bj = 0; bj < 2; ++bj) rw[m][bj] = *(const u32x4*)(gate + (size_t)(row0 + ai * 128 + m * 16) * 4096 + cc + bj * 128);
#pragma unroll
            for (int m = 0; m < 4; ++m)
#pragma unroll
                for (int bj = 0; bj < 2; ++bj) { f32x4 a0, a1; unpack8(rw[m][bj], a0, a1); acc[ai][bj][m][0] *= a0; acc[ai][bj][m][1] *= a1; }
            __builtin_amdgcn_sched_barrier(0);
        }
    }
    __device__ __forceinline__ void operator()(const f32x4 (&acc)[2][2][4][2], const Unit& u, int wr, int wc, int fr, int fq) const {
        const int row0 = u.pm * 256 + wr * 64 + fr, cc = u.pn * 256 + wc * 32 + 8 * fq;
#pragma unroll
        for (int ai = 0; ai < 2; ++ai)
#pragma unroll
            for (int m = 0; m < 4; ++m) { const int row = row0 + ai * 128 + m * 16;
                const bf16_t* gp = gate + (size_t)row * 4096 + 2048 + cc; bf16_t* o = merged + (size_t)row * D + cc;
#pragma unroll
                for (int bj = 0; bj < 2; ++bj) { const u32x4 gw = *(const u32x4*)(gp + bj * 128); f32x4 g0, g1; unpack8(gw, g0, g1);
                    *(u32x4*)(o + bj * 128) = pack8(acc[ai][bj][m][0] * g0, acc[ai][bj][m][1] * g1); } }
    }
};
constexpr int OUT_SPLIT = 4, OUT_KT = (D / 64) / OUT_SPLIT;
struct EpiOut {
    static constexpr bool HAS_MID = false;
    const float* xp; const float* xs; float* y; bf16_t* hb; float* ssq; float* part;
    __device__ __forceinline__ void operator()(const f32x4 (&acc)[2][2][4][2], const Unit& u, int wr, int wc, int fr, int fq) const {
        int zoff = 0; asm volatile("" : "+v"(zoff));
        const int row0 = u.pm * 256 + wr * 64 + fr + zoff, cc = u.pn * 256 + wc * 32 + 8 * fq;
        if (u.half) {
            float* ps = part + ((size_t)(u.kt0 / OUT_KT) * MS + (row0 - MP)) * D + cc;
#pragma unroll
            for (int m = 0; m < 4; ++m)
#pragma unroll
                for (int bj = 0; bj < 2; ++bj) { *(f32x4*)(ps + (size_t)(m * 16) * D + bj * 128) = acc[0][bj][m][0]; *(f32x4*)(ps + (size_t)(m * 16) * D + bj * 128 + 4) = acc[0][bj][m][1]; }
            return; }
#pragma unroll
        for (int ai = 0; ai < 2; ++ai) {
            if (ai == 1 && u.half) break;
            f32x4 xv[4][2][2];
#pragma unroll
            for (int m = 0; m < 4; ++m) { const int row = row0 + ai * 128 + m * 16; const bool ok = row < MV;
                const float* xr = (row < MP ? xp + (size_t)row * D : xs + (size_t)(ok ? row - MP : 0) * D) + cc;
#pragma unroll
                for (int bj = 0; bj < 2; ++bj) { xv[m][bj][0] = *(const f32x4*)(xr + bj * 128); xv[m][bj][1] = *(const f32x4*)(xr + bj * 128 + 4); } }
            __builtin_amdgcn_sched_barrier(0);
#pragma unroll
            for (int m = 0; m < 4; ++m) { const int row = row0 + ai * 128 + m * 16; const bool ok = row < MV;
                bf16_t* ob = hb + (size_t)row * D + cc;
                float s = 0.f;
#pragma unroll
                for (int bj = 0; bj < 2; ++bj) { f32x4 h0 = acc[ai][bj][m][0], h1 = acc[ai][bj][m][1];
                    if (ok) { h0 += xv[m][bj][0]; h1 += xv[m][bj][1]; }
                    *(u32x4*)(ob + bj * 128) = pack8(h0, h1);
                    s += (h0[0] * h0[0] + h0[1] * h0[1]) + (h0[2] * h0[2] + h0[3] * h0[3]) + (h1[0] * h1[0] + h1[1] * h1[1]) + (h1[2] * h1[2] + h1[3] * h1[3]); }
                s += __shfl_xor(s, 16); s += __shfl_xor(s, 32);
                if (fq == 0) ssq[(size_t)(u.pn * 4 + wc) * MT + row] = s; }
            __builtin_amdgcn_sched_barrier(0);
        }
    }
};
struct EpiGU {
    static constexpr bool HAS_MID = false;
    const LAS float* tab; bf16_t* hid;
    __device__ __forceinline__ void operator()(const f32x4 (&acc)[2][2][4][2], const Unit& u, int wr, int wc, int fr, int fq) const {
        const int row0 = u.pm * 256 + wr * 64 + fr, cc = u.pn * 128 + wc * 32 + 8 * fq;
#pragma unroll
        for (int ai = 0; ai < 2; ++ai)
#pragma unroll
            for (int m = 0; m < 4; ++m) { const int row = row0 + ai * 128 + m * 16;
                const float sc = tab[(u.half ? 256 : 0) + ((ai * 128 + wr * 64 + m * 16 + fr) & (u.half ? 127 : 255))];
                f32x4 r0, r1;
#pragma unroll
                for (int j = 0; j < 4; ++j) { const float g0 = acc[ai][0][m][0][j] * sc, u0 = acc[ai][1][m][0][j] * sc, g1 = acc[ai][0][m][1][j] * sc, u1 = acc[ai][1][m][1][j] * sc;
                    r0[j] = g0 * fast_sigmoid(g0) * u0; r1[j] = g1 * fast_sigmoid(g1) * u1; }
                *(u32x4*)(hid + (size_t)row * FF + cc) = pack8(r0, r1); }
    }
};
constexpr int DN_SPLIT = 11, DN_KT = (FF / 64) / DN_SPLIT;
struct EpiDown {
    static constexpr bool HAS_MID = false;
    float* y; float* part; const bf16_t* hb;
    __device__ __forceinline__ void operator()(const f32x4 (&acc)[2][2][4][2], const Unit& u, int wr, int wc, int fr, int fq) const {
        const int row0 = u.pm * 256 + wr * 64 + fr, cc = u.pn * 256 + wc * 32 + 8 * fq;
#pragma unroll
        for (int ai = 0; ai < 2; ++ai)
#pragma unroll
            for (int m = 0; m < 4; ++m) { const int row = row0 + ai * 128 + m * 16;
                if (row < MV) { float* o = y + (size_t)row * D + cc;
                    if (u.half) {
                        float* ps = part + ((size_t)(u.kt0 / DN_KT) * MS + (row - MP)) * D + cc;
#pragma unroll
                        for (int bj = 0; bj < 2; ++bj) { *(f32x4*)(ps + bj * 128) = acc[ai][bj][m][0]; *(f32x4*)(ps + bj * 128 + 4) = acc[ai][bj][m][1]; }
                    } else {
#pragma unroll
                    for (int bj = 0; bj < 2; ++bj) { const u32x4 hw = *(const u32x4*)(hb + (size_t)row * D + cc + bj * 128); f32x4 h0, h1; unpack8(hw, h0, h1);
                        *(f32x4*)(o + bj * 128) = h0 + acc[ai][bj][m][0]; *(f32x4*)(o + bj * 128 + 4) = h1 + acc[ai][bj][m][1]; } } } }
    }
};

struct EpiWA {
    static constexpr bool HAS_MID = false;
    bf16_t* dst;
    __device__ __forceinline__ void operator()(const f32x4 (&acc)[2][2][4][2], const Unit& u, int wr, int wc, int fr, int fq) const {
        const int row0 = u.pm * 256 + wr * 64 + fr, cc = wc * 32 + 8 * fq;
#pragma unroll
        for (int ai = 0; ai < 2; ++ai)
#pragma unroll
            for (int m = 0; m < 4; ++m) { bf16_t* o = dst + (size_t)(row0 + ai * 128 + m * 16) * 2048 + cc;
#pragma unroll
                for (int bj = 0; bj < 2; ++bj) *(u32x4*)(o + bj * 128) = pack8(acc[ai][bj][m][0], acc[ai][bj][m][1]); }
    }
};

__device__ __forceinline__ void p0_item(const float* W, int N, int k0, int n0, const float* gsc, bf16_t* dst, int ldd, int drow0, int dcol0, LAS float* scr, int lane) {
    const float* wp = W + (size_t)k0 * N + n0 + lane;
    float v[64];
#pragma unroll
    for (int i = 0; i < 64; ++i) v[i] = wp[(size_t)i * N];
    if (gsc) {
#pragma unroll
        for (int i = 0; i < 64; ++i) v[i] *= gsc[k0 + i]; }
#pragma unroll
    for (int i = 0; i < 64; ++i) scr[i * 65 + lane] = v[i];
    asm volatile("s_waitcnt lgkmcnt(0)" ::: "memory");
    const int c = lane & 7;
#pragma unroll
    for (int j = 0; j < 8; ++j) { const int n = (lane >> 3) + 8 * j; const LAS float* s = scr + (8 * c) * 65 + n;
        u32x4 o; o.x = cvt_pk_bf16(s[0 * 65], s[1 * 65]); o.y = cvt_pk_bf16(s[2 * 65], s[3 * 65]); o.z = cvt_pk_bf16(s[4 * 65], s[5 * 65]); o.w = cvt_pk_bf16(s[6 * 65], s[7 * 65]);
        *(u32x4*)(dst + (size_t)(drow0 + n) * ldd + dcol0 + k0 + 8 * c) = o; }
    asm volatile("s_waitcnt lgkmcnt(0)" ::: "memory");
}

struct Params {
    const float *x_prompt, *x_sample, *cache_k, *cache_v, *state_pool, *g_mix, *w_in, *w_pool, *s_pool, *w_branch, *w_out, *g_ffn, *w_gate_up, *w_down, *g_final;
    float* out; unsigned char* ws; int ph_lo, ph_hi;
};

__device__ __forceinline__ void xn_row(const Params& p, int m, int lane);
__device__ __forceinline__ void phase0(const Params& p, LAS unsigned char* lds, int gw, int NGW, int wave, int lane, unsigned xcc) {
    LAS float* scr = (LAS float*)(lds + wave * 16640);
    bf16_t* Wt_in = (bf16_t*)(p.ws + WS_WIN); bf16_t* Wt_br = (bf16_t*)(p.ws + WS_WBR); bf16_t* Wt_out = (bf16_t*)(p.ws + WS_WOUT);
    bf16_t* Wt_gu = (bf16_t*)(p.ws + WS_WGU); bf16_t* Wt_dn = (bf16_t*)(p.ws + WS_WDN); bf16_t* XN = (bf16_t*)(p.ws + WS_XN);
    bf16_t* TMPA = (bf16_t*)(p.ws + WS_TMPA); bf16_t* WPB = (bf16_t*)(p.ws + WS_WPB);
    constexpr int I_IN = (D / 64) * (NIN / 64), I_BR = (D / 64) * (D / 64), I_OUT = (D / 64) * (D / 64), I_GU = (D / 64) * (NGU / 64), I_DN = (FF / 64) * (D / 64);
    constexpr int NITEMS = I_IN + I_BR + I_OUT + I_GU + I_DN;
    unsigned* ctr = (unsigned*)(p.ws + WS_BAR) + 3648 + 64 * (xcc & 7);
    constexpr int NXN = MT / 2;
    for (;;) {
        unsigned kq = 0; if (lane == 0) kq = __hip_atomic_fetch_add(ctr, 1u, __ATOMIC_RELAXED, __HIP_MEMORY_SCOPE_AGENT);
        const int it = 8 * (int)__builtin_amdgcn_readfirstlane(kq) + (int)(xcc & 7);
        if (it >= NITEMS + NXN) break;
        if (it >= NITEMS) { xn_row(p, 2 * (it - NITEMS), lane); xn_row(p, 2 * (it - NITEMS) + 1, lane); continue; }
        int r = it;
        if (r < I_IN) { const int nb = NIN / 64; const int n0 = 64 * (r % nb); int drow = n0;
            if (n0 >= 4096) { const int q = n0 - 4096; drow = q < 2048 ? 4096 + (q / 128) * 256 + (q % 128) : 4096 + ((q - 2048) / 128) * 256 + 128 + ((q - 2048) % 128); }
            p0_item(p.w_in, NIN, 64 * (r / nb), n0, p.g_mix, Wt_in, D, drow, 0, scr, lane); continue; } r -= I_IN;
        if (r < I_BR) { const int nb = D / 64; const int k0 = 64 * (r / nb), n0 = 64 * (r % nb);
            if (k0 < 1024) p0_item(p.w_branch, D, k0, n0, p.s_pool, TMPA, 1024, n0, 0, scr, lane);
            else p0_item(p.w_branch, D, k0, n0, nullptr, Wt_br, 2048, n0, 0, scr, lane);
            continue; } r -= I_BR;
        if (r < I_OUT) { const int nb = D / 64; p0_item(p.w_out, D, 64 * (r / nb), 64 * (r % nb), nullptr, Wt_out, D, 64 * (r % nb), 0, scr, lane); continue; } r -= I_OUT;
        if (r < I_GU) { const int nb = NGU / 64; const int n0 = 64 * (r % nb); const int drow = n0 < FF ? (n0 / 128) * 256 + (n0 % 128) : ((n0 - FF) / 128) * 256 + 128 + ((n0 - FF) % 128);
            p0_item(p.w_gate_up, NGU, 64 * (r / nb), n0, p.g_ffn, Wt_gu, D, drow, 0, scr, lane); continue; } r -= I_GU;
        { const int nb = D / 64; p0_item(p.w_down, D, 64 * (r / nb), 64 * (r % nb), nullptr, Wt_dn, FF, 64 * (r % nb), 0, scr, lane); }
    }
}
__device__ __forceinline__ void xn_row(const Params& p, int m, int lane) {
    bf16_t* XN = (bf16_t*)(p.ws + WS_XN);
    u32x2* o8 = (u32x2*)(XN + (size_t)m * D) + lane;
    if (m >= MV) {
#pragma unroll
        for (int j = 0; j < 8; ++j) o8[64 * j] = (u32x2){0u, 0u};
        return; }
    const f32x4* xr = (const f32x4*)(m < MP ? p.x_prompt + (size_t)m * D : p.x_sample + (size_t)(m - MP) * D) + lane;
    f32x4 v[8]; float s = 0.f;
#pragma unroll
    for (int j = 0; j < 8; ++j) { v[j] = xr[64 * j]; s += (v[j].x * v[j].x + v[j].y * v[j].y) + (v[j].z * v[j].z + v[j].w * v[j].w); }
    const float rs = __builtin_amdgcn_rsqf(wave_sum(s) * (1.0f / D) + EPS);
#pragma unroll
    for (int j = 0; j < 8; ++j) o8[64 * j] = (u32x2){cvt_pk_bf16(v[j].x * rs, v[j].y * rs), cvt_pk_bf16(v[j].z * rs, v[j].w * rs)};
}
__device__ __forceinline__ void phase0b(const Params& p, int gw, int NGW, int lane) {
    bf16_t* WPB = (bf16_t*)(p.ws + WS_WPB);
    for (int i = gw * 64 + lane; i < 4 * 256 * 256 / 8; i += NGW * 64) { const f32x4 a = *(const f32x4*)(p.w_pool + (size_t)i * 8), b = *(const f32x4*)(p.w_pool + (size_t)i * 8 + 4); *(u32x4*)(WPB + (size_t)i * 8) = pack8(a, b); }
    float* ssq = (float*)(p.ws + WS_SSQ);
    for (int i = gw * 64 + lane; i < MT; i += NGW * 64) ssq[i] = 0.f;
}

constexpr int VROW = 320;
__device__ __forceinline__ s16x4 vtr(const LAS unsigned char* p) { typedef short v4i16_t __attribute__((ext_vector_type(4))); return __builtin_bit_cast(s16x4, __builtin_amdgcn_ds_read_tr16_b64_v4i16((LAS v4i16_t*)p)); }
__device__ __forceinline__ bf16x8 cvt8(const f32x4& a, const f32x4& b) { u32x4 w = pack8(a, b); return __builtin_bit_cast(bf16x8, w); }

__device__ __forceinline__ void attn_unit(const Params& p, LAS unsigned char* vl, int unit, int lane) {
    const bf16_t* Ub = (const bf16_t*)(p.ws + WS_QKVU);
    const bf16_t* Qb = Ub + (size_t)MT * 1024; const bf16_t* Kb = Qb + (size_t)MT * 1024; const bf16_t* Vb = Kb + (size_t)MT * 1024;
    bf16_t* AO = (bf16_t*)(p.ws + WS_AO);
    const int n = lane & 31, hh = lane >> 5;
    const bool sample = unit < 64;
    int b, h, qrow0, nblk;
    if (sample) { b = unit >> 3; h = unit & 7; qrow0 = MP + b * DSEQ; nblk = 1 + PAST / 32; }
    else { const int u2 = unit - 64; const int qb = u2 & 127; h = (u2 >> 7) & 7; b = u2 >> 10; qrow0 = b * SEQ + qb * 32; nblk = qb + 1; }
    bf16x8 qf[8];
    { const bf16_t* qp = Qb + (size_t)(qrow0 + n) * 1024 + h * HD + 64 * hh;
#pragma unroll
      for (int kk = 0; kk < 8; ++kk) qf[kk] = *(const bf16x8*)(qp + 8 * kk); }
    f32x16 o[4];
#pragma unroll
    for (int db = 0; db < 4; ++db)
#pragma unroll
        for (int r = 0; r < 16; ++r) o[db][r] = 0.f;
    float R = (sample && n >= DSEQ) ? -1e30f : 0.f;
    const float* ck = p.cache_k + (size_t)b * PAST * 1024 + h * HD; const float* cv = p.cache_v + (size_t)b * PAST * 1024 + h * HD;
    const int vaddr = (4 * hh + ((lane & 15) >> 2)) * VROW + (16 * ((lane >> 4) & 1) + 4 * (lane & 3)) * 2;
    for (int blk = 0; blk < nblk; ++blk) {
        bf16x8 kf[8];
        const bool diag = (blk == 0);
        if (!sample || blk == 0) {
            const int s0 = qrow0 - blk * 32;
            const bf16_t* kp = Kb + (size_t)(s0 + n) * 1024 + h * HD + 64 * hh;
#pragma unroll
            for (int kk = 0; kk < 8; ++kk) kf[kk] = *(const bf16x8*)(kp + 8 * kk);
            const bf16_t* vp = Vb + (size_t)(s0 + (lane >> 4)) * 1024 + h * HD + 8 * (lane & 15);
#pragma unroll
            for (int it = 0; it < 8; ++it) { const u32x4 w = *(const u32x4*)(vp + (size_t)(4 * it) * 1024); *(LAS u32x4*)(vl + (4 * it + (lane >> 4)) * VROW + 16 * (lane & 15)) = w; }
        } else {
            const int s0 = PAST - blk * 32;
            const float* kp = ck + (size_t)(s0 + n) * 1024 + 64 * hh;
#pragma unroll
            for (int kk = 0; kk < 8; ++kk) kf[kk] = cvt8(*(const f32x4*)(kp + 8 * kk), *(const f32x4*)(kp + 8 * kk + 4));
            const float* vp = cv + (size_t)(s0 + (lane >> 4)) * 1024 + 8 * (lane & 15);
#pragma unroll
            for (int it = 0; it < 8; ++it) { const f32x4 a = *(const f32x4*)(vp + (size_t)(4 * it) * 1024), c = *(const f32x4*)(vp + (size_t)(4 * it) * 1024 + 4);
                *(LAS u32x4*)(vl + (4 * it + (lane >> 4)) * VROW + 16 * (lane & 15)) = pack8(a, c); }
        }
        f32x16 st;
#pragma unroll
        for (int r = 0; r < 16; ++r) st[r] = 0.f;
#pragma unroll
        for (int kk = 0; kk < 8; ++kk) st = __builtin_amdgcn_mfma_f32_32x32x16_bf16(kf[kk], qf[kk], st, 0, 0, 0);
        float l1m[16], ls[16];
#pragma unroll
        for (int r = 0; r < 16; ++r) { const int i = (r & 3) + 8 * (r >> 2) + 4 * hh; const bool valid = !diag || (i < n);
            const float z = st[r] * 0.08838834764831845f; const float sp = fmaxf(z, 0.f) + __logf(1.0f + __expf(-fabsf(z)));
            l1m[r] = valid ? -sp : 0.f; ls[r] = valid ? (z - sp) : -1e30f; }
        float gown[4], goth[4];
#pragma unroll
        for (int a = 0; a < 4; ++a) { gown[a] = (l1m[4 * a] + l1m[4 * a + 1]) + (l1m[4 * a + 2] + l1m[4 * a + 3]); goth[a] = __shfl_xor(gown[a], 32); }
        float wv[16]; float tail = R;
#pragma unroll
        for (int a = 3; a >= 0; --a) { float sfx = tail + (hh == 0 ? goth[a] : 0.f);
#pragma unroll
            for (int rr = 3; rr >= 0; --rr) { wv[4 * a + rr] = __expf(ls[4 * a + rr] + sfx); sfx += l1m[4 * a + rr]; }
            tail += gown[a] + goth[a]; }
        R = tail;
        bf16x8 wb[2];
#pragma unroll
        for (int s = 0; s < 2; ++s) wb[s] = cvt8((f32x4){wv[8 * s], wv[8 * s + 1], wv[8 * s + 2], wv[8 * s + 3]}, (f32x4){wv[8 * s + 4], wv[8 * s + 5], wv[8 * s + 6], wv[8 * s + 7]});
        asm volatile("s_waitcnt lgkmcnt(0)" ::: "memory");
#pragma unroll
        for (int db = 0; db < 4; ++db)
#pragma unroll
            for (int s = 0; s < 2; ++s) { const s16x4 lo = vtr(vl + vaddr + (16 * s) * VROW + 64 * db), hi = vtr(vl + vaddr + (16 * s + 8) * VROW + 64 * db);
                const bf16x8 vf = (bf16x8){lo[0], lo[1], lo[2], lo[3], hi[0], hi[1], hi[2], hi[3]};
                o[db] = __builtin_amdgcn_mfma_f32_32x32x16_bf16(vf, wb[s], o[db], 0, 0, 0); }
        asm volatile("s_waitcnt lgkmcnt(0)" ::: "memory");
        if (__all(R < -104.0f)) break;
    }
    if (!sample || n < DSEQ) {
        bf16_t* op = AO + (size_t)(qrow0 + n) * 2048 + 1024 + h * HD + 4 * hh;
#pragma unroll
        for (int db = 0; db < 4; ++db)
#pragma unroll
            for (int a = 0; a < 4; ++a) *(u32x2*)(op + 32 * db + 8 * a) = (u32x2){cvt_pk_bf16(o[db][4 * a], o[db][4 * a + 1]), cvt_pk_bf16(o[db][4 * a + 2], o[db][4 * a + 3])};
    }
}

template <int W>
__device__ __forceinline__ void diff_chunk(const Params& p, int ch, int cc) {
    const bf16_t* Ub = (const bf16_t*)(p.ws + WS_QKVU); bf16_t* AO = (bf16_t*)(p.ws + WS_AO);
    const int m0 = ch * 16; const bool prompt = m0 < MP; const int t0 = prompt ? (m0 & (SEQ - 1)) : PAST;
    const bf16_t* up = Ub + (size_t)m0 * 1024 + cc * 8;
    u32x4 raw[15 + W];
#pragma unroll
    for (int r = 0; r < 16; ++r) raw[W - 1 + r] = *(const u32x4*)(up + (size_t)r * 1024);
    if (prompt) {
#pragma unroll
        for (int j = 1; j < W; ++j) { const u32x4 v = *(const u32x4*)(t0 > 0 ? up - (size_t)j * 1024 : up); raw[W - 1 - j] = (t0 > 0) ? v : (u32x4){0u, 0u, 0u, 0u}; }
    } else { const float* hp = p.state_pool + (size_t)((m0 - MP) >> 4) * 15 * 1024 + cc * 8;
#pragma unroll
        for (int j = 1; j < W; ++j) raw[W - 1 - j] = pack8(*(const f32x4*)(hp + (size_t)(15 - j) * 1024), *(const f32x4*)(hp + (size_t)(15 - j) * 1024 + 4)); }
    f32x4 s0 = (f32x4){0.f, 0.f, 0.f, 0.f}, s1 = s0;
#pragma unroll
    for (int j = 1; j < W; ++j) { f32x4 a, c; unpack8(raw[W - 1 - j], a, c); s0 += a; s1 += c; }
#pragma unroll
    for (int r = 0; r < 16; ++r) { f32x4 a, c; unpack8(raw[W - 1 + r], a, c); s0 += a; s1 += c;
        const int t = t0 + r; const float ic = 1.0f / (float)(t + 1 < W ? t + 1 : W);
        *(u32x4*)(AO + (size_t)(m0 + r) * 2048 + cc * 8) = pack8(s0 * ic - a, s1 * ic - c);
        f32x4 da, dc; unpack8(raw[r], da, dc); s0 -= da; s1 -= dc; }
}
constexpr int N_ATT_UNITS = 64 + 4096, N_DIFF_ITEMS = (MV / 32) * 4, N_P2_ITEMS = N_ATT_UNITS + N_DIFF_ITEMS;
__device__ __forceinline__ void diff_item(const Params& p, int wi, int lane) {
    const int g = wi & 3, ch = 2 * (wi >> 2) + (lane >> 5), cc = 32 * g + (lane & 31);
    if (g == 0) diff_chunk<2>(p, ch, cc); else if (g == 1) diff_chunk<4>(p, ch, cc); else if (g == 2) diff_chunk<8>(p, ch, cc); else diff_chunk<16>(p, ch, cc);
}

__global__ void __launch_bounds__(512, 2) fwd_megakernel(Params p) {
    extern __shared__ __attribute__((aligned(16))) unsigned char lds_raw[];
    LAS unsigned char* lds = (LAS unsigned char*)lds_raw;
    const int tid = threadIdx.x, lane = tid & 63, wave = __builtin_amdgcn_readfirstlane(tid >> 6);
    const int G = gridDim.x, bx = blockIdx.x;
    const int vcu = (G % 8 == 0) ? (bx % 8) * (G / 8) + bx / 8 : bx;
    const int gw = vcu * 8 + wave, NGW = G * 8;
    cg::grid_group grid = cg::this_grid();
    volatile LAS unsigned* xst = (volatile LAS unsigned*)(lds + LDS_BYTES - 64);
    if (tid < 2) xst[tid] = 0u;
    __syncthreads();
    XcdBarrier xbar = xcd_barrier_post((unsigned*)(p.ws + WS_BAR), xst);
#define IN(k) (p.ph_lo <= (k) && (k) < p.ph_hi)
#define SEAM(k) do { if (IN(k) && IN((k) + 1)) { if (p.ph_hi > 64) grid.sync();   xcd_barrier(xbar); } STAMP(); } while (0)
    bf16_t* Wt_in = (bf16_t*)(p.ws + WS_WIN); bf16_t* Wt_br = (bf16_t*)(p.ws + WS_WBR); bf16_t* Wt_out = (bf16_t*)(p.ws + WS_WOUT);
    bf16_t* Wt_gu = (bf16_t*)(p.ws + WS_WGU); bf16_t* Wt_dn = (bf16_t*)(p.ws + WS_WDN); bf16_t* XN = (bf16_t*)(p.ws + WS_XN);
    bf16_t* QKVU = (bf16_t*)(p.ws + WS_QKVU); bf16_t* GATE = (bf16_t*)(p.ws + WS_GATE); bf16_t* AO = (bf16_t*)(p.ws + WS_AO);
    bf16_t* MERGED = (bf16_t*)(p.ws + WS_MERGED); bf16_t* HID = (bf16_t*)(p.ws + WS_HID); float* SSQ = (float*)(p.ws + WS_SSQ);
    float* Y = p.out + OFF_Y;
#ifdef PROBE_T
    unsigned long long tstamp[10]; int nst = 0;
#define STAMP() do { tstamp[nst++] = __builtin_amdgcn_s_memrealtime(); } while (0)
#else
#define STAMP() do {} while (0)
#endif
    STAMP();

    if (IN(0)) { phase0(p, lds, gw, NGW, wave, lane, xbar.x);
#ifdef PROBE_T
#endif
        phase0b(p, gw, NGW, lane);
    }
    SEAM(0);
    if (IN(1)) { pg8::Gemm g{XN, Wt_in, D, D, MT, NIN, D}; pg8::StaticOrder S; S.init(64, NIN / 256, D / 64, G, bx, 64, 1); EpiIn E{QKVU, GATE, p.out}; pg8::gemm_phase(lds, g, S, E); }
    SEAM(1);
    if (IN(2)) {
        LAS unsigned char* vl = lds + wave * (32 * VROW);
        unsigned* ctr = (unsigned*)(p.ws + WS_BAR) + 3584;
        int item = gw;
        while (item < N_P2_ITEMS) {
            if (item < N_ATT_UNITS) attn_unit(p, vl, item, lane); else diff_item(p, item - N_ATT_UNITS, lane);
            unsigned nx = 0; if (lane == 0) nx = __hip_atomic_fetch_add(ctr, 1u, __ATOMIC_RELAXED, __HIP_MEMORY_SCOPE_AGENT);
            item = NGW + (int)__builtin_amdgcn_readfirstlane(nx);
        }
        __syncthreads();
        for (int gq = 0; gq < 4; ++gq) { pg8::Gemm g{(const bf16_t*)(p.ws + WS_TMPA) + gq * 256, (const bf16_t*)(p.ws + WS_WPB) + gq * 65536, 1024, 256, 2048, 256, 256};
            pg8::StaticOrder S; S.init(8, 1, 4, G, (bx + G - 8 * gq) % G); EpiWA E{Wt_br + gq * 256}; pg8::gemm_phase(lds, g, S, E); }
    }
    SEAM(2);
    if (IN(3)) {
        { pg8::Gemm g{AO, Wt_br, 2048, 2048, MT, D, 2048}; pg8::StaticOrder S; S.init(64, 8, 32, G, bx, 64, 1); EpiMerged E{GATE, MERGED}; pg8::gemm_phase(lds, g, S, E); }
    }
    SEAM(3);
    if (IN(4)) { pg8::Gemm g{MERGED, Wt_out, D, D, MT, D, D}; pg8::StaticOrder S; S.init(64, 8, 32, G, bx, 64, OUT_SPLIT); EpiOut E{p.x_prompt, p.x_sample, Y, XN, (float*)(p.ws + WS_SSQP), (float*)(p.ws + WS_AO)}; pg8::gemm_phase(lds, g, S, E); }
    if (IN(4) && IN(5)) xcd_barrier(xbar);
    if (IN(4)) {
        for (int r = gw; r < MS; r += NGW) {
            const f32x4* xr = (const f32x4*)(p.x_sample + (size_t)r * D) + lane; const f32x4* pr = (const f32x4*)((const float*)(p.ws + WS_AO) + (size_t)r * D) + lane;
            u32x2* o8 = (u32x2*)(XN + (size_t)(MP + r) * D) + lane; float* sp = (float*)(p.ws + WS_SSQP);
            float sq = 0.f;
#pragma unroll
            for (int j = 0; j < 8; ++j) { f32x4 v = xr[64 * j];
#pragma unroll
                for (int c = 0; c < OUT_SPLIT; ++c) v += pr[(size_t)c * MS * D / 4 + 64 * j];
                sq += (v.x * v.x + v.y * v.y) + (v.z * v.z + v.w * v.w);
                o8[64 * j] = (u32x2){cvt_pk_bf16(v.x, v.y), cvt_pk_bf16(v.z, v.w)}; }
            sq = wave_sum(sq);
            if (lane < 32) sp[(size_t)lane * MT + MP + r] = lane == 0 ? sq : 0.f;
        }
    }
    SEAM(4);
    if (IN(5)) { pg8::Gemm g{XN, Wt_gu, D, D, MT, NGU, D}; pg8::StaticOrder S; S.init(64, NGU / 256, 32, G, bx, 64, 1);
        LAS float* tab = (LAS float*)(lds + 131072);
        { pg8::Unit u0; S.next(0, u0); const float* sp = (const float*)(p.ws + WS_SSQP);
          if (tid < 384) { const int row = tid < 256 ? u0.pm * 256 + tid : MP + (tid - 256); float a = 0.f;
#pragma unroll 8
              for (int k = 0; k < 32; ++k) a += sp[(size_t)k * MT + row];
              tab[tid] = __builtin_amdgcn_rsqf(a * (1.0f / D) + EPS); }
          __syncthreads(); }
        EpiGU E{tab, HID}; pg8::gemm_phase(lds, g, S, E); }
    SEAM(5);
    if (IN(6)) { pg8::Gemm g{HID, Wt_dn, FF, FF, MT, D, FF}; pg8::StaticOrder S; S.init(64, 8, FF / 64, G, bx, 64, DN_SPLIT); EpiDown E{Y, (float*)(p.ws + WS_AO), XN}; pg8::gemm_phase(lds, g, S, E); }
    SEAM(6);
    if (IN(7)) {
        for (int m = gw; m < MV; m += NGW) {
            f32x4* yr = (f32x4*)(Y + (size_t)m * D) + lane; const f32x4* gf = (const f32x4*)p.g_final + lane;
            f32x4 v[8]; float s = 0.f;
            if (m < MP) {
#pragma unroll
                for (int j = 0; j < 8; ++j) v[j] = yr[64 * j];
            } else {
                const u32x2* hr = (const u32x2*)(XN + (size_t)m * D) + lane;
#pragma unroll
                for (int j = 0; j < 8; ++j) { const u32x2 w2 = hr[64 * j]; v[j] = (f32x4){bflo(w2.x), bfhi(w2.x), bflo(w2.y), bfhi(w2.y)}; } }
            if (m >= MP) { const f32x4* pr = (const f32x4*)((const float*)(p.ws + WS_AO) + (size_t)(m - MP) * D) + lane;
                for (int c = 0; c < DN_SPLIT; ++c)
#pragma unroll
                    for (int j = 0; j < 8; ++j) v[j] += pr[(size_t)c * MS * D / 4 + 64 * j]; }
#pragma unroll
            for (int j = 0; j < 8; ++j) s += (v[j].x * v[j].x + v[j].y * v[j].y) + (v[j].z * v[j].z + v[j].w * v[j].w);
            const float rs = __builtin_amdgcn_rsqf(wave_sum(s) * (1.0f / D) + EPS);
#pragma unroll
            for (int j = 0; j < 8; ++j) yr[64 * j] = v[j] * rs * gf[64 * j];
        }
    }
#ifdef PROBE_T
    STAMP();
    if (bx == 0 && tid == 0) {
        const unsigned long long e1 = (unsigned long long)__hip_atomic_load((long long*)(p.ws + WS_SSQ + 512 * 1024), __ATOMIC_RELAXED, __HIP_MEMORY_SCOPE_AGENT);
        const unsigned long long e2 = (unsigned long long)__hip_atomic_load((long long*)(p.ws + WS_SSQ + 512 * 1024 + 256), __ATOMIC_RELAXED, __HIP_MEMORY_SCOPE_AGENT);
        (void)e1; (void)e2;
        const float ta = (float)(tstamp[PROBE_A + 1] - tstamp[PROBE_A]) * 0.01f, tb = (float)(tstamp[PROBE_B + 1] - tstamp[PROBE_B]) * 0.01f;
        asm volatile("s_waitcnt vmcnt(0)" ::: "memory");
        atomicAdd(Y, 4.0f + ta * (1.0f / 256.0f)); atomicAdd(p.out + OFF_PP, 1.5f + tb * (1.0f / 500.0f));
    }
#endif
#undef IN
#undef SEAM
}

extern "C" void kernel_launch(void* const* d_in, const int* in_sizes, int n_in, void* d_out, int out_size, void* d_ws, size_t ws_size, hipStream_t stream) {
    static int grid = 0;
    if (grid == 0) {
        if (n_in != 15 || (size_t)out_size != OUT_TOTAL || ws_size < WS_END) { fprintf(stderr, "kernel_launch: unexpected shapes: n_in %d out %d ws %zu\n", n_in, out_size, ws_size); grid = -1; return; }
        int dev = 0, cus = 0, per_cu = 0;
        hipGetDevice(&dev); hipDeviceGetAttribute(&cus, hipDeviceAttributeMultiprocessorCount, dev);
        hipFuncSetAttribute((const void*)fwd_megakernel, hipFuncAttributeMaxDynamicSharedMemorySize, LDS_BYTES);
        hipOccupancyMaxActiveBlocksPerMultiprocessor(&per_cu, (const void*)fwd_megakernel, 512, LDS_BYTES);
        if (per_cu < 1) { fprintf(stderr, "kernel_launch: occupancy query says %d blocks per CU\n", per_cu); per_cu = 1; }
        (void)hipGetLastError();
        grid = cus;
    }
    if (grid < 0) return;
    Params p{};
    const float** pp = (const float**)&p;
    for (int i = 0; i < 15; ++i) pp[i] = (const float*)d_in[i];
    p.out = (float*)d_out; p.ws = (unsigned char*)d_ws;
#if N_LAUNCH_MODE == 1
    p.ph_lo = 0; p.ph_hi = 8;
    void* args[] = {&p};
    if (hipMemsetAsync((char*)d_ws + WS_BAR, 0, WS_BAR_BYTES, stream) != hipSuccess) fprintf(stderr, "kernel_launch: memset of the barrier words failed\n");
    hipError_t e = hipLaunchCooperativeKernel((const void*)fwd_megakernel, dim3(grid), dim3(512), args, LDS_BYTES, stream);
    if (e != hipSuccess) fprintf(stderr, "cooperative launch failed: %s (grid %d)\n", hipGetErrorString(e), grid);
#else
    for (int ph = 0; ph < 8; ++ph) { p.ph_lo = ph; p.ph_hi = ph + 1; hipLaunchKernelGGL(fwd_megakernel, dim3(grid), dim3(512), LDS_BYTES, stream, p); }
#endif
}
```

```cpp
#include <hip/hip_runtime.h>
#include <hip/hip_cooperative_groups.h>
#include <cstdio>
#include <cstdint>
namespace cg = cooperative_groups;

#define PROBE_A 6
#define PROBE_B 4
#ifndef N_LAUNCH_MODE
#define N_LAUNCH_MODE 1
#endif

#define LAS __attribute__((address_space(3)))
typedef unsigned short bf16_t;
typedef short bf16x8 __attribute__((ext_vector_type(8)));
typedef short s16x4 __attribute__((ext_vector_type(4)));
typedef float f32x4 __attribute__((ext_vector_type(4)));
typedef float f32x16 __attribute__((ext_vector_type(16)));
typedef unsigned u32x4 __attribute__((ext_vector_type(4)));
typedef unsigned u32x2 __attribute__((ext_vector_type(2)));

constexpr int D = 2048, MP = 16384, MS = 128, MV = MP + MS, MT = 16640;
constexpr int SEQ = 4096, DSEQ = 16, PAST = 4096, NH = 8, HD = 128;
constexpr int NIN = 8192, FF = 5632, NGU = 2 * FF, AW = 1024;
constexpr float EPS = 1e-6f;
constexpr size_t OFF_Y = 0, OFF_KP = (size_t)MV * D, OFF_VP = OFF_KP + (size_t)MP * 1024, OFF_PP = OFF_VP + (size_t)MP * 1024,
                 OFF_KS = OFF_PP + 4 * 15 * 1024, OFF_VS = OFF_KS + (size_t)MS * 1024, OFF_PS = OFF_VS + (size_t)MS * 1024, OUT_TOTAL = OFF_PS + 8 * 15 * 1024;
constexpr size_t MiB = 1u << 20;
constexpr size_t WS_SSQ = 0, WS_WIN = 1 * MiB, WS_WBR = 33 * MiB, WS_WOUT = 41 * MiB, WS_WGU = 49 * MiB, WS_WDN = 93 * MiB, WS_XN = 115 * MiB,
                 WS_QKVU = 180 * MiB, WS_GATE = 310 * MiB, WS_AO = 440 * MiB, WS_TMPA = 505 * MiB, WS_WPB = 509 * MiB, WS_SSQP = 510 * MiB, WS_END = 513 * MiB;
constexpr size_t WS_BAR = 768 * 1024, WS_BAR_BYTES = 32768;
constexpr size_t WS_H2B = WS_WIN;
static_assert(WS_H2B + (size_t)MV * D * 2 <= WS_WDN, "h2 overlay");
constexpr size_t WS_MERGED = WS_QKVU;
constexpr size_t WS_HID = WS_QKVU;
static_assert((size_t)MT * FF * 2 <= WS_AO - WS_QKVU, "hid overlay");
constexpr int LDS_BYTES = 147456;

typedef __bf16 bf16x2_t __attribute__((ext_vector_type(2)));
typedef float f32x2_t __attribute__((ext_vector_type(2)));
__device__ __forceinline__ unsigned cvt_pk_bf16(float lo, float hi) { const f32x2_t v = {lo, hi}; return __builtin_bit_cast(unsigned, __builtin_convertvector(v, bf16x2_t)); }
__device__ __forceinline__ float bf2f(unsigned short b) { return __uint_as_float(((unsigned)b) << 16); }
__device__ __forceinline__ float bflo(unsigned w) { return __uint_as_float(w << 16); }
__device__ __forceinline__ float bfhi(unsigned w) { return __uint_as_float(w & 0xffff0000u); }
__device__ __forceinline__ float fast_sigmoid(float x) { return __builtin_amdgcn_rcpf(1.0f + __expf(-x)); }
__device__ __forceinline__ float wave_sum(float v) {
#pragma unroll
    for (int o = 1; o < 64; o <<= 1) v += __shfl_xor(v, o);
    return v;
}

#define XB_TMO      128
#define XB_XCNT(j)  (256  + 64 * (j))
#define XB_XSUB(j)  (1280 + 64 * (j))
#define XB_XGEN(j)  (2304 + 64 * (j))
#define XB_TOP      3328
#define XB_TOPGEN   3392
#define XCD_BAR_WORDS 3456
#define XB_SPIN_CAP (1u << 18)

__device__ __forceinline__ unsigned xb_ld(unsigned* p)              { return __hip_atomic_load(p, __ATOMIC_RELAXED, __HIP_MEMORY_SCOPE_AGENT); }
__device__ __forceinline__ unsigned xb_add(unsigned* p, unsigned v) { return __hip_atomic_fetch_add(p, v, __ATOMIC_RELAXED, __HIP_MEMORY_SCOPE_AGENT); }
__device__ __forceinline__ unsigned xb_xcc_id() { return (unsigned)__builtin_amdgcn_s_getreg((3 << 11) | 20) & 0xFu; }
#define XB_SPIN(cond, bar) do { unsigned _sp = 0; while (cond) { __builtin_amdgcn_s_sleep(1); \
    if ((++_sp & 255u) == 0u) { if (xb_ld(&(bar)[XB_TMO])) break; if (_sp > XB_SPIN_CAP) { atomicAdd(&(bar)[XB_TMO], 1u); break; } } } } while (0)

struct XcdBarrier {
    unsigned* bar; unsigned x;
    volatile LAS unsigned* st;
};

__device__ __forceinline__ XcdBarrier xcd_barrier_post(unsigned* bar, volatile LAS unsigned* st) {
    XcdBarrier b; b.bar = bar; b.x = xb_xcc_id(); b.st = st;
    if (threadIdx.x == 0) (void)xb_add(&bar[XB_XCNT(b.x)], 1u);
    return b;
}
__device__ __forceinline__ void xcd_barrier_complete(unsigned* bar, unsigned x, unsigned& nloc, unsigned& nx) {
    const unsigned G = gridDim.x * gridDim.y * gridDim.z;
    unsigned sum, cnt, mine, sp = 0u;
    for (;;) {
        sum = 0u; cnt = 0u; mine = 0u;
#pragma unroll
        for (unsigned j = 0; j < 16; ++j) { const unsigned c = xb_ld(&bar[XB_XCNT(j)]); sum += c; cnt += (c > 0u) ? 1u : 0u; mine = (j == x) ? c : mine; }
        if (sum == G) break;
        __builtin_amdgcn_s_sleep(1);
        if ((++sp & 255u) == 0u) { if (xb_ld(&bar[XB_TMO])) break; if (sp > XB_SPIN_CAP) { atomicAdd(&bar[XB_TMO], 1u); break; } }
    }
    nloc = mine > 0u ? mine : 1u; nx = cnt > 0u ? cnt : 1u;
}

__device__ __forceinline__ void xcd_barrier(const XcdBarrier& b) {
    asm volatile("s_waitcnt vmcnt(0)" ::: "memory");
    __syncthreads();
    if (threadIdx.x == 0) {
        unsigned* bar = b.bar;
        __builtin_amdgcn_s_waitcnt(0);
        unsigned nloc = b.st[0], nx = b.st[1];
        if (nloc == 0u) { xcd_barrier_complete(bar, b.x, nloc, nx); b.st[0] = nloc; b.st[1] = nx; }
        const unsigned old = xb_add(&bar[XB_XSUB(b.x)], 1u);
        const unsigned gen = old / nloc;
        if (old + 1u == (gen + 1u) * nloc) {
            __builtin_amdgcn_fence(__ATOMIC_RELEASE, "agent");
            asm volatile("s_waitcnt vmcnt(0)" ::: "memory");
            const unsigned og = xb_add(&bar[XB_TOP], 1u);
            const unsigned tg = og / nx;
            if (og + 1u == (tg + 1u) * nx) xb_add(&bar[XB_TOPGEN], 1u);
            else XB_SPIN(xb_ld(&bar[XB_TOPGEN]) == tg, bar);
            __builtin_amdgcn_fence(__ATOMIC_ACQUIRE, "agent");
            xb_add(&bar[XB_XGEN(b.x)], 1u);
            asm volatile("s_waitcnt vmcnt(0)" ::: "memory");
        } else {
            XB_SPIN(xb_ld(&bar[XB_XGEN(b.x)]) == gen, bar);
            __builtin_amdgcn_fence(__ATOMIC_ACQUIRE, "agent");
            asm volatile("s_waitcnt vmcnt(0)" ::: "memory");
        }
    }
    __syncthreads();
}

namespace pg8 {
constexpr int BM = 256, BK = 64, HALF = 128, HTB = HALF * BK * 2, STAGE_BYTES = 8 * HTB, NXCD = 8, WGM = 8;
__host__ __device__ __forceinline__ int lds_byte(int r, int c) { const int st = (r >> 4) * 2 + (c >> 5), rr = r & 15, cc = c & 31, ob = rr * 64 + cc * 2; return st * 1024 + (ob ^ (((ob >> 9) & 1) << 5)); }
__host__ __device__ __forceinline__ void stage_rc(int b, int& R, int& C) { const int st = b / 1024, sb = b % 1024, swz = sb ^ (((sb >> 9) & 1) << 5); R = (st >> 1) * 16 + swz / 64; C = (st & 1) * 32 + (swz % 64) / 2; }
__host__ __device__ __forceinline__ int perm32(int rho) { const int n = rho >> 4, i = rho & 15; return 8 * (i >> 2) + 4 * n + (i & 3); }

struct Unit { int pm, pn, kt0, nkt, half; };
struct Gemm { const bf16_t* A; const bf16_t* Bt; int lda, ldb, M, N, K; };

struct StaticOrder {
    int nM, nN, nwg, G, c, ktfull, pmS, nS, ktS;
    __device__ void init(int nM_, int nN_, int ktfull_, int G_, int c_, int pmS_ = 0, int ksplit = 0) { nM = nM_; nN = nN_; nwg = nM * nN; G = G_; c = c_; ktfull = ktfull_; pmS = pmS_; nS = nN * ksplit; ktS = ksplit ? ktfull / ksplit : 0; }
    __device__ bool next(int i, Unit& u) const {
        const int L = i * G + c;
        if (L >= nwg) { const int t = L - nwg;
            if (t >= nS) return false;
            u.pm = pmS; u.pn = t % nN; u.kt0 = (t / nN) * ktS; u.nkt = ktS; u.half = 1; return true; }
        int wgid = L; { const int q = nwg / NXCD, r = nwg % NXCD, xcd = wgid % NXCD, off = wgid / NXCD; wgid = (xcd < r ? xcd * (q + 1) : r * (q + 1) + (xcd - r) * q) + off; }
        const int nig = WGM * nN, gid = wgid / nig, fm = gid * WGM, gsz = (nM - fm) < WGM ? (nM - fm) : WGM;
        u.pm = fm + ((wgid % nig) % gsz); u.pn = (wgid % nig) / gsz; u.kt0 = 0; u.nkt = ktfull; u.half = 0; return true;
    }
};

template <class Epi>
__device__ __forceinline__ void gemm_phase(LAS unsigned char* lds, const Gemm g, const StaticOrder& S, const Epi& E) {
    int tid_ = threadIdx.x; asm volatile("" : "+v"(tid_));
    const int tid = tid_, wid = __builtin_amdgcn_readfirstlane(tid >> 6), lane = tid & 63, wr = wid >> 2, wc = wid & 3, fr = lane & 15, fq = lane >> 4;
    unsigned voffA[2], voffB[2];
#pragma unroll
    for (int i = 0; i < 2; ++i) { int R, C; stage_rc(tid * 16 + i * 8192, R, C); const int Rb = (R & ~31) + perm32(R & 31);
        voffA[i] = (unsigned)(R * g.lda + C) * 2u; voffB[i] = (unsigned)(Rb * g.ldb + C) * 2u; }
    const size_t kstep = (size_t)(BK * 2);
    const size_t hstepA = (size_t)HALF * g.lda * 2, hstepB = (size_t)HALF * g.ldb * 2;
    const size_t tstepA = 2 * hstepA, tstepB = 2 * hstepB;
    const unsigned ldsw = (unsigned)wid * 1024u;
    const int aoff = lds_byte(wr * 64 + fr, fq * 8), boff = lds_byte(wc * 32 + fr, fq * 8);
#define PG8_SA(b, h) (((b) * 2 + (h)) * HTB)
#define PG8_SB(b, h) ((4 + (b) * 2 + (h)) * HTB)
#define PG8_STAGE(bufoff, gbase, voff) do { _Pragma("unroll") for (int _i = 0; _i < 2; ++_i) \
        __builtin_amdgcn_global_load_lds((const unsigned*)((const char*)(gbase) + (voff)[_i]), (LAS unsigned*)(lds + (bufoff) + ldsw + _i * 8192), 16, 0, 0); } while (0)
#define PG8_LDA(dst, b, h) do { _Pragma("unroll") for (int m = 0; m < 4; ++m) _Pragma("unroll") for (int k = 0; k < 2; ++k) dst[m][k] = *(const LAS bf16x8*)(lds + PG8_SA(b, h) + aoff + m * 2048 + k * 1024); } while (0)
#define PG8_LDB(dst, b, h) do { _Pragma("unroll") for (int n = 0; n < 2; ++n) _Pragma("unroll") for (int k = 0; k < 2; ++k) dst[n][k] = *(const LAS bf16x8*)(lds + PG8_SB(b, h) + boff + n * 2048 + k * 1024); } while (0)
#define PG8_MMA(ai, bj, At, Bt) do { __builtin_amdgcn_s_setprio(1); _Pragma("unroll") for (int m = 0; m < 4; ++m) _Pragma("unroll") for (int n = 0; n < 2; ++n) _Pragma("unroll") for (int k = 0; k < 2; ++k) \
        acc[ai][bj][m][n] = __builtin_amdgcn_mfma_f32_16x16x32_bf16(Bt[n][k], At[m][k], acc[ai][bj][m][n], 0, 0, 0); __builtin_amdgcn_s_setprio(0); } while (0)
#define PG8_WAIT_V(n) asm volatile("s_waitcnt vmcnt(" #n ")" ::: "memory")
#define PG8_WAIT_L(n) asm volatile("s_waitcnt lgkmcnt(" #n ")" ::: "memory")
#define PG8_BAR __builtin_amdgcn_s_barrier()
#define PG8_SCHED __builtin_amdgcn_sched_barrier(0)
    Unit cur, nxt; int ui = 0;
    if (!S.next(0, cur)) return;
    f32x4 acc[2][2][4][2];
#pragma unroll
    for (int a = 0; a < 2; ++a)
#pragma unroll
        for (int b = 0; b < 2; ++b)
#pragma unroll
            for (int m = 0; m < 4; ++m)
#pragma unroll
                for (int n = 0; n < 2; ++n) acc[a][b][m][n] = (f32x4){0.f, 0.f, 0.f, 0.f};
    bf16x8 At[4][2], B0[2][2], B1[2][2];
    const char* cA = (const char*)g.A + (size_t)cur.pm * tstepA + (size_t)cur.kt0 * kstep; const char* cB = (const char*)g.Bt + (size_t)cur.pn * tstepB + (size_t)cur.kt0 * kstep;
    PG8_STAGE(PG8_SB(0, 0), cB, voffB); PG8_STAGE(PG8_SB(0, 1), cB + hstepB, voffB); PG8_STAGE(PG8_SA(0, 0), cA, voffA); PG8_STAGE(PG8_SA(0, 1), cA + hstepA, voffA);
    if (wr == 1) PG8_BAR;
    PG8_WAIT_V(2); PG8_BAR;
    PG8_STAGE(PG8_SB(1, 0), cB + kstep, voffB); PG8_STAGE(PG8_SA(1, 0), cA + kstep, voffA); PG8_STAGE(PG8_SB(1, 1), cB + hstepB + kstep, voffB);
    PG8_WAIT_V(6); PG8_BAR;
    for (;;) {
        const bool has_next = S.next(ui + 1, nxt);
        const char* nA = has_next ? (const char*)g.A + (size_t)nxt.pm * tstepA + (size_t)nxt.kt0 * kstep : cA; const char* nB = has_next ? (const char*)g.Bt + (size_t)nxt.pn * tstepB + (size_t)nxt.kt0 * kstep : cB;
        const int nt = cur.nkt; const bool full = !cur.half;
        for (int t = 0; t < nt; t += 2) {
            const bool last = (t == nt - 2);
            if constexpr (Epi::HAS_MID) { if (t == (nt >> 1)) E.mid(acc, cur, wr, wc, fr, fq); }
            const char* a1 = cA + (size_t)(t + 1) * kstep;
            const char* a2 = last ? nA : cA + (size_t)(t + 2) * kstep; const char* b2 = last ? nB : cB + (size_t)(t + 2) * kstep;
            const char* a3 = a2 + kstep; const char* b3 = b2 + kstep;
            PG8_LDB(B0, 0, 0); PG8_LDB(B1, 0, 1); PG8_SCHED; PG8_LDA(At, 0, 0); PG8_STAGE(PG8_SA(1, 1), a1 + hstepA, voffA);
            PG8_WAIT_V(8); PG8_WAIT_L(0); PG8_BAR; PG8_MMA(0, 0, At, B0); PG8_MMA(0, 1, At, B1); PG8_BAR; PG8_SCHED;
            if (full) PG8_LDA(At, 0, 1); PG8_STAGE(PG8_SB(0, 0), b2, voffB); PG8_STAGE(PG8_SB(0, 1), b2 + hstepB, voffB); PG8_STAGE(PG8_SA(0, 0), a2, voffA);
            PG8_WAIT_V(8); PG8_WAIT_L(0); PG8_BAR; if (full) { PG8_MMA(1, 0, At, B0); PG8_MMA(1, 1, At, B1); } PG8_BAR; PG8_SCHED;
            PG8_LDB(B0, 1, 0); PG8_LDB(B1, 1, 1); PG8_SCHED; PG8_LDA(At, 1, 0); PG8_STAGE(PG8_SA(0, 1), a2 + hstepA, voffA);
            PG8_WAIT_V(8); PG8_WAIT_L(0); PG8_BAR; PG8_MMA(0, 0, At, B0); PG8_MMA(0, 1, At, B1); PG8_BAR; PG8_SCHED;
            if (full) PG8_LDA(At, 1, 1); PG8_STAGE(PG8_SB(1, 0), b3, voffB); PG8_STAGE(PG8_SB(1, 1), b3 + hstepB, voffB); PG8_STAGE(PG8_SA(1, 0), a3, voffA);
            PG8_WAIT_V(8); PG8_WAIT_L(0); PG8_BAR; if (full) { PG8_MMA(1, 0, At, B0); PG8_MMA(1, 1, At, B1); } PG8_BAR; PG8_SCHED;
        }
        if (wr == 0) PG8_BAR;
        E(acc, cur, wr, wc, fr, fq);
        if (!has_next) break;
#pragma unroll
        for (int a = 0; a < 2; ++a)
#pragma unroll
            for (int b = 0; b < 2; ++b)
#pragma unroll
                for (int m = 0; m < 4; ++m)
#pragma unroll
                    for (int n = 0; n < 2; ++n) acc[a][b][m][n] = (f32x4){0.f, 0.f, 0.f, 0.f};
        cur = nxt; cA = nA; cB = nB; ++ui;
        if (wr == 1) PG8_BAR;
    }
    PG8_WAIT_V(0);
    PG8_BAR;
#undef PG8_SA
#undef PG8_SB
#undef PG8_STAGE
#undef PG8_LDA
#undef PG8_LDB
#undef PG8_MMA
#undef PG8_WAIT_V
#undef PG8_WAIT_L
#undef PG8_BAR
#undef PG8_SCHED
}
}
using pg8::Unit;

__device__ __forceinline__ u32x4 pack8(const f32x4& v0, const f32x4& v1) {
    u32x4 w; w.x = cvt_pk_bf16(v0[0], v0[1]); w.y = cvt_pk_bf16(v0[2], v0[3]); w.z = cvt_pk_bf16(v1[0], v1[1]); w.w = cvt_pk_bf16(v1[2], v1[3]); return w;
}
__device__ __forceinline__ void unpack8(const u32x4& w, f32x4& v0, f32x4& v1) {
    v0 = (f32x4){bflo(w.x), bfhi(w.x), bflo(w.y), bfhi(w.y)}; v1 = (f32x4){bflo(w.z), bfhi(w.z), bflo(w.w), bfhi(w.w)};
}

struct EpiIn {
    static constexpr bool HAS_MID = false;
    bf16_t* qkvu; bf16_t* gate; float* out;
    __device__ __forceinline__ void operator()(const f32x4 (&acc)[2][2][4][2], const Unit& u, int wr, int wc, int fr, int fq) const {
        const int row0 = u.pm * 256 + wr * 64 + fr, cw = wc * 32 + 8 * fq;
        if (u.pn >= 16) {
            bf16_t* base = gate + (size_t)row0 * 4096 + (u.pn - 16) * 128 + cw;
#pragma unroll
            for (int ai = 0; ai < 2; ++ai)
#pragma unroll
                for (int m = 0; m < 4; ++m) { bf16_t* rowp = base + (size_t)(ai * 128 + m * 16) * 4096;
                    f32x4 r0, r1, b0, b1;
#pragma unroll
                    for (int j = 0; j < 4; ++j) { b0[j] = fmaxf(fast_sigmoid(acc[ai][1][m][0][j]), 1e-30f); b1[j] = fmaxf(fast_sigmoid(acc[ai][1][m][1][j]), 1e-30f);
                        r0[j] = fast_sigmoid(acc[ai][0][m][0][j]) * __builtin_amdgcn_rcpf(b0[j]); r1[j] = fast_sigmoid(acc[ai][0][m][1][j]) * __builtin_amdgcn_rcpf(b1[j]); }
                    *(u32x4*)rowp = pack8(r0, r1); *(u32x4*)(rowp + 2048) = pack8(b0, b1); }
        } else {
            const int sec = u.pn >> 2, cc = (u.pn & 3) * 256 + cw;
            bf16_t* base = qkvu + (size_t)sec * MT * 1024 + (size_t)row0 * 1024 + cc;
#pragma unroll
            for (int ai = 0; ai < 2; ++ai)
#pragma unroll
                for (int m = 0; m < 4; ++m) { bf16_t* rowp = base + (size_t)(ai * 128 + m * 16) * 1024;
#pragma unroll
                    for (int bj = 0; bj < 2; ++bj) *(u32x4*)(rowp + bj * 128) = pack8(acc[ai][bj][m][0], acc[ai][bj][m][1]); }
            if (sec >= 2) {
                const size_t offp = (sec == 2) ? OFF_KP : OFF_VP, offs = (sec == 2) ? OFF_KS : OFF_VS;
#pragma unroll
                for (int ai = 0; ai < 2; ++ai)
#pragma unroll
                    for (int m = 0; m < 4; ++m) { const int row = row0 + ai * 128 + m * 16;
                        if (row < MV) { float* o = out + (row < MP ? offp + (size_t)row * 1024 : offs + (size_t)(row - MP) * 1024) + cc;
#pragma unroll
                            for (int bj = 0; bj < 2; ++bj) { *(f32x4*)(o + bj * 128) = acc[ai][bj][m][0]; *(f32x4*)(o + bj * 128 + 4) = acc[ai][bj][m][1]; } } }
            } else if (sec == 0 && ((u.pm & 15) == 15 || u.pm == 64)) {
#pragma unroll
                for (int ai = 0; ai < 2; ++ai)
#pragma unroll
                    for (int m = 0; m < 4; ++m) { const int row = row0 + ai * 128 + m * 16; long off = -1;
                        if (row < MP) { const int t = row & (SEQ - 1); if (t >= SEQ - 15) off = (long)OFF_PP + ((long)(row >> 12) * 15 + (t - (SEQ - 15))) * 1024; }
                        else if (row < MV) { const int t = (row - MP) & 15, b = (row - MP) >> 4; if (t >= 1) off = (long)OFF_PS + ((long)b * 15 + (t - 1)) * 1024; }
                        if (off >= 0) { float* o = out + off + cc;
#pragma unroll
                            for (int bj = 0; bj < 2; ++bj) { *(f32x4*)(o + bj * 128) = acc[ai][bj][m][0]; *(f32x4*)(o + bj * 128 + 4) = acc[ai][bj][m][1]; } } }
            }
        }
    }
};
struct EpiMerged {
    static constexpr bool HAS_MID = true;
    const bf16_t* gate; bf16_t* merged;
    __device__ __forceinline__ void mid(f32x4 (&acc)[2][2][4][2], const Unit& u, int wr, int wc, int fr, int fq) const {
        int zoff = 0; asm volatile("" : "+v"(zoff));
        const int row0 = u.pm * 256 + wr * 64 + fr + zoff, cc = u.pn * 256 + wc * 32 + 8 * fq;
#pragma unroll
        for (int ai = 0; ai < 2; ++ai) {
            if (ai == 1 && u.half) break;
            u32x4 rw[4][2];
#pragma unroll
            for (int m = 0; m < 4; ++m)
#pragma unroll
                for (int bj = 0; bj < 2; ++bj) rw[m][bj] = *(const u32x4*)(gate + (size_t)(row0 + ai * 128 + m * 16) * 4096 + cc + bj * 128);
#pragma unroll
            for (int m = 0; m < 4; ++m)
#pragma unroll
                for (int bj = 0; bj < 2; ++bj) { f32x4 a0, a1; unpack8(rw[m][bj], a0, a1); acc[ai][bj][m][0] *= a0; acc[ai][bj][m][1] *= a1; }
            __builtin_amdgcn_sched_barrier(0);
        }
    }
    __device__ __forceinline__ void operator()(const f32x4 (&acc)[2][2][4][2], const Unit& u, int wr, int wc, int fr, int fq) const {
        const int row0 = u.pm * 256 + wr * 64 + fr, cc = u.pn * 256 + wc * 32 + 8 * fq;
#pragma unroll
        for (int ai = 0; ai < 2; ++ai)
#pragma unroll
            for (int m = 0; m < 4; ++m) { const int row = row0 + ai * 128 + m * 16;
                const bf16_t* gp = gate + (size_t)row * 4096 + 2048 + cc; bf16_t* o = merged + (size_t)row * D + cc;
#pragma unroll
                for (int bj = 0; bj < 2; ++bj) { const u32x4 gw = *(const u32x4*)(gp + bj * 128); f32x4 g0, g1; unpack8(gw, g0, g1);
                    *(u32x4*)(o + bj * 128) = pack8(acc[ai][bj][m][0] * g0, acc[ai][bj][m][1] * g1); } }
    }
};
constexpr int OUT_SPLIT = 4, OUT_KT = (D / 64) / OUT_SPLIT;
struct EpiOut {
    static constexpr bool HAS_MID = false;
    const float* xp; const float* xs; float* y; bf16_t* hb; float* ssq; float* part;
    __device__ __forceinline__ void operator()(const f32x4 (&acc)[2][2][4][2], const Unit& u, int wr, int wc, int fr, int fq) const {
        int zoff = 0; asm volatile("" : "+v"(zoff));
        const int row0 = u.pm * 256 + wr * 64 + fr + zoff, cc = u.pn * 256 + wc * 32 + 8 * fq;
        if (u.half) {
            float* ps = part + ((size_t)(u.kt0 / OUT_KT) * MS + (row0 - MP)) * D + cc;
#pragma unroll
            for (int m = 0; m < 4; ++m)
#pragma unroll
                for (int bj = 0; bj < 2; ++bj) { *(f32x4*)(ps + (size_t)(m * 16) * D + bj * 128) = acc[0][bj][m][0]; *(f32x4*)(ps + (size_t)(m * 16) * D + bj * 128 + 4) = acc[0][bj][m][1]; }
            return; }
#pragma unroll
        for (int ai = 0; ai < 2; ++ai) {
            if (ai == 1 && u.half) break;
            f32x4 xv[4][2][2];
#pragma unroll
            for (int m = 0; m < 4; ++m) { const int row = row0 + ai * 128 + m * 16; const bool ok = row < MV;
                const float* xr = (row < MP ? xp + (size_t)row * D : xs + (size_t)(ok ? row - MP : 0) * D) + cc;
#pragma unroll
                for (int bj = 0; bj < 2; ++bj) { xv[m][bj][0] = *(const f32x4*)(xr + bj * 128); xv[m][bj][1] = *(const f32x4*)(xr + bj * 128 + 4); } }
            __builtin_amdgcn_sched_barrier(0);
#pragma unroll
            for (int m = 0; m < 4; ++m) { const int row = row0 + ai * 128 + m * 16; const bool ok = row < MV;
                bf16_t* ob = hb + (size_t)row * D + cc;
                float s = 0.f;
#pragma unroll
                for (int bj = 0; bj < 2; ++bj) { f32x4 h0 = acc[ai][bj][m][0], h1 = acc[ai][bj][m][1];
                    if (ok) { h0 += xv[m][bj][0]; h1 += xv[m][bj][1]; }
                    *(u32x4*)(ob + bj * 128) = pack8(h0, h1);
                    s += (h0[0] * h0[0] + h0[1] * h0[1]) + (h0[2] * h0[2] + h0[3] * h0[3]) + (h1[0] * h1[0] + h1[1] * h1[1]) + (h1[2] * h1[2] + h1[3] * h1[3]); }
                s += __shfl_xor(s, 16); s += __shfl_xor(s, 32);
                if (fq == 0) ssq[(size_t)(u.pn * 4 + wc) * MT + row] = s; }
            __builtin_amdgcn_sched_barrier(0);
        }
    }
};
struct EpiGU {
    static constexpr bool HAS_MID = false;
    const LAS float* tab; bf16_t* hid;
    __device__ __forceinline__ void operator()(const f32x4 (&acc)[2][2][4][2], const Unit& u, int wr, int wc, int fr, int fq) const {
        const int row0 = u.pm * 256 + wr * 64 + fr, cc = u.pn * 128 + wc * 32 + 8 * fq;
#pragma unroll
        for (int ai = 0; ai < 2; ++ai)
#pragma unroll
            for (int m = 0; m < 4; ++m) { const int row = row0 + ai * 128 + m * 16;
                const float sc = tab[(u.half ? 256 : 0) + ((ai * 128 + wr * 64 + m * 16 + fr) & (u.half ? 127 : 255))];
                f32x4 r0, r1;
#pragma unroll
                for (int j = 0; j < 4; ++j) { const float g0 = acc[ai][0][m][0][j] * sc, u0 = acc[ai][1][m][0][j] * sc, g1 = acc[ai][0][m][1][j] * sc, u1 = acc[ai][1][m][1][j] * sc;
                    r0[j] = g0 * fast_sigmoid(g0) * u0; r1[j] = g1 * fast_sigmoid(g1) * u1; }
                *(u32x4*)(hid + (size_t)row * FF + cc) = pack8(r0, r1); }
    }
};
constexpr int DN_SPLIT = 11, DN_KT = (FF / 64) / DN_SPLIT;
struct EpiDown {
    static constexpr bool HAS_MID = false;
    float* y; float* part; const bf16_t* hb; bf16_t* h2b;
    __device__ __forceinline__ void operator()(const f32x4 (&acc)[2][2][4][2], const Unit& u, int wr, int wc, int fr, int fq) const {
        const int row0 = u.pm * 256 + wr * 64 + fr, cc = u.pn * 256 + wc * 32 + 8 * fq;
#pragma unroll
        for (int ai = 0; ai < 2; ++ai)
#pragma unroll
            for (int m = 0; m < 4; ++m) { const int row = row0 + ai * 128 + m * 16;
                if (row < MV) { float* o = y + (size_t)row * D + cc;
                    if (u.half) {
                        float* ps = part + ((size_t)(u.kt0 / DN_KT) * MS + (row - MP)) * D + cc;
#pragma unroll
                        for (int bj = 0; bj < 2; ++bj) { *(f32x4*)(ps + bj * 128) = acc[ai][bj][m][0]; *(f32x4*)(ps + bj * 128 + 4) = acc[ai][bj][m][1]; }
                    } else {
#pragma unroll
                    for (int bj = 0; bj < 2; ++bj) { const u32x4 hw = *(const u32x4*)(hb + (size_t)row * D + cc + bj * 128); f32x4 h0, h1; unpack8(hw, h0, h1);
                        *(u32x4*)(h2b + (size_t)row * D + cc + bj * 128) = pack8(h0 + acc[ai][bj][m][0], h1 + acc[ai][bj][m][1]); } } } }
    }
};

struct EpiWA {
    static constexpr bool HAS_MID = false;
    bf16_t* dst;
    __device__ __forceinline__ void operator()(const f32x4 (&acc)[2][2][4][2], const Unit& u, int wr, int wc, int fr, int fq) const {
        const int row0 = u.pm * 256 + wr * 64 + fr, cc = wc * 32 + 8 * fq;
#pragma unroll
        for (int ai = 0; ai < 2; ++ai)
#pragma unroll
            for (int m = 0; m < 4; ++m) { bf16_t* o = dst + (size_t)(row0 + ai * 128 + m * 16) * 2048 + cc;
#pragma unroll
                for (int bj = 0; bj < 2; ++bj) *(u32x4*)(o + bj * 128) = pack8(acc[ai][bj][m][0], acc[ai][bj][m][1]); }
    }
};

__device__ __forceinline__ void p0_item(const float* W, int N, int k0, int n0, const float* gsc, bf16_t* dst, int ldd, int drow0, int dcol0, LAS float* scr, int lane) {
    const float* wp = W + (size_t)k0 * N + n0 + lane;
    float v[64];
#pragma unroll
    for (int i = 0; i < 64; ++i) v[i] = wp[(size_t)i * N];
    if (gsc) {
#pragma unroll
        for (int i = 0; i < 64; ++i) v[i] *= gsc[k0 + i]; }
#pragma unroll
    for (int i = 0; i < 64; ++i) scr[i * 65 + lane] = v[i];
    asm volatile("s_waitcnt lgkmcnt(0)" ::: "memory");
    const int c = lane & 7;
#pragma unroll
    for (int j = 0; j < 8; ++j) { const int n = (lane >> 3) + 8 * j; const LAS float* s = scr + (8 * c) * 65 + n;
        u32x4 o; o.x = cvt_pk_bf16(s[0 * 65], s[1 * 65]); o.y = cvt_pk_bf16(s[2 * 65], s[3 * 65]); o.z = cvt_pk_bf16(s[4 * 65], s[5 * 65]); o.w = cvt_pk_bf16(s[6 * 65], s[7 * 65]);
        *(u32x4*)(dst + (size_t)(drow0 + n) * ldd + dcol0 + k0 + 8 * c) = o; }
    asm volatile("s_waitcnt lgkmcnt(0)" ::: "memory");
}

struct Params {
    const float *x_prompt, *x_sample, *cache_k, *cache_v, *state_pool, *g_mix, *w_in, *w_pool, *s_pool, *w_branch, *w_out, *g_ffn, *w_gate_up, *w_down, *g_final;
    float* out; unsigned char* ws; int ph_lo, ph_hi;
};

__device__ __forceinline__ void xn_row(const Params& p, int m, int lane);
__device__ __forceinline__ void phase0(const Params& p, LAS unsigned char* lds, int gw, int NGW, int wave, int lane, unsigned xcc) {
    LAS float* scr = (LAS float*)(lds + wave * 16640);
    bf16_t* Wt_in = (bf16_t*)(p.ws + WS_WIN); bf16_t* Wt_br = (bf16_t*)(p.ws + WS_WBR); bf16_t* Wt_out = (bf16_t*)(p.ws + WS_WOUT);
    bf16_t* Wt_gu = (bf16_t*)(p.ws + WS_WGU); bf16_t* Wt_dn = (bf16_t*)(p.ws + WS_WDN); bf16_t* XN = (bf16_t*)(p.ws + WS_XN);
    bf16_t* TMPA = (bf16_t*)(p.ws + WS_TMPA); bf16_t* WPB = (bf16_t*)(p.ws + WS_WPB);
    constexpr int I_IN = (D / 64) * (NIN / 64), I_BR = (D / 64) * (D / 64), I_OUT = (D / 64) * (D / 64), I_GU = (D / 64) * (NGU / 64), I_DN = (FF / 64) * (D / 64);
    constexpr int NITEMS = I_IN + I_BR + I_OUT + I_GU + I_DN;
    unsigned* ctr = (unsigned*)(p.ws + WS_BAR) + 3648 + 64 * (xcc & 7);
    constexpr int NXN = MT / 2;
    for (;;) {
        unsigned kq = 0; if (lane == 0) kq = __hip_atomic_fetch_add(ctr, 1u, __ATOMIC_RELAXED, __HIP_MEMORY_SCOPE_AGENT);
        const int it = 8 * (int)__builtin_amdgcn_readfirstlane(kq) + (int)(xcc & 7);
        if (it >= NITEMS + NXN) break;
        if (it >= NITEMS) { xn_row(p, 2 * (it - NITEMS), lane); xn_row(p, 2 * (it - NITEMS) + 1, lane); continue; }
        int r = it;
        if (r < I_IN) { const int nb = NIN / 64; const int n0 = 64 * (r % nb); int drow = n0;
            if (n0 >= 4096) { const int q = n0 - 4096; drow = q < 2048 ? 4096 + (q / 128) * 256 + (q % 128) : 4096 + ((q - 2048) / 128) * 256 + 128 + ((q - 2048) % 128); }
            p0_item(p.w_in, NIN, 64 * (r / nb), n0, p.g_mix, Wt_in, D, drow, 0, scr, lane); continue; } r -= I_IN;
        if (r < I_BR) { const int nb = D / 64; const int k0 = 64 * (r / nb), n0 = 64 * (r % nb);
            if (k0 < 1024) p0_item(p.w_branch, D, k0, n0, p.s_pool, TMPA, 1024, n0, 0, scr, lane);
            else p0_item(p.w_branch, D, k0, n0, nullptr, Wt_br, 2048, n0, 0, scr, lane);
            continue; } r -= I_BR;
        if (r < I_OUT) { const int nb = D / 64; p0_item(p.w_out, D, 64 * (r / nb), 64 * (r % nb), nullptr, Wt_out, D, 64 * (r % nb), 0, scr, lane); continue; } r -= I_OUT;
        if (r < I_GU) { const int nb = NGU / 64; const int n0 = 64 * (r % nb); const int drow = n0 < FF ? (n0 / 128) * 256 + (n0 % 128) : ((n0 - FF) / 128) * 256 + 128 + ((n0 - FF) % 128);
            p0_item(p.w_gate_up, NGU, 64 * (r / nb), n0, p.g_ffn, Wt_gu, D, drow, 0, scr, lane); continue; } r -= I_GU;
        { const int nb = D / 64; p0_item(p.w_down, D, 64 * (r / nb), 64 * (r % nb), nullptr, Wt_dn, FF, 64 * (r % nb), 0, scr, lane); }
    }
}
__device__ __forceinline__ void xn_row(const Params& p, int m, int lane) {
    bf16_t* XN = (bf16_t*)(p.ws + WS_XN);
    u32x2* o8 = (u32x2*)(XN + (size_t)m * D) + lane;
    if (m >= MV) {
#pragma unroll
        for (int j = 0; j < 8; ++j) o8[64 * j] = (u32x2){0u, 0u};
        return; }
    const f32x4* xr = (const f32x4*)(m < MP ? p.x_prompt + (size_t)m * D : p.x_sample + (size_t)(m - MP) * D) + lane;
    f32x4 v[8]; float s = 0.f;
#pragma unroll
    for (int j = 0; j < 8; ++j) { v[j] = xr[64 * j]; s += (v[j].x * v[j].x + v[j].y * v[j].y) + (v[j].z * v[j].z + v[j].w * v[j].w); }
    const float rs = __builtin_amdgcn_rsqf(wave_sum(s) * (1.0f / D) + EPS);
#pragma unroll
    for (int j = 0; j < 8; ++j) o8[64 * j] = (u32x2){cvt_pk_bf16(v[j].x * rs, v[j].y * rs), cvt_pk_bf16(v[j].z * rs, v[j].w * rs)};
}
__device__ __forceinline__ void phase0b(const Params& p, int gw, int NGW, int lane) {
    bf16_t* WPB = (bf16_t*)(p.ws + WS_WPB);
    for (int i = gw * 64 + lane; i < 4 * 256 * 256 / 8; i += NGW * 64) { const f32x4 a = *(const f32x4*)(p.w_pool + (size_t)i * 8), b = *(const f32x4*)(p.w_pool + (size_t)i * 8 + 4); *(u32x4*)(WPB + (size_t)i * 8) = pack8(a, b); }
    float* ssq = (float*)(p.ws + WS_SSQ);
    for (int i = gw * 64 + lane; i < MT; i += NGW * 64) ssq[i] = 0.f;
}

constexpr int VROW = 320;
__device__ __forceinline__ s16x4 vtr(const LAS unsigned char* p) { typedef short v4i16_t __attribute__((ext_vector_type(4))); return __builtin_bit_cast(s16x4, __builtin_amdgcn_ds_read_tr16_b64_v4i16((LAS v4i16_t*)p)); }
__device__ __forceinline__ bf16x8 cvt8(const f32x4& a, const f32x4& b) { u32x4 w = pack8(a, b); return __builtin_bit_cast(bf16x8, w); }

__device__ __forceinline__ void attn_unit(const Params& p, LAS unsigned char* vl, int unit, int lane) {
    const bf16_t* Ub = (const bf16_t*)(p.ws + WS_QKVU);
    const bf16_t* Qb = Ub + (size_t)MT * 1024; const bf16_t* Kb = Qb + (size_t)MT * 1024; const bf16_t* Vb = Kb + (size_t)MT * 1024;
    bf16_t* AO = (bf16_t*)(p.ws + WS_AO);
    const int n = lane & 31, hh = lane >> 5;
    const bool sample = unit < 64;
    int b, h, qrow0, nblk;
    if (sample) { b = unit >> 3; h = unit & 7; qrow0 = MP + b * DSEQ; nblk = 1 + PAST / 32; }
    else { const int u2 = unit - 64; const int qb = u2 & 127; h = (u2 >> 7) & 7; b = u2 >> 10; qrow0 = b * SEQ + qb * 32; nblk = qb + 1; }
    bf16x8 qf[8];
    { const bf16_t* qp = Qb + (size_t)(qrow0 + n) * 1024 + h * HD + 64 * hh;
#pragma unroll
      for (int kk = 0; kk < 8; ++kk) qf[kk] = *(const bf16x8*)(qp + 8 * kk); }
    f32x16 o[4];
#pragma unroll
    for (int db = 0; db < 4; ++db)
#pragma unroll
        for (int r = 0; r < 16; ++r) o[db][r] = 0.f;
    float R = (sample && n >= DSEQ) ? -1e30f : 0.f;
    const float* ck = p.cache_k + (size_t)b * PAST * 1024 + h * HD; const float* cv = p.cache_v + (size_t)b * PAST * 1024 + h * HD;
    const int vaddr = (4 * hh + ((lane & 15) >> 2)) * VROW + (16 * ((lane >> 4) & 1) + 4 * (lane & 3)) * 2;
    for (int blk = 0; blk < nblk; ++blk) {
        bf16x8 kf[8];
        const bool diag = (blk == 0);
        if (!sample || blk == 0) {
            const int s0 = qrow0 - blk * 32;
            const bf16_t* kp = Kb + (size_t)(s0 + n) * 1024 + h * HD + 64 * hh;
#pragma unroll
            for (int kk = 0; kk < 8; ++kk) kf[kk] = *(const bf16x8*)(kp + 8 * kk);
            const bf16_t* vp = Vb + (size_t)(s0 + (lane >> 4)) * 1024 + h * HD + 8 * (lane & 15);
#pragma unroll
            for (int it = 0; it < 8; ++it) { const u32x4 w = *(const u32x4*)(vp + (size_t)(4 * it) * 1024); *(LAS u32x4*)(vl + (4 * it + (lane >> 4)) * VROW + 16 * (lane & 15)) = w; }
        } else {
            const int s0 = PAST - blk * 32;
            const float* kp = ck + (size_t)(s0 + n) * 1024 + 64 * hh;
#pragma unroll
            for (int kk = 0; kk < 8; ++kk) kf[kk] = cvt8(*(const f32x4*)(kp + 8 * kk), *(const f32x4*)(kp + 8 * kk + 4));
            const float* vp = cv + (size_t)(s0 + (lane >> 4)) * 1024 + 8 * (lane & 15);
#pragma unroll
            for (int it = 0; it < 8; ++it) { const f32x4 a = *(const f32x4*)(vp + (size_t)(4 * it) * 1024), c = *(const f32x4*)(vp + (size_t)(4 * it) * 1024 + 4);
                *(LAS u32x4*)(vl + (4 * it + (lane >> 4)) * VROW + 16 * (lane & 15)) = pack8(a, c); }
        }
        f32x16 st;
#pragma unroll
        for (int r = 0; r < 16; ++r) st[r] = 0.f;
#pragma unroll
        for (int kk = 0; kk < 8; ++kk) st = __builtin_amdgcn_mfma_f32_32x32x16_bf16(kf[kk], qf[kk], st, 0, 0, 0);
        float l1m[16], ls[16];
#pragma unroll
        for (int r = 0; r < 16; ++r) { const int i = (r & 3) + 8 * (r >> 2) + 4 * hh; const bool valid = !diag || (i < n);
            const float z = st[r] * 0.08838834764831845f; const float sp = fmaxf(z, 0.f) + __logf(1.0f + __expf(-fabsf(z)));
            l1m[r] = valid ? -sp : 0.f; ls[r] = valid ? (z - sp) : -1e30f; }
        float gown[4], goth[4];
#pragma unroll
        for (int a = 0; a < 4; ++a) { gown[a] = (l1m[4 * a] + l1m[4 * a + 1]) + (l1m[4 * a + 2] + l1m[4 * a + 3]); goth[a] = __shfl_xor(gown[a], 32); }
        float wv[16]; float tail = R;
#pragma unroll
        for (int a = 3; a >= 0; --a) { float sfx = tail + (hh == 0 ? goth[a] : 0.f);
#pragma unroll
            for (int rr = 3; rr >= 0; --rr) { wv[4 * a + rr] = __expf(ls[4 * a + rr] + sfx); sfx += l1m[4 * a + rr]; }
            tail += gown[a] + goth[a]; }
        R = tail;
        bf16x8 wb[2];
#pragma unroll
        for (int s = 0; s < 2; ++s) wb[s] = cvt8((f32x4){wv[8 * s], wv[8 * s + 1], wv[8 * s + 2], wv[8 * s + 3]}, (f32x4){wv[8 * s + 4], wv[8 * s + 5], wv[8 * s + 6], wv[8 * s + 7]});
        asm volatile("s_waitcnt lgkmcnt(0)" ::: "memory");
#pragma unroll
        for (int db = 0; db < 4; ++db)
#pragma unroll
            for (int s = 0; s < 2; ++s) { const s16x4 lo = vtr(vl + vaddr + (16 * s) * VROW + 64 * db), hi = vtr(vl + vaddr + (16 * s + 8) * VROW + 64 * db);
                const bf16x8 vf = (bf16x8){lo[0], lo[1], lo[2], lo[3], hi[0], hi[1], hi[2], hi[3]};
                o[db] = __builtin_amdgcn_mfma_f32_32x32x16_bf16(vf, wb[s], o[db], 0, 0, 0); }
        asm volatile("s_waitcnt lgkmcnt(0)" ::: "memory");
        if (__all(R < -104.0f)) break;
    }
    if (!sample || n < DSEQ) {
        bf16_t* op = AO + (size_t)(qrow0 + n) * 2048 + 1024 + h * HD + 4 * hh;
#pragma unroll
        for (int db = 0; db < 4; ++db)
#pragma unroll
            for (int a = 0; a < 4; ++a) *(u32x2*)(op + 32 * db + 8 * a) = (u32x2){cvt_pk_bf16(o[db][4 * a], o[db][4 * a + 1]), cvt_pk_bf16(o[db][4 * a + 2], o[db][4 * a + 3])};
    }
}

template <int W>
__device__ __forceinline__ void diff_chunk(const Params& p, int ch, int cc) {
    const bf16_t* Ub = (const bf16_t*)(p.ws + WS_QKVU); bf16_t* AO = (bf16_t*)(p.ws + WS_AO);
    const int m0 = ch * 16; const bool prompt = m0 < MP; const int t0 = prompt ? (m0 & (SEQ - 1)) : PAST;
    const bf16_t* up = Ub + (size_t)m0 * 1024 + cc * 8;
    u32x4 raw[15 + W];
#pragma unroll
    for (int r = 0; r < 16; ++r) raw[W - 1 + r] = *(const u32x4*)(up + (size_t)r * 1024);
    if (prompt) {
#pragma unroll
        for (int j = 1; j < W; ++j) { const u32x4 v = *(const u32x4*)(t0 > 0 ? up - (size_t)j * 1024 : up); raw[W - 1 - j] = (t0 > 0) ? v : (u32x4){0u, 0u, 0u, 0u}; }
    } else { const float* hp = p.state_pool + (size_t)((m0 - MP) >> 4) * 15 * 1024 + cc * 8;
#pragma unroll
        for (int j = 1; j < W; ++j) raw[W - 1 - j] = pack8(*(const f32x4*)(hp + (size_t)(15 - j) * 1024), *(const f32x4*)(hp + (size_t)(15 - j) * 1024 + 4)); }
    f32x4 s0 = (f32x4){0.f, 0.f, 0.f, 0.f}, s1 = s0;
#pragma unroll
    for (int j = 1; j < W; ++j) { f32x4 a, c; unpack8(raw[W - 1 - j], a, c); s0 += a; s1 += c; }
#pragma unroll
    for (int r = 0; r < 16; ++r) { f32x4 a, c; unpack8(raw[W - 1 + r], a, c); s0 += a; s1 += c;
        const int t = t0 + r; const float ic = 1.0f / (float)(t + 1 < W ? t + 1 : W);
        *(u32x4*)(AO + (size_t)(m0 + r) * 2048 + cc * 8) = pack8(s0 * ic - a, s1 * ic - c);
        f32x4 da, dc; unpack8(raw[r], da, dc); s0 -= da; s1 -= dc; }
}
constexpr int N_ATT_UNITS = 64 + 4096, N_DIFF_ITEMS = (MV / 32) * 4, N_P2_ITEMS = N_ATT_UNITS + N_DIFF_ITEMS;
__device__ __forceinline__ void diff_item(const Params& p, int wi, int lane) {
    const int g = wi & 3, ch = 2 * (wi >> 2) + (lane >> 5), cc = 32 * g + (lane & 31);
    if (g == 0) diff_chunk<2>(p, ch, cc); else if (g == 1) diff_chunk<4>(p, ch, cc); else if (g == 2) diff_chunk<8>(p, ch, cc); else diff_chunk<16>(p, ch, cc);
}

__global__ void __launch_bounds__(512, 2) fwd_megakernel(Params p) {
    extern __shared__ __attribute__((aligned(16))) unsigned char lds_raw[];
    LAS unsigned char* lds = (LAS unsigned char*)lds_raw;
    const int tid = threadIdx.x, lane = tid & 63, wave = __builtin_amdgcn_readfirstlane(tid >> 6);
    const int G = gridDim.x, bx = blockIdx.x;
    const int vcu = (G % 8 == 0) ? (bx % 8) * (G / 8) + bx / 8 : bx;
    const int gw = vcu * 8 + wave, NGW = G * 8;
    cg::grid_group grid = cg::this_grid();
    volatile LAS unsigned* xst = (volatile LAS unsigned*)(lds + LDS_BYTES - 64);
    if (tid < 2) xst[tid] = 0u;
    __syncthreads();
    XcdBarrier xbar = xcd_barrier_post((unsigned*)(p.ws + WS_BAR), xst);
#define IN(k) (p.ph_lo <= (k) && (k) < p.ph_hi)
#define SEAM(k) do { if (IN(k) && IN((k) + 1)) { if (p.ph_hi > 64) grid.sync();   xcd_barrier(xbar); } STAMP(); } while (0)
    bf16_t* Wt_in = (bf16_t*)(p.ws + WS_WIN); bf16_t* Wt_br = (bf16_t*)(p.ws + WS_WBR); bf16_t* Wt_out = (bf16_t*)(p.ws + WS_WOUT);
    bf16_t* Wt_gu = (bf16_t*)(p.ws + WS_WGU); bf16_t* Wt_dn = (bf16_t*)(p.ws + WS_WDN); bf16_t* XN = (bf16_t*)(p.ws + WS_XN);
    bf16_t* QKVU = (bf16_t*)(p.ws + WS_QKVU); bf16_t* GATE = (bf16_t*)(p.ws + WS_GATE); bf16_t* AO = (bf16_t*)(p.ws + WS_AO);
    bf16_t* MERGED = (bf16_t*)(p.ws + WS_MERGED); bf16_t* HID = (bf16_t*)(p.ws + WS_HID); float* SSQ = (float*)(p.ws + WS_SSQ);
    float* Y = p.out + OFF_Y;
#ifdef PROBE_T
    unsigned long long tstamp[10]; int nst = 0;
#define STAMP() do { tstamp[nst++] = __builtin_amdgcn_s_memrealtime(); } while (0)
#else
#define STAMP() do {} while (0)
#endif
    STAMP();

    if (IN(0)) { phase0(p, lds, gw, NGW, wave, lane, xbar.x);
#ifdef PROBE_T
#endif
        phase0b(p, gw, NGW, lane);
    }
    SEAM(0);
    if (IN(1)) { pg8::Gemm g{XN, Wt_in, D, D, MT, NIN, D}; pg8::StaticOrder S; S.init(64, NIN / 256, D / 64, G, bx, 64, 1); EpiIn E{QKVU, GATE, p.out}; pg8::gemm_phase(lds, g, S, E); }
    SEAM(1);
    if (IN(2)) {
        LAS unsigned char* vl = lds + wave * (32 * VROW);
        unsigned* ctr = (unsigned*)(p.ws + WS_BAR) + 3584;
        int item = gw;
        while (item < N_P2_ITEMS) {
            if (item < N_ATT_UNITS) attn_unit(p, vl, item, lane); else diff_item(p, item - N_ATT_UNITS, lane);
            unsigned nx = 0; if (lane == 0) nx = __hip_atomic_fetch_add(ctr, 1u, __ATOMIC_RELAXED, __HIP_MEMORY_SCOPE_AGENT);
            item = NGW + (int)__builtin_amdgcn_readfirstlane(nx);
        }
        __syncthreads();
        for (int gq = 0; gq < 4; ++gq) { pg8::Gemm g{(const bf16_t*)(p.ws + WS_TMPA) + gq * 256, (const bf16_t*)(p.ws + WS_WPB) + gq * 65536, 1024, 256, 2048, 256, 256};
            pg8::StaticOrder S; S.init(8, 1, 4, G, (bx + G - 8 * gq) % G); EpiWA E{Wt_br + gq * 256}; pg8::gemm_phase(lds, g, S, E); }
    }
    SEAM(2);
    if (IN(3)) {
        { pg8::Gemm g{AO, Wt_br, 2048, 2048, MT, D, 2048}; pg8::StaticOrder S; S.init(64, 8, 32, G, bx, 64, 1); EpiMerged E{GATE, MERGED}; pg8::gemm_phase(lds, g, S, E); }
    }
    SEAM(3);
    if (IN(4)) { pg8::Gemm g{MERGED, Wt_out, D, D, MT, D, D}; pg8::StaticOrder S; S.init(64, 8, 32, G, bx, 64, OUT_SPLIT); EpiOut E{p.x_prompt, p.x_sample, Y, XN, (float*)(p.ws + WS_SSQP), (float*)(p.ws + WS_AO)}; pg8::gemm_phase(lds, g, S, E); }
    if (IN(4) && IN(5)) xcd_barrier(xbar);
    if (IN(4)) {
        for (int r = gw; r < MS; r += NGW) {
            const f32x4* xr = (const f32x4*)(p.x_sample + (size_t)r * D) + lane; const f32x4* pr = (const f32x4*)((const float*)(p.ws + WS_AO) + (size_t)r * D) + lane;
            u32x2* o8 = (u32x2*)(XN + (size_t)(MP + r) * D) + lane; float* sp = (float*)(p.ws + WS_SSQP);
            float sq = 0.f;
#pragma unroll
            for (int j = 0; j < 8; ++j) { f32x4 v = xr[64 * j];
#pragma unroll
                for (int c = 0; c < OUT_SPLIT; ++c) v += pr[(size_t)c * MS * D / 4 + 64 * j];
                sq += (v.x * v.x + v.y * v.y) + (v.z * v.z + v.w * v.w);
                o8[64 * j] = (u32x2){cvt_pk_bf16(v.x, v.y), cvt_pk_bf16(v.z, v.w)}; }
            sq = wave_sum(sq);
            if (lane < 32) sp[(size_t)lane * MT + MP + r] = lane == 0 ? sq : 0.f;
        }
    }
    SEAM(4);
    if (IN(5)) { pg8::Gemm g{XN, Wt_gu, D, D, MT, NGU, D}; pg8::StaticOrder S; S.init(64, NGU / 256, 32, G, bx, 64, 1);
        LAS float* tab = (LAS float*)(lds + 131072);
        { pg8::Unit u0; S.next(0, u0); const float* sp = (const float*)(p.ws + WS_SSQP);
          if (tid < 384) { const int row = tid < 256 ? u0.pm * 256 + tid : MP + (tid - 256); float a = 0.f;
#pragma unroll 8
              for (int k = 0; k < 32; ++k) a += sp[(size_t)k * MT + row];
              tab[tid] = __builtin_amdgcn_rsqf(a * (1.0f / D) + EPS); }
          __syncthreads(); }
        EpiGU E{tab, HID}; pg8::gemm_phase(lds, g, S, E); }
    SEAM(5);
    if (IN(6)) { pg8::Gemm g{HID, Wt_dn, FF, FF, MT, D, FF}; pg8::StaticOrder S; S.init(64, 8, FF / 64, G, bx, 64, DN_SPLIT); EpiDown E{Y, (float*)(p.ws + WS_AO), XN, (bf16_t*)(p.ws + WS_H2B)}; pg8::gemm_phase(lds, g, S, E); }
    SEAM(6);
    if (IN(7)) {
        for (int m = gw; m < MV; m += NGW) {
            f32x4* yr = (f32x4*)(Y + (size_t)m * D) + lane; const f32x4* gf = (const f32x4*)p.g_final + lane;
            f32x4 v[8]; float s = 0.f;
            {
                const u32x2* hr = (const u32x2*)((m < MP ? (const bf16_t*)(p.ws + WS_H2B) : (const bf16_t*)XN) + (size_t)m * D) + lane;
#pragma unroll
                for (int j = 0; j < 8; ++j) { const u32x2 w2 = hr[64 * j]; v[j] = (f32x4){bflo(w2.x), bfhi(w2.x), bflo(w2.y), bfhi(w2.y)}; } }
            if (m >= MP) { const f32x4* pr = (const f32x4*)((const float*)(p.ws + WS_AO) + (size_t)(m - MP) * D) + lane;
                for (int c = 0; c < DN_SPLIT; ++c)
#pragma unroll
                    for (int j = 0; j < 8; ++j) v[j] += pr[(size_t)c * MS * D / 4 + 64 * j]; }
#pragma unroll
            for (int j = 0; j < 8; ++j) s += (v[j].x * v[j].x + v[j].y * v[j].y) + (v[j].z * v[j].z + v[j].w * v[j].w);
            const float rs = __builtin_amdgcn_rsqf(wave_sum(s) * (1.0f / D) + EPS);
#pragma unroll
            for (int j = 0; j < 8; ++j) yr[64 * j] = v[j] * rs * gf[64 * j];
        }
    }
#ifdef PROBE_T
    STAMP();
    if (bx == 0 && tid == 0) {
        const unsigned long long e1 = (unsigned long long)__hip_atomic_load((long long*)(p.ws + WS_SSQ + 512 * 1024), __ATOMIC_RELAXED, __HIP_MEMORY_SCOPE_AGENT);
        const unsigned long long e2 = (unsigned long long)__hip_atomic_load((long long*)(p.ws + WS_SSQ + 512 * 1024 + 256), __ATOMIC_RELAXED, __HIP_MEMORY_SCOPE_AGENT);
        (void)e1; (void)e2;
        const float ta = (float)(tstamp[PROBE_A + 1] - tstamp[PROBE_A]) * 0.01f, tb = (float)(tstamp[PROBE_B + 1] - tstamp[PROBE_B]) * 0.01f;
        asm volatile("s_waitcnt vmcnt(0)" ::: "memory");
        atomicAdd(Y, 4.0f + ta * (1.0f / 256.0f)); atomicAdd(p.out + OFF_PP, 1.5f + tb * (1.0f / 500.0f));
    }
#endif
#undef IN
#undef SEAM
}

extern "C" void kernel_launch(void* const* d_in, const int* in_sizes, int n_in, void* d_out, int out_size, void* d_ws, size_t ws_size, hipStream_t stream) {
    static int grid = 0;
    if (grid == 0) {
        if (n_in != 15 || (size_t)out_size != OUT_TOTAL || ws_size < WS_END) { fprintf(stderr, "kernel_launch: unexpected shapes: n_in %d out %d ws %zu\n", n_in, out_size, ws_size); grid = -1; return; }
        int dev = 0, cus = 0, per_cu = 0;
        hipGetDevice(&dev); hipDeviceGetAttribute(&cus, hipDeviceAttributeMultiprocessorCount, dev);
        hipFuncSetAttribute((const void*)fwd_megakernel, hipFuncAttributeMaxDynamicSharedMemorySize, LDS_BYTES);
        hipOccupancyMaxActiveBlocksPerMultiprocessor(&per_cu, (const void*)fwd_megakernel, 512, LDS_BYTES);
        if (per_cu < 1) { fprintf(stderr, "kernel_launch: occupancy query says %d blocks per CU\n", per_cu); per_cu = 1; }
        (void)hipGetLastError();
        grid = cus;
    }
    if (grid < 0) return;
    Params p{};
    const float** pp = (const float**)&p;
    for (int i = 0; i < 15; ++i) pp[i] = (const float*)d_in[i];
    p.out = (float*)d_out; p.ws = (unsigned char*)d_ws;
#if N_LAUNCH_MODE == 1
    p.ph_lo = 0; p.ph_hi = 8;
    void* args[] = {&p};
    if (hipMemsetAsync((char*)d_ws + WS_BAR, 0, WS_BAR_BYTES, stream) != hipSuccess) fprintf(stderr, "kernel_launch: memset of the barrier words failed\n");
    hipError_t e = hipLaunchCooperativeKernel((const void*)fwd_megakernel, dim3(grid), dim3(512), args, LDS_BYTES, stream);
    if (e != hipSuccess) fprintf(stderr, "cooperative launch failed: %s (grid %d)\n", hipGetErrorString(e), grid);
#else
    for (int ph = 0; ph < 8; ++ph) { p.ph_lo = ph; p.ph_hi = ph + 1; hipLaunchKernelGGL(fwd_megakernel, dim3(grid), dim3(512), LDS_BYTES, stream, p); }
#endif
}
```

```cpp
#include <hip/hip_runtime.h>
#include <hip/hip_cooperative_groups.h>
#include <cstdio>
#include <cstdint>
namespace cg = cooperative_groups;

#define PROBE_A 6
#define PROBE_B 4
#ifndef N_LAUNCH_MODE
#define N_LAUNCH_MODE 1
#endif

#define LAS __attribute__((address_space(3)))
typedef unsigned short bf16_t;
typedef short bf16x8 __attribute__((ext_vector_type(8)));
typedef short s16x4 __attribute__((ext_vector_type(4)));
typedef float f32x4 __attribute__((ext_vector_type(4)));
typedef float f32x16 __attribute__((ext_vector_type(16)));
typedef unsigned u32x4 __attribute__((ext_vector_type(4)));
typedef unsigned u32x2 __attribute__((ext_vector_type(2)));

constexpr int D = 2048, MP = 16384, MS = 128, MV = MP + MS, MT = 16640;
constexpr int SEQ = 4096, DSEQ = 16, PAST = 4096, NH = 8, HD = 128;
constexpr int NIN = 8192, FF = 5632, NGU = 2 * FF, AW = 1024;
constexpr float EPS = 1e-6f;
constexpr size_t OFF_Y = 0, OFF_KP = (size_t)MV * D, OFF_VP = OFF_KP + (size_t)MP * 1024, OFF_PP = OFF_VP + (size_t)MP * 1024,
                 OFF_KS = OFF_PP + 4 * 15 * 1024, OFF_VS = OFF_KS + (size_t)MS * 1024, OFF_PS = OFF_VS + (size_t)MS * 1024, OUT_TOTAL = OFF_PS + 8 * 15 * 1024;
constexpr size_t MiB = 1u << 20;
constexpr size_t WS_SSQ = 0, WS_WIN = 1 * MiB, WS_WBR = 33 * MiB, WS_WOUT = 41 * MiB, WS_WGU = 49 * MiB, WS_WDN = 93 * MiB, WS_XN = 115 * MiB,
                 WS_QKVU = 180 * MiB, WS_GATE = 310 * MiB, WS_AO = 440 * MiB, WS_TMPA = 505 * MiB, WS_WPB = 509 * MiB, WS_SSQP = 510 * MiB, WS_END = 513 * MiB;
constexpr size_t WS_BAR = 768 * 1024, WS_BAR_BYTES = 32768;
constexpr size_t WS_H2B = WS_WIN;
static_assert(WS_H2B + (size_t)MV * D * 2 <= WS_WDN, "h2 overlay");
constexpr size_t WS_MERGED = WS_QKVU;
constexpr size_t WS_HID = WS_QKVU;
static_assert((size_t)MT * FF * 2 <= WS_AO - WS_QKVU, "hid overlay");
constexpr int LDS_BYTES = 147456;

typedef __bf16 bf16x2_t __attribute__((ext_vector_type(2)));
typedef float f32x2_t __attribute__((ext_vector_type(2)));
__device__ __forceinline__ unsigned cvt_pk_bf16(float lo, float hi) { const f32x2_t v = {lo, hi}; return __builtin_bit_cast(unsigned, __builtin_convertvector(v, bf16x2_t)); }
__device__ __forceinline__ float bf2f(unsigned short b) { return __uint_as_float(((unsigned)b) << 16); }
__device__ __forceinline__ float bflo(unsigned w) { return __uint_as_float(w << 16); }
__device__ __forceinline__ float bfhi(unsigned w) { return __uint_as_float(w & 0xffff0000u); }
__device__ __forceinline__ float fast_sigmoid(float x) { return __builtin_amdgcn_rcpf(1.0f + __expf(-x)); }
__device__ __forceinline__ float wave_sum(float v) {
#pragma unroll
    for (int o = 1; o < 64; o <<= 1) v += __shfl_xor(v, o);
    return v;
}

#define XB_TMO      128
#define XB_XCNT(j)  (256  + 64 * (j))
#define XB_XSUB(j)  (1280 + 64 * (j))
#define XB_XGEN(j)  (2304 + 64 * (j))
#define XB_TOP      3328
#define XB_TOPGEN   3392
#define XCD_BAR_WORDS 3456
#define XB_SPIN_CAP (1u << 18)

__device__ __forceinline__ unsigned xb_ld(unsigned* p)              { return __hip_atomic_load(p, __ATOMIC_RELAXED, __HIP_MEMORY_SCOPE_AGENT); }
__device__ __forceinline__ unsigned xb_add(unsigned* p, unsigned v) { return __hip_atomic_fetch_add(p, v, __ATOMIC_RELAXED, __HIP_MEMORY_SCOPE_AGENT); }
__device__ __forceinline__ unsigned xb_xcc_id() { return (unsigned)__builtin_amdgcn_s_getreg((3 << 11) | 20) & 0xFu; }
#define XB_SPIN(cond, bar) do { unsigned _sp = 0; while (cond) { __builtin_amdgcn_s_sleep(1); \
    if ((++_sp & 255u) == 0u) { if (xb_ld(&(bar)[XB_TMO])) break; if (_sp > XB_SPIN_CAP) { atomicAdd(&(bar)[XB_TMO], 1u); break; } } } } while (0)

struct XcdBarrier {
    unsigned* bar; unsigned x;
    volatile LAS unsigned* st;
};

__device__ __forceinline__ XcdBarrier xcd_barrier_post(unsigned* bar, volatile LAS unsigned* st) {
    XcdBarrier b; b.bar = bar; b.x = xb_xcc_id(); b.st = st;
    if (threadIdx.x == 0) (void)xb_add(&bar[XB_XCNT(b.x)], 1u);
    return b;
}
__device__ __forceinline__ void xcd_barrier_complete(unsigned* bar, unsigned x, unsigned& nloc, unsigned& nx) {
    const unsigned G = gridDim.x * gridDim.y * gridDim.z;
    unsigned sum, cnt, mine, sp = 0u;
    for (;;) {
        sum = 0u; cnt = 0u; mine = 0u;
#pragma unroll
        for (unsigned j = 0; j < 16; ++j) { const unsigned c = xb_ld(&bar[XB_XCNT(j)]); sum += c; cnt += (c > 0u) ? 1u : 0u; mine = (j == x) ? c : mine; }
        if (sum == G) break;
        __builtin_amdgcn_s_sleep(1);
        if ((++sp & 255u) == 0u) { if (xb_ld(&bar[XB_TMO])) break; if (sp > XB_SPIN_CAP) { atomicAdd(&bar[XB_TMO], 1u); break; } }
    }
    nloc = mine > 0u ? mine : 1u; nx = cnt > 0u ? cnt : 1u;
}

__device__ __forceinline__ void xcd_barrier(const XcdBarrier& b) {
    asm volatile("s_waitcnt vmcnt(0)" ::: "memory");
    __syncthreads();
    if (threadIdx.x == 0) {
        unsigned* bar = b.bar;
        __builtin_amdgcn_s_waitcnt(0);
        unsigned nloc = b.st[0], nx = b.st[1];
        if (nloc == 0u) { xcd_barrier_complete(bar, b.x, nloc, nx); b.st[0] = nloc; b.st[1] = nx; }
        const unsigned old = xb_add(&bar[XB_XSUB(b.x)], 1u);
        const unsigned gen = old / nloc;
        if (old + 1u == (gen + 1u) * nloc) {
            __builtin_amdgcn_fence(__ATOMIC_RELEASE, "agent");
            asm volatile("s_waitcnt vmcnt(0)" ::: "memory");
            const unsigned og = xb_add(&bar[XB_TOP], 1u);
            const unsigned tg = og / nx;
            if (og + 1u == (tg + 1u) * nx) xb_add(&bar[XB_TOPGEN], 1u);
            else XB_SPIN(xb_ld(&bar[XB_TOPGEN]) == tg, bar);
            __builtin_amdgcn_fence(__ATOMIC_ACQUIRE, "agent");
            xb_add(&bar[XB_XGEN(b.x)], 1u);
            asm volatile("s_waitcnt vmcnt(0)" ::: "memory");
        } else {
            XB_SPIN(xb_ld(&bar[XB_XGEN(b.x)]) == gen, bar);
            __builtin_amdgcn_fence(__ATOMIC_ACQUIRE, "agent");
            asm volatile("s_waitcnt vmcnt(0)" ::: "memory");
        }
    }
    __syncthreads();
}

namespace pg8 {
constexpr int BM = 256, BK = 64, HALF = 128, HTB = HALF * BK * 2, STAGE_BYTES = 8 * HTB, NXCD = 8, WGM = 8;
__host__ __device__ __forceinline__ int lds_byte(int r, int c) { const int st = (r >> 4) * 2 + (c >> 5), rr = r & 15, cc = c & 31, ob = rr * 64 + cc * 2; return st * 1024 + (ob ^ (((ob >> 9) & 1) << 5)); }
__host__ __device__ __forceinline__ void stage_rc(int b, int& R, int& C) { const int st = b / 1024, sb = b % 1024, swz = sb ^ (((sb >> 9) & 1) << 5); R = (st >> 1) * 16 + swz / 64; C = (st & 1) * 32 + (swz % 64) / 2; }
__host__ __device__ __forceinline__ int perm32(int rho) { const int n = rho >> 4, i = rho & 15; return 8 * (i >> 2) + 4 * n + (i & 3); }

struct Unit { int pm, pn, kt0, nkt, half; };
struct Gemm { const bf16_t* A; const bf16_t* Bt; int lda, ldb, M, N, K; };

struct StaticOrder {
    int nM, nN, nwg, G, c, ktfull, pmS, nS, ktS;
    __device__ void init(int nM_, int nN_, int ktfull_, int G_, int c_, int pmS_ = 0, int ksplit = 0) { nM = nM_; nN = nN_; nwg = nM * nN; G = G_; c = c_; ktfull = ktfull_; pmS = pmS_; nS = nN * ksplit; ktS = ksplit ? ktfull / ksplit : 0; }
    __device__ bool next(int i, Unit& u) const {
        const int L = i * G + c;
        if (L >= nwg) { const int t = L - nwg;
            if (t >= nS) return false;
            u.pm = pmS; u.pn = t % nN; u.kt0 = (t / nN) * ktS; u.nkt = ktS; u.half = 1; return true; }
        int wgid = L; { const int q = nwg / NXCD, r = nwg % NXCD, xcd = wgid % NXCD, off = wgid / NXCD; wgid = (xcd < r ? xcd * (q + 1) : r * (q + 1) + (xcd - r) * q) + off; }
        const int nig = WGM * nN, gid = wgid / nig, fm = gid * WGM, gsz = (nM - fm) < WGM ? (nM - fm) : WGM;
        u.pm = fm + ((wgid % nig) % gsz); u.pn = (wgid % nig) / gsz; u.kt0 = 0; u.nkt = ktfull; u.half = 0; return true;
    }
};

template <class Epi>
__device__ __forceinline__ void gemm_phase(LAS unsigned char* lds, const Gemm g, const StaticOrder& S, const Epi& E) {
    int tid_ = threadIdx.x; asm volatile("" : "+v"(tid_));
    const int tid = tid_, wid = __builtin_amdgcn_readfirstlane(tid >> 6), lane = tid & 63, wr = wid >> 2, wc = wid & 3, fr = lane & 15, fq = lane >> 4;
    unsigned voffA[2], voffB[2];
#pragma unroll
    for (int i = 0; i < 2; ++i) { int R, C; stage_rc(tid * 16 + i * 8192, R, C); const int Rb = (R & ~31) + perm32(R & 31);
        voffA[i] = (unsigned)(R * g.lda + C) * 2u; voffB[i] = (unsigned)(Rb * g.ldb + C) * 2u; }
    const size_t kstep = (size_t)(BK * 2);
    const size_t hstepA = (size_t)HALF * g.lda * 2, hstepB = (size_t)HALF * g.ldb * 2;
    const size_t tstepA = 2 * hstepA, tstepB = 2 * hstepB;
    const unsigned ldsw = (unsigned)wid * 1024u;
    const int aoff = lds_byte(wr * 64 + fr, fq * 8), boff = lds_byte(wc * 32 + fr, fq * 8);
#define PG8_SA(b, h) (((b) * 2 + (h)) * HTB)
#define PG8_SB(b, h) ((4 + (b) * 2 + (h)) * HTB)
#define PG8_STAGE(bufoff, gbase, voff) do { _Pragma("unroll") for (int _i = 0; _i < 2; ++_i) \
        __builtin_amdgcn_global_load_lds((const unsigned*)((const char*)(gbase) + (voff)[_i]), (LAS unsigned*)(lds + (bufoff) + ldsw + _i * 8192), 16, 0, 0); } while (0)
#define PG8_LDA(dst, b, h) do { _Pragma("unroll") for (int m = 0; m < 4; ++m) _Pragma("unroll") for (int k = 0; k < 2; ++k) dst[m][k] = *(const LAS bf16x8*)(lds + PG8_SA(b, h) + aoff + m * 2048 + k * 1024); } while (0)
#define PG8_LDB(dst, b, h) do { _Pragma("unroll") for (int n = 0; n < 2; ++n) _Pragma("unroll") for (int k = 0; k < 2; ++k) dst[n][k] = *(const LAS bf16x8*)(lds + PG8_SB(b, h) + boff + n * 2048 + k * 1024); } while (0)
#define PG8_MMA(ai, bj, At, Bt) do { __builtin_amdgcn_s_setprio(1); _Pragma("unroll") for (int m = 0; m < 4; ++m) _Pragma("unroll") for (int n = 0; n < 2; ++n) _Pragma("unroll") for (int k = 0; k < 2; ++k) \
        acc[ai][bj][m][n] = __builtin_amdgcn_mfma_f32_16x16x32_bf16(Bt[n][k], At[m][k], acc[ai][bj][m][n], 0, 0, 0); __builtin_amdgcn_s_setprio(0); } while (0)
#define PG8_WAIT_V(n) asm volatile("s_waitcnt vmcnt(" #n ")" ::: "memory")
#define PG8_WAIT_L(n) asm volatile("s_waitcnt lgkmcnt(" #n ")" ::: "memory")
#define PG8_BAR __builtin_amdgcn_s_barrier()
#define PG8_SCHED __builtin_amdgcn_sched_barrier(0)
    Unit cur, nxt; int ui = 0;
    if (!S.next(0, cur)) return;
    f32x4 acc[2][2][4][2];
#pragma unroll
    for (int a = 0; a < 2; ++a)
#pragma unroll
        for (int b = 0; b < 2; ++b)
#pragma unroll
            for (int m = 0; m < 4; ++m)
#pragma unroll
                for (int n = 0; n < 2; ++n) acc[a][b][m][n] = (f32x4){0.f, 0.f, 0.f, 0.f};
    bf16x8 At[4][2], B0[2][2], B1[2][2];
    const char* cA = (const char*)g.A + (size_t)cur.pm * tstepA + (size_t)cur.kt0 * kstep; const char* cB = (const char*)g.Bt + (size_t)cur.pn * tstepB + (size_t)cur.kt0 * kstep;
    PG8_STAGE(PG8_SB(0, 0), cB, voffB); PG8_STAGE(PG8_SB(0, 1), cB + hstepB, voffB); PG8_STAGE(PG8_SA(0, 0), cA, voffA); PG8_STAGE(PG8_SA(0, 1), cA + hstepA, voffA);
    if (wr == 1) PG8_BAR;
    PG8_WAIT_V(2); PG8_BAR;
    PG8_STAGE(PG8_SB(1, 0), cB + kstep, voffB); PG8_STAGE(PG8_SA(1, 0), cA + kstep, voffA); PG8_STAGE(PG8_SB(1, 1), cB + hstepB + kstep, voffB);
    PG8_WAIT_V(6); PG8_BAR;
    for (;;) {
        const bool has_next = S.next(ui + 1, nxt);
        const char* nA = has_next ? (const char*)g.A + (size_t)nxt.pm * tstepA + (size_t)nxt.kt0 * kstep : cA; const char* nB = has_next ? (const char*)g.Bt + (size_t)nxt.pn * tstepB + (size_t)nxt.kt0 * kstep : cB;
        const int nt = cur.nkt; const bool full = !cur.half;
        for (int t = 0; t < nt; t += 2) {
            const bool last = (t == nt - 2);
            if constexpr (Epi::HAS_MID) { if (!cur.half && t == (nt >> 1)) E.mid(acc, cur, wr, wc, fr, fq); }
            const char* a1 = cA + (size_t)(t + 1) * kstep;
            const char* a2 = last ? nA : cA + (size_t)(t + 2) * kstep; const char* b2 = last ? nB : cB + (size_t)(t + 2) * kstep;
            const char* a3 = a2 + kstep; const char* b3 = b2 + kstep;
            PG8_LDB(B0, 0, 0); PG8_LDB(B1, 0, 1); PG8_SCHED; PG8_LDA(At, 0, 0); PG8_STAGE(PG8_SA(1, 1), a1 + hstepA, voffA);
            PG8_WAIT_V(8); PG8_WAIT_L(0); PG8_BAR; PG8_MMA(0, 0, At, B0); PG8_MMA(0, 1, At, B1); PG8_BAR; PG8_SCHED;
            if (full) PG8_LDA(At, 0, 1); PG8_STAGE(PG8_SB(0, 0), b2, voffB); PG8_STAGE(PG8_SB(0, 1), b2 + hstepB, voffB); PG8_STAGE(PG8_SA(0, 0), a2, voffA);
            PG8_WAIT_V(8); PG8_WAIT_L(0); PG8_BAR; if (full) { PG8_MMA(1, 0, At, B0); PG8_MMA(1, 1, At, B1); } PG8_BAR; PG8_SCHED;
            PG8_LDB(B0, 1, 0); PG8_LDB(B1, 1, 1); PG8_SCHED; PG8_LDA(At, 1, 0); PG8_STAGE(PG8_SA(0, 1), a2 + hstepA, voffA);
            PG8_WAIT_V(8); PG8_WAIT_L(0); PG8_BAR; PG8_MMA(0, 0, At, B0); PG8_MMA(0, 1, At, B1); PG8_BAR; PG8_SCHED;
            if (full) PG8_LDA(At, 1, 1); PG8_STAGE(PG8_SB(1, 0), b3, voffB); PG8_STAGE(PG8_SB(1, 1), b3 + hstepB, voffB); PG8_STAGE(PG8_SA(1, 0), a3, voffA);
            PG8_WAIT_V(8); PG8_WAIT_L(0); PG8_BAR; if (full) { PG8_MMA(1, 0, At, B0); PG8_MMA(1, 1, At, B1); } PG8_BAR; PG8_SCHED;
        }
        if (wr == 0) PG8_BAR;
        E(acc, cur, wr, wc, fr, fq);
        if (!has_next) break;
#pragma unroll
        for (int a = 0; a < 2; ++a)
#pragma unroll
            for (int b = 0; b < 2; ++b)
#pragma unroll
                for (int m = 0; m < 4; ++m)
#pragma unroll
                    for (int n = 0; n < 2; ++n) acc[a][b][m][n] = (f32x4){0.f, 0.f, 0.f, 0.f};
        cur = nxt; cA = nA; cB = nB; ++ui;
        if (wr == 1) PG8_BAR;
    }
    PG8_WAIT_V(0);
    PG8_BAR;
#undef PG8_SA
#undef PG8_SB
#undef PG8_STAGE
#undef PG8_LDA
#undef PG8_LDB
#undef PG8_MMA
#undef PG8_WAIT_V
#undef PG8_WAIT_L
#undef PG8_BAR
#undef PG8_SCHED
}
}
using pg8::Unit;

__device__ __forceinline__ u32x4 pack8(const f32x4& v0, const f32x4& v1) {
    u32x4 w; w.x = cvt_pk_bf16(v0[0], v0[1]); w.y = cvt_pk_bf16(v0[2], v0[3]); w.z = cvt_pk_bf16(v1[0], v1[1]); w.w = cvt_pk_bf16(v1[2], v1[3]); return w;
}
__device__ __forceinline__ void unpack8(const u32x4& w, f32x4& v0, f32x4& v1) {
    v0 = (f32x4){bflo(w.x), bfhi(w.x), bflo(w.y), bfhi(w.y)}; v1 = (f32x4){bflo(w.z), bfhi(w.z), bflo(w.w), bfhi(w.w)};
}

struct EpiIn {
    static constexpr bool HAS_MID = false;
    bf16_t* qkvu; bf16_t* gate; float* out;
    __device__ __forceinline__ void operator()(const f32x4 (&acc)[2][2][4][2], const Unit& u, int wr, int wc, int fr, int fq) const {
        const int row0 = u.pm * 256 + wr * 64 + fr, cw = wc * 32 + 8 * fq;
        if (u.pn >= 16) {
            bf16_t* base = gate + (size_t)row0 * 4096 + (u.pn - 16) * 128 + cw;
#pragma unroll
            for (int ai = 0; ai < 2; ++ai)
#pragma unroll
                for (int m = 0; m < 4; ++m) { bf16_t* rowp = base + (size_t)(ai * 128 + m * 16) * 4096;
                    f32x4 r0, r1, b0, b1;
#pragma unroll
                    for (int j = 0; j < 4; ++j) { b0[j] = fmaxf(fast_sigmoid(acc[ai][1][m][0][j]), 1e-30f); b1[j] = fmaxf(fast_sigmoid(acc[ai][1][m][1][j]), 1e-30f);
                        r0[j] = fast_sigmoid(acc[ai][0][m][0][j]) * __builtin_amdgcn_rcpf(b0[j]); r1[j] = fast_sigmoid(acc[ai][0][m][1][j]) * __builtin_amdgcn_rcpf(b1[j]); }
                    *(u32x4*)rowp = pack8(r0, r1); *(u32x4*)(rowp + 2048) = pack8(b0, b1); }
        } else {
            const int sec = u.pn >> 2, cc = (u.pn & 3) * 256 + cw;
            bf16_t* base = qkvu + (size_t)sec * MT * 1024 + (size_t)row0 * 1024 + cc;
#pragma unroll
            for (int ai = 0; ai < 2; ++ai)
#pragma unroll
                for (int m = 0; m < 4; ++m) { bf16_t* rowp = base + (size_t)(ai * 128 + m * 16) * 1024;
#pragma unroll
                    for (int bj = 0; bj < 2; ++bj) *(u32x4*)(rowp + bj * 128) = pack8(acc[ai][bj][m][0], acc[ai][bj][m][1]); }
            if (sec >= 2) {
                const size_t offp = (sec == 2) ? OFF_KP : OFF_VP, offs = (sec == 2) ? OFF_KS : OFF_VS;
#pragma unroll
                for (int ai = 0; ai < 2; ++ai)
#pragma unroll
                    for (int m = 0; m < 4; ++m) { const int row = row0 + ai * 128 + m * 16;
                        if (row < MV) { float* o = out + (row < MP ? offp + (size_t)row * 1024 : offs + (size_t)(row - MP) * 1024) + cc;
#pragma unroll
                            for (int bj = 0; bj < 2; ++bj) { *(f32x4*)(o + bj * 128) = acc[ai][bj][m][0]; *(f32x4*)(o + bj * 128 + 4) = acc[ai][bj][m][1]; } } }
            } else if (sec == 0 && ((u.pm & 15) == 15 || u.pm == 64)) {
#pragma unroll
                for (int ai = 0; ai < 2; ++ai)
#pragma unroll
                    for (int m = 0; m < 4; ++m) { const int row = row0 + ai * 128 + m * 16; long off = -1;
                        if (row < MP) { const int t = row & (SEQ - 1); if (t >= SEQ - 15) off = (long)OFF_PP + ((long)(row >> 12) * 15 + (t - (SEQ - 15))) * 1024; }
                        else if (row < MV) { const int t = (row - MP) & 15, b = (row - MP) >> 4; if (t >= 1) off = (long)OFF_PS + ((long)b * 15 + (t - 1)) * 1024; }
                        if (off >= 0) { float* o = out + off + cc;
#pragma unroll
                            for (int bj = 0; bj < 2; ++bj) { *(f32x4*)(o + bj * 128) = acc[ai][bj][m][0]; *(f32x4*)(o + bj * 128 + 4) = acc[ai][bj][m][1]; } } }
            }
        }
    }
};
constexpr int MG_SPLIT = 4, MG_KT = (2048 / 64) / MG_SPLIT;
struct EpiMerged {
    static constexpr bool HAS_MID = true;
    const bf16_t* gate; bf16_t* merged; float* part;
    __device__ __forceinline__ void mid(f32x4 (&acc)[2][2][4][2], const Unit& u, int wr, int wc, int fr, int fq) const {
        int zoff = 0; asm volatile("" : "+v"(zoff));
        const int row0 = u.pm * 256 + wr * 64 + fr + zoff, cc = u.pn * 256 + wc * 32 + 8 * fq;
#pragma unroll
        for (int ai = 0; ai < 2; ++ai) {
            if (ai == 1 && u.half) break;
            u32x4 rw[4][2];
#pragma unroll
            for (int m = 0; m < 4; ++m)
#pragma unroll
                for (int bj = 0; bj < 2; ++bj) rw[m][bj] = *(const u32x4*)(gate + (size_t)(row0 + ai * 128 + m * 16) * 4096 + cc + bj * 128);
#pragma unroll
            for (int m = 0; m < 4; ++m)
#pragma unroll
                for (int bj = 0; bj < 2; ++bj) { f32x4 a0, a1; unpack8(rw[m][bj], a0, a1); acc[ai][bj][m][0] *= a0; acc[ai][bj][m][1] *= a1; }
            __builtin_amdgcn_sched_barrier(0);
        }
    }
    __device__ __forceinline__ void operator()(const f32x4 (&acc)[2][2][4][2], const Unit& u, int wr, int wc, int fr, int fq) const {
        const int row0 = u.pm * 256 + wr * 64 + fr, cc = u.pn * 256 + wc * 32 + 8 * fq;
        if (u.half) {
            float* ps = part + ((size_t)(u.kt0 / MG_KT) * MS + (row0 - MP)) * D + cc;
#pragma unroll
            for (int m = 0; m < 4; ++m)
#pragma unroll
                for (int bj = 0; bj < 2; ++bj) { *(f32x4*)(ps + (size_t)(m * 16) * D + bj * 128) = acc[0][bj][m][0]; *(f32x4*)(ps + (size_t)(m * 16) * D + bj * 128 + 4) = acc[0][bj][m][1]; }
            return; }
#pragma unroll
        for (int ai = 0; ai < 2; ++ai)
#pragma unroll
            for (int m = 0; m < 4; ++m) { const int row = row0 + ai * 128 + m * 16;
                const bf16_t* gp = gate + (size_t)row * 4096 + 2048 + cc; bf16_t* o = merged + (size_t)row * D + cc;
#pragma unroll
                for (int bj = 0; bj < 2; ++bj) { const u32x4 gw = *(const u32x4*)(gp + bj * 128); f32x4 g0, g1; unpack8(gw, g0, g1);
                    *(u32x4*)(o + bj * 128) = pack8(acc[ai][bj][m][0] * g0, acc[ai][bj][m][1] * g1); } }
    }
};
constexpr int OUT_SPLIT = 4, OUT_KT = (D / 64) / OUT_SPLIT;
struct EpiOut {
    static constexpr bool HAS_MID = false;
    const float* xp; const float* xs; float* y; bf16_t* hb; float* ssq; float* part;
    __device__ __forceinline__ void operator()(const f32x4 (&acc)[2][2][4][2], const Unit& u, int wr, int wc, int fr, int fq) const {
        int zoff = 0; asm volatile("" : "+v"(zoff));
        const int row0 = u.pm * 256 + wr * 64 + fr + zoff, cc = u.pn * 256 + wc * 32 + 8 * fq;
        if (u.half) {
            float* ps = part + ((size_t)(u.kt0 / OUT_KT) * MS + (row0 - MP)) * D + cc;
#pragma unroll
            for (int m = 0; m < 4; ++m)
#pragma unroll
                for (int bj = 0; bj < 2; ++bj) { *(f32x4*)(ps + (size_t)(m * 16) * D + bj * 128) = acc[0][bj][m][0]; *(f32x4*)(ps + (size_t)(m * 16) * D + bj * 128 + 4) = acc[0][bj][m][1]; }
            return; }
#pragma unroll
        for (int ai = 0; ai < 2; ++ai) {
            if (ai == 1 && u.half) break;
            f32x4 xv[4][2][2];
#pragma unroll
            for (int m = 0; m < 4; ++m) { const int row = row0 + ai * 128 + m * 16; const bool ok = row < MV;
                const float* xr = (row < MP ? xp + (size_t)row * D : xs + (size_t)(ok ? row - MP : 0) * D) + cc;
#pragma unroll
                for (int bj = 0; bj < 2; ++bj) { xv[m][bj][0] = *(const f32x4*)(xr + bj * 128); xv[m][bj][1] = *(const f32x4*)(xr + bj * 128 + 4); } }
            __builtin_amdgcn_sched_barrier(0);
#pragma unroll
            for (int m = 0; m < 4; ++m) { const int row = row0 + ai * 128 + m * 16; const bool ok = row < MV;
                bf16_t* ob = hb + (size_t)row * D + cc;
                float s = 0.f;
#pragma unroll
                for (int bj = 0; bj < 2; ++bj) { f32x4 h0 = acc[ai][bj][m][0], h1 = acc[ai][bj][m][1];
                    if (ok) { h0 += xv[m][bj][0]; h1 += xv[m][bj][1]; }
                    *(u32x4*)(ob + bj * 128) = pack8(h0, h1);
                    s += (h0[0] * h0[0] + h0[1] * h0[1]) + (h0[2] * h0[2] + h0[3] * h0[3]) + (h1[0] * h1[0] + h1[1] * h1[1]) + (h1[2] * h1[2] + h1[3] * h1[3]); }
                s += __shfl_xor(s, 16); s += __shfl_xor(s, 32);
                if (fq == 0) ssq[(size_t)(u.pn * 4 + wc) * MT + row] = s; }
            __builtin_amdgcn_sched_barrier(0);
        }
    }
};
struct EpiGU {
    static constexpr bool HAS_MID = false;
    const LAS float* tab; bf16_t* hid;
    __device__ __forceinline__ void operator()(const f32x4 (&acc)[2][2][4][2], const Unit& u, int wr, int wc, int fr, int fq) const {
        const int row0 = u.pm * 256 + wr * 64 + fr, cc = u.pn * 128 + wc * 32 + 8 * fq;
#pragma unroll
        for (int ai = 0; ai < 2; ++ai)
#pragma unroll
            for (int m = 0; m < 4; ++m) { const int row = row0 + ai * 128 + m * 16;
                const float sc = tab[(u.half ? 256 : 0) + ((ai * 128 + wr * 64 + m * 16 + fr) & (u.half ? 127 : 255))];
                f32x4 r0, r1;
#pragma unroll
                for (int j = 0; j < 4; ++j) { const float g0 = acc[ai][0][m][0][j] * sc, u0 = acc[ai][1][m][0][j] * sc, g1 = acc[ai][0][m][1][j] * sc, u1 = acc[ai][1][m][1][j] * sc;
                    r0[j] = g0 * fast_sigmoid(g0) * u0; r1[j] = g1 * fast_sigmoid(g1) * u1; }
                *(u32x4*)(hid + (size_t)row * FF + cc) = pack8(r0, r1); }
    }
};
constexpr int DN_SPLIT = 11, DN_KT = (FF / 64) / DN_SPLIT;
struct EpiDown {
    static constexpr bool HAS_MID = false;
    float* y; float* part; const bf16_t* hb; bf16_t* h2b;
    __device__ __forceinline__ void operator()(const f32x4 (&acc)[2][2][4][2], const Unit& u, int wr, int wc, int fr, int fq) const {
        const int row0 = u.pm * 256 + wr * 64 + fr, cc = u.pn * 256 + wc * 32 + 8 * fq;
#pragma unroll
        for (int ai = 0; ai < 2; ++ai)
#pragma unroll
            for (int m = 0; m < 4; ++m) { const int row = row0 + ai * 128 + m * 16;
                if (row < MV) { float* o = y + (size_t)row * D + cc;
                    if (u.half) {
                        float* ps = part + ((size_t)(u.kt0 / DN_KT) * MS + (row - MP)) * D + cc;
#pragma unroll
                        for (int bj = 0; bj < 2; ++bj) { *(f32x4*)(ps + bj * 128) = acc[ai][bj][m][0]; *(f32x4*)(ps + bj * 128 + 4) = acc[ai][bj][m][1]; }
                    } else {
#pragma unroll
                    for (int bj = 0; bj < 2; ++bj) { const u32x4 hw = *(const u32x4*)(hb + (size_t)row * D + cc + bj * 128); f32x4 h0, h1; unpack8(hw, h0, h1);
                        *(u32x4*)(h2b + (size_t)row * D + cc + bj * 128) = pack8(h0 + acc[ai][bj][m][0], h1 + acc[ai][bj][m][1]); } } } }
    }
};

struct EpiWA {
    static constexpr bool HAS_MID = false;
    bf16_t* dst;
    __device__ __forceinline__ void operator()(const f32x4 (&acc)[2][2][4][2], const Unit& u, int wr, int wc, int fr, int fq) const {
        const int row0 = u.pm * 256 + wr * 64 + fr, cc = wc * 32 + 8 * fq;
#pragma unroll
        for (int ai = 0; ai < 2; ++ai)
#pragma unroll
            for (int m = 0; m < 4; ++m) { bf16_t* o = dst + (size_t)(row0 + ai * 128 + m * 16) * 2048 + cc;
#pragma unroll
                for (int bj = 0; bj < 2; ++bj) *(u32x4*)(o + bj * 128) = pack8(acc[ai][bj][m][0], acc[ai][bj][m][1]); }
    }
};

__device__ __forceinline__ void p0_item(const float* W, int N, int k0, int n0, const float* gsc, bf16_t* dst, int ldd, int drow0, int dcol0, LAS float* scr, int lane) {
    const float* wp = W + (size_t)k0 * N + n0 + lane;
    float v[64];
#pragma unroll
    for (int i = 0; i < 64; ++i) v[i] = wp[(size_t)i * N];
    if (gsc) {
#pragma unroll
        for (int i = 0; i < 64; ++i) v[i] *= gsc[k0 + i]; }
#pragma unroll
    for (int i = 0; i < 64; ++i) scr[i * 65 + lane] = v[i];
    asm volatile("s_waitcnt lgkmcnt(0)" ::: "memory");
    const int c = lane & 7;
#pragma unroll
    for (int j = 0; j < 8; ++j) { const int n = (lane >> 3) + 8 * j; const LAS float* s = scr + (8 * c) * 65 + n;
        u32x4 o; o.x = cvt_pk_bf16(s[0 * 65], s[1 * 65]); o.y = cvt_pk_bf16(s[2 * 65], s[3 * 65]); o.z = cvt_pk_bf16(s[4 * 65], s[5 * 65]); o.w = cvt_pk_bf16(s[6 * 65], s[7 * 65]);
        *(u32x4*)(dst + (size_t)(drow0 + n) * ldd + dcol0 + k0 + 8 * c) = o; }
    asm volatile("s_waitcnt lgkmcnt(0)" ::: "memory");
}

struct Params {
    const float *x_prompt, *x_sample, *cache_k, *cache_v, *state_pool, *g_mix, *w_in, *w_pool, *s_pool, *w_branch, *w_out, *g_ffn, *w_gate_up, *w_down, *g_final;
    float* out; unsigned char* ws; int ph_lo, ph_hi;
};

__device__ __forceinline__ void xn_row(const Params& p, int m, int lane);
__device__ __forceinline__ void phase0(const Params& p, LAS unsigned char* lds, int gw, int NGW, int wave, int lane, unsigned xcc) {
    LAS float* scr = (LAS float*)(lds + wave * 16640);
    bf16_t* Wt_in = (bf16_t*)(p.ws + WS_WIN); bf16_t* Wt_br = (bf16_t*)(p.ws + WS_WBR); bf16_t* Wt_out = (bf16_t*)(p.ws + WS_WOUT);
    bf16_t* Wt_gu = (bf16_t*)(p.ws + WS_WGU); bf16_t* Wt_dn = (bf16_t*)(p.ws + WS_WDN); bf16_t* XN = (bf16_t*)(p.ws + WS_XN);
    bf16_t* TMPA = (bf16_t*)(p.ws + WS_TMPA); bf16_t* WPB = (bf16_t*)(p.ws + WS_WPB);
    constexpr int I_IN = (D / 64) * (NIN / 64), I_BR = (D / 64) * (D / 64), I_OUT = (D / 64) * (D / 64), I_GU = (D / 64) * (NGU / 64), I_DN = (FF / 64) * (D / 64);
    constexpr int NITEMS = I_IN + I_BR + I_OUT + I_GU + I_DN;
    unsigned* ctr = (unsigned*)(p.ws + WS_BAR) + 3648 + 64 * (xcc & 7);
    constexpr int NXN = MT / 2;
    for (;;) {
        unsigned kq = 0; if (lane == 0) kq = __hip_atomic_fetch_add(ctr, 1u, __ATOMIC_RELAXED, __HIP_MEMORY_SCOPE_AGENT);
        const int it = 8 * (int)__builtin_amdgcn_readfirstlane(kq) + (int)(xcc & 7);
        if (it >= NITEMS + NXN) break;
        if (it >= NITEMS) { xn_row(p, 2 * (it - NITEMS), lane); xn_row(p, 2 * (it - NITEMS) + 1, lane); continue; }
        int r = it;
        if (r < I_IN) { const int nb = NIN / 64; const int n0 = 64 * (r % nb); int drow = n0;
            if (n0 >= 4096) { const int q = n0 - 4096; drow = q < 2048 ? 4096 + (q / 128) * 256 + (q % 128) : 4096 + ((q - 2048) / 128) * 256 + 128 + ((q - 2048) % 128); }
            p0_item(p.w_in, NIN, 64 * (r / nb), n0, p.g_mix, Wt_in, D, drow, 0, scr, lane); continue; } r -= I_IN;
        if (r < I_BR) { const int nb = D / 64; const int k0 = 64 * (r / nb), n0 = 64 * (r % nb);
            if (k0 < 1024) p0_item(p.w_branch, D, k0, n0, p.s_pool, TMPA, 1024, n0, 0, scr, lane);
            else p0_item(p.w_branch, D, k0, n0, nullptr, Wt_br, 2048, n0, 0, scr, lane);
            continue; } r -= I_BR;
        if (r < I_OUT) { const int nb = D / 64; p0_item(p.w_out, D, 64 * (r / nb), 64 * (r % nb), nullptr, Wt_out, D, 64 * (r % nb), 0, scr, lane); continue; } r -= I_OUT;
        if (r < I_GU) { const int nb = NGU / 64; const int n0 = 64 * (r % nb); const int drow = n0 < FF ? (n0 / 128) * 256 + (n0 % 128) : ((n0 - FF) / 128) * 256 + 128 + ((n0 - FF) % 128);
            p0_item(p.w_gate_up, NGU, 64 * (r / nb), n0, p.g_ffn, Wt_gu, D, drow, 0, scr, lane); continue; } r -= I_GU;
        { const int nb = D / 64; p0_item(p.w_down, D, 64 * (r / nb), 64 * (r % nb), nullptr, Wt_dn, FF, 64 * (r % nb), 0, scr, lane); }
    }
}
__device__ __forceinline__ void xn_row(const Params& p, int m, int lane) {
    bf16_t* XN = (bf16_t*)(p.ws + WS_XN);
    u32x2* o8 = (u32x2*)(XN + (size_t)m * D) + lane;
    if (m >= MV) {
#pragma unroll
        for (int j = 0; j < 8; ++j) o8[64 * j] = (u32x2){0u, 0u};
        return; }
    const f32x4* xr = (const f32x4*)(m < MP ? p.x_prompt + (size_t)m * D : p.x_sample + (size_t)(m - MP) * D) + lane;
    f32x4 v[8]; float s = 0.f;
#pragma unroll
    for (int j = 0; j < 8; ++j) { v[j] = xr[64 * j]; s += (v[j].x * v[j].x + v[j].y * v[j].y) + (v[j].z * v[j].z + v[j].w * v[j].w); }
    const float rs = __builtin_amdgcn_rsqf(wave_sum(s) * (1.0f / D) + EPS);
#pragma unroll
    for (int j = 0; j < 8; ++j) o8[64 * j] = (u32x2){cvt_pk_bf16(v[j].x * rs, v[j].y * rs), cvt_pk_bf16(v[j].z * rs, v[j].w * rs)};
}
__device__ __forceinline__ void phase0b(const Params& p, int gw, int NGW, int lane) {
    bf16_t* WPB = (bf16_t*)(p.ws + WS_WPB);
    for (int i = gw * 64 + lane; i < 4 * 256 * 256 / 8; i += NGW * 64) { const f32x4 a = *(const f32x4*)(p.w_pool + (size_t)i * 8), b = *(const f32x4*)(p.w_pool + (size_t)i * 8 + 4); *(u32x4*)(WPB + (size_t)i * 8) = pack8(a, b); }
    float* ssq = (float*)(p.ws + WS_SSQ);
    for (int i = gw * 64 + lane; i < MT; i += NGW * 64) ssq[i] = 0.f;
}

constexpr int VROW = 320;
__device__ __forceinline__ s16x4 vtr(const LAS unsigned char* p) { typedef short v4i16_t __attribute__((ext_vector_type(4))); return __builtin_bit_cast(s16x4, __builtin_amdgcn_ds_read_tr16_b64_v4i16((LAS v4i16_t*)p)); }
__device__ __forceinline__ bf16x8 cvt8(const f32x4& a, const f32x4& b) { u32x4 w = pack8(a, b); return __builtin_bit_cast(bf16x8, w); }

__device__ __forceinline__ void attn_unit(const Params& p, LAS unsigned char* vl, int unit, int lane) {
    const bf16_t* Ub = (const bf16_t*)(p.ws + WS_QKVU);
    const bf16_t* Qb = Ub + (size_t)MT * 1024; const bf16_t* Kb = Qb + (size_t)MT * 1024; const bf16_t* Vb = Kb + (size_t)MT * 1024;
    bf16_t* AO = (bf16_t*)(p.ws + WS_AO);
    const int n = lane & 31, hh = lane >> 5;
    const bool sample = unit < 64;
    int b, h, qrow0, nblk;
    if (sample) { b = unit >> 3; h = unit & 7; qrow0 = MP + b * DSEQ; nblk = 1 + PAST / 32; }
    else { const int u2 = unit - 64; const int qb = u2 & 127; h = (u2 >> 7) & 7; b = u2 >> 10; qrow0 = b * SEQ + qb * 32; nblk = qb + 1; }
    bf16x8 qf[8];
    { const bf16_t* qp = Qb + (size_t)(qrow0 + n) * 1024 + h * HD + 64 * hh;
#pragma unroll
      for (int kk = 0; kk < 8; ++kk) qf[kk] = *(const bf16x8*)(qp + 8 * kk); }
    f32x16 o[4];
#pragma unroll
    for (int db = 0; db < 4; ++db)
#pragma unroll
        for (int r = 0; r < 16; ++r) o[db][r] = 0.f;
    float R = (sample && n >= DSEQ) ? -1e30f : 0.f;
    const float* ck = p.cache_k + (size_t)b * PAST * 1024 + h * HD; const float* cv = p.cache_v + (size_t)b * PAST * 1024 + h * HD;
    const int vaddr = (4 * hh + ((lane & 15) >> 2)) * VROW + (16 * ((lane >> 4) & 1) + 4 * (lane & 3)) * 2;
    for (int blk = 0; blk < nblk; ++blk) {
        bf16x8 kf[8];
        const bool diag = (blk == 0);
        if (!sample || blk == 0) {
            const int s0 = qrow0 - blk * 32;
            const bf16_t* kp = Kb + (size_t)(s0 + n) * 1024 + h * HD + 64 * hh;
#pragma unroll
            for (int kk = 0; kk < 8; ++kk) kf[kk] = *(const bf16x8*)(kp + 8 * kk);
            const bf16_t* vp = Vb + (size_t)(s0 + (lane >> 4)) * 1024 + h * HD + 8 * (lane & 15);
#pragma unroll
            for (int it = 0; it < 8; ++it) { const u32x4 w = *(const u32x4*)(vp + (size_t)(4 * it) * 1024); *(LAS u32x4*)(vl + (4 * it + (lane >> 4)) * VROW + 16 * (lane & 15)) = w; }
        } else {
            const int s0 = PAST - blk * 32;
            const float* kp = ck + (size_t)(s0 + n) * 1024 + 64 * hh;
#pragma unroll
            for (int kk = 0; kk < 8; ++kk) kf[kk] = cvt8(*(const f32x4*)(kp + 8 * kk), *(const f32x4*)(kp + 8 * kk + 4));
            const float* vp = cv + (size_t)(s0 + (lane >> 4)) * 1024 + 8 * (lane & 15);
#pragma unroll
            for (int it = 0; it < 8; ++it) { const f32x4 a = *(const f32x4*)(vp + (size_t)(4 * it) * 1024), c = *(const f32x4*)(vp + (size_t)(4 * it) * 1024 + 4);
                *(LAS u32x4*)(vl + (4 * it + (lane >> 4)) * VROW + 16 * (lane & 15)) = pack8(a, c); }
        }
        f32x16 st;
#pragma unroll
        for (int r = 0; r < 16; ++r) st[r] = 0.f;
#pragma unroll
        for (int kk = 0; kk < 8; ++kk) st = __builtin_amdgcn_mfma_f32_32x32x16_bf16(kf[kk], qf[kk], st, 0, 0, 0);
        float l1m[16], ls[16];
#pragma unroll
        for (int r = 0; r < 16; ++r) { const int i = (r & 3) + 8 * (r >> 2) + 4 * hh; const bool valid = !diag || (i < n);
            const float z = st[r] * 0.08838834764831845f; const float sp = fmaxf(z, 0.f) + __logf(1.0f + __expf(-fabsf(z)));
            l1m[r] = valid ? -sp : 0.f; ls[r] = valid ? (z - sp) : -1e30f; }
        float gown[4], goth[4];
#pragma unroll
        for (int a = 0; a < 4; ++a) { gown[a] = (l1m[4 * a] + l1m[4 * a + 1]) + (l1m[4 * a + 2] + l1m[4 * a + 3]); goth[a] = __shfl_xor(gown[a], 32); }
        float wv[16]; float tail = R;
#pragma unroll
        for (int a = 3; a >= 0; --a) { float sfx = tail + (hh == 0 ? goth[a] : 0.f);
#pragma unroll
            for (int rr = 3; rr >= 0; --rr) { wv[4 * a + rr] = __expf(ls[4 * a + rr] + sfx); sfx += l1m[4 * a + rr]; }
            tail += gown[a] + goth[a]; }
        R = tail;
        bf16x8 wb[2];
#pragma unroll
        for (int s = 0; s < 2; ++s) wb[s] = cvt8((f32x4){wv[8 * s], wv[8 * s + 1], wv[8 * s + 2], wv[8 * s + 3]}, (f32x4){wv[8 * s + 4], wv[8 * s + 5], wv[8 * s + 6], wv[8 * s + 7]});
        asm volatile("s_waitcnt lgkmcnt(0)" ::: "memory");
#pragma unroll
        for (int db = 0; db < 4; ++db)
#pragma unroll
            for (int s = 0; s < 2; ++s) { const s16x4 lo = vtr(vl + vaddr + (16 * s) * VROW + 64 * db), hi = vtr(vl + vaddr + (16 * s + 8) * VROW + 64 * db);
                const bf16x8 vf = (bf16x8){lo[0], lo[1], lo[2], lo[3], hi[0], hi[1], hi[2], hi[3]};
                o[db] = __builtin_amdgcn_mfma_f32_32x32x16_bf16(vf, wb[s], o[db], 0, 0, 0); }
        asm volatile("s_waitcnt lgkmcnt(0)" ::: "memory");
        if (__all(R < -104.0f)) break;
    }
    if (!sample || n < DSEQ) {
        bf16_t* op = AO + (size_t)(qrow0 + n) * 2048 + 1024 + h * HD + 4 * hh;
#pragma unroll
        for (int db = 0; db < 4; ++db)
#pragma unroll
            for (int a = 0; a < 4; ++a) *(u32x2*)(op + 32 * db + 8 * a) = (u32x2){cvt_pk_bf16(o[db][4 * a], o[db][4 * a + 1]), cvt_pk_bf16(o[db][4 * a + 2], o[db][4 * a + 3])};
    }
}

template <int W>
__device__ __forceinline__ void diff_chunk(const Params& p, int ch, int cc) {
    const bf16_t* Ub = (const bf16_t*)(p.ws + WS_QKVU); bf16_t* AO = (bf16_t*)(p.ws + WS_AO);
    const int m0 = ch * 16; const bool prompt = m0 < MP; const int t0 = prompt ? (m0 & (SEQ - 1)) : PAST;
    const bf16_t* up = Ub + (size_t)m0 * 1024 + cc * 8;
    u32x4 raw[15 + W];
#pragma unroll
    for (int r = 0; r < 16; ++r) raw[W - 1 + r] = *(const u32x4*)(up + (size_t)r * 1024);
    if (prompt) {
#pragma unroll
        for (int j = 1; j < W; ++j) { const u32x4 v = *(const u32x4*)(t0 > 0 ? up - (size_t)j * 1024 : up); raw[W - 1 - j] = (t0 > 0) ? v : (u32x4){0u, 0u, 0u, 0u}; }
    } else { const float* hp = p.state_pool + (size_t)((m0 - MP) >> 4) * 15 * 1024 + cc * 8;
#pragma unroll
        for (int j = 1; j < W; ++j) raw[W - 1 - j] = pack8(*(const f32x4*)(hp + (size_t)(15 - j) * 1024), *(const f32x4*)(hp + (size_t)(15 - j) * 1024 + 4)); }
    f32x4 s0 = (f32x4){0.f, 0.f, 0.f, 0.f}, s1 = s0;
#pragma unroll
    for (int j = 1; j < W; ++j) { f32x4 a, c; unpack8(raw[W - 1 - j], a, c); s0 += a; s1 += c; }
#pragma unroll
    for (int r = 0; r < 16; ++r) { f32x4 a, c; unpack8(raw[W - 1 + r], a, c); s0 += a; s1 += c;
        const int t = t0 + r; const float ic = 1.0f / (float)(t + 1 < W ? t + 1 : W);
        *(u32x4*)(AO + (size_t)(m0 + r) * 2048 + cc * 8) = pack8(s0 * ic - a, s1 * ic - c);
        f32x4 da, dc; unpack8(raw[r], da, dc); s0 -= da; s1 -= dc; }
}
constexpr int N_ATT_UNITS = 64 + 4096, N_DIFF_ITEMS = (MV / 32) * 4, N_P2_ITEMS = N_ATT_UNITS + N_DIFF_ITEMS;
__device__ __forceinline__ void diff_item(const Params& p, int wi, int lane) {
    const int g = wi & 3, ch = 2 * (wi >> 2) + (lane >> 5), cc = 32 * g + (lane & 31);
    if (g == 0) diff_chunk<2>(p, ch, cc); else if (g == 1) diff_chunk<4>(p, ch, cc); else if (g == 2) diff_chunk<8>(p, ch, cc); else diff_chunk<16>(p, ch, cc);
}

__global__ void __launch_bounds__(512, 2) fwd_megakernel(Params p) {
    extern __shared__ __attribute__((aligned(16))) unsigned char lds_raw[];
    LAS unsigned char* lds = (LAS unsigned char*)lds_raw;
    const int tid = threadIdx.x, lane = tid & 63, wave = __builtin_amdgcn_readfirstlane(tid >> 6);
    const int G = gridDim.x, bx = blockIdx.x;
    const int vcu = (G % 8 == 0) ? (bx % 8) * (G / 8) + bx / 8 : bx;
    const int gw = vcu * 8 + wave, NGW = G * 8;
    cg::grid_group grid = cg::this_grid();
    volatile LAS unsigned* xst = (volatile LAS unsigned*)(lds + LDS_BYTES - 64);
    if (tid < 2) xst[tid] = 0u;
    __syncthreads();
    XcdBarrier xbar = xcd_barrier_post((unsigned*)(p.ws + WS_BAR), xst);
#define IN(k) (p.ph_lo <= (k) && (k) < p.ph_hi)
#define SEAM(k) do { if (IN(k) && IN((k) + 1)) { if (p.ph_hi > 64) grid.sync();   xcd_barrier(xbar); } STAMP(); } while (0)
    bf16_t* Wt_in = (bf16_t*)(p.ws + WS_WIN); bf16_t* Wt_br = (bf16_t*)(p.ws + WS_WBR); bf16_t* Wt_out = (bf16_t*)(p.ws + WS_WOUT);
    bf16_t* Wt_gu = (bf16_t*)(p.ws + WS_WGU); bf16_t* Wt_dn = (bf16_t*)(p.ws + WS_WDN); bf16_t* XN = (bf16_t*)(p.ws + WS_XN);
    bf16_t* QKVU = (bf16_t*)(p.ws + WS_QKVU); bf16_t* GATE = (bf16_t*)(p.ws + WS_GATE); bf16_t* AO = (bf16_t*)(p.ws + WS_AO);
    bf16_t* MERGED = (bf16_t*)(p.ws + WS_MERGED); bf16_t* HID = (bf16_t*)(p.ws + WS_HID); float* SSQ = (float*)(p.ws + WS_SSQ);
    float* Y = p.out + OFF_Y;
#ifdef PROBE_T
    unsigned long long tstamp[10]; int nst = 0;
#define STAMP() do { tstamp[nst++] = __builtin_amdgcn_s_memrealtime(); } while (0)
#else
#define STAMP() do {} while (0)
#endif
    STAMP();

    if (IN(0)) { phase0(p, lds, gw, NGW, wave, lane, xbar.x);
#ifdef PROBE_T
#endif
        phase0b(p, gw, NGW, lane);
    }
    SEAM(0);
    if (IN(1)) { pg8::Gemm g{XN, Wt_in, D, D, MT, NIN, D}; pg8::StaticOrder S; S.init(64, NIN / 256, D / 64, G, bx, 64, 1); EpiIn E{QKVU, GATE, p.out}; pg8::gemm_phase(lds, g, S, E); }
    SEAM(1);
    if (IN(2)) {
        LAS unsigned char* vl = lds + wave * (32 * VROW);
        unsigned* ctr = (unsigned*)(p.ws + WS_BAR) + 3584;
        int item = gw;
        while (item < N_P2_ITEMS) {
            if (item < N_ATT_UNITS) attn_unit(p, vl, item, lane); else diff_item(p, item - N_ATT_UNITS, lane);
            unsigned nx = 0; if (lane == 0) nx = __hip_atomic_fetch_add(ctr, 1u, __ATOMIC_RELAXED, __HIP_MEMORY_SCOPE_AGENT);
            item = NGW + (int)__builtin_amdgcn_readfirstlane(nx);
        }
        __syncthreads();
        for (int gq = 0; gq < 4; ++gq) { pg8::Gemm g{(const bf16_t*)(p.ws + WS_TMPA) + gq * 256, (const bf16_t*)(p.ws + WS_WPB) + gq * 65536, 1024, 256, 2048, 256, 256};
            pg8::StaticOrder S; S.init(8, 1, 4, G, (bx + G - 8 * gq) % G); EpiWA E{Wt_br + gq * 256}; pg8::gemm_phase(lds, g, S, E); }
    }
    SEAM(2);
    if (IN(3)) {
        { pg8::Gemm g{AO, Wt_br, 2048, 2048, MT, D, 2048}; pg8::StaticOrder S; S.init(64, 8, 32, G, bx, 64, MG_SPLIT); EpiMerged E{GATE, MERGED, (float*)(p.ws + WS_XN)}; pg8::gemm_phase(lds, g, S, E); }
    }
    if (IN(3) && IN(4)) xcd_barrier(xbar);
    if (IN(3)) {
        for (int r = gw; r < MS; r += NGW) {
            const f32x4* pr = (const f32x4*)((const float*)(p.ws + WS_XN) + (size_t)r * D) + lane;
            const u32x2* gr = (const u32x2*)(GATE + (size_t)(MP + r) * 4096) + lane; u32x2* o8 = (u32x2*)(MERGED + (size_t)(MP + r) * D) + lane;
#pragma unroll
            for (int j = 0; j < 8; ++j) { const size_t cs = (size_t)MS * D / 4;
                const f32x4 a = pr[64 * j] + pr[cs + 64 * j], b = pr[2 * cs + 64 * j] + pr[3 * cs + 64 * j];
                const u32x2 rw = gr[64 * j], bw = gr[512 + 64 * j];
                const f32x4 rr = (f32x4){bflo(rw.x), bfhi(rw.x), bflo(rw.y), bfhi(rw.y)}, gb = (f32x4){bflo(bw.x), bfhi(bw.x), bflo(bw.y), bfhi(bw.y)};
                const f32x4 v = gb * (rr * a + b);
                o8[64 * j] = (u32x2){cvt_pk_bf16(v.x, v.y), cvt_pk_bf16(v.z, v.w)}; }
        }
    }
    SEAM(3);
    if (IN(4)) { pg8::Gemm g{MERGED, Wt_out, D, D, MT, D, D}; pg8::StaticOrder S; S.init(64, 8, 32, G, bx, 64, OUT_SPLIT); EpiOut E{p.x_prompt, p.x_sample, Y, XN, (float*)(p.ws + WS_SSQP), (float*)(p.ws + WS_AO)}; pg8::gemm_phase(lds, g, S, E); }
    if (IN(4) && IN(5)) xcd_barrier(xbar);
    if (IN(4)) {
        for (int r = gw; r < MS; r += NGW) {
            const f32x4* xr = (const f32x4*)(p.x_sample + (size_t)r * D) + lane; const f32x4* pr = (const f32x4*)((const float*)(p.ws + WS_AO) + (size_t)r * D) + lane;
            u32x2* o8 = (u32x2*)(XN + (size_t)(MP + r) * D) + lane; float* sp = (float*)(p.ws + WS_SSQP);
            float sq = 0.f;
#pragma unroll
            for (int j = 0; j < 8; ++j) { f32x4 v = xr[64 * j];
#pragma unroll
                for (int c = 0; c < OUT_SPLIT; ++c) v += pr[(size_t)c * MS * D / 4 + 64 * j];
                sq += (v.x * v.x + v.y * v.y) + (v.z * v.z + v.w * v.w);
                o8[64 * j] = (u32x2){cvt_pk_bf16(v.x, v.y), cvt_pk_bf16(v.z, v.w)}; }
            sq = wave_sum(sq);
            if (lane < 32) sp[(size_t)lane * MT + MP + r] = lane == 0 ? sq : 0.f;
        }
    }
    SEAM(4);
    if (IN(5)) { pg8::Gemm g{XN, Wt_gu, D, D, MT, NGU, D}; pg8::StaticOrder S; S.init(64, NGU / 256, 32, G, bx, 64, 1);
        LAS float* tab = (LAS float*)(lds + 131072);
        { pg8::Unit u0; S.next(0, u0); const float* sp = (const float*)(p.ws + WS_SSQP);
          if (tid < 384) { const int row = tid < 256 ? u0.pm * 256 + tid : MP + (tid - 256); float a = 0.f;
#pragma unroll 8
              for (int k = 0; k < 32; ++k) a += sp[(size_t)k * MT + row];
              tab[tid] = __builtin_amdgcn_rsqf(a * (1.0f / D) + EPS); }
          __syncthreads(); }
        EpiGU E{tab, HID}; pg8::gemm_phase(lds, g, S, E); }
    SEAM(5);
    if (IN(6)) { pg8::Gemm g{HID, Wt_dn, FF, FF, MT, D, FF}; pg8::StaticOrder S; S.init(64, 8, FF / 64, G, bx, 64, DN_SPLIT); EpiDown E{Y, (float*)(p.ws + WS_AO), XN, (bf16_t*)(p.ws + WS_H2B)}; pg8::gemm_phase(lds, g, S, E); }
    SEAM(6);
    if (IN(7)) {
        for (int m = gw; m < MV; m += NGW) {
            f32x4* yr = (f32x4*)(Y + (size_t)m * D) + lane; const f32x4* gf = (const f32x4*)p.g_final + lane;
            f32x4 v[8]; float s = 0.f;
            {
                const u32x2* hr = (const u32x2*)((m < MP ? (const bf16_t*)(p.ws + WS_H2B) : (const bf16_t*)XN) + (size_t)m * D) + lane;
#pragma unroll
                for (int j = 0; j < 8; ++j) { const u32x2 w2 = hr[64 * j]; v[j] = (f32x4){bflo(w2.x), bfhi(w2.x), bflo(w2.y), bfhi(w2.y)}; } }
            if (m >= MP) { const f32x4* pr = (const f32x4*)((const float*)(p.ws + WS_AO) + (size_t)(m - MP) * D) + lane;
                for (int c = 0; c < DN_SPLIT; ++c)
#pragma unroll
                    for (int j = 0; j < 8; ++j) v[j] += pr[(size_t)c * MS * D / 4 + 64 * j]; }
#pragma unroll
            for (int j = 0; j < 8; ++j) s += (v[j].x * v[j].x + v[j].y * v[j].y) + (v[j].z * v[j].z + v[j].w * v[j].w);
            const float rs = __builtin_amdgcn_rsqf(wave_sum(s) * (1.0f / D) + EPS);
#pragma unroll
            for (int j = 0; j < 8; ++j) yr[64 * j] = v[j] * rs * gf[64 * j];
        }
    }
#ifdef PROBE_T
    STAMP();
    if (bx == 0 && tid == 0) {
        const unsigned long long e1 = (unsigned long long)__hip_atomic_load((long long*)(p.ws + WS_SSQ + 512 * 1024), __ATOMIC_RELAXED, __HIP_MEMORY_SCOPE_AGENT);
        const unsigned long long e2 = (unsigned long long)__hip_atomic_load((long long*)(p.ws + WS_SSQ + 512 * 1024 + 256), __ATOMIC_RELAXED, __HIP_MEMORY_SCOPE_AGENT);
        (void)e1; (void)e2;
        const float ta = (float)(tstamp[PROBE_A + 1] - tstamp[PROBE_A]) * 0.01f, tb = (float)(tstamp[PROBE_B + 1] - tstamp[PROBE_B]) * 0.01f;
        asm volatile("s_waitcnt vmcnt(0)" ::: "memory");
        atomicAdd(Y, 4.0f + ta * (1.0f / 256.0f)); atomicAdd(p.out + OFF_PP, 1.5f + tb * (1.0f / 500.0f));
    }
#endif
#undef IN
#undef SEAM
}

extern "C" void kernel_launch(void* const* d_in, const int* in_sizes, int n_in, void* d_out, int out_size, void* d_ws, size_t ws_size, hipStream_t stream) {
    static int grid = 0;
    if (grid == 0) {
        if (n_in != 15 || (size_t)out_size != OUT_TOTAL || ws_size < WS_END) { fprintf(stderr, "kernel_launch: unexpected shapes: n_in %d out %d ws %zu\n", n_in, out_size, ws_size); grid = -1; return; }
        int dev = 0, cus = 0, per_cu = 0;
        hipGetDevice(&dev); hipDeviceGetAttribute(&cus, hipDeviceAttributeMultiprocessorCount, dev);
        hipFuncSetAttribute((const void*)fwd_megakernel, hipFuncAttributeMaxDynamicSharedMemorySize, LDS_BYTES);
        hipOccupancyMaxActiveBlocksPerMultiprocessor(&per_cu, (const void*)fwd_megakernel, 512, LDS_BYTES);
        if (per_cu < 1) { fprintf(stderr, "kernel_launch: occupancy query says %d blocks per CU\n", per_cu); per_cu = 1; }
        (void)hipGetLastError();
        grid = cus;
    }
    if (grid < 0) return;
    Params p{};
    const float** pp = (const float**)&p;
    for (int i = 0; i < 15; ++i) pp[i] = (const float*)d_in[i];
    p.out = (float*)d_out; p.ws = (unsigned char*)d_ws;
#if N_LAUNCH_MODE == 1
    p.ph_lo = 0; p.ph_hi = 8;
    void* args[] = {&p};
    if (hipMemsetAsync((char*)d_ws + WS_BAR, 0, WS_BAR_BYTES, stream) != hipSuccess) fprintf(stderr, "kernel_launch: memset of the barrier words failed\n");
    hipError_t e = hipLaunchCooperativeKernel((const void*)fwd_megakernel, dim3(grid), dim3(512), args, LDS_BYTES, stream);
    if (e != hipSuccess) fprintf(stderr, "cooperative launch failed: %s (grid %d)\n", hipGetErrorString(e), grid);
#else
    for (int ph = 0; ph < 8; ++ph) { p.ph_lo = ph; p.ph_hi = ph + 1; hipLaunchKernelGGL(fwd_megakernel, dim3(grid), dim3(512), LDS_BYTES, stream, p); }
#endif
}
```

```cpp
#include <hip/hip_runtime.h>
#include <hip/hip_cooperative_groups.h>
#include <cstdio>
#include <cstdint>
namespace cg = cooperative_groups;

#define PROBE_A 6
#define PROBE_B 4
#ifndef N_LAUNCH_MODE
#define N_LAUNCH_MODE 1
#endif

#define LAS __attribute__((address_space(3)))
typedef unsigned short bf16_t;
typedef short bf16x8 __attribute__((ext_vector_type(8)));
typedef short s16x4 __attribute__((ext_vector_type(4)));
typedef float f32x4 __attribute__((ext_vector_type(4)));
typedef float f32x16 __attribute__((ext_vector_type(16)));
typedef unsigned u32x4 __attribute__((ext_vector_type(4)));
typedef unsigned u32x2 __attribute__((ext_vector_type(2)));

constexpr int D = 2048, MP = 16384, MS = 128, MV = MP + MS, MT = 16640;
constexpr int SEQ = 4096, DSEQ = 16, PAST = 4096, NH = 8, HD = 128;
constexpr int NIN = 8192, FF = 5632, NGU = 2 * FF, AW = 1024;
constexpr float EPS = 1e-6f;
constexpr size_t OFF_Y = 0, OFF_KP = (size_t)MV * D, OFF_VP = OFF_KP + (size_t)MP * 1024, OFF_PP = OFF_VP + (size_t)MP * 1024,
                 OFF_KS = OFF_PP + 4 * 15 * 1024, OFF_VS = OFF_KS + (size_t)MS * 1024, OFF_PS = OFF_VS + (size_t)MS * 1024, OUT_TOTAL = OFF_PS + 8 * 15 * 1024;
constexpr size_t MiB = 1u << 20;
constexpr size_t WS_SSQ = 0, WS_WIN = 1 * MiB, WS_WBR = 33 * MiB, WS_WOUT = 41 * MiB, WS_WGU = 49 * MiB, WS_WDN = 93 * MiB, WS_XN = 115 * MiB,
                 WS_QKVU = 180 * MiB, WS_GATE = 310 * MiB, WS_AO = 440 * MiB, WS_TMPA = 505 * MiB, WS_WPB = 509 * MiB, WS_SSQP = 510 * MiB, WS_END = 513 * MiB;
constexpr size_t WS_BAR = 768 * 1024, WS_BAR_BYTES = 32768;
constexpr size_t WS_H2B = WS_WIN;
static_assert(WS_H2B + (size_t)MV * D * 2 <= WS_WDN, "h2 overlay");
constexpr size_t WS_MERGED = WS_QKVU;
constexpr size_t WS_HID = WS_QKVU;
static_assert((size_t)MT * FF * 2 <= WS_AO - WS_QKVU, "hid overlay");
constexpr int LDS_BYTES = 147456;

typedef __bf16 bf16x2_t __attribute__((ext_vector_type(2)));
typedef float f32x2_t __attribute__((ext_vector_type(2)));
__device__ __forceinline__ unsigned cvt_pk_bf16(float lo, float hi) { const f32x2_t v = {lo, hi}; return __builtin_bit_cast(unsigned, __builtin_convertvector(v, bf16x2_t)); }
__device__ __forceinline__ float bf2f(unsigned short b) { return __uint_as_float(((unsigned)b) << 16); }
__device__ __forceinline__ float bflo(unsigned w) { return __uint_as_float(w << 16); }
__device__ __forceinline__ float bfhi(unsigned w) { return __uint_as_float(w & 0xffff0000u); }
__device__ __forceinline__ float fast_sigmoid(float x) { return __builtin_amdgcn_rcpf(1.0f + __expf(-x)); }
__device__ __forceinline__ float wave_sum(float v) {
#pragma unroll
    for (int o = 1; o < 64; o <<= 1) v += __shfl_xor(v, o);
    return v;
}

#define XB_TMO      128
#define XB_XCNT(j)  (256  + 64 * (j))
#define XB_XSUB(j)  (1280 + 64 * (j))
#define XB_XGEN(j)  (2304 + 64 * (j))
#define XB_TOP      3328
#define XB_TOPGEN   3392
#define XCD_BAR_WORDS 3456
#define XB_SPIN_CAP (1u << 18)

__device__ __forceinline__ unsigned xb_ld(unsigned* p)              { return __hip_atomic_load(p, __ATOMIC_RELAXED, __HIP_MEMORY_SCOPE_AGENT); }
__device__ __forceinline__ unsigned xb_add(unsigned* p, unsigned v) { return __hip_atomic_fetch_add(p, v, __ATOMIC_RELAXED, __HIP_MEMORY_SCOPE_AGENT); }
__device__ __forceinline__ unsigned xb_xcc_id() { return (unsigned)__builtin_amdgcn_s_getreg((3 << 11) | 20) & 0xFu; }
#define XB_SPIN(cond, bar) do { unsigned _sp = 0; while (cond) { __builtin_amdgcn_s_sleep(1); \
    if ((++_sp & 255u) == 0u) { if (xb_ld(&(bar)[XB_TMO])) break; if (_sp > XB_SPIN_CAP) { atomicAdd(&(bar)[XB_TMO], 1u); break; } } } } while (0)

struct XcdBarrier {
    unsigned* bar; unsigned x;
    volatile LAS unsigned* st;
};

__device__ __forceinline__ XcdBarrier xcd_barrier_post(unsigned* bar, volatile LAS unsigned* st) {
    XcdBarrier b; b.bar = bar; b.x = xb_xcc_id(); b.st = st;
    if (threadIdx.x == 0) (void)xb_add(&bar[XB_XCNT(b.x)], 1u);
    return b;
}
__device__ __forceinline__ void xcd_barrier_complete(unsigned* bar, unsigned x, unsigned& nloc, unsigned& nx) {
    const unsigned G = gridDim.x * gridDim.y * gridDim.z;
    unsigned sum, cnt, mine, sp = 0u;
    for (;;) {
        sum = 0u; cnt = 0u; mine = 0u;
#pragma unroll
        for (unsigned j = 0; j < 16; ++j) { const unsigned c = xb_ld(&bar[XB_XCNT(j)]); sum += c; cnt += (c > 0u) ? 1u : 0u; mine = (j == x) ? c : mine; }
        if (sum == G) break;
        __builtin_amdgcn_s_sleep(1);
        if ((++sp & 255u) == 0u) { if (xb_ld(&bar[XB_TMO])) break; if (sp > XB_SPIN_CAP) { atomicAdd(&bar[XB_TMO], 1u); break; } }
    }
    nloc = mine > 0u ? mine : 1u; nx = cnt > 0u ? cnt : 1u;
}

__device__ __forceinline__ void xcd_barrier(const XcdBarrier& b) {
    asm volatile("s_waitcnt vmcnt(0)" ::: "memory");
    __syncthreads();
    if (threadIdx.x == 0) {
        unsigned* bar = b.bar;
        __builtin_amdgcn_s_waitcnt(0);
        unsigned nloc = b.st[0], nx = b.st[1];
        if (nloc == 0u) { xcd_barrier_complete(bar, b.x, nloc, nx); b.st[0] = nloc; b.st[1] = nx; }
        const unsigned old = xb_add(&bar[XB_XSUB(b.x)], 1u);
        const unsigned gen = old / nloc;
        if (old + 1u == (gen + 1u) * nloc) {
            __builtin_amdgcn_fence(__ATOMIC_RELEASE, "agent");
            asm volatile("s_waitcnt vmcnt(0)" ::: "memory");
            const unsigned og = xb_add(&bar[XB_TOP], 1u);
            const unsigned tg = og / nx;
            if (og + 1u == (tg + 1u) * nx) xb_add(&bar[XB_TOPGEN], 1u);
            else XB_SPIN(xb_ld(&bar[XB_TOPGEN]) == tg, bar);
            __builtin_amdgcn_fence(__ATOMIC_ACQUIRE, "agent");
            xb_add(&bar[XB_XGEN(b.x)], 1u);
            asm volatile("s_waitcnt vmcnt(0)" ::: "memory");
        } else {
            XB_SPIN(xb_ld(&bar[XB_XGEN(b.x)]) == gen, bar);
            __builtin_amdgcn_fence(__ATOMIC_ACQUIRE, "agent");
            asm volatile("s_waitcnt vmcnt(0)" ::: "memory");
        }
    }
    __syncthreads();
}

namespace pg8 {
constexpr int BM = 256, BK = 64, HALF = 128, HTB = HALF * BK * 2, STAGE_BYTES = 8 * HTB, NXCD = 8, WGM = 8;
__host__ __device__ __forceinline__ int lds_byte(int r, int c) { const int st = (r >> 4) * 2 + (c >> 5), rr = r & 15, cc = c & 31, ob = rr * 64 + cc * 2; return st * 1024 + (ob ^ (((ob >> 9) & 1) << 5)); }
__host__ __device__ __forceinline__ void stage_rc(int b, int& R, int& C) { const int st = b / 1024, sb = b % 1024, swz = sb ^ (((sb >> 9) & 1) << 5); R = (st >> 1) * 16 + swz / 64; C = (st & 1) * 32 + (swz % 64) / 2; }
__host__ __device__ __forceinline__ int perm32(int rho) { const int n = rho >> 4, i = rho & 15; return 8 * (i >> 2) + 4 * n + (i & 3); }

struct Unit { int pm, pn, kt0, nkt, half; };
struct Gemm { const bf16_t* A; const bf16_t* Bt; int lda, ldb, M, N, K; };

struct StaticOrder {
    int nM, nN, nwg, G, c, ktfull, pmS, nS, ktS;
    __device__ void init(int nM_, int nN_, int ktfull_, int G_, int c_, int pmS_ = 0, int ksplit = 0) { nM = nM_; nN = nN_; nwg = nM * nN; G = G_; c = c_; ktfull = ktfull_; pmS = pmS_; nS = nN * ksplit; ktS = ksplit ? ktfull / ksplit : 0; }
    __device__ bool next(int i, Unit& u) const {
        const int L = i * G + c;
        if (L >= nwg) { const int t = L - nwg;
            if (t >= nS) return false;
            u.pm = pmS; u.pn = t % nN; u.kt0 = (t / nN) * ktS; u.nkt = ktS; u.half = 1; return true; }
        int wgid = L; { const int q = nwg / NXCD, r = nwg % NXCD, xcd = wgid % NXCD, off = wgid / NXCD; wgid = (xcd < r ? xcd * (q + 1) : r * (q + 1) + (xcd - r) * q) + off; }
        const int nig = WGM * nN, gid = wgid / nig, fm = gid * WGM, gsz = (nM - fm) < WGM ? (nM - fm) : WGM;
        u.pm = fm + ((wgid % nig) % gsz); u.pn = (wgid % nig) / gsz; u.kt0 = 0; u.nkt = ktfull; u.half = 0; return true;
    }
};

template <class Epi>
__device__ __forceinline__ void gemm_phase(LAS unsigned char* lds, const Gemm g, const StaticOrder& S, const Epi& E) {
    int tid_ = threadIdx.x; asm volatile("" : "+v"(tid_));
    const int tid = tid_, wid = __builtin_amdgcn_readfirstlane(tid >> 6), lane = tid & 63, wr = wid >> 2, wc = wid & 3, fr = lane & 15, fq = lane >> 4;
    unsigned voffA[2], voffB[2];
#pragma unroll
    for (int i = 0; i < 2; ++i) { int R, C; stage_rc(tid * 16 + i * 8192, R, C); const int Rb = (R & ~31) + perm32(R & 31);
        voffA[i] = (unsigned)(R * g.lda + C) * 2u; voffB[i] = (unsigned)(Rb * g.ldb + C) * 2u; }
    const size_t kstep = (size_t)(BK * 2);
    const size_t hstepA = (size_t)HALF * g.lda * 2, hstepB = (size_t)HALF * g.ldb * 2;
    const size_t tstepA = 2 * hstepA, tstepB = 2 * hstepB;
    const unsigned ldsw = (unsigned)wid * 1024u;
    const int aoff = lds_byte(wr * 64 + fr, fq * 8), boff = lds_byte(wc * 32 + fr, fq * 8);
#define PG8_SA(b, h) (((b) * 2 + (h)) * HTB)
#define PG8_SB(b, h) ((4 + (b) * 2 + (h)) * HTB)
#define PG8_STAGE(bufoff, gbase, voff) do { _Pragma("unroll") for (int _i = 0; _i < 2; ++_i) \
        __builtin_amdgcn_global_load_lds((const unsigned*)((const char*)(gbase) + (voff)[_i]), (LAS unsigned*)(lds + (bufoff) + ldsw + _i * 8192), 16, 0, 0); } while (0)
#define PG8_LDA(dst, b, h) do { _Pragma("unroll") for (int m = 0; m < 4; ++m) _Pragma("unroll") for (int k = 0; k < 2; ++k) dst[m][k] = *(const LAS bf16x8*)(lds + PG8_SA(b, h) + aoff + m * 2048 + k * 1024); } while (0)
#define PG8_LDB(dst, b, h) do { _Pragma("unroll") for (int n = 0; n < 2; ++n) _Pragma("unroll") for (int k = 0; k < 2; ++k) dst[n][k] = *(const LAS bf16x8*)(lds + PG8_SB(b, h) + boff + n * 2048 + k * 1024); } while (0)
#define PG8_MMA(ai, bj, At, Bt) do { __builtin_amdgcn_s_setprio(1); _Pragma("unroll") for (int m = 0; m < 4; ++m) _Pragma("unroll") for (int n = 0; n < 2; ++n) _Pragma("unroll") for (int k = 0; k < 2; ++k) \
        acc[ai][bj][m][n] = __builtin_amdgcn_mfma_f32_16x16x32_bf16(Bt[n][k], At[m][k], acc[ai][bj][m][n], 0, 0, 0); __builtin_amdgcn_s_setprio(0); } while (0)
#define PG8_WAIT_V(n) asm volatile("s_waitcnt vmcnt(" #n ")" ::: "memory")
#define PG8_WAIT_L(n) asm volatile("s_waitcnt lgkmcnt(" #n ")" ::: "memory")
#define PG8_BAR __builtin_amdgcn_s_barrier()
#define PG8_SCHED __builtin_amdgcn_sched_barrier(0)
    Unit cur, nxt; int ui = 0;
    if (!S.next(0, cur)) return;
    f32x4 acc[2][2][4][2];
#pragma unroll
    for (int a = 0; a < 2; ++a)
#pragma unroll
        for (int b = 0; b < 2; ++b)
#pragma unroll
            for (int m = 0; m < 4; ++m)
#pragma unroll
                for (int n = 0; n < 2; ++n) acc[a][b][m][n] = (f32x4){0.f, 0.f, 0.f, 0.f};
    bf16x8 At[4][2], B0[2][2], B1[2][2];
    const char* cA = (const char*)g.A + (size_t)cur.pm * tstepA + (size_t)cur.kt0 * kstep; const char* cB = (const char*)g.Bt + (size_t)cur.pn * tstepB + (size_t)cur.kt0 * kstep;
    PG8_STAGE(PG8_SB(0, 0), cB, voffB); PG8_STAGE(PG8_SB(0, 1), cB + hstepB, voffB); PG8_STAGE(PG8_SA(0, 0), cA, voffA); PG8_STAGE(PG8_SA(0, 1), cA + hstepA, voffA);
    if (wr == 1) PG8_BAR;
    PG8_WAIT_V(2); PG8_BAR;
    PG8_STAGE(PG8_SB(1, 0), cB + kstep, voffB); PG8_STAGE(PG8_SA(1, 0), cA + kstep, voffA); PG8_STAGE(PG8_SB(1, 1), cB + hstepB + kstep, voffB);
    PG8_WAIT_V(6); PG8_BAR;
    for (;;) {
        const bool has_next = S.next(ui + 1, nxt);
        const char* nA = has_next ? (const char*)g.A + (size_t)nxt.pm * tstepA + (size_t)nxt.kt0 * kstep : cA; const char* nB = has_next ? (const char*)g.Bt + (size_t)nxt.pn * tstepB + (size_t)nxt.kt0 * kstep : cB;
        const int nt = cur.nkt; const bool full = !cur.half;
        for (int t = 0; t < nt; t += 2) {
            const bool last = (t == nt - 2);
            if constexpr (Epi::HAS_MID) { if (!cur.half && t == (nt >> 1)) E.mid(acc, cur, wr, wc, fr, fq); }
            const char* a1 = cA + (size_t)(t + 1) * kstep;
            const char* a2 = last ? nA : cA + (size_t)(t + 2) * kstep; const char* b2 = last ? nB : cB + (size_t)(t + 2) * kstep;
            const char* a3 = a2 + kstep; const char* b3 = b2 + kstep;
            PG8_LDB(B0, 0, 0); PG8_LDB(B1, 0, 1); PG8_SCHED; PG8_LDA(At, 0, 0); PG8_STAGE(PG8_SA(1, 1), a1 + hstepA, voffA);
            PG8_WAIT_V(8); PG8_WAIT_L(0); PG8_BAR; PG8_MMA(0, 0, At, B0); PG8_MMA(0, 1, At, B1); PG8_BAR; PG8_SCHED;
            if (full) PG8_LDA(At, 0, 1); PG8_STAGE(PG8_SB(0, 0), b2, voffB); PG8_STAGE(PG8_SB(0, 1), b2 + hstepB, voffB); PG8_STAGE(PG8_SA(0, 0), a2, voffA);
            PG8_WAIT_V(8); PG8_WAIT_L(0); PG8_BAR; if (full) { PG8_MMA(1, 0, At, B0); PG8_MMA(1, 1, At, B1); } PG8_BAR; PG8_SCHED;
            PG8_LDB(B0, 1, 0); PG8_LDB(B1, 1, 1); PG8_SCHED; PG8_LDA(At, 1, 0); PG8_STAGE(PG8_SA(0, 1), a2 + hstepA, voffA);
            PG8_WAIT_V(8); PG8_WAIT_L(0); PG8_BAR; PG8_MMA(0, 0, At, B0); PG8_MMA(0, 1, At, B1); PG8_BAR; PG8_SCHED;
            if (full) PG8_LDA(At, 1, 1); PG8_STAGE(PG8_SB(1, 0), b3, voffB); PG8_STAGE(PG8_SB(1, 1), b3 + hstepB, voffB); PG8_STAGE(PG8_SA(1, 0), a3, voffA);
            PG8_WAIT_V(8); PG8_WAIT_L(0); PG8_BAR; if (full) { PG8_MMA(1, 0, At, B0); PG8_MMA(1, 1, At, B1); } PG8_BAR; PG8_SCHED;
        }
        if (wr == 0) PG8_BAR;
        E(acc, cur, wr, wc, fr, fq);
        if (!has_next) break;
#pragma unroll
        for (int a = 0; a < 2; ++a)
#pragma unroll
            for (int b = 0; b < 2; ++b)
#pragma unroll
                for (int m = 0; m < 4; ++m)
#pragma unroll
                    for (int n = 0; n < 2; ++n) acc[a][b][m][n] = (f32x4){0.f, 0.f, 0.f, 0.f};
        cur = nxt; cA = nA; cB = nB; ++ui;
        if (wr == 1) PG8_BAR;
    }
    PG8_WAIT_V(0);
    PG8_BAR;
#undef PG8_SA
#undef PG8_SB
#undef PG8_STAGE
#undef PG8_LDA
#undef PG8_LDB
#undef PG8_MMA
#undef PG8_WAIT_V
#undef PG8_WAIT_L
#undef PG8_BAR
#undef PG8_SCHED
}
}
using pg8::Unit;

__device__ __forceinline__ u32x4 pack8(const f32x4& v0, const f32x4& v1) {
    u32x4 w; w.x = cvt_pk_bf16(v0[0], v0[1]); w.y = cvt_pk_bf16(v0[2], v0[3]); w.z = cvt_pk_bf16(v1[0], v1[1]); w.w = cvt_pk_bf16(v1[2], v1[3]); return w;
}
__device__ __forceinline__ void unpack8(const u32x4& w, f32x4& v0, f32x4& v1) {
    v0 = (f32x4){bflo(w.x), bfhi(w.x), bflo(w.y), bfhi(w.y)}; v1 = (f32x4){bflo(w.z), bfhi(w.z), bflo(w.w), bfhi(w.w)};
}

struct EpiIn {
    static constexpr bool HAS_MID = false;
    bf16_t* qkvu; bf16_t* gate; float* out;
    __device__ __forceinline__ void operator()(const f32x4 (&acc)[2][2][4][2], const Unit& u, int wr, int wc, int fr, int fq) const {
        const int row0 = u.pm * 256 + wr * 64 + fr, cw = wc * 32 + 8 * fq;
        if (u.pn >= 16) {
            bf16_t* base = gate + (size_t)row0 * 4096 + (u.pn - 16) * 128 + cw;
#pragma unroll
            for (int ai = 0; ai < 2; ++ai)
#pragma unroll
                for (int m = 0; m < 4; ++m) { bf16_t* rowp = base + (size_t)(ai * 128 + m * 16) * 4096;
                    f32x4 r0, r1, b0, b1;
#pragma unroll
                    for (int j = 0; j < 4; ++j) { b0[j] = fmaxf(fast_sigmoid(acc[ai][1][m][0][j]), 1e-30f); b1[j] = fmaxf(fast_sigmoid(acc[ai][1][m][1][j]), 1e-30f);
                        r0[j] = fast_sigmoid(acc[ai][0][m][0][j]) * __builtin_amdgcn_rcpf(b0[j]); r1[j] = fast_sigmoid(acc[ai][0][m][1][j]) * __builtin_amdgcn_rcpf(b1[j]); }
                    *(u32x4*)rowp = pack8(r0, r1); *(u32x4*)(rowp + 2048) = pack8(b0, b1); }
        } else {
            const int sec = u.pn >> 2, cc = (u.pn & 3) * 256 + cw;
            bf16_t* base = qkvu + (size_t)sec * MT * 1024 + (size_t)row0 * 1024 + cc;
#pragma unroll
            for (int ai = 0; ai < 2; ++ai)
#pragma unroll
                for (int m = 0; m < 4; ++m) { bf16_t* rowp = base + (size_t)(ai * 128 + m * 16) * 1024;
#pragma unroll
                    for (int bj = 0; bj < 2; ++bj) *(u32x4*)(rowp + bj * 128) = pack8(acc[ai][bj][m][0], acc[ai][bj][m][1]); }
            if (sec >= 2) {
                const size_t offp = (sec == 2) ? OFF_KP : OFF_VP, offs = (sec == 2) ? OFF_KS : OFF_VS;
#pragma unroll
                for (int ai = 0; ai < 2; ++ai)
#pragma unroll
                    for (int m = 0; m < 4; ++m) { const int row = row0 + ai * 128 + m * 16;
                        if (row < MV) { float* o = out + (row < MP ? offp + (size_t)row * 1024 : offs + (size_t)(row - MP) * 1024) + cc;
#pragma unroll
                            for (int bj = 0; bj < 2; ++bj) { *(f32x4*)(o + bj * 128) = acc[ai][bj][m][0]; *(f32x4*)(o + bj * 128 + 4) = acc[ai][bj][m][1]; } } }
            } else if (sec == 0 && ((u.pm & 15) == 15 || u.pm == 64)) {
#pragma unroll
                for (int ai = 0; ai < 2; ++ai)
#pragma unroll
                    for (int m = 0; m < 4; ++m) { const int row = row0 + ai * 128 + m * 16; long off = -1;
                        if (row < MP) { const int t = row & (SEQ - 1); if (t >= SEQ - 15) off = (long)OFF_PP + ((long)(row >> 12) * 15 + (t - (SEQ - 15))) * 1024; }
                        else if (row < MV) { const int t = (row - MP) & 15, b = (row - MP) >> 4; if (t >= 1) off = (long)OFF_PS + ((long)b * 15 + (t - 1)) * 1024; }
                        if (off >= 0) { float* o = out + off + cc;
#pragma unroll
                            for (int bj = 0; bj < 2; ++bj) { *(f32x4*)(o + bj * 128) = acc[ai][bj][m][0]; *(f32x4*)(o + bj * 128 + 4) = acc[ai][bj][m][1]; } } }
            }
        }
    }
};
constexpr int MG_SPLIT = 4, MG_KT = (2048 / 64) / MG_SPLIT;
struct EpiMerged {
    static constexpr bool HAS_MID = true;
    const bf16_t* gate; bf16_t* merged; float* part;
    __device__ __forceinline__ void mid(f32x4 (&acc)[2][2][4][2], const Unit& u, int wr, int wc, int fr, int fq) const {
        int zoff = 0; asm volatile("" : "+v"(zoff));
        const int row0 = u.pm * 256 + wr * 64 + fr + zoff, cc = u.pn * 256 + wc * 32 + 8 * fq;
#pragma unroll
        for (int ai = 0; ai < 2; ++ai) {
            if (ai == 1 && u.half) break;
            u32x4 rw[4][2];
#pragma unroll
            for (int m = 0; m < 4; ++m)
#pragma unroll
                for (int bj = 0; bj < 2; ++bj) rw[m][bj] = *(const u32x4*)(gate + (size_t)(row0 + ai * 128 + m * 16) * 4096 + cc + bj * 128);
#pragma unroll
            for (int m = 0; m < 4; ++m)
#pragma unroll
                for (int bj = 0; bj < 2; ++bj) { f32x4 a0, a1; unpack8(rw[m][bj], a0, a1); acc[ai][bj][m][0] *= a0; acc[ai][bj][m][1] *= a1; }
            __builtin_amdgcn_sched_barrier(0);
        }
    }
    __device__ __forceinline__ void operator()(const f32x4 (&acc)[2][2][4][2], const Unit& u, int wr, int wc, int fr, int fq) const {
        const int row0 = u.pm * 256 + wr * 64 + fr, cc = u.pn * 256 + wc * 32 + 8 * fq;
        if (u.half) {
            float* ps = part + ((size_t)(u.kt0 / MG_KT) * MS + (row0 - MP)) * D + cc;
#pragma unroll
            for (int m = 0; m < 4; ++m)
#pragma unroll
                for (int bj = 0; bj < 2; ++bj) { *(f32x4*)(ps + (size_t)(m * 16) * D + bj * 128) = acc[0][bj][m][0]; *(f32x4*)(ps + (size_t)(m * 16) * D + bj * 128 + 4) = acc[0][bj][m][1]; }
            return; }
#pragma unroll
        for (int ai = 0; ai < 2; ++ai)
#pragma unroll
            for (int m = 0; m < 4; ++m) { const int row = row0 + ai * 128 + m * 16;
                const bf16_t* gp = gate + (size_t)row * 4096 + 2048 + cc; bf16_t* o = merged + (size_t)row * D + cc;
#pragma unroll
                for (int bj = 0; bj < 2; ++bj) { const u32x4 gw = *(const u32x4*)(gp + bj * 128); f32x4 g0, g1; unpack8(gw, g0, g1);
                    *(u32x4*)(o + bj * 128) = pack8(acc[ai][bj][m][0] * g0, acc[ai][bj][m][1] * g1); } }
    }
};
constexpr int OUT_SPLIT = 4, OUT_KT = (D / 64) / OUT_SPLIT;
struct EpiOut {
    static constexpr bool HAS_MID = false;
    const float* xp; const float* xs; float* y; bf16_t* hb; float* ssq; float* part;
    __device__ __forceinline__ void operator()(const f32x4 (&acc)[2][2][4][2], const Unit& u, int wr, int wc, int fr, int fq) const {
        int zoff = 0; asm volatile("" : "+v"(zoff));
        const int row0 = u.pm * 256 + wr * 64 + fr + zoff, cc = u.pn * 256 + wc * 32 + 8 * fq;
        if (u.half) {
            float* ps = part + ((size_t)(u.kt0 / OUT_KT) * MS + (row0 - MP)) * D + cc;
#pragma unroll
            for (int m = 0; m < 4; ++m)
#pragma unroll
                for (int bj = 0; bj < 2; ++bj) { *(f32x4*)(ps + (size_t)(m * 16) * D + bj * 128) = acc[0][bj][m][0]; *(f32x4*)(ps + (size_t)(m * 16) * D + bj * 128 + 4) = acc[0][bj][m][1]; }
            return; }
#pragma unroll
        for (int ai = 0; ai < 2; ++ai) {
            if (ai == 1 && u.half) break;
            f32x4 xv[4][2][2];
#pragma unroll
            for (int m = 0; m < 4; ++m) { const int row = row0 + ai * 128 + m * 16; const bool ok = row < MV;
                const float* xr = (row < MP ? xp + (size_t)row * D : xs + (size_t)(ok ? row - MP : 0) * D) + cc;
#pragma unroll
                for (int bj = 0; bj < 2; ++bj) { xv[m][bj][0] = *(const f32x4*)(xr + bj * 128); xv[m][bj][1] = *(const f32x4*)(xr + bj * 128 + 4); } }
            __builtin_amdgcn_sched_barrier(0);
#pragma unroll
            for (int m = 0; m < 4; ++m) { const int row = row0 + ai * 128 + m * 16; const bool ok = row < MV;
                bf16_t* ob = hb + (size_t)row * D + cc;
                float s = 0.f;
#pragma unroll
                for (int bj = 0; bj < 2; ++bj) { f32x4 h0 = acc[ai][bj][m][0], h1 = acc[ai][bj][m][1];
                    if (ok) { h0 += xv[m][bj][0]; h1 += xv[m][bj][1]; }
                    *(u32x4*)(ob + bj * 128) = pack8(h0, h1);
                    s += (h0[0] * h0[0] + h0[1] * h0[1]) + (h0[2] * h0[2] + h0[3] * h0[3]) + (h1[0] * h1[0] + h1[1] * h1[1]) + (h1[2] * h1[2] + h1[3] * h1[3]); }
                s += __shfl_xor(s, 16); s += __shfl_xor(s, 32);
                if (fq == 0) ssq[(size_t)(u.pn * 4 + wc) * MT + row] = s; }
            __builtin_amdgcn_sched_barrier(0);
        }
    }
};
struct EpiGU {
    static constexpr bool HAS_MID = false;
    const LAS float* tab; bf16_t* hid;
    __device__ __forceinline__ void operator()(const f32x4 (&acc)[2][2][4][2], const Unit& u, int wr, int wc, int fr, int fq) const {
        const int row0 = u.pm * 256 + wr * 64 + fr, cc = u.pn * 128 + wc * 32 + 8 * fq;
#pragma unroll
        for (int ai = 0; ai < 2; ++ai)
#pragma unroll
            for (int m = 0; m < 4; ++m) { const int row = row0 + ai * 128 + m * 16;
                const float sc = tab[(u.half ? 256 : 0) + ((ai * 128 + wr * 64 + m * 16 + fr) & (u.half ? 127 : 255))];
                f32x4 r0, r1;
#pragma unroll
                for (int j = 0; j < 4; ++j) { const float g0 = acc[ai][0][m][0][j] * sc, u0 = acc[ai][1][m][0][j] * sc, g1 = acc[ai][0][m][1][j] * sc, u1 = acc[ai][1][m][1][j] * sc;
                    r0[j] = g0 * fast_sigmoid(g0) * u0; r1[j] = g1 * fast_sigmoid(g1) * u1; }
                *(u32x4*)(hid + (size_t)row * FF + cc) = pack8(r0, r1); }
    }
};
constexpr int DN_SPLIT = 11, DN_KT = (FF / 64) / DN_SPLIT;
struct EpiDown {
    static constexpr bool HAS_MID = false;
    float* y; float* part; const bf16_t* hb; bf16_t* h2b;
    __device__ __forceinline__ void operator()(const f32x4 (&acc)[2][2][4][2], const Unit& u, int wr, int wc, int fr, int fq) const {
        const int row0 = u.pm * 256 + wr * 64 + fr, cc = u.pn * 256 + wc * 32 + 8 * fq;
#pragma unroll
        for (int ai = 0; ai < 2; ++ai)
#pragma unroll
            for (int m = 0; m < 4; ++m) { const int row = row0 + ai * 128 + m * 16;
                if (row < MV) { float* o = y + (size_t)row * D + cc;
                    if (u.half) {
                        float* ps = part + ((size_t)(u.kt0 / DN_KT) * MS + (row - MP)) * D + cc;
#pragma unroll
                        for (int bj = 0; bj < 2; ++bj) { *(f32x4*)(ps + bj * 128) = acc[ai][bj][m][0]; *(f32x4*)(ps + bj * 128 + 4) = acc[ai][bj][m][1]; }
                    } else {
#pragma unroll
                    for (int bj = 0; bj < 2; ++bj) { const u32x4 hw = *(const u32x4*)(hb + (size_t)row * D + cc + bj * 128); f32x4 h0, h1; unpack8(hw, h0, h1);
                        *(u32x4*)(h2b + (size_t)row * D + cc + bj * 128) = pack8(h0 + acc[ai][bj][m][0], h1 + acc[ai][bj][m][1]); } } } }
    }
};

struct EpiWA {
    static constexpr bool HAS_MID = false;
    bf16_t* dst;
    __device__ __forceinline__ void operator()(const f32x4 (&acc)[2][2][4][2], const Unit& u, int wr, int wc, int fr, int fq) const {
        const int row0 = u.pm * 256 + wr * 64 + fr, cc = wc * 32 + 8 * fq;
#pragma unroll
        for (int ai = 0; ai < 2; ++ai)
#pragma unroll
            for (int m = 0; m < 4; ++m) { bf16_t* o = dst + (size_t)(row0 + ai * 128 + m * 16) * 2048 + cc;
#pragma unroll
                for (int bj = 0; bj < 2; ++bj) *(u32x4*)(o + bj * 128) = pack8(acc[ai][bj][m][0], acc[ai][bj][m][1]); }
    }
};

__device__ __forceinline__ void p0_item(const float* W, int N, int k0, int n0, const float* gsc, bf16_t* dst, int ldd, int drow0, int dcol0, LAS float* scr, int lane) {
    const float* wp = W + (size_t)k0 * N + n0 + lane;
    float v[64];
#pragma unroll
    for (int i = 0; i < 64; ++i) v[i] = wp[(size_t)i * N];
    if (gsc) {
#pragma unroll
        for (int i = 0; i < 64; ++i) v[i] *= gsc[k0 + i]; }
#pragma unroll
    for (int i = 0; i < 64; ++i) scr[i * 65 + lane] = v[i];
    asm volatile("s_waitcnt lgkmcnt(0)" ::: "memory");
    const int c = lane & 7;
#pragma unroll
    for (int j = 0; j < 8; ++j) { const int n = (lane >> 3) + 8 * j; const LAS float* s = scr + (8 * c) * 65 + n;
        u32x4 o; o.x = cvt_pk_bf16(s[0 * 65], s[1 * 65]); o.y = cvt_pk_bf16(s[2 * 65], s[3 * 65]); o.z = cvt_pk_bf16(s[4 * 65], s[5 * 65]); o.w = cvt_pk_bf16(s[6 * 65], s[7 * 65]);
        *(u32x4*)(dst + (size_t)(drow0 + n) * ldd + dcol0 + k0 + 8 * c) = o; }
    asm volatile("s_waitcnt lgkmcnt(0)" ::: "memory");
}

struct Params {
    const float *x_prompt, *x_sample, *cache_k, *cache_v, *state_pool, *g_mix, *w_in, *w_pool, *s_pool, *w_branch, *w_out, *g_ffn, *w_gate_up, *w_down, *g_final;
    float* out; unsigned char* ws; int ph_lo, ph_hi;
};

__device__ __forceinline__ void xn_row(const Params& p, int m, int lane);
__device__ __forceinline__ void phase0(const Params& p, LAS unsigned char* lds, int gw, int NGW, int wave, int lane, unsigned xcc) {
    LAS float* scr = (LAS float*)(lds + wave * 16640);
    bf16_t* Wt_in = (bf16_t*)(p.ws + WS_WIN); bf16_t* Wt_br = (bf16_t*)(p.ws + WS_WBR); bf16_t* Wt_out = (bf16_t*)(p.ws + WS_WOUT);
    bf16_t* Wt_gu = (bf16_t*)(p.ws + WS_WGU); bf16_t* Wt_dn = (bf16_t*)(p.ws + WS_WDN); bf16_t* XN = (bf16_t*)(p.ws + WS_XN);
    bf16_t* TMPA = (bf16_t*)(p.ws + WS_TMPA); bf16_t* WPB = (bf16_t*)(p.ws + WS_WPB);
    constexpr int I_IN = (D / 64) * (NIN / 64), I_BR = (D / 64) * (D / 64), I_OUT = (D / 64) * (D / 64), I_GU = (D / 64) * (NGU / 64), I_DN = (FF / 64) * (D / 64);
    constexpr int NITEMS = I_IN + I_BR + I_OUT + I_GU + I_DN;
    unsigned* ctr = (unsigned*)(p.ws + WS_BAR) + 3648 + 64 * (xcc & 7);
    constexpr int NXN = MT / 2;
    for (;;) {
        unsigned kq = 0; if (lane == 0) kq = __hip_atomic_fetch_add(ctr, 1u, __ATOMIC_RELAXED, __HIP_MEMORY_SCOPE_AGENT);
        const int it = 8 * (int)__builtin_amdgcn_readfirstlane(kq) + (int)(xcc & 7);
        if (it >= NITEMS + NXN) break;
        if (it >= NITEMS) { xn_row(p, 2 * (it - NITEMS), lane); xn_row(p, 2 * (it - NITEMS) + 1, lane); continue; }
        int r = it;
        if (r < I_IN) { const int nb = NIN / 64; const int n0 = 64 * (r % nb); int drow = n0;
            if (n0 >= 4096) { const int q = n0 - 4096; drow = q < 2048 ? 4096 + (q / 128) * 256 + (q % 128) : 4096 + ((q - 2048) / 128) * 256 + 128 + ((q - 2048) % 128); }
            p0_item(p.w_in, NIN, 64 * (r / nb), n0, p.g_mix, Wt_in, D, drow, 0, scr, lane); continue; } r -= I_IN;
        if (r < I_BR) { const int nb = D / 64; const int k0 = 64 * (r / nb), n0 = 64 * (r % nb);
            if (k0 < 1024) p0_item(p.w_branch, D, k0, n0, p.s_pool, TMPA, 1024, n0, 0, scr, lane);
            else p0_item(p.w_branch, D, k0, n0, nullptr, Wt_br, 2048, n0, 0, scr, lane);
            continue; } r -= I_BR;
        if (r < I_OUT) { const int nb = D / 64; p0_item(p.w_out, D, 64 * (r / nb), 64 * (r % nb), nullptr, Wt_out, D, 64 * (r % nb), 0, scr, lane); continue; } r -= I_OUT;
        if (r < I_GU) { const int nb = NGU / 64; const int n0 = 64 * (r % nb); const int drow = n0 < FF ? (n0 / 128) * 256 + (n0 % 128) : ((n0 - FF) / 128) * 256 + 128 + ((n0 - FF) % 128);
            p0_item(p.w_gate_up, NGU, 64 * (r / nb), n0, p.g_ffn, Wt_gu, D, drow, 0, scr, lane); continue; } r -= I_GU;
        { const int nb = D / 64; p0_item(p.w_down, D, 64 * (r / nb), 64 * (r % nb), nullptr, Wt_dn, FF, 64 * (r % nb), 0, scr, lane); }
    }
}
__device__ __forceinline__ void xn_row(const Params& p, int m, int lane) {
    bf16_t* XN = (bf16_t*)(p.ws + WS_XN);
    u32x2* o8 = (u32x2*)(XN + (size_t)m * D) + lane;
    if (m >= MV) {
#pragma unroll
        for (int j = 0; j < 8; ++j) o8[64 * j] = (u32x2){0u, 0u};
        return; }
    const f32x4* xr = (const f32x4*)(m < MP ? p.x_prompt + (size_t)m * D : p.x_sample + (size_t)(m - MP) * D) + lane;
    f32x4 v[8]; float s = 0.f;
#pragma unroll
    for (int j = 0; j < 8; ++j) { v[j] = xr[64 * j]; s += (v[j].x * v[j].x + v[j].y * v[j].y) + (v[j].z * v[j].z + v[j].w * v[j].w); }
    const float rs = __builtin_amdgcn_rsqf(wave_sum(s) * (1.0f / D) + EPS);
#pragma unroll
    for (int j = 0; j < 8; ++j) o8[64 * j] = (u32x2){cvt_pk_bf16(v[j].x * rs, v[j].y * rs), cvt_pk_bf16(v[j].z * rs, v[j].w * rs)};
}
__device__ __forceinline__ void phase0b(const Params& p, int gw, int NGW, int lane) {
    bf16_t* WPB = (bf16_t*)(p.ws + WS_WPB);
    for (int i = gw * 64 + lane; i < 4 * 256 * 256 / 8; i += NGW * 64) { const f32x4 a = *(const f32x4*)(p.w_pool + (size_t)i * 8), b = *(const f32x4*)(p.w_pool + (size_t)i * 8 + 4); *(u32x4*)(WPB + (size_t)i * 8) = pack8(a, b); }
    float* ssq = (float*)(p.ws + WS_SSQ);
    for (int i = gw * 64 + lane; i < MT; i += NGW * 64) ssq[i] = 0.f;
}

constexpr int VROW = 320;
__device__ __forceinline__ s16x4 vtr(const LAS unsigned char* p) { typedef short v4i16_t __attribute__((ext_vector_type(4))); return __builtin_bit_cast(s16x4, __builtin_amdgcn_ds_read_tr16_b64_v4i16((LAS v4i16_t*)p)); }
__device__ __forceinline__ bf16x8 cvt8(const f32x4& a, const f32x4& b) { u32x4 w = pack8(a, b); return __builtin_bit_cast(bf16x8, w); }

__device__ __forceinline__ void attn_unit(const Params& p, LAS unsigned char* vl, int unit, int lane) {
    const bf16_t* Ub = (const bf16_t*)(p.ws + WS_QKVU);
    const bf16_t* Qb = Ub + (size_t)MT * 1024; const bf16_t* Kb = Qb + (size_t)MT * 1024; const bf16_t* Vb = Kb + (size_t)MT * 1024;
    bf16_t* AO = (bf16_t*)(p.ws + WS_AO);
    const int n = lane & 31, hh = lane >> 5;
    const bool sample = unit < 64;
    int b, h, qrow0, nblk;
    if (sample) { b = unit >> 3; h = unit & 7; qrow0 = MP + b * DSEQ; nblk = 1 + PAST / 32; }
    else { const int u2 = unit - 64; const int qb = u2 & 127; h = (u2 >> 7) & 7; b = u2 >> 10; qrow0 = b * SEQ + qb * 32; nblk = qb + 1; }
    bf16x8 qf[8];
    { const bf16_t* qp = Qb + (size_t)(qrow0 + n) * 1024 + h * HD + 64 * hh;
#pragma unroll
      for (int kk = 0; kk < 8; ++kk) qf[kk] = *(const bf16x8*)(qp + 8 * kk); }
    f32x16 o[4];
#pragma unroll
    for (int db = 0; db < 4; ++db)
#pragma unroll
        for (int r = 0; r < 16; ++r) o[db][r] = 0.f;
    float R = (sample && n >= DSEQ) ? -1e30f : 0.f;
    const float* ck = p.cache_k + (size_t)b * PAST * 1024 + h * HD; const float* cv = p.cache_v + (size_t)b * PAST * 1024 + h * HD;
    const int vaddr = (4 * hh + ((lane & 15) >> 2)) * VROW + (16 * ((lane >> 4) & 1) + 4 * (lane & 3)) * 2;
    for (int blk = 0; blk < nblk; ++blk) {
        bf16x8 kf[8];
        const bool diag = (blk == 0);
        if (!sample || blk == 0) {
            const int s0 = qrow0 - blk * 32;
            const bf16_t* kp = Kb + (size_t)(s0 + n) * 1024 + h * HD + 64 * hh;
#pragma unroll
            for (int kk = 0; kk < 8; ++kk) kf[kk] = *(const bf16x8*)(kp + 8 * kk);
            const bf16_t* vp = Vb + (size_t)(s0 + (lane >> 4)) * 1024 + h * HD + 8 * (lane & 15);
#pragma unroll
            for (int it = 0; it < 8; ++it) { const u32x4 w = *(const u32x4*)(vp + (size_t)(4 * it) * 1024); *(LAS u32x4*)(vl + (4 * it + (lane >> 4)) * VROW + 16 * (lane & 15)) = w; }
        } else {
            const int s0 = PAST - blk * 32;
            const float* kp = ck + (size_t)(s0 + n) * 1024 + 64 * hh;
#pragma unroll
            for (int kk = 0; kk < 8; ++kk) kf[kk] = cvt8(*(const f32x4*)(kp + 8 * kk), *(const f32x4*)(kp + 8 * kk + 4));
            const float* vp = cv + (size_t)(s0 + (lane >> 4)) * 1024 + 8 * (lane & 15);
#pragma unroll
            for (int it = 0; it < 8; ++it) { const f32x4 a = *(const f32x4*)(vp + (size_t)(4 * it) * 1024), c = *(const f32x4*)(vp + (size_t)(4 * it) * 1024 + 4);
                *(LAS u32x4*)(vl + (4 * it + (lane >> 4)) * VROW + 16 * (lane & 15)) = pack8(a, c); }
        }
        f32x16 st;
#pragma unroll
        for (int r = 0; r < 16; ++r) st[r] = 0.f;
#pragma unroll
        for (int kk = 0; kk < 8; ++kk) st = __builtin_amdgcn_mfma_f32_32x32x16_bf16(kf[kk], qf[kk], st, 0, 0, 0);
        float l1m[16], ls[16];
#pragma unroll
        for (int r = 0; r < 16; ++r) { const int i = (r & 3) + 8 * (r >> 2) + 4 * hh; const bool valid = !diag || (i < n);
            const float z = st[r] * 0.08838834764831845f; const float sp = fmaxf(z, 0.f) + __logf(1.0f + __expf(-fabsf(z)));
            l1m[r] = valid ? -sp : 0.f; ls[r] = valid ? (z - sp) : -1e30f; }
        float gown[4], goth[4];
#pragma unroll
        for (int a = 0; a < 4; ++a) { gown[a] = (l1m[4 * a] + l1m[4 * a + 1]) + (l1m[4 * a + 2] + l1m[4 * a + 3]); goth[a] = __shfl_xor(gown[a], 32); }
        float wv[16]; float tail = R;
#pragma unroll
        for (int a = 3; a >= 0; --a) { float sfx = tail + (hh == 0 ? goth[a] : 0.f);
#pragma unroll
            for (int rr = 3; rr >= 0; --rr) { wv[4 * a + rr] = __expf(ls[4 * a + rr] + sfx); sfx += l1m[4 * a + rr]; }
            tail += gown[a] + goth[a]; }
        R = tail;
        bf16x8 wb[2];
#pragma unroll
        for (int s = 0; s < 2; ++s) wb[s] = cvt8((f32x4){wv[8 * s], wv[8 * s + 1], wv[8 * s + 2], wv[8 * s + 3]}, (f32x4){wv[8 * s + 4], wv[8 * s + 5], wv[8 * s + 6], wv[8 * s + 7]});
        asm volatile("s_waitcnt lgkmcnt(0)" ::: "memory");
#pragma unroll
        for (int db = 0; db < 4; ++db)
#pragma unroll
            for (int s = 0; s < 2; ++s) { const s16x4 lo = vtr(vl + vaddr + (16 * s) * VROW + 64 * db), hi = vtr(vl + vaddr + (16 * s + 8) * VROW + 64 * db);
                const bf16x8 vf = (bf16x8){lo[0], lo[1], lo[2], lo[3], hi[0], hi[1], hi[2], hi[3]};
                o[db] = __builtin_amdgcn_mfma_f32_32x32x16_bf16(vf, wb[s], o[db], 0, 0, 0); }
        asm volatile("s_waitcnt lgkmcnt(0)" ::: "memory");
        if (__all(R < -104.0f)) break;
    }
    if (!sample || n < DSEQ) {
        bf16_t* op = AO + (size_t)(qrow0 + n) * 2048 + 1024 + h * HD + 4 * hh;
#pragma unroll
        for (int db = 0; db < 4; ++db)
#pragma unroll
            for (int a = 0; a < 4; ++a) *(u32x2*)(op + 32 * db + 8 * a) = (u32x2){cvt_pk_bf16(o[db][4 * a], o[db][4 * a + 1]), cvt_pk_bf16(o[db][4 * a + 2], o[db][4 * a + 3])};
    }
}

constexpr int AKROW = 272, AVROW = 288, AKB = 32 * AKROW, AVB = 32 * AVROW, AFLAG = 2 * AKB + 2 * AVB;
__device__ __forceinline__ void attn_wg_unit(const Params& p, LAS unsigned char* lds, int wgu, int wave, int lane) {
    const bf16_t* Ub = (const bf16_t*)(p.ws + WS_QKVU);
    const bf16_t* Qb = Ub + (size_t)MT * 1024; const bf16_t* Kb = Qb + (size_t)MT * 1024; const bf16_t* Vb = Kb + (size_t)MT * 1024;
    bf16_t* AO = (bf16_t*)(p.ws + WS_AO);
    const int n = lane & 31, hh = lane >> 5;
    const int qg = wgu & 15, h = (wgu >> 4) & 7, b = wgu >> 7;
    const int qtop = qg * 8 + 7, qbw = qg * 8 + wave, qrow0 = b * SEQ + qbw * 32;
    bf16x8 qf[8];
    { const bf16_t* qp = Qb + (size_t)(qrow0 + n) * 1024 + h * HD + 64 * hh;
#pragma unroll
      for (int kk = 0; kk < 8; ++kk) qf[kk] = *(const bf16x8*)(qp + 8 * kk); }
    f32x16 o[4];
#pragma unroll
    for (int db = 0; db < 4; ++db)
#pragma unroll
        for (int r = 0; r < 16; ++r) o[db][r] = 0.f;
    float R = 0.f; bool done = false;
    LAS int* flags = (LAS int*)(lds + AFLAG);
    const int lrow = 4 * wave + (lane >> 4), lch = lane & 15;
    const size_t gbase = ((size_t)b * SEQ + lrow) * 1024 + h * HD + 8 * lch;
    const int vaddr = (4 * hh + ((lane & 15) >> 2)) * AVROW + (16 * ((lane >> 4) & 1) + 4 * (lane & 3)) * 2;
    u32x4 kr = *(const u32x4*)(Kb + gbase + (size_t)qtop * 32 * 1024), vr = *(const u32x4*)(Vb + gbase + (size_t)qtop * 32 * 1024);
    for (int s = 0; s <= qtop; ++s) {
        const int kb = qtop - s, bo = s & 1;
        *(LAS u32x4*)(lds + bo * AKB + lrow * AKROW + 16 * lch) = kr;
        *(LAS u32x4*)(lds + 2 * AKB + bo * AVB + lrow * AVROW + 16 * lch) = vr;
        if (kb > 0) { kr = *(const u32x4*)(Kb + gbase + (size_t)(kb - 1) * 32 * 1024); vr = *(const u32x4*)(Vb + gbase + (size_t)(kb - 1) * 32 * 1024); }
        asm volatile("s_waitcnt lgkmcnt(0)" ::: "memory"); __builtin_amdgcn_s_barrier(); asm volatile("" ::: "memory");
        if (s >= 8) {
            int all = 1;
#pragma unroll
            for (int w = 0; w < 8; ++w) all &= flags[((s - 1) & 1) * 8 + w];
            if (__builtin_amdgcn_readfirstlane(all)) break;
        }
        if (!done && kb <= qbw) {
            const LAS unsigned char* kl = lds + bo * AKB + n * AKROW + 128 * hh; const LAS unsigned char* vl = lds + 2 * AKB + bo * AVB;
            f32x16 st;
#pragma unroll
            for (int r = 0; r < 16; ++r) st[r] = 0.f;
            { bf16x8 kf[8];
#pragma unroll
              for (int kk = 0; kk < 8; ++kk) kf[kk] = *(const LAS bf16x8*)(kl + 16 * kk);
#pragma unroll
              for (int kk = 0; kk < 8; ++kk) st = __builtin_amdgcn_mfma_f32_32x32x16_bf16(kf[kk], qf[kk], st, 0, 0, 0); }
            const bool diag = (kb == qbw);
            float l1m[16];
#pragma unroll
            for (int r = 0; r < 16; ++r) { const int i = (r & 3) + 8 * (r >> 2) + 4 * hh; const bool valid = !diag || (i < n);
                const float z = st[r] * 0.08838834764831845f; const float sp = fmaxf(z, 0.f) + __logf(1.0f + __expf(-fabsf(z)));
                l1m[r] = valid ? -sp : 0.f; st[r] = valid ? (z - sp) : -1e30f; }
            float gown[4], goth[4];
#pragma unroll
            for (int a = 0; a < 4; ++a) { gown[a] = (l1m[4 * a] + l1m[4 * a + 1]) + (l1m[4 * a + 2] + l1m[4 * a + 3]); goth[a] = __shfl_xor(gown[a], 32); }
            float tail = R;
#pragma unroll
            for (int a = 3; a >= 0; --a) { float sfx = tail + (hh == 0 ? goth[a] : 0.f);
#pragma unroll
                for (int rr = 3; rr >= 0; --rr) { st[4 * a + rr] = __expf(st[4 * a + rr] + sfx); sfx += l1m[4 * a + rr]; }
                tail += gown[a] + goth[a]; }
            R = tail;
            bf16x8 wb[2];
#pragma unroll
            for (int q = 0; q < 2; ++q) wb[q] = cvt8((f32x4){st[8 * q], st[8 * q + 1], st[8 * q + 2], st[8 * q + 3]}, (f32x4){st[8 * q + 4], st[8 * q + 5], st[8 * q + 6], st[8 * q + 7]});
#pragma unroll
            for (int db = 0; db < 4; ++db)
#pragma unroll
                for (int q = 0; q < 2; ++q) { const s16x4 lo = vtr(vl + vaddr + (16 * q) * AVROW + 64 * db), hi = vtr(vl + vaddr + (16 * q + 8) * AVROW + 64 * db);
                    const bf16x8 vf = (bf16x8){lo[0], lo[1], lo[2], lo[3], hi[0], hi[1], hi[2], hi[3]};
                    o[db] = __builtin_amdgcn_mfma_f32_32x32x16_bf16(vf, wb[q], o[db], 0, 0, 0); }
            if (__all(R < -104.0f)) done = true;
        }
        if (lane == 0) flags[(s & 1) * 8 + wave] = done ? 1 : 0;
    }
    { bf16_t* op = AO + (size_t)(qrow0 + n) * 2048 + 1024 + h * HD + 4 * hh;
#pragma unroll
      for (int db = 0; db < 4; ++db)
#pragma unroll
          for (int a = 0; a < 4; ++a) *(u32x2*)(op + 32 * db + 8 * a) = (u32x2){cvt_pk_bf16(o[db][4 * a], o[db][4 * a + 1]), cvt_pk_bf16(o[db][4 * a + 2], o[db][4 * a + 3])}; }
    asm volatile("s_waitcnt lgkmcnt(0)" ::: "memory"); __builtin_amdgcn_s_barrier(); asm volatile("" ::: "memory");
}

template <int W>
__device__ __forceinline__ void diff_chunk(const Params& p, int ch, int cc) {
    const bf16_t* Ub = (const bf16_t*)(p.ws + WS_QKVU); bf16_t* AO = (bf16_t*)(p.ws + WS_AO);
    const int m0 = ch * 16; const bool prompt = m0 < MP; const int t0 = prompt ? (m0 & (SEQ - 1)) : PAST;
    const bf16_t* up = Ub + (size_t)m0 * 1024 + cc * 8;
    u32x4 raw[15 + W];
#pragma unroll
    for (int r = 0; r < 16; ++r) raw[W - 1 + r] = *(const u32x4*)(up + (size_t)r * 1024);
    if (prompt) {
#pragma unroll
        for (int j = 1; j < W; ++j) { const u32x4 v = *(const u32x4*)(t0 > 0 ? up - (size_t)j * 1024 : up); raw[W - 1 - j] = (t0 > 0) ? v : (u32x4){0u, 0u, 0u, 0u}; }
    } else { const float* hp = p.state_pool + (size_t)((m0 - MP) >> 4) * 15 * 1024 + cc * 8;
#pragma unroll
        for (int j = 1; j < W; ++j) raw[W - 1 - j] = pack8(*(const f32x4*)(hp + (size_t)(15 - j) * 1024), *(const f32x4*)(hp + (size_t)(15 - j) * 1024 + 4)); }
    f32x4 s0 = (f32x4){0.f, 0.f, 0.f, 0.f}, s1 = s0;
#pragma unroll
    for (int j = 1; j < W; ++j) { f32x4 a, c; unpack8(raw[W - 1 - j], a, c); s0 += a; s1 += c; }
#pragma unroll
    for (int r = 0; r < 16; ++r) { f32x4 a, c; unpack8(raw[W - 1 + r], a, c); s0 += a; s1 += c;
        const int t = t0 + r; const float ic = 1.0f / (float)(t + 1 < W ? t + 1 : W);
        *(u32x4*)(AO + (size_t)(m0 + r) * 2048 + cc * 8) = pack8(s0 * ic - a, s1 * ic - c);
        f32x4 da, dc; unpack8(raw[r], da, dc); s0 -= da; s1 -= dc; }
}
constexpr int N_ATT_UNITS = 64, N_DIFF_ITEMS = (MV / 32) * 4, N_P2_ITEMS = N_ATT_UNITS + N_DIFF_ITEMS;
__device__ __forceinline__ void diff_item(const Params& p, int wi, int lane) {
    const int g = wi & 3, ch = 2 * (wi >> 2) + (lane >> 5), cc = 32 * g + (lane & 31);
    if (g == 0) diff_chunk<2>(p, ch, cc); else if (g == 1) diff_chunk<4>(p, ch, cc); else if (g == 2) diff_chunk<8>(p, ch, cc); else diff_chunk<16>(p, ch, cc);
}

__global__ void __launch_bounds__(512, 2) fwd_megakernel(Params p) {
    extern __shared__ __attribute__((aligned(16))) unsigned char lds_raw[];
    LAS unsigned char* lds = (LAS unsigned char*)lds_raw;
    const int tid = threadIdx.x, lane = tid & 63, wave = __builtin_amdgcn_readfirstlane(tid >> 6);
    const int G = gridDim.x, bx = blockIdx.x;
    const int vcu = (G % 8 == 0) ? (bx % 8) * (G / 8) + bx / 8 : bx;
    const int gw = vcu * 8 + wave, NGW = G * 8;
    cg::grid_group grid = cg::this_grid();
    volatile LAS unsigned* xst = (volatile LAS unsigned*)(lds + LDS_BYTES - 64);
    if (tid < 2) xst[tid] = 0u;
    __syncthreads();
    XcdBarrier xbar = xcd_barrier_post((unsigned*)(p.ws + WS_BAR), xst);
#define IN(k) (p.ph_lo <= (k) && (k) < p.ph_hi)
#define SEAM(k) do { if (IN(k) && IN((k) + 1)) { if (p.ph_hi > 64) grid.sync();   xcd_barrier(xbar); } STAMP(); } while (0)
    bf16_t* Wt_in = (bf16_t*)(p.ws + WS_WIN); bf16_t* Wt_br = (bf16_t*)(p.ws + WS_WBR); bf16_t* Wt_out = (bf16_t*)(p.ws + WS_WOUT);
    bf16_t* Wt_gu = (bf16_t*)(p.ws + WS_WGU); bf16_t* Wt_dn = (bf16_t*)(p.ws + WS_WDN); bf16_t* XN = (bf16_t*)(p.ws + WS_XN);
    bf16_t* QKVU = (bf16_t*)(p.ws + WS_QKVU); bf16_t* GATE = (bf16_t*)(p.ws + WS_GATE); bf16_t* AO = (bf16_t*)(p.ws + WS_AO);
    bf16_t* MERGED = (bf16_t*)(p.ws + WS_MERGED); bf16_t* HID = (bf16_t*)(p.ws + WS_HID); float* SSQ = (float*)(p.ws + WS_SSQ);
    float* Y = p.out + OFF_Y;
#ifdef PROBE_T
    unsigned long long tstamp[10]; int nst = 0;
#define STAMP() do { tstamp[nst++] = __builtin_amdgcn_s_memrealtime(); } while (0)
#else
#define STAMP() do {} while (0)
#endif
    STAMP();

    if (IN(0)) { phase0(p, lds, gw, NGW, wave, lane, xbar.x);
#ifdef PROBE_T
#endif
        phase0b(p, gw, NGW, lane);
    }
    SEAM(0);
    if (IN(1)) { pg8::Gemm g{XN, Wt_in, D, D, MT, NIN, D}; pg8::StaticOrder S; S.init(64, NIN / 256, D / 64, G, bx, 64, 1); EpiIn E{QKVU, GATE, p.out}; pg8::gemm_phase(lds, g, S, E); }
    SEAM(1);
    if (IN(2)) {
        constexpr int NSW = 8;
        if (vcu < NSW) { LAS unsigned char* vl = lds + wave * (32 * VROW); attn_unit(p, vl, vcu * 8 + wave, lane); }
        else { for (int wu = vcu - NSW; wu < 512; wu += G - NSW) attn_wg_unit(p, lds, wu, wave, lane); }
        unsigned* ctr = (unsigned*)(p.ws + WS_BAR) + 3584;
        for (;;) {
            unsigned nx = 0; if (lane == 0) nx = __hip_atomic_fetch_add(ctr, 1u, __ATOMIC_RELAXED, __HIP_MEMORY_SCOPE_AGENT);
            const int item = (int)__builtin_amdgcn_readfirstlane(nx);
            if (item >= N_DIFF_ITEMS) break;
            diff_item(p, item, lane);
        }
        __syncthreads();
        for (int gq = 0; gq < 4; ++gq) { pg8::Gemm g{(const bf16_t*)(p.ws + WS_TMPA) + gq * 256, (const bf16_t*)(p.ws + WS_WPB) + gq * 65536, 1024, 256, 2048, 256, 256};
            pg8::StaticOrder S; S.init(8, 1, 4, G, (bx + G - 8 * gq) % G); EpiWA E{Wt_br + gq * 256}; pg8::gemm_phase(lds, g, S, E); }
    }
    SEAM(2);
    if (IN(3)) {
        { pg8::Gemm g{AO, Wt_br, 2048, 2048, MT, D, 2048}; pg8::StaticOrder S; S.init(64, 8, 32, G, bx, 64, MG_SPLIT); EpiMerged E{GATE, MERGED, (float*)(p.ws + WS_XN)}; pg8::gemm_phase(lds, g, S, E); }
    }
    if (IN(3) && IN(4)) xcd_barrier(xbar);
    if (IN(3)) {
        for (int r = gw; r < MS; r += NGW) {
            const f32x4* pr = (const f32x4*)((const float*)(p.ws + WS_XN) + (size_t)r * D) + lane;
            const u32x2* gr = (const u32x2*)(GATE + (size_t)(MP + r) * 4096) + lane; u32x2* o8 = (u32x2*)(MERGED + (size_t)(MP + r) * D) + lane;
#pragma unroll
            for (int j = 0; j < 8; ++j) { const size_t cs = (size_t)MS * D / 4;
                const f32x4 a = pr[64 * j] + pr[cs + 64 * j], b = pr[2 * cs + 64 * j] + pr[3 * cs + 64 * j];
                const u32x2 rw = gr[64 * j], bw = gr[512 + 64 * j];
                const f32x4 rr = (f32x4){bflo(rw.x), bfhi(rw.x), bflo(rw.y), bfhi(rw.y)}, gb = (f32x4){bflo(bw.x), bfhi(bw.x), bflo(bw.y), bfhi(bw.y)};
                const f32x4 v = gb * (rr * a + b);
                o8[64 * j] = (u32x2){cvt_pk_bf16(v.x, v.y), cvt_pk_bf16(v.z, v.w)}; }
        }
    }
    SEAM(3);
    if (IN(4)) { pg8::Gemm g{MERGED, Wt_out, D, D, MT, D, D}; pg8::StaticOrder S; S.init(64, 8, 32, G, bx, 64, OUT_SPLIT); EpiOut E{p.x_prompt, p.x_sample, Y, XN, (float*)(p.ws + WS_SSQP), (float*)(p.ws + WS_AO)}; pg8::gemm_phase(lds, g, S, E); }
    if (IN(4) && IN(5)) xcd_barrier(xbar);
    if (IN(4)) {
        for (int r = gw; r < MS; r += NGW) {
            const f32x4* xr = (const f32x4*)(p.x_sample + (size_t)r * D) + lane; const f32x4* pr = (const f32x4*)((const float*)(p.ws + WS_AO) + (size_t)r * D) + lane;
            u32x2* o8 = (u32x2*)(XN + (size_t)(MP + r) * D) + lane; float* sp = (float*)(p.ws + WS_SSQP);
            float sq = 0.f;
#pragma unroll
            for (int j = 0; j < 8; ++j) { f32x4 v = xr[64 * j];
#pragma unroll
                for (int c = 0; c < OUT_SPLIT; ++c) v += pr[(size_t)c * MS * D / 4 + 64 * j];
                sq += (v.x * v.x + v.y * v.y) + (v.z * v.z + v.w * v.w);
                o8[64 * j] = (u32x2){cvt_pk_bf16(v.x, v.y), cvt_pk_bf16(v.z, v.w)}; }
            sq = wave_sum(sq);
            if (lane < 32) sp[(size_t)lane * MT + MP + r] = lane == 0 ? sq : 0.f;
        }
    }
    SEAM(4);
    if (IN(5)) { pg8::Gemm g{XN, Wt_gu, D, D, MT, NGU, D}; pg8::StaticOrder S; S.init(64, NGU / 256, 32, G, bx, 64, 1);
        LAS float* tab = (LAS float*)(lds + 131072);
        { pg8::Unit u0; S.next(0, u0); const float* sp = (const float*)(p.ws + WS_SSQP);
          if (tid < 384) { const int row = tid < 256 ? u0.pm * 256 + tid : MP + (tid - 256); float a = 0.f;
#pragma unroll 8
              for (int k = 0; k < 32; ++k) a += sp[(size_t)k * MT + row];
              tab[tid] = __builtin_amdgcn_rsqf(a * (1.0f / D) + EPS); }
          __syncthreads(); }
        EpiGU E{tab, HID}; pg8::gemm_phase(lds, g, S, E); }
    SEAM(5);
    if (IN(6)) { pg8::Gemm g{HID, Wt_dn, FF, FF, MT, D, FF}; pg8::StaticOrder S; S.init(64, 8, FF / 64, G, bx, 64, DN_SPLIT); EpiDown E{Y, (float*)(p.ws + WS_AO), XN, (bf16_t*)(p.ws + WS_H2B)}; pg8::gemm_phase(lds, g, S, E); }
    SEAM(6);
    if (IN(7)) {
        for (int m = gw; m < MV; m += NGW) {
            f32x4* yr = (f32x4*)(Y + (size_t)m * D) + lane; const f32x4* gf = (const f32x4*)p.g_final + lane;
            f32x4 v[8]; float s = 0.f;
            {
                const u32x2* hr = (const u32x2*)((m < MP ? (const bf16_t*)(p.ws + WS_H2B) : (const bf16_t*)XN) + (size_t)m * D) + lane;
#pragma unroll
                for (int j = 0; j < 8; ++j) { const u32x2 w2 = hr[64 * j]; v[j] = (f32x4){bflo(w2.x), bfhi(w2.x), bflo(w2.y), bfhi(w2.y)}; } }
            if (m >= MP) { const f32x4* pr = (const f32x4*)((const float*)(p.ws + WS_AO) + (size_t)(m - MP) * D) + lane;
                for (int c = 0; c < DN_SPLIT; ++c)
#pragma unroll
                    for (int j = 0; j < 8; ++j) v[j] += pr[(size_t)c * MS * D / 4 + 64 * j]; }
#pragma unroll
            for (int j = 0; j < 8; ++j) s += (v[j].x * v[j].x + v[j].y * v[j].y) + (v[j].z * v[j].z + v[j].w * v[j].w);
            const float rs = __builtin_amdgcn_rsqf(wave_sum(s) * (1.0f / D) + EPS);
#pragma unroll
            for (int j = 0; j < 8; ++j) yr[64 * j] = v[j] * rs * gf[64 * j];
        }
    }
#ifdef PROBE_T
    STAMP();
    if (bx == 0 && tid == 0) {
        const unsigned long long e1 = (unsigned long long)__hip_atomic_load((long long*)(p.ws + WS_SSQ + 512 * 1024), __ATOMIC_RELAXED, __HIP_MEMORY_SCOPE_AGENT);
        const unsigned long long e2 = (unsigned long long)__hip_atomic_load((long long*)(p.ws + WS_SSQ + 512 * 1024 + 256), __ATOMIC_RELAXED, __HIP_MEMORY_SCOPE_AGENT);
        (void)e1; (void)e2;
        const float ta = (float)(tstamp[PROBE_A + 1] - tstamp[PROBE_A]) * 0.01f, tb = (float)(tstamp[PROBE_B + 1] - tstamp[PROBE_B]) * 0.01f;
        asm volatile("s_waitcnt vmcnt(0)" ::: "memory");
        atomicAdd(Y, 4.0f + ta * (1.0f / 256.0f)); atomicAdd(p.out + OFF_PP, 1.5f + tb * (1.0f / 500.0f));
    }
#endif
#undef IN
#undef SEAM
}

extern "C" void kernel_launch(void* const* d_in, const int* in_sizes, int n_in, void* d_out, int out_size, void* d_ws, size_t ws_size, hipStream_t stream) {
    static int grid = 0;
    if (grid == 0) {
        if (n_in != 15 || (size_t)out_size != OUT_TOTAL || ws_size < WS_END) { fprintf(stderr, "kernel_launch: unexpected shapes: n_in %d out %d ws %zu\n", n_in, out_size, ws_size); grid = -1; return; }
        int dev = 0, cus = 0, per_cu = 0;
        hipGetDevice(&dev); hipDeviceGetAttribute(&cus, hipDeviceAttributeMultiprocessorCount, dev);
        hipFuncSetAttribute((const void*)fwd_megakernel, hipFuncAttributeMaxDynamicSharedMemorySize, LDS_BYTES);
        hipOccupancyMaxActiveBlocksPerMultiprocessor(&per_cu, (const void*)fwd_megakernel, 512, LDS_BYTES);
        if (per_cu < 1) { fprintf(stderr, "kernel_launch: occupancy query says %d blocks per CU\n", per_cu); per_cu = 1; }
        (void)hipGetLastError();
        grid = cus;
    }
    if (grid < 0) return;
    Params p{};
    const float** pp = (const float**)&p;
    for (int i = 0; i < 15; ++i) pp[i] = (const float*)d_in[i];
    p.out = (float*)d_out; p.ws = (unsigned char*)d_ws;
#if N_LAUNCH_MODE == 1
    p.ph_lo = 0; p.ph_hi = 8;
    void* args[] = {&p};
    if (hipMemsetAsync((char*)d_ws + WS_BAR, 0, WS_BAR_BYTES, stream) != hipSuccess) fprintf(stderr, "kernel_launch: memset of the barrier words failed\n");
    hipError_t e = hipLaunchCooperativeKernel((const void*)fwd_megakernel, dim3(grid), dim3(512), args, LDS_BYTES, stream);
    if (e != hipSuccess) fprintf(stderr, "cooperative launch failed: %s (grid %d)\n", hipGetErrorString(e), grid);
#else
    for (int ph = 0; ph < 8; ++ph) { p.ph_lo = ph; p.ph_hi = ph + 1; hipLaunchKernelGGL(fwd_megakernel, dim3(grid), dim3(512), LDS_BYTES, stream, p); }
#endif
}
```

```cpp
#include <hip/hip_runtime.h>
#include <hip/hip_cooperative_groups.h>
#include <cstdio>
#include <cstdint>
namespace cg = cooperative_groups;

#define PROBE_A 6
#define PROBE_B 4
#ifndef N_LAUNCH_MODE
#define N_LAUNCH_MODE 1
#endif

#define LAS __attribute__((address_space(3)))
typedef unsigned short bf16_t;
typedef short bf16x8 __attribute__((ext_vector_type(8)));
typedef short s16x4 __attribute__((ext_vector_type(4)));
typedef float f32x4 __attribute__((ext_vector_type(4)));
typedef float f32x16 __attribute__((ext_vector_type(16)));
typedef unsigned u32x4 __attribute__((ext_vector_type(4)));
typedef unsigned u32x2 __attribute__((ext_vector_type(2)));

constexpr int D = 2048, MP = 16384, MS = 128, MV = MP + MS, MT = 16640;
constexpr int SEQ = 4096, DSEQ = 16, PAST = 4096, NH = 8, HD = 128;
constexpr int NIN = 8192, FF = 5632, NGU = 2 * FF, AW = 1024;
constexpr float EPS = 1e-6f;
constexpr size_t OFF_Y = 0, OFF_KP = (size_t)MV * D, OFF_VP = OFF_KP + (size_t)MP * 1024, OFF_PP = OFF_VP + (size_t)MP * 1024,
                 OFF_KS = OFF_PP + 4 * 15 * 1024, OFF_VS = OFF_KS + (size_t)MS * 1024, OFF_PS = OFF_VS + (size_t)MS * 1024, OUT_TOTAL = OFF_PS + 8 * 15 * 1024;
constexpr size_t MiB = 1u << 20;
constexpr size_t WS_SSQ = 0, WS_WIN = 1 * MiB, WS_WBR = 33 * MiB, WS_WOUT = 41 * MiB, WS_WGU = 49 * MiB, WS_WDN = 93 * MiB, WS_XN = 115 * MiB,
                 WS_QKVU = 180 * MiB, WS_GATE = 310 * MiB, WS_AO = 440 * MiB, WS_TMPA = 505 * MiB, WS_WPB = 509 * MiB, WS_SSQP = 510 * MiB, WS_END = 513 * MiB;
constexpr size_t WS_BAR = 768 * 1024, WS_BAR_BYTES = 32768;
constexpr size_t WS_H2B = WS_WIN;
static_assert(WS_H2B + (size_t)MV * D * 2 <= WS_WDN, "h2 overlay");
constexpr size_t WS_MERGED = WS_QKVU;
constexpr size_t WS_HID = WS_QKVU;
static_assert((size_t)MT * FF * 2 <= WS_AO - WS_QKVU, "hid overlay");
constexpr int LDS_BYTES = 147456;

typedef __bf16 bf16x2_t __attribute__((ext_vector_type(2)));
typedef float f32x2_t __attribute__((ext_vector_type(2)));
__device__ __forceinline__ unsigned cvt_pk_bf16(float lo, float hi) { const f32x2_t v = {lo, hi}; return __builtin_bit_cast(unsigned, __builtin_convertvector(v, bf16x2_t)); }
__device__ __forceinline__ float bf2f(unsigned short b) { return __uint_as_float(((unsigned)b) << 16); }
__device__ __forceinline__ float bflo(unsigned w) { return __uint_as_float(w << 16); }
__device__ __forceinline__ float bfhi(unsigned w) { return __uint_as_float(w & 0xffff0000u); }
__device__ __forceinline__ float fast_sigmoid(float x) { return __builtin_amdgcn_rcpf(1.0f + __expf(-x)); }
__device__ __forceinline__ float wave_sum(float v) {
#pragma unroll
    for (int o = 1; o < 64; o <<= 1) v += __shfl_xor(v, o);
    return v;
}

#define XB_TMO      128
#define XB_XCNT(j)  (256  + 64 * (j))
#define XB_XSUB(j)  (1280 + 64 * (j))
#define XB_XGEN(j)  (2304 + 64 * (j))
#define XB_TOP      3328
#define XB_TOPGEN   3392
#define XCD_BAR_WORDS 3456
#define XB_SPIN_CAP (1u << 18)

__device__ __forceinline__ unsigned xb_ld(unsigned* p)              { return __hip_atomic_load(p, __ATOMIC_RELAXED, __HIP_MEMORY_SCOPE_AGENT); }
__device__ __forceinline__ unsigned xb_add(unsigned* p, unsigned v) { return __hip_atomic_fetch_add(p, v, __ATOMIC_RELAXED, __HIP_MEMORY_SCOPE_AGENT); }
__device__ __forceinline__ unsigned xb_xcc_id() { return (unsigned)__builtin_amdgcn_s_getreg((3 << 11) | 20) & 0xFu; }
#define XB_SPIN(cond, bar) do { unsigned _sp = 0; while (cond) { __builtin_amdgcn_s_sleep(1); \
    if ((++_sp & 255u) == 0u) { if (xb_ld(&(bar)[XB_TMO])) break; if (_sp > XB_SPIN_CAP) { atomicAdd(&(bar)[XB_TMO], 1u); break; } } } } while (0)

struct XcdBarrier {
    unsigned* bar; unsigned x;
    volatile LAS unsigned* st;
};

__device__ __forceinline__ XcdBarrier xcd_barrier_post(unsigned* bar, volatile LAS unsigned* st) {
    XcdBarrier b; b.bar = bar; b.x = xb_xcc_id(); b.st = st;
    if (threadIdx.x == 0) (void)xb_add(&bar[XB_XCNT(b.x)], 1u);
    return b;
}
__device__ __forceinline__ void xcd_barrier_complete(unsigned* bar, unsigned x, unsigned& nloc, unsigned& nx) {
    const unsigned G = gridDim.x * gridDim.y * gridDim.z;
    unsigned sum, cnt, mine, sp = 0u;
    for (;;) {
        sum = 0u; cnt = 0u; mine = 0u;
#pragma unroll
        for (unsigned j = 0; j < 16; ++j) { const unsigned c = xb_ld(&bar[XB_XCNT(j)]); sum += c; cnt += (c > 0u) ? 1u : 0u; mine = (j == x) ? c : mine; }
        if (sum == G) break;
        __builtin_amdgcn_s_sleep(1);
        if ((++sp & 255u) == 0u) { if (xb_ld(&bar[XB_TMO])) break; if (sp > XB_SPIN_CAP) { atomicAdd(&bar[XB_TMO], 1u); break; } }
    }
    nloc = mine > 0u ? mine : 1u; nx = cnt > 0u ? cnt : 1u;
}

__device__ __forceinline__ void xcd_barrier(const XcdBarrier& b) {
    asm volatile("s_waitcnt vmcnt(0)" ::: "memory");
    __syncthreads();
    if (threadIdx.x == 0) {
        unsigned* bar = b.bar;
        __builtin_amdgcn_s_waitcnt(0);
        unsigned nloc = b.st[0], nx = b.st[1];
        if (nloc == 0u) { xcd_barrier_complete(bar, b.x, nloc, nx); b.st[0] = nloc; b.st[1] = nx; }
        const unsigned old = xb_add(&bar[XB_XSUB(b.x)], 1u);
        const unsigned gen = old / nloc;
        if (old + 1u == (gen + 1u) * nloc) {
            __builtin_amdgcn_fence(__ATOMIC_RELEASE, "agent");
            asm volatile("s_waitcnt vmcnt(0)" ::: "memory");
            const unsigned og = xb_add(&bar[XB_TOP], 1u);
            const unsigned tg = og / nx;
            if (og + 1u == (tg + 1u) * nx) xb_add(&bar[XB_TOPGEN], 1u);
            else XB_SPIN(xb_ld(&bar[XB_TOPGEN]) == tg, bar);
            __builtin_amdgcn_fence(__ATOMIC_ACQUIRE, "agent");
            xb_add(&bar[XB_XGEN(b.x)], 1u);
            asm volatile("s_waitcnt vmcnt(0)" ::: "memory");
        } else {
            XB_SPIN(xb_ld(&bar[XB_XGEN(b.x)]) == gen, bar);
            __builtin_amdgcn_fence(__ATOMIC_ACQUIRE, "agent");
            asm volatile("s_waitcnt vmcnt(0)" ::: "memory");
        }
    }
    __syncthreads();
}

namespace pg8 {
constexpr int BM = 256, BK = 64, HALF = 128, HTB = HALF * BK * 2, STAGE_BYTES = 8 * HTB, NXCD = 8, WGM = 8;
__host__ __device__ __forceinline__ int lds_byte(int r, int c) { const int st = (r >> 4) * 2 + (c >> 5), rr = r & 15, cc = c & 31, ob = rr * 64 + cc * 2; return st * 1024 + (ob ^ (((ob >> 9) & 1) << 5)); }
__host__ __device__ __forceinline__ void stage_rc(int b, int& R, int& C) { const int st = b / 1024, sb = b % 1024, swz = sb ^ (((sb >> 9) & 1) << 5); R = (st >> 1) * 16 + swz / 64; C = (st & 1) * 32 + (swz % 64) / 2; }
__host__ __device__ __forceinline__ int perm32(int rho) { const int n = rho >> 4, i = rho & 15; return 8 * (i >> 2) + 4 * n + (i & 3); }

struct Unit { int pm, pn, kt0, nkt, half; };
struct Gemm { const bf16_t* A; const bf16_t* Bt; int lda, ldb, M, N, K; };

struct StaticOrder {
    int nM, nN, nwg, G, c, ktfull, pmS, nS, ktS;
    __device__ void init(int nM_, int nN_, int ktfull_, int G_, int c_, int pmS_ = 0, int ksplit = 0) { nM = nM_; nN = nN_; nwg = nM * nN; G = G_; c = c_; ktfull = ktfull_; pmS = pmS_; nS = nN * ksplit; ktS = ksplit ? ktfull / ksplit : 0; }
    __device__ bool next(int i, Unit& u) const {
        const int L = i * G + c;
        if (L >= nwg) { const int t = L - nwg;
            if (t >= nS) return false;
            u.pm = pmS; u.pn = t % nN; u.kt0 = (t / nN) * ktS; u.nkt = ktS; u.half = 1; return true; }
        int wgid = L; { const int q = nwg / NXCD, r = nwg % NXCD, xcd = wgid % NXCD, off = wgid / NXCD; wgid = (xcd < r ? xcd * (q + 1) : r * (q + 1) + (xcd - r) * q) + off; }
        const int nig = WGM * nN, gid = wgid / nig, fm = gid * WGM, gsz = (nM - fm) < WGM ? (nM - fm) : WGM;
        u.pm = fm + ((wgid % nig) % gsz); u.pn = (wgid % nig) / gsz; u.kt0 = 0; u.nkt = ktfull; u.half = 0; return true;
    }
};

template <class Epi>
__device__ __forceinline__ void gemm_phase(LAS unsigned char* lds, const Gemm g, const StaticOrder& S, const Epi& E) {
    int tid_ = threadIdx.x; asm volatile("" : "+v"(tid_));
    const int tid = tid_, wid = __builtin_amdgcn_readfirstlane(tid >> 6), lane = tid & 63, wr = wid >> 2, wc = wid & 3, fr = lane & 15, fq = lane >> 4;
    unsigned voffA[2], voffB[2];
#pragma unroll
    for (int i = 0; i < 2; ++i) { int R, C; stage_rc(tid * 16 + i * 8192, R, C); const int Rb = (R & ~31) + perm32(R & 31);
        voffA[i] = (unsigned)(R * g.lda + C) * 2u; voffB[i] = (unsigned)(Rb * g.ldb + C) * 2u; }
    const size_t kstep = (size_t)(BK * 2);
    const size_t hstepA = (size_t)HALF * g.lda * 2, hstepB = (size_t)HALF * g.ldb * 2;
    const size_t tstepA = 2 * hstepA, tstepB = 2 * hstepB;
    const unsigned ldsw = (unsigned)wid * 1024u;
    const int aoff = lds_byte(wr * 64 + fr, fq * 8), boff = lds_byte(wc * 32 + fr, fq * 8);
#define PG8_SA(b, h) (((b) * 2 + (h)) * HTB)
#define PG8_SB(b, h) ((4 + (b) * 2 + (h)) * HTB)
#define PG8_STAGE(bufoff, gbase, voff) do { _Pragma("unroll") for (int _i = 0; _i < 2; ++_i) \
        __builtin_amdgcn_global_load_lds((const unsigned*)((const char*)(gbase) + (voff)[_i]), (LAS unsigned*)(lds + (bufoff) + ldsw + _i * 8192), 16, 0, 0); } while (0)
#define PG8_LDA(dst, b, h) do { _Pragma("unroll") for (int m = 0; m < 4; ++m) _Pragma("unroll") for (int k = 0; k < 2; ++k) dst[m][k] = *(const LAS bf16x8*)(lds + PG8_SA(b, h) + aoff + m * 2048 + k * 1024); } while (0)
#define PG8_LDB(dst, b, h) do { _Pragma("unroll") for (int n = 0; n < 2; ++n) _Pragma("unroll") for (int k = 0; k < 2; ++k) dst[n][k] = *(const LAS bf16x8*)(lds + PG8_SB(b, h) + boff + n * 2048 + k * 1024); } while (0)
#define PG8_MMA(ai, bj, At, Bt) do { __builtin_amdgcn_s_setprio(1); _Pragma("unroll") for (int m = 0; m < 4; ++m) _Pragma("unroll") for (int n = 0; n < 2; ++n) _Pragma("unroll") for (int k = 0; k < 2; ++k) \
        acc[ai][bj][m][n] = __builtin_amdgcn_mfma_f32_16x16x32_bf16(Bt[n][k], At[m][k], acc[ai][bj][m][n], 0, 0, 0); __builtin_amdgcn_s_setprio(0); } while (0)
#define PG8_WAIT_V(n) asm volatile("s_waitcnt vmcnt(" #n ")" ::: "memory")
#define PG8_WAIT_L(n) asm volatile("s_waitcnt lgkmcnt(" #n ")" ::: "memory")
#define PG8_BAR __builtin_amdgcn_s_barrier()
#define PG8_SCHED __builtin_amdgcn_sched_barrier(0)
    Unit cur, nxt; int ui = 0;
    if (!S.next(0, cur)) return;
    f32x4 acc[2][2][4][2];
#pragma unroll
    for (int a = 0; a < 2; ++a)
#pragma unroll
        for (int b = 0; b < 2; ++b)
#pragma unroll
            for (int m = 0; m < 4; ++m)
#pragma unroll
                for (int n = 0; n < 2; ++n) acc[a][b][m][n] = (f32x4){0.f, 0.f, 0.f, 0.f};
    bf16x8 At[4][2], B0[2][2], B1[2][2];
    const char* cA = (const char*)g.A + (size_t)cur.pm * tstepA + (size_t)cur.kt0 * kstep; const char* cB = (const char*)g.Bt + (size_t)cur.pn * tstepB + (size_t)cur.kt0 * kstep;
    PG8_STAGE(PG8_SB(0, 0), cB, voffB); PG8_STAGE(PG8_SB(0, 1), cB + hstepB, voffB); PG8_STAGE(PG8_SA(0, 0), cA, voffA); PG8_STAGE(PG8_SA(0, 1), cA + hstepA, voffA);
    if (wr == 1) PG8_BAR;
    PG8_WAIT_V(2); PG8_BAR;
    PG8_STAGE(PG8_SB(1, 0), cB + kstep, voffB); PG8_STAGE(PG8_SA(1, 0), cA + kstep, voffA); PG8_STAGE(PG8_SB(1, 1), cB + hstepB + kstep, voffB);
    PG8_WAIT_V(6); PG8_BAR;
    for (;;) {
        const bool has_next = S.next(ui + 1, nxt);
        const char* nA = has_next ? (const char*)g.A + (size_t)nxt.pm * tstepA + (size_t)nxt.kt0 * kstep : cA; const char* nB = has_next ? (const char*)g.Bt + (size_t)nxt.pn * tstepB + (size_t)nxt.kt0 * kstep : cB;
        const int nt = cur.nkt; const bool full = !cur.half;
        for (int t = 0; t < nt; t += 2) {
            const bool last = (t == nt - 2);
            if constexpr (Epi::HAS_MID) { if (!cur.half && t == (nt >> 1)) E.mid(acc, cur, wr, wc, fr, fq); }
            const char* a1 = cA + (size_t)(t + 1) * kstep;
            const char* a2 = last ? nA : cA + (size_t)(t + 2) * kstep; const char* b2 = last ? nB : cB + (size_t)(t + 2) * kstep;
            const char* a3 = a2 + kstep; const char* b3 = b2 + kstep;
            PG8_LDB(B0, 0, 0); PG8_LDB(B1, 0, 1); PG8_SCHED; PG8_LDA(At, 0, 0); PG8_STAGE(PG8_SA(1, 1), a1 + hstepA, voffA);
            PG8_WAIT_V(8); PG8_WAIT_L(0); PG8_BAR; PG8_MMA(0, 0, At, B0); PG8_MMA(0, 1, At, B1); PG8_BAR; PG8_SCHED;
            if (full) PG8_LDA(At, 0, 1); PG8_STAGE(PG8_SB(0, 0), b2, voffB); PG8_STAGE(PG8_SB(0, 1), b2 + hstepB, voffB); PG8_STAGE(PG8_SA(0, 0), a2, voffA);
            PG8_WAIT_V(8); PG8_WAIT_L(0); PG8_BAR; if (full) { PG8_MMA(1, 0, At, B0); PG8_MMA(1, 1, At, B1); } PG8_BAR; PG8_SCHED;
            PG8_LDB(B0, 1, 0); PG8_LDB(B1, 1, 1); PG8_SCHED; PG8_LDA(At, 1, 0); PG8_STAGE(PG8_SA(0, 1), a2 + hstepA, voffA);
            PG8_WAIT_V(8); PG8_WAIT_L(0); PG8_BAR; PG8_MMA(0, 0, At, B0); PG8_MMA(0, 1, At, B1); PG8_BAR; PG8_SCHED;
            if (full) PG8_LDA(At, 1, 1); PG8_STAGE(PG8_SB(1, 0), b3, voffB); PG8_STAGE(PG8_SB(1, 1), b3 + hstepB, voffB); PG8_STAGE(PG8_SA(1, 0), a3, voffA);
            PG8_WAIT_V(8); PG8_WAIT_L(0); PG8_BAR; if (full) { PG8_MMA(1, 0, At, B0); PG8_MMA(1, 1, At, B1); } PG8_BAR; PG8_SCHED;
        }
        if (wr == 0) PG8_BAR;
        E(acc, cur, wr, wc, fr, fq);
        if (!has_next) break;
#pragma unroll
        for (int a = 0; a < 2; ++a)
#pragma unroll
            for (int b = 0; b < 2; ++b)
#pragma unroll
                for (int m = 0; m < 4; ++m)
#pragma unroll
                    for (int n = 0; n < 2; ++n) acc[a][b][m][n] = (f32x4){0.f, 0.f, 0.f, 0.f};
        cur = nxt; cA = nA; cB = nB; ++ui;
        if (wr == 1) PG8_BAR;
    }
    PG8_WAIT_V(0);
    PG8_BAR;
#undef PG8_SA
#undef PG8_SB
#undef PG8_STAGE
#undef PG8_LDA
#undef PG8_LDB
#undef PG8_MMA
#undef PG8_WAIT_V
#undef PG8_WAIT_L
#undef PG8_BAR
#undef PG8_SCHED
}
}
using pg8::Unit;

__device__ __forceinline__ u32x4 pack8(const f32x4& v0, const f32x4& v1) {
    u32x4 w; w.x = cvt_pk_bf16(v0[0], v0[1]); w.y = cvt_pk_bf16(v0[2], v0[3]); w.z = cvt_pk_bf16(v1[0], v1[1]); w.w = cvt_pk_bf16(v1[2], v1[3]); return w;
}
__device__ __forceinline__ void unpack8(const u32x4& w, f32x4& v0, f32x4& v1) {
    v0 = (f32x4){bflo(w.x), bfhi(w.x), bflo(w.y), bfhi(w.y)}; v1 = (f32x4){bflo(w.z), bfhi(w.z), bflo(w.w), bfhi(w.w)};
}

struct EpiIn {
    static constexpr bool HAS_MID = false;
    bf16_t* qkvu; bf16_t* gate; float* out;
    __device__ __forceinline__ void operator()(const f32x4 (&acc)[2][2][4][2], const Unit& u, int wr, int wc, int fr, int fq) const {
        const int row0 = u.pm * 256 + wr * 64 + fr, cw = wc * 32 + 8 * fq;
        if (u.pn >= 16) {
            bf16_t* base = gate + (size_t)row0 * 4096 + (u.pn - 16) * 128 + cw;
#pragma unroll
            for (int ai = 0; ai < 2; ++ai)
#pragma unroll
                for (int m = 0; m < 4; ++m) { bf16_t* rowp = base + (size_t)(ai * 128 + m * 16) * 4096;
                    f32x4 r0, r1, b0, b1;
#pragma unroll
                    for (int j = 0; j < 4; ++j) { b0[j] = fmaxf(fast_sigmoid(acc[ai][1][m][0][j]), 1e-30f); b1[j] = fmaxf(fast_sigmoid(acc[ai][1][m][1][j]), 1e-30f);
                        r0[j] = fast_sigmoid(acc[ai][0][m][0][j]) * __builtin_amdgcn_rcpf(b0[j]); r1[j] = fast_sigmoid(acc[ai][0][m][1][j]) * __builtin_amdgcn_rcpf(b1[j]); }
                    *(u32x4*)rowp = pack8(r0, r1); *(u32x4*)(rowp + 2048) = pack8(b0, b1); }
        } else {
            const int sec = u.pn >> 2, cc = (u.pn & 3) * 256 + cw;
            bf16_t* base = qkvu + (size_t)sec * MT * 1024 + (size_t)row0 * 1024 + cc;
#pragma unroll
            for (int ai = 0; ai < 2; ++ai)
#pragma unroll
                for (int m = 0; m < 4; ++m) { bf16_t* rowp = base + (size_t)(ai * 128 + m * 16) * 1024;
#pragma unroll
                    for (int bj = 0; bj < 2; ++bj) *(u32x4*)(rowp + bj * 128) = pack8(acc[ai][bj][m][0], acc[ai][bj][m][1]); }
            if (sec >= 2) {
                const size_t offp = (sec == 2) ? OFF_KP : OFF_VP, offs = (sec == 2) ? OFF_KS : OFF_VS;
#pragma unroll
                for (int ai = 0; ai < 2; ++ai)
#pragma unroll
                    for (int m = 0; m < 4; ++m) { const int row = row0 + ai * 128 + m * 16;
                        if (row < MV) { float* o = out + (row < MP ? offp + (size_t)row * 1024 : offs + (size_t)(row - MP) * 1024) + cc;
#pragma unroll
                            for (int bj = 0; bj < 2; ++bj) { *(f32x4*)(o + bj * 128) = acc[ai][bj][m][0]; *(f32x4*)(o + bj * 128 + 4) = acc[ai][bj][m][1]; } } }
            } else if (sec == 0 && ((u.pm & 15) == 15 || u.pm == 64)) {
#pragma unroll
                for (int ai = 0; ai < 2; ++ai)
#pragma unroll
                    for (int m = 0; m < 4; ++m) { const int row = row0 + ai * 128 + m * 16; long off = -1;
                        if (row < MP) { const int t = row & (SEQ - 1); if (t >= SEQ - 15) off = (long)OFF_PP + ((long)(row >> 12) * 15 + (t - (SEQ - 15))) * 1024; }
                        else if (row < MV) { const int t = (row - MP) & 15, b = (row - MP) >> 4; if (t >= 1) off = (long)OFF_PS + ((long)b * 15 + (t - 1)) * 1024; }
                        if (off >= 0) { float* o = out + off + cc;
#pragma unroll
                            for (int bj = 0; bj < 2; ++bj) { *(f32x4*)(o + bj * 128) = acc[ai][bj][m][0]; *(f32x4*)(o + bj * 128 + 4) = acc[ai][bj][m][1]; } } }
            }
        }
    }
};
constexpr int MG_SPLIT = 4, MG_KT = (2048 / 64) / MG_SPLIT;
struct EpiMerged {
    static constexpr bool HAS_MID = true;
    const bf16_t* gate; bf16_t* merged; float* part;
    __device__ __forceinline__ void mid(f32x4 (&acc)[2][2][4][2], const Unit& u, int wr, int wc, int fr, int fq) const {
        int zoff = 0; asm volatile("" : "+v"(zoff));
        const int row0 = u.pm * 256 + wr * 64 + fr + zoff, cc = u.pn * 256 + wc * 32 + 8 * fq;
#pragma unroll
        for (int ai = 0; ai < 2; ++ai) {
            if (ai == 1 && u.half) break;
            u32x4 rw[4][2];
#pragma unroll
            for (int m = 0; m < 4; ++m)
#pragma unroll
                for (int bj = 0; bj < 2; ++bj) rw[m][bj] = *(const u32x4*)(gate + (size_t)(row0 + ai * 128 + m * 16) * 4096 + cc + bj * 128);
#pragma unroll
            for (int m = 0; m < 4; ++m)
#pragma unroll
                for (int bj = 0; bj < 2; ++bj) { f32x4 a0, a1; unpack8(rw[m][bj], a0, a1); acc[ai][bj][m][0] *= a0; acc[ai][bj][m][1] *= a1; }
            __builtin_amdgcn_sched_barrier(0);
        }
    }
    __device__ __forceinline__ void operator()(const f32x4 (&acc)[2][2][4][2], const Unit& u, int wr, int wc, int fr, int fq) const {
        const int row0 = u.pm * 256 + wr * 64 + fr, cc = u.pn * 256 + wc * 32 + 8 * fq;
        if (u.half) {
            float* ps = part + ((size_t)(u.kt0 / MG_KT) * MS + (row0 - MP)) * D + cc;
#pragma unroll
            for (int m = 0; m < 4; ++m)
#pragma unroll
                for (int bj = 0; bj < 2; ++bj) { *(f32x4*)(ps + (size_t)(m * 16) * D + bj * 128) = acc[0][bj][m][0]; *(f32x4*)(ps + (size_t)(m * 16) * D + bj * 128 + 4) = acc[0][bj][m][1]; }
            return; }
#pragma unroll
        for (int ai = 0; ai < 2; ++ai)
#pragma unroll
            for (int m = 0; m < 4; ++m) { const int row = row0 + ai * 128 + m * 16;
                const bf16_t* gp = gate + (size_t)row * 4096 + 2048 + cc; bf16_t* o = merged + (size_t)row * D + cc;
#pragma unroll
                for (int bj = 0; bj < 2; ++bj) { const u32x4 gw = *(const u32x4*)(gp + bj * 128); f32x4 g0, g1; unpack8(gw, g0, g1);
                    *(u32x4*)(o + bj * 128) = pack8(acc[ai][bj][m][0] * g0, acc[ai][bj][m][1] * g1); } }
    }
};
constexpr int OUT_SPLIT = 4, OUT_KT = (D / 64) / OUT_SPLIT;
struct EpiOut {
    static constexpr bool HAS_MID = false;
    const float* xp; const float* xs; float* y; bf16_t* hb; float* ssq; float* part;
    __device__ __forceinline__ void operator()(const f32x4 (&acc)[2][2][4][2], const Unit& u, int wr, int wc, int fr, int fq) const {
        int zoff = 0; asm volatile("" : "+v"(zoff));
        const int row0 = u.pm * 256 + wr * 64 + fr + zoff, cc = u.pn * 256 + wc * 32 + 8 * fq;
        if (u.half) {
            float* ps = part + ((size_t)(u.kt0 / OUT_KT) * MS + (row0 - MP)) * D + cc;
#pragma unroll
            for (int m = 0; m < 4; ++m)
#pragma unroll
                for (int bj = 0; bj < 2; ++bj) { *(f32x4*)(ps + (size_t)(m * 16) * D + bj * 128) = acc[0][bj][m][0]; *(f32x4*)(ps + (size_t)(m * 16) * D + bj * 128 + 4) = acc[0][bj][m][1]; }
            return; }
#pragma unroll
        for (int ai = 0; ai < 2; ++ai) {
            if (ai == 1 && u.half) break;
            f32x4 xv[4][2][2];
#pragma unroll
            for (int m = 0; m < 4; ++m) { const int row = row0 + ai * 128 + m * 16; const bool ok = row < MV;
                const float* xr = (row < MP ? xp + (size_t)row * D : xs + (size_t)(ok ? row - MP : 0) * D) + cc;
#pragma unroll
                for (int bj = 0; bj < 2; ++bj) { xv[m][bj][0] = *(const f32x4*)(xr + bj * 128); xv[m][bj][1] = *(const f32x4*)(xr + bj * 128 + 4); } }
            __builtin_amdgcn_sched_barrier(0);
#pragma unroll
            for (int m = 0; m < 4; ++m) { const int row = row0 + ai * 128 + m * 16; const bool ok = row < MV;
                bf16_t* ob = hb + (size_t)row * D + cc;
                float s = 0.f;
#pragma unroll
                for (int bj = 0; bj < 2; ++bj) { f32x4 h0 = acc[ai][bj][m][0], h1 = acc[ai][bj][m][1];
                    if (ok) { h0 += xv[m][bj][0]; h1 += xv[m][bj][1]; }
                    *(u32x4*)(ob + bj * 128) = pack8(h0, h1);
                    s += (h0[0] * h0[0] + h0[1] * h0[1]) + (h0[2] * h0[2] + h0[3] * h0[3]) + (h1[0] * h1[0] + h1[1] * h1[1]) + (h1[2] * h1[2] + h1[3] * h1[3]); }
                s += __shfl_xor(s, 16); s += __shfl_xor(s, 32);
                if (fq == 0) ssq[(size_t)(u.pn * 4 + wc) * MT + row] = s; }
            __builtin_amdgcn_sched_barrier(0);
        }
    }
};
struct EpiGU {
    static constexpr bool HAS_MID = false;
    const LAS float* tab; bf16_t* hid;
    __device__ __forceinline__ void operator()(const f32x4 (&acc)[2][2][4][2], const Unit& u, int wr, int wc, int fr, int fq) const {
        const int row0 = u.pm * 256 + wr * 64 + fr, cc = u.pn * 128 + wc * 32 + 8 * fq;
#pragma unroll
        for (int ai = 0; ai < 2; ++ai)
#pragma unroll
            for (int m = 0; m < 4; ++m) { const int row = row0 + ai * 128 + m * 16;
                const float sc = tab[(u.half ? 256 : 0) + ((ai * 128 + wr * 64 + m * 16 + fr) & (u.half ? 127 : 255))];
                f32x4 r0, r1;
#pragma unroll
                for (int j = 0; j < 4; ++j) { const float g0 = acc[ai][0][m][0][j] * sc, u0 = acc[ai][1][m][0][j] * sc, g1 = acc[ai][0][m][1][j] * sc, u1 = acc[ai][1][m][1][j] * sc;
                    r0[j] = g0 * fast_sigmoid(g0) * u0; r1[j] = g1 * fast_sigmoid(g1) * u1; }
                *(u32x4*)(hid + (size_t)row * FF + cc) = pack8(r0, r1); }
    }
};
constexpr int DN_SPLIT = 11, DN_KT = (FF / 64) / DN_SPLIT;
struct EpiDown {
    static constexpr bool HAS_MID = false;
    float* y; float* part; const bf16_t* hb; bf16_t* h2b;
    __device__ __forceinline__ void operator()(const f32x4 (&acc)[2][2][4][2], const Unit& u, int wr, int wc, int fr, int fq) const {
        const int row0 = u.pm * 256 + wr * 64 + fr, cc = u.pn * 256 + wc * 32 + 8 * fq;
#pragma unroll
        for (int ai = 0; ai < 2; ++ai)
#pragma unroll
            for (int m = 0; m < 4; ++m) { const int row = row0 + ai * 128 + m * 16;
                if (row < MV) { float* o = y + (size_t)row * D + cc;
                    if (u.half) {
                        float* ps = part + ((size_t)(u.kt0 / DN_KT) * MS + (row - MP)) * D + cc;
#pragma unroll
                        for (int bj = 0; bj < 2; ++bj) { *(f32x4*)(ps + bj * 128) = acc[ai][bj][m][0]; *(f32x4*)(ps + bj * 128 + 4) = acc[ai][bj][m][1]; }
                    } else {
#pragma unroll
                    for (int bj = 0; bj < 2; ++bj) { const u32x4 hw = *(const u32x4*)(hb + (size_t)row * D + cc + bj * 128); f32x4 h0, h1; unpack8(hw, h0, h1);
                        *(u32x4*)(h2b + (size_t)row * D + cc + bj * 128) = pack8(h0 + acc[ai][bj][m][0], h1 + acc[ai][bj][m][1]); } } } }
    }
};

struct EpiWA {
    static constexpr bool HAS_MID = false;
    bf16_t* dst;
    __device__ __forceinline__ void operator()(const f32x4 (&acc)[2][2][4][2], const Unit& u, int wr, int wc, int fr, int fq) const {
        const int row0 = u.pm * 256 + wr * 64 + fr, cc = wc * 32 + 8 * fq;
#pragma unroll
        for (int ai = 0; ai < 2; ++ai)
#pragma unroll
            for (int m = 0; m < 4; ++m) { bf16_t* o = dst + (size_t)(row0 + ai * 128 + m * 16) * 2048 + cc;
#pragma unroll
                for (int bj = 0; bj < 2; ++bj) *(u32x4*)(o + bj * 128) = pack8(acc[ai][bj][m][0], acc[ai][bj][m][1]); }
    }
};

__device__ __forceinline__ void p0_item(const float* W, int N, int k0, int n0, const float* gsc, bf16_t* dst, int ldd, int drow0, int dcol0, LAS float* scr, int lane) {
    const float* wp = W + (size_t)k0 * N + n0 + lane;
    float v[64];
#pragma unroll
    for (int i = 0; i < 64; ++i) v[i] = wp[(size_t)i * N];
    if (gsc) {
#pragma unroll
        for (int i = 0; i < 64; ++i) v[i] *= gsc[k0 + i]; }
#pragma unroll
    for (int i = 0; i < 64; ++i) scr[i * 65 + lane] = v[i];
    asm volatile("s_waitcnt lgkmcnt(0)" ::: "memory");
    const int c = lane & 7;
#pragma unroll
    for (int j = 0; j < 8; ++j) { const int n = (lane >> 3) + 8 * j; const LAS float* s = scr + (8 * c) * 65 + n;
        u32x4 o; o.x = cvt_pk_bf16(s[0 * 65], s[1 * 65]); o.y = cvt_pk_bf16(s[2 * 65], s[3 * 65]); o.z = cvt_pk_bf16(s[4 * 65], s[5 * 65]); o.w = cvt_pk_bf16(s[6 * 65], s[7 * 65]);
        *(u32x4*)(dst + (size_t)(drow0 + n) * ldd + dcol0 + k0 + 8 * c) = o; }
    asm volatile("s_waitcnt lgkmcnt(0)" ::: "memory");
}

struct Params {
    const float *x_prompt, *x_sample, *cache_k, *cache_v, *state_pool, *g_mix, *w_in, *w_pool, *s_pool, *w_branch, *w_out, *g_ffn, *w_gate_up, *w_down, *g_final;
    float* out; unsigned char* ws; int ph_lo, ph_hi;
};

__device__ __forceinline__ void xn_row(const Params& p, int m, int lane);
__device__ __forceinline__ void phase0(const Params& p, LAS unsigned char* lds, int gw, int NGW, int wave, int lane, unsigned xcc) {
    LAS float* scr = (LAS float*)(lds + wave * 16640);
    bf16_t* Wt_in = (bf16_t*)(p.ws + WS_WIN); bf16_t* Wt_br = (bf16_t*)(p.ws + WS_WBR); bf16_t* Wt_out = (bf16_t*)(p.ws + WS_WOUT);
    bf16_t* Wt_gu = (bf16_t*)(p.ws + WS_WGU); bf16_t* Wt_dn = (bf16_t*)(p.ws + WS_WDN); bf16_t* XN = (bf16_t*)(p.ws + WS_XN);
    bf16_t* TMPA = (bf16_t*)(p.ws + WS_TMPA); bf16_t* WPB = (bf16_t*)(p.ws + WS_WPB);
    constexpr int I_IN = (D / 64) * (NIN / 64), I_BR = (D / 64) * (D / 64), I_OUT = (D / 64) * (D / 64), I_GU = (D / 64) * (NGU / 64), I_DN = (FF / 64) * (D / 64);
    constexpr int NITEMS = I_IN + I_BR + I_OUT + I_GU + I_DN;
    unsigned* ctr = (unsigned*)(p.ws + WS_BAR) + 3648 + 64 * (xcc & 7);
    constexpr int NXN = MT / 2;
    for (;;) {
        unsigned kq = 0; if (lane == 0) kq = __hip_atomic_fetch_add(ctr, 1u, __ATOMIC_RELAXED, __HIP_MEMORY_SCOPE_AGENT);
        const int it = 8 * (int)__builtin_amdgcn_readfirstlane(kq) + (int)(xcc & 7);
        if (it >= NITEMS + NXN) break;
        if (it >= NITEMS) { xn_row(p, 2 * (it - NITEMS), lane); xn_row(p, 2 * (it - NITEMS) + 1, lane); continue; }
        int r = it;
        if (r < I_IN) { const int nb = NIN / 64; const int n0 = 64 * (r % nb); int drow = n0;
            if (n0 >= 4096) { const int q = n0 - 4096; drow = q < 2048 ? 4096 + (q / 128) * 256 + (q % 128) : 4096 + ((q - 2048) / 128) * 256 + 128 + ((q - 2048) % 128); }
            p0_item(p.w_in, NIN, 64 * (r / nb), n0, p.g_mix, Wt_in, D, drow, 0, scr, lane); continue; } r -= I_IN;
        if (r < I_BR) { const int nb = D / 64; const int k0 = 64 * (r / nb), n0 = 64 * (r % nb);
            if (k0 < 1024) p0_item(p.w_branch, D, k0, n0, p.s_pool, TMPA, 1024, n0, 0, scr, lane);
            else p0_item(p.w_branch, D, k0, n0, nullptr, Wt_br, 2048, n0, 0, scr, lane);
            continue; } r -= I_BR;
        if (r < I_OUT) { const int nb = D / 64; p0_item(p.w_out, D, 64 * (r / nb), 64 * (r % nb), nullptr, Wt_out, D, 64 * (r % nb), 0, scr, lane); continue; } r -= I_OUT;
        if (r < I_GU) { const int nb = NGU / 64; const int n0 = 64 * (r % nb); const int drow = n0 < FF ? (n0 / 128) * 256 + (n0 % 128) : ((n0 - FF) / 128) * 256 + 128 + ((n0 - FF) % 128);
            p0_item(p.w_gate_up, NGU, 64 * (r / nb), n0, p.g_ffn, Wt_gu, D, drow, 0, scr, lane); continue; } r -= I_GU;
        { const int nb = D / 64; p0_item(p.w_down, D, 64 * (r / nb), 64 * (r % nb), nullptr, Wt_dn, FF, 64 * (r % nb), 0, scr, lane); }
    }
}
__device__ __forceinline__ void xn_row(const Params& p, int m, int lane) {
    bf16_t* XN = (bf16_t*)(p.ws + WS_XN);
    u32x2* o8 = (u32x2*)(XN + (size_t)m * D) + lane;
    if (m >= MV) {
#pragma unroll
        for (int j = 0; j < 8; ++j) o8[64 * j] = (u32x2){0u, 0u};
        return; }
    const f32x4* xr = (const f32x4*)(m < MP ? p.x_prompt + (size_t)m * D : p.x_sample + (size_t)(m - MP) * D) + lane;
    f32x4 v[8]; float s = 0.f;
#pragma unroll
    for (int j = 0; j < 8; ++j) { v[j] = xr[64 * j]; s += (v[j].x * v[j].x + v[j].y * v[j].y) + (v[j].z * v[j].z + v[j].w * v[j].w); }
    const float rs = __builtin_amdgcn_rsqf(wave_sum(s) * (1.0f / D) + EPS);
#pragma unroll
    for (int j = 0; j < 8; ++j) o8[64 * j] = (u32x2){cvt_pk_bf16(v[j].x * rs, v[j].y * rs), cvt_pk_bf16(v[j].z * rs, v[j].w * rs)};
}
__device__ __forceinline__ void phase0b(const Params& p, int gw, int NGW, int lane) {
    bf16_t* WPB = (bf16_t*)(p.ws + WS_WPB);
    for (int i = gw * 64 + lane; i < 4 * 256 * 256 / 8; i += NGW * 64) { const f32x4 a = *(const f32x4*)(p.w_pool + (size_t)i * 8), b = *(const f32x4*)(p.w_pool + (size_t)i * 8 + 4); *(u32x4*)(WPB + (size_t)i * 8) = pack8(a, b); }
    float* ssq = (float*)(p.ws + WS_SSQ);
    for (int i = gw * 64 + lane; i < MT; i += NGW * 64) ssq[i] = 0.f;
}

constexpr int VROW = 320;
__device__ __forceinline__ s16x4 vtr(const LAS unsigned char* p) { typedef short v4i16_t __attribute__((ext_vector_type(4))); return __builtin_bit_cast(s16x4, __builtin_amdgcn_ds_read_tr16_b64_v4i16((LAS v4i16_t*)p)); }
__device__ __forceinline__ bf16x8 cvt8(const f32x4& a, const f32x4& b) { u32x4 w = pack8(a, b); return __builtin_bit_cast(bf16x8, w); }

__device__ __forceinline__ void attn_unit(const Params& p, LAS unsigned char* vl, int unit, int lane) {
    const bf16_t* Ub = (const bf16_t*)(p.ws + WS_QKVU);
    const bf16_t* Qb = Ub + (size_t)MT * 1024; const bf16_t* Kb = Qb + (size_t)MT * 1024; const bf16_t* Vb = Kb + (size_t)MT * 1024;
    bf16_t* AO = (bf16_t*)(p.ws + WS_AO);
    const int n = lane & 31, hh = lane >> 5;
    const bool sample = unit < 64;
    int b, h, qrow0, nblk;
    if (sample) { b = unit >> 3; h = unit & 7; qrow0 = MP + b * DSEQ; nblk = 1 + PAST / 32; }
    else { const int u2 = unit - 64; const int qb = u2 & 127; h = (u2 >> 7) & 7; b = u2 >> 10; qrow0 = b * SEQ + qb * 32; nblk = qb + 1; }
    bf16x8 qf[8];
    { const bf16_t* qp = Qb + (size_t)(qrow0 + n) * 1024 + h * HD + 64 * hh;
#pragma unroll
      for (int kk = 0; kk < 8; ++kk) qf[kk] = *(const bf16x8*)(qp + 8 * kk); }
    f32x16 o[4];
#pragma unroll
    for (int db = 0; db < 4; ++db)
#pragma unroll
        for (int r = 0; r < 16; ++r) o[db][r] = 0.f;
    float R = (sample && n >= DSEQ) ? -1e30f : 0.f;
    const float* ck = p.cache_k + (size_t)b * PAST * 1024 + h * HD; const float* cv = p.cache_v + (size_t)b * PAST * 1024 + h * HD;
    const int vaddr = (4 * hh + ((lane & 15) >> 2)) * VROW + (16 * ((lane >> 4) & 1) + 4 * (lane & 3)) * 2;
    for (int blk = 0; blk < nblk; ++blk) {
        bf16x8 kf[8];
        const bool diag = (blk == 0);
        if (!sample || blk == 0) {
            const int s0 = qrow0 - blk * 32;
            const bf16_t* kp = Kb + (size_t)(s0 + n) * 1024 + h * HD + 64 * hh;
#pragma unroll
            for (int kk = 0; kk < 8; ++kk) kf[kk] = *(const bf16x8*)(kp + 8 * kk);
            const bf16_t* vp = Vb + (size_t)(s0 + (lane >> 4)) * 1024 + h * HD + 8 * (lane & 15);
#pragma unroll
            for (int it = 0; it < 8; ++it) { const u32x4 w = *(const u32x4*)(vp + (size_t)(4 * it) * 1024); *(LAS u32x4*)(vl + (4 * it + (lane >> 4)) * VROW + 16 * (lane & 15)) = w; }
        } else {
            const int s0 = PAST - blk * 32;
            const float* kp = ck + (size_t)(s0 + n) * 1024 + 64 * hh;
#pragma unroll
            for (int kk = 0; kk < 8; ++kk) kf[kk] = cvt8(*(const f32x4*)(kp + 8 * kk), *(const f32x4*)(kp + 8 * kk + 4));
            const float* vp = cv + (size_t)(s0 + (lane >> 4)) * 1024 + 8 * (lane & 15);
#pragma unroll
            for (int it = 0; it < 8; ++it) { const f32x4 a = *(const f32x4*)(vp + (size_t)(4 * it) * 1024), c = *(const f32x4*)(vp + (size_t)(4 * it) * 1024 + 4);
                *(LAS u32x4*)(vl + (4 * it + (lane >> 4)) * VROW + 16 * (lane & 15)) = pack8(a, c); }
        }
        f32x16 st;
#pragma unroll
        for (int r = 0; r < 16; ++r) st[r] = 0.f;
#pragma unroll
        for (int kk = 0; kk < 8; ++kk) st = __builtin_amdgcn_mfma_f32_32x32x16_bf16(kf[kk], qf[kk], st, 0, 0, 0);
        float l1m[16], ls[16];
#pragma unroll
        for (int r = 0; r < 16; ++r) { const int i = (r & 3) + 8 * (r >> 2) + 4 * hh; const bool valid = !diag || (i < n);
            const float z = st[r] * 0.08838834764831845f; const float sp = fmaxf(z, 0.f) + __logf(1.0f + __expf(-fabsf(z)));
            l1m[r] = valid ? -sp : 0.f; ls[r] = valid ? (z - sp) : -1e30f; }
        float gown[4], goth[4];
#pragma unroll
        for (int a = 0; a < 4; ++a) { gown[a] = (l1m[4 * a] + l1m[4 * a + 1]) + (l1m[4 * a + 2] + l1m[4 * a + 3]); goth[a] = __shfl_xor(gown[a], 32); }
        float wv[16]; float tail = R;
#pragma unroll
        for (int a = 3; a >= 0; --a) { float sfx = tail + (hh == 0 ? goth[a] : 0.f);
#pragma unroll
            for (int rr = 3; rr >= 0; --rr) { wv[4 * a + rr] = __expf(ls[4 * a + rr] + sfx); sfx += l1m[4 * a + rr]; }
            tail += gown[a] + goth[a]; }
        R = tail;
        bf16x8 wb[2];
#pragma unroll
        for (int s = 0; s < 2; ++s) wb[s] = cvt8((f32x4){wv[8 * s], wv[8 * s + 1], wv[8 * s + 2], wv[8 * s + 3]}, (f32x4){wv[8 * s + 4], wv[8 * s + 5], wv[8 * s + 6], wv[8 * s + 7]});
        asm volatile("s_waitcnt lgkmcnt(0)" ::: "memory");
#pragma unroll
        for (int db = 0; db < 4; ++db)
#pragma unroll
            for (int s = 0; s < 2; ++s) { const s16x4 lo = vtr(vl + vaddr + (16 * s) * VROW + 64 * db), hi = vtr(vl + vaddr + (16 * s + 8) * VROW + 64 * db);
                const bf16x8 vf = (bf16x8){lo[0], lo[1], lo[2], lo[3], hi[0], hi[1], hi[2], hi[3]};
                o[db] = __builtin_amdgcn_mfma_f32_32x32x16_bf16(vf, wb[s], o[db], 0, 0, 0); }
        asm volatile("s_waitcnt lgkmcnt(0)" ::: "memory");
        if (__all(R < -104.0f)) break;
    }
    if (!sample || n < DSEQ) {
        bf16_t* op = AO + (size_t)(qrow0 + n) * 2048 + 1024 + h * HD + 4 * hh;
#pragma unroll
        for (int db = 0; db < 4; ++db)
#pragma unroll
            for (int a = 0; a < 4; ++a) *(u32x2*)(op + 32 * db + 8 * a) = (u32x2){cvt_pk_bf16(o[db][4 * a], o[db][4 * a + 1]), cvt_pk_bf16(o[db][4 * a + 2], o[db][4 * a + 3])};
    }
}

constexpr int AKROW = 272, AVROW = 288, AKB = 32 * AKROW, AVB = 32 * AVROW, AFLAG = 2 * AKB + 2 * AVB;
__device__ __forceinline__ void sb_block(const LAS unsigned char* kl, const LAS unsigned char* vl, int vaddr, const bf16x8 (&qf)[8], f32x16 (&o)[4], float& R, bool diag, int n, int hh) {
            f32x16 st;
#pragma unroll
            for (int r = 0; r < 16; ++r) st[r] = 0.f;
            { bf16x8 kf[8];
#pragma unroll
              for (int kk = 0; kk < 8; ++kk) kf[kk] = *(const LAS bf16x8*)(kl + 16 * kk);
#pragma unroll
              for (int kk = 0; kk < 8; ++kk) st = __builtin_amdgcn_mfma_f32_32x32x16_bf16(kf[kk], qf[kk], st, 0, 0, 0); }
            float l1m[16];
#pragma unroll
            for (int r = 0; r < 16; ++r) { const int i = (r & 3) + 8 * (r >> 2) + 4 * hh; const bool valid = !diag || (i < n);
                const float z = st[r] * 0.08838834764831845f; const float sp = fmaxf(z, 0.f) + __logf(1.0f + __expf(-fabsf(z)));
                l1m[r] = valid ? -sp : 0.f; st[r] = valid ? (z - sp) : -1e30f; }
            float gown[4], goth[4];
#pragma unroll
            for (int a = 0; a < 4; ++a) { gown[a] = (l1m[4 * a] + l1m[4 * a + 1]) + (l1m[4 * a + 2] + l1m[4 * a + 3]); goth[a] = __shfl_xor(gown[a], 32); }
            float tail = R;
#pragma unroll
            for (int a = 3; a >= 0; --a) { float sfx = tail + (hh == 0 ? goth[a] : 0.f);
#pragma unroll
                for (int rr = 3; rr >= 0; --rr) { st[4 * a + rr] = __expf(st[4 * a + rr] + sfx); sfx += l1m[4 * a + rr]; }
                tail += gown[a] + goth[a]; }
            R = tail;
            bf16x8 wb[2];
#pragma unroll
            for (int q = 0; q < 2; ++q) wb[q] = cvt8((f32x4){st[8 * q], st[8 * q + 1], st[8 * q + 2], st[8 * q + 3]}, (f32x4){st[8 * q + 4], st[8 * q + 5], st[8 * q + 6], st[8 * q + 7]});
#pragma unroll
            for (int db = 0; db < 4; ++db)
#pragma unroll
                for (int q = 0; q < 2; ++q) { const s16x4 lo = vtr(vl + vaddr + (16 * q) * AVROW + 64 * db), hi = vtr(vl + vaddr + (16 * q + 8) * AVROW + 64 * db);
                    const bf16x8 vf = (bf16x8){lo[0], lo[1], lo[2], lo[3], hi[0], hi[1], hi[2], hi[3]};
                    o[db] = __builtin_amdgcn_mfma_f32_32x32x16_bf16(vf, wb[q], o[db], 0, 0, 0); }
}
__device__ __forceinline__ void attn_wg_unit(const Params& p, LAS unsigned char* lds, int wgu, int wave, int lane) {
    const bf16_t* Ub = (const bf16_t*)(p.ws + WS_QKVU);
    const bf16_t* Qb = Ub + (size_t)MT * 1024; const bf16_t* Kb = Qb + (size_t)MT * 1024; const bf16_t* Vb = Kb + (size_t)MT * 1024;
    bf16_t* AO = (bf16_t*)(p.ws + WS_AO);
    const int n = lane & 31, hh = lane >> 5;
    const int qg = wgu & 15, h = (wgu >> 4) & 7, b = wgu >> 7;
    const int qtop = qg * 8 + 7, qbw = qg * 8 + wave, qrow0 = b * SEQ + qbw * 32;
    bf16x8 qf[8];
    { const bf16_t* qp = Qb + (size_t)(qrow0 + n) * 1024 + h * HD + 64 * hh;
#pragma unroll
      for (int kk = 0; kk < 8; ++kk) qf[kk] = *(const bf16x8*)(qp + 8 * kk); }
    f32x16 o[4];
#pragma unroll
    for (int db = 0; db < 4; ++db)
#pragma unroll
        for (int r = 0; r < 16; ++r) o[db][r] = 0.f;
    float R = 0.f; bool done = false;
    LAS int* flags = (LAS int*)(lds + AFLAG);
    const int lrow = 4 * wave + (lane >> 4), lch = lane & 15;
    const size_t gbase = ((size_t)b * SEQ + lrow) * 1024 + h * HD + 8 * lch;
    const int vaddr = (4 * hh + ((lane & 15) >> 2)) * AVROW + (16 * ((lane >> 4) & 1) + 4 * (lane & 3)) * 2;
    u32x4 kr = *(const u32x4*)(Kb + gbase + (size_t)qtop * 32 * 1024), vr = *(const u32x4*)(Vb + gbase + (size_t)qtop * 32 * 1024);
    for (int s = 0; s <= qtop; ++s) {
        const int kb = qtop - s, bo = s & 1;
        *(LAS u32x4*)(lds + bo * AKB + lrow * AKROW + 16 * lch) = kr;
        *(LAS u32x4*)(lds + 2 * AKB + bo * AVB + lrow * AVROW + 16 * lch) = vr;
        if (kb > 0) { kr = *(const u32x4*)(Kb + gbase + (size_t)(kb - 1) * 32 * 1024); vr = *(const u32x4*)(Vb + gbase + (size_t)(kb - 1) * 32 * 1024); }
        asm volatile("s_waitcnt lgkmcnt(0)" ::: "memory"); __builtin_amdgcn_s_barrier(); asm volatile("" ::: "memory");
        if (s >= 8) {
            int all = 1;
#pragma unroll
            for (int w = 0; w < 8; ++w) all &= flags[((s - 1) & 1) * 8 + w];
            if (__builtin_amdgcn_readfirstlane(all)) break;
        }
        if (!done && kb <= qbw) {
            sb_block(lds + bo * AKB + n * AKROW + 128 * hh, lds + 2 * AKB + bo * AVB, vaddr, qf, o, R, kb == qbw, n, hh);
            if (__all(R < -104.0f)) done = true;
        }
        if (lane == 0) flags[(s & 1) * 8 + wave] = done ? 1 : 0;
    }
    { bf16_t* op = AO + (size_t)(qrow0 + n) * 2048 + 1024 + h * HD + 4 * hh;
#pragma unroll
      for (int db = 0; db < 4; ++db)
#pragma unroll
          for (int a = 0; a < 4; ++a) *(u32x2*)(op + 32 * db + 8 * a) = (u32x2){cvt_pk_bf16(o[db][4 * a], o[db][4 * a + 1]), cvt_pk_bf16(o[db][4 * a + 2], o[db][4 * a + 3])}; }
    asm volatile("s_waitcnt lgkmcnt(0)" ::: "memory"); __builtin_amdgcn_s_barrier(); asm volatile("" ::: "memory");
}

__device__ __forceinline__ void attn_wg_sample(const Params& p, LAS unsigned char* lds, int unit, int wave, int lane) {
    const bf16_t* Ub = (const bf16_t*)(p.ws + WS_QKVU);
    const bf16_t* Qb = Ub + (size_t)MT * 1024; const bf16_t* Kb = Qb + (size_t)MT * 1024; const bf16_t* Vb = Kb + (size_t)MT * 1024;
    bf16_t* AO = (bf16_t*)(p.ws + WS_AO);
    const int n = lane & 31, hh = lane >> 5;
    const int b = unit >> 3, h = unit & 7, qrow0 = MP + b * DSEQ;
    bf16x8 qf[8];
    { const bf16_t* qp = Qb + (size_t)(qrow0 + n) * 1024 + h * HD + 64 * hh;
#pragma unroll
      for (int kk = 0; kk < 8; ++kk) qf[kk] = *(const bf16x8*)(qp + 8 * kk); }
    f32x16 o[4];
#pragma unroll
    for (int db = 0; db < 4; ++db)
#pragma unroll
        for (int r = 0; r < 16; ++r) o[db][r] = 0.f;
    float R = (n >= DSEQ) ? -1e30f : 0.f; bool done = false;
    LAS int* flags = (LAS int*)(lds + AFLAG);
    const int lrow = 4 * wave + (lane >> 4), lch = lane & 15;
    const int vaddr = (4 * hh + ((lane & 15) >> 2)) * AVROW + (16 * ((lane >> 4) & 1) + 4 * (lane & 3)) * 2;
    const float* ck = p.cache_k + (size_t)b * PAST * 1024 + h * HD + 8 * lch; const float* cv = p.cache_v + (size_t)b * PAST * 1024 + h * HD + 8 * lch;
    u32x4 kr = *(const u32x4*)(Kb + (size_t)(qrow0 + lrow) * 1024 + h * HD + 8 * lch), vr = *(const u32x4*)(Vb + (size_t)(qrow0 + lrow) * 1024 + h * HD + 8 * lch);
    constexpr int NSTEP = 1 + PAST / 32;
    for (int s = 0; s < NSTEP; ++s) {
        const int bo = s & 1;
        *(LAS u32x4*)(lds + bo * AKB + lrow * AKROW + 16 * lch) = kr;
        *(LAS u32x4*)(lds + 2 * AKB + bo * AVB + lrow * AVROW + 16 * lch) = vr;
        f32x4 ka0, ka1, va0, va1;
        const bool more = s + 1 < NSTEP;
        if (more) { const size_t po = (size_t)(PAST - 32 * (s + 1) + lrow) * 1024; ka0 = *(const f32x4*)(ck + po); ka1 = *(const f32x4*)(ck + po + 4); va0 = *(const f32x4*)(cv + po); va1 = *(const f32x4*)(cv + po + 4); }
        asm volatile("s_waitcnt lgkmcnt(0)" ::: "memory"); __builtin_amdgcn_s_barrier(); asm volatile("" ::: "memory");
        if (s >= 1) { if (__builtin_amdgcn_readfirstlane(flags[((s - 1) & 1) * 8])) break; }
        if (wave == 0 && !done) {
            sb_block(lds + bo * AKB + n * AKROW + 128 * hh, lds + 2 * AKB + bo * AVB, vaddr, qf, o, R, s == 0, n, hh);
            if (__all(R < -104.0f)) done = true;
        }
        if (wave == 0 && lane == 0) flags[(s & 1) * 8] = done ? 1 : 0;
        if (more) { kr = pack8(ka0, ka1); vr = pack8(va0, va1); }
    }
    if (wave == 0 && n < DSEQ) { bf16_t* op = AO + (size_t)(qrow0 + n) * 2048 + 1024 + h * HD + 4 * hh;
#pragma unroll
      for (int db = 0; db < 4; ++db)
#pragma unroll
          for (int a = 0; a < 4; ++a) *(u32x2*)(op + 32 * db + 8 * a) = (u32x2){cvt_pk_bf16(o[db][4 * a], o[db][4 * a + 1]), cvt_pk_bf16(o[db][4 * a + 2], o[db][4 * a + 3])}; }
    asm volatile("s_waitcnt lgkmcnt(0)" ::: "memory"); __builtin_amdgcn_s_barrier(); asm volatile("" ::: "memory");
}

template <int W>
__device__ __forceinline__ void diff_chunk(const Params& p, int ch, int cc) {
    const bf16_t* Ub = (const bf16_t*)(p.ws + WS_QKVU); bf16_t* AO = (bf16_t*)(p.ws + WS_AO);
    const int m0 = ch * 16; const bool prompt = m0 < MP; const int t0 = prompt ? (m0 & (SEQ - 1)) : PAST;
    const bf16_t* up = Ub + (size_t)m0 * 1024 + cc * 8;
    u32x4 raw[15 + W];
#pragma unroll
    for (int r = 0; r < 16; ++r) raw[W - 1 + r] = *(const u32x4*)(up + (size_t)r * 1024);
    if (prompt) {
#pragma unroll
        for (int j = 1; j < W; ++j) { const u32x4 v = *(const u32x4*)(t0 > 0 ? up - (size_t)j * 1024 : up); raw[W - 1 - j] = (t0 > 0) ? v : (u32x4){0u, 0u, 0u, 0u}; }
    } else { const float* hp = p.state_pool + (size_t)((m0 - MP) >> 4) * 15 * 1024 + cc * 8;
#pragma unroll
        for (int j = 1; j < W; ++j) raw[W - 1 - j] = pack8(*(const f32x4*)(hp + (size_t)(15 - j) * 1024), *(const f32x4*)(hp + (size_t)(15 - j) * 1024 + 4)); }
    f32x4 s0 = (f32x4){0.f, 0.f, 0.f, 0.f}, s1 = s0;
#pragma unroll
    for (int j = 1; j < W; ++j) { f32x4 a, c; unpack8(raw[W - 1 - j], a, c); s0 += a; s1 += c; }
#pragma unroll
    for (int r = 0; r < 16; ++r) { f32x4 a, c; unpack8(raw[W - 1 + r], a, c); s0 += a; s1 += c;
        const int t = t0 + r; const float ic = 1.0f / (float)(t + 1 < W ? t + 1 : W);
        *(u32x4*)(AO + (size_t)(m0 + r) * 2048 + cc * 8) = pack8(s0 * ic - a, s1 * ic - c);
        f32x4 da, dc; unpack8(raw[r], da, dc); s0 -= da; s1 -= dc; }
}
constexpr int N_ATT_UNITS = 64, N_DIFF_ITEMS = (MV / 32) * 4, N_P2_ITEMS = N_ATT_UNITS + N_DIFF_ITEMS;
__device__ __forceinline__ void diff_item(const Params& p, int wi, int lane) {
    const int g = wi & 3, ch = 2 * (wi >> 2) + (lane >> 5), cc = 32 * g + (lane & 31);
    if (g == 0) diff_chunk<2>(p, ch, cc); else if (g == 1) diff_chunk<4>(p, ch, cc); else if (g == 2) diff_chunk<8>(p, ch, cc); else diff_chunk<16>(p, ch, cc);
}

__global__ void __launch_bounds__(512, 2) fwd_megakernel(Params p) {
    extern __shared__ __attribute__((aligned(16))) unsigned char lds_raw[];
    LAS unsigned char* lds = (LAS unsigned char*)lds_raw;
    const int tid = threadIdx.x, lane = tid & 63, wave = __builtin_amdgcn_readfirstlane(tid >> 6);
    const int G = gridDim.x, bx = blockIdx.x;
    const int vcu = (G % 8 == 0) ? (bx % 8) * (G / 8) + bx / 8 : bx;
    const int gw = vcu * 8 + wave, NGW = G * 8;
    cg::grid_group grid = cg::this_grid();
    volatile LAS unsigned* xst = (volatile LAS unsigned*)(lds + LDS_BYTES - 64);
    if (tid < 2) xst[tid] = 0u;
    __syncthreads();
    XcdBarrier xbar = xcd_barrier_post((unsigned*)(p.ws + WS_BAR), xst);
#define IN(k) (p.ph_lo <= (k) && (k) < p.ph_hi)
#define SEAM(k) do { if (IN(k) && IN((k) + 1)) { if (p.ph_hi > 64) grid.sync();   xcd_barrier(xbar); } STAMP(); } while (0)
    bf16_t* Wt_in = (bf16_t*)(p.ws + WS_WIN); bf16_t* Wt_br = (bf16_t*)(p.ws + WS_WBR); bf16_t* Wt_out = (bf16_t*)(p.ws + WS_WOUT);
    bf16_t* Wt_gu = (bf16_t*)(p.ws + WS_WGU); bf16_t* Wt_dn = (bf16_t*)(p.ws + WS_WDN); bf16_t* XN = (bf16_t*)(p.ws + WS_XN);
    bf16_t* QKVU = (bf16_t*)(p.ws + WS_QKVU); bf16_t* GATE = (bf16_t*)(p.ws + WS_GATE); bf16_t* AO = (bf16_t*)(p.ws + WS_AO);
    bf16_t* MERGED = (bf16_t*)(p.ws + WS_MERGED); bf16_t* HID = (bf16_t*)(p.ws + WS_HID); float* SSQ = (float*)(p.ws + WS_SSQ);
    float* Y = p.out + OFF_Y;
#ifdef PROBE_T
    unsigned long long tstamp[10]; int nst = 0;
#define STAMP() do { tstamp[nst++] = __builtin_amdgcn_s_memrealtime(); } while (0)
#else
#define STAMP() do {} while (0)
#endif
    STAMP();

    if (IN(0)) { phase0(p, lds, gw, NGW, wave, lane, xbar.x);
#ifdef PROBE_T
#endif
        phase0b(p, gw, NGW, lane);
    }
    SEAM(0);
    if (IN(1)) { pg8::Gemm g{XN, Wt_in, D, D, MT, NIN, D}; pg8::StaticOrder S; S.init(64, NIN / 256, D / 64, G, bx, 64, 1); EpiIn E{QKVU, GATE, p.out}; pg8::gemm_phase(lds, g, S, E); }
    SEAM(1);
    if (IN(2)) {
        for (int su = vcu; su < 64; su += G) attn_wg_sample(p, lds, su, wave, lane);
        for (int wu = vcu; wu < 512; wu += G) attn_wg_unit(p, lds, wu, wave, lane);
        unsigned* ctr = (unsigned*)(p.ws + WS_BAR) + 3584;
        for (;;) {
            unsigned nx = 0; if (lane == 0) nx = __hip_atomic_fetch_add(ctr, 1u, __ATOMIC_RELAXED, __HIP_MEMORY_SCOPE_AGENT);
            const int item = (int)__builtin_amdgcn_readfirstlane(nx);
            if (item >= N_DIFF_ITEMS) break;
            diff_item(p, item, lane);
        }
        __syncthreads();
        for (int gq = 0; gq < 4; ++gq) { pg8::Gemm g{(const bf16_t*)(p.ws + WS_TMPA) + gq * 256, (const bf16_t*)(p.ws + WS_WPB) + gq * 65536, 1024, 256, 2048, 256, 256};
            pg8::StaticOrder S; S.init(8, 1, 4, G, (bx + G - 8 * gq) % G); EpiWA E{Wt_br + gq * 256}; pg8::gemm_phase(lds, g, S, E); }
    }
    SEAM(2);
    if (IN(3)) {
        { pg8::Gemm g{AO, Wt_br, 2048, 2048, MT, D, 2048}; pg8::StaticOrder S; S.init(64, 8, 32, G, bx, 64, MG_SPLIT); EpiMerged E{GATE, MERGED, (float*)(p.ws + WS_XN)}; pg8::gemm_phase(lds, g, S, E); }
    }
    if (IN(3) && IN(4)) xcd_barrier(xbar);
    if (IN(3)) {
        for (int r = gw; r < MS; r += NGW) {
            const f32x4* pr = (const f32x4*)((const float*)(p.ws + WS_XN) + (size_t)r * D) + lane;
            const u32x2* gr = (const u32x2*)(GATE + (size_t)(MP + r) * 4096) + lane; u32x2* o8 = (u32x2*)(MERGED + (size_t)(MP + r) * D) + lane;
#pragma unroll
            for (int j = 0; j < 8; ++j) { const size_t cs = (size_t)MS * D / 4;
                const f32x4 a = pr[64 * j] + pr[cs + 64 * j], b = pr[2 * cs + 64 * j] + pr[3 * cs + 64 * j];
                const u32x2 rw = gr[64 * j], bw = gr[512 + 64 * j];
                const f32x4 rr = (f32x4){bflo(rw.x), bfhi(rw.x), bflo(rw.y), bfhi(rw.y)}, gb = (f32x4){bflo(bw.x), bfhi(bw.x), bflo(bw.y), bfhi(bw.y)};
                const f32x4 v = gb * (rr * a + b);
                o8[64 * j] = (u32x2){cvt_pk_bf16(v.x, v.y), cvt_pk_bf16(v.z, v.w)}; }
        }
    }
    SEAM(3);
    if (IN(4)) { pg8::Gemm g{MERGED, Wt_out, D, D, MT, D, D}; pg8::StaticOrder S; S.init(64, 8, 32, G, bx, 64, OUT_SPLIT); EpiOut E{p.x_prompt, p.x_sample, Y, XN, (float*)(p.ws + WS_SSQP), (float*)(p.ws + WS_AO)}; pg8::gemm_phase(lds, g, S, E); }
    if (IN(4) && IN(5)) xcd_barrier(xbar);
    if (IN(4)) {
        for (int r = gw; r < MS; r += NGW) {
            const f32x4* xr = (const f32x4*)(p.x_sample + (size_t)r * D) + lane; const f32x4* pr = (const f32x4*)((const float*)(p.ws + WS_AO) + (size_t)r * D) + lane;
            u32x2* o8 = (u32x2*)(XN + (size_t)(MP + r) * D) + lane; float* sp = (float*)(p.ws + WS_SSQP);
            float sq = 0.f;
#pragma unroll
            for (int j = 0; j < 8; ++j) { f32x4 v = xr[64 * j];
#pragma unroll
                for (int c = 0; c < OUT_SPLIT; ++c) v += pr[(size_t)c * MS * D / 4 + 64 * j];
                sq += (v.x * v.x + v.y * v.y) + (v.z * v.z + v.w * v.w);
                o8[64 * j] = (u32x2){cvt_pk_bf16(v.x, v.y), cvt_pk_bf16(v.z, v.w)}; }
            sq = wave_sum(sq);
            if (lane < 32) sp[(size_t)lane * MT + MP + r] = lane == 0 ? sq : 0.f;
        }
    }
    SEAM(4);
    if (IN(5)) { pg8::Gemm g{XN, Wt_gu, D, D, MT, NGU, D}; pg8::StaticOrder S; S.init(64, NGU / 256, 32, G, bx, 64, 1);
        LAS float* tab = (LAS float*)(lds + 131072);
        { pg8::Unit u0; S.next(0, u0); const float* sp = (const float*)(p.ws + WS_SSQP);
          if (tid < 384) { const int row = tid < 256 ? u0.pm * 256 + tid : MP + (tid - 256); float a = 0.f;
#pragma unroll 8
              for (int k = 0; k < 32; ++k) a += sp[(size_t)k * MT + row];
              tab[tid] = __builtin_amdgcn_rsqf(a * (1.0f / D) + EPS); }
          __syncthreads(); }
        EpiGU E{tab, HID}; pg8::gemm_phase(lds, g, S, E); }
    SEAM(5);
    if (IN(6)) { pg8::Gemm g{HID, Wt_dn, FF, FF, MT, D, FF}; pg8::StaticOrder S; S.init(64, 8, FF / 64, G, bx, 64, DN_SPLIT); EpiDown E{Y, (float*)(p.ws + WS_AO), XN, (bf16_t*)(p.ws + WS_H2B)}; pg8::gemm_phase(lds, g, S, E); }
    SEAM(6);
    if (IN(7)) {
        for (int m = gw; m < MV; m += NGW) {
            f32x4* yr = (f32x4*)(Y + (size_t)m * D) + lane; const f32x4* gf = (const f32x4*)p.g_final + lane;
            f32x4 v[8]; float s = 0.f;
            {
                const u32x2* hr = (const u32x2*)((m < MP ? (const bf16_t*)(p.ws + WS_H2B) : (const bf16_t*)XN) + (size_t)m * D) + lane;
#pragma unroll
                for (int j = 0; j < 8; ++j) { const u32x2 w2 = hr[64 * j]; v[j] = (f32x4){bflo(w2.x), bfhi(w2.x), bflo(w2.y), bfhi(w2.y)}; } }
            if (m >= MP) { const f32x4* pr = (const f32x4*)((const float*)(p.ws + WS_AO) + (size_t)(m - MP) * D) + lane;
                for (int c = 0; c < DN_SPLIT; ++c)
#pragma unroll
                    for (int j = 0; j < 8; ++j) v[j] += pr[(size_t)c * MS * D / 4 + 64 * j]; }
#pragma unroll
            for (int j = 0; j < 8; ++j) s += (v[j].x * v[j].x + v[j].y * v[j].y) + (v[j].z * v[j].z + v[j].w * v[j].w);
            const float rs = __builtin_amdgcn_rsqf(wave_sum(s) * (1.0f / D) + EPS);
#pragma unroll
            for (int j = 0; j < 8; ++j) yr[64 * j] = v[j] * rs * gf[64 * j];
        }
    }
#ifdef PROBE_T
    STAMP();
    if (bx == 0 && tid == 0) {
        const unsigned long long e1 = (unsigned long long)__hip_atomic_load((long long*)(p.ws + WS_SSQ + 512 * 1024), __ATOMIC_RELAXED, __HIP_MEMORY_SCOPE_AGENT);
        const unsigned long long e2 = (unsigned long long)__hip_atomic_load((long long*)(p.ws + WS_SSQ + 512 * 1024 + 256), __ATOMIC_RELAXED, __HIP_MEMORY_SCOPE_AGENT);
        (void)e1; (void)e2;
        const float ta = (float)(tstamp[PROBE_A + 1] - tstamp[PROBE_A]) * 0.01f, tb = (float)(tstamp[PROBE_B + 1] - tstamp[PROBE_B]) * 0.01f;
        asm volatile("s_waitcnt vmcnt(0)" ::: "memory");
        atomicAdd(Y, 4.0f + ta * (1.0f / 256.0f)); atomicAdd(p.out + OFF_PP, 1.5f + tb * (1.0f / 500.0f));
    }
#endif
#undef IN
#undef SEAM
}

extern "C" void kernel_launch(void* const* d_in, const int* in_sizes, int n_in, void* d_out, int out_size, void* d_ws, size_t ws_size, hipStream_t stream) {
    static int grid = 0;
    if (grid == 0) {
        if (n_in != 15 || (size_t)out_size != OUT_TOTAL || ws_size < WS_END) { fprintf(stderr, "kernel_launch: unexpected shapes: n_in %d out %d ws %zu\n", n_in, out_size, ws_size); grid = -1; return; }
        int dev = 0, cus = 0, per_cu = 0;
        hipGetDevice(&dev); hipDeviceGetAttribute(&cus, hipDeviceAttributeMultiprocessorCount, dev);
        hipFuncSetAttribute((const void*)fwd_megakernel, hipFuncAttributeMaxDynamicSharedMemorySize, LDS_BYTES);
        hipOccupancyMaxActiveBlocksPerMultiprocessor(&per_cu, (const void*)fwd_megakernel, 512, LDS_BYTES);
        if (per_cu < 1) { fprintf(stderr, "kernel_launch: occupancy query says %d blocks per CU\n", per_cu); per_cu = 1; }
        (void)hipGetLastError();
        grid = cus;
    }
    if (grid < 0) return;
    Params p{};
    const float** pp = (const float**)&p;
    for (int i = 0; i < 15; ++i) pp[i] = (const float*)d_in[i];
    p.out = (float*)d_out; p.ws = (unsigned char*)d_ws;
#if N_LAUNCH_MODE == 1
    p.ph_lo = 0; p.ph_hi = 8;
    void* args[] = {&p};
    if (hipMemsetAsync((char*)d_ws + WS_BAR, 0, WS_BAR_BYTES, stream) != hipSuccess) fprintf(stderr, "kernel_launch: memset of the barrier words failed\n");
    hipError_t e = hipLaunchCooperativeKernel((const void*)fwd_megakernel, dim3(grid), dim3(512), args, LDS_BYTES, stream);
    if (e != hipSuccess) fprintf(stderr, "cooperative launch failed: %s (grid %d)\n", hipGetErrorString(e), grid);
#else
    for (int ph = 0; ph < 8; ++ph) { p.ph_lo = ph; p.ph_hi = ph + 1; hipLaunchKernelGGL(fwd_megakernel, dim3(grid), dim3(512), LDS_BYTES, stream, p); }
#endif
}
```

```cpp
#include <hip/hip_runtime.h>
#include <hip/hip_cooperative_groups.h>
#include <cstdio>
#include <cstdint>
namespace cg = cooperative_groups;

#define PROBE_A 6
#define PROBE_B 4
#ifndef N_LAUNCH_MODE
#define N_LAUNCH_MODE 1
#endif

#define LAS __attribute__((address_space(3)))
typedef unsigned short bf16_t;
typedef short bf16x8 __attribute__((ext_vector_type(8)));
typedef short s16x4 __attribute__((ext_vector_type(4)));
typedef float f32x4 __attribute__((ext_vector_type(4)));
typedef float f32x16 __attribute__((ext_vector_type(16)));
typedef unsigned u32x4 __attribute__((ext_vector_type(4)));
typedef unsigned u32x2 __attribute__((ext_vector_type(2)));

constexpr int D = 2048, MP = 16384, MS = 128, MV = MP + MS, MT = 16640;
constexpr int SEQ = 4096, DSEQ = 16, PAST = 4096, NH = 8, HD = 128;
constexpr int NIN = 8192, FF = 5632, NGU = 2 * FF, AW = 1024;
constexpr float EPS = 1e-6f;
constexpr size_t OFF_Y = 0, OFF_KP = (size_t)MV * D, OFF_VP = OFF_KP + (size_t)MP * 1024, OFF_PP = OFF_VP + (size_t)MP * 1024,
                 OFF_KS = OFF_PP + 4 * 15 * 1024, OFF_VS = OFF_KS + (size_t)MS * 1024, OFF_PS = OFF_VS + (size_t)MS * 1024, OUT_TOTAL = OFF_PS + 8 * 15 * 1024;
constexpr size_t MiB = 1u << 20;
constexpr size_t WS_SSQ = 0, WS_WIN = 1 * MiB, WS_WBR = 33 * MiB, WS_WOUT = 41 * MiB, WS_WGU = 49 * MiB, WS_WDN = 93 * MiB, WS_XN = 115 * MiB,
                 WS_QKVU = 180 * MiB, WS_GATE = 310 * MiB, WS_AO = 440 * MiB, WS_TMPA = 505 * MiB, WS_WPB = 509 * MiB, WS_SSQP = 510 * MiB, WS_END = 513 * MiB;
constexpr size_t WS_BAR = 768 * 1024, WS_BAR_BYTES = 32768;
constexpr size_t WS_H2B = WS_WIN;
static_assert(WS_H2B + (size_t)MV * D * 2 <= WS_WDN, "h2 overlay");
constexpr size_t WS_MERGED = WS_QKVU;
constexpr size_t WS_HID = WS_QKVU;
static_assert((size_t)MT * FF * 2 <= WS_AO - WS_QKVU, "hid overlay");
constexpr int LDS_BYTES = 147456;

typedef __bf16 bf16x2_t __attribute__((ext_vector_type(2)));
typedef float f32x2_t __attribute__((ext_vector_type(2)));
__device__ __forceinline__ unsigned cvt_pk_bf16(float lo, float hi) { const f32x2_t v = {lo, hi}; return __builtin_bit_cast(unsigned, __builtin_convertvector(v, bf16x2_t)); }
__device__ __forceinline__ float bf2f(unsigned short b) { return __uint_as_float(((unsigned)b) << 16); }
__device__ __forceinline__ float bflo(unsigned w) { return __uint_as_float(w << 16); }
__device__ __forceinline__ float bfhi(unsigned w) { return __uint_as_float(w & 0xffff0000u); }
__device__ __forceinline__ float fast_sigmoid(float x) { return __builtin_amdgcn_rcpf(1.0f + __expf(-x)); }
__device__ __forceinline__ float wave_sum(float v) {
#pragma unroll
    for (int o = 1; o < 64; o <<= 1) v += __shfl_xor(v, o);
    return v;
}

#define XB_TMO      128
#define XB_XCNT(j)  (256  + 64 * (j))
#define XB_XSUB(j)  (1280 + 64 * (j))
#define XB_XGEN(j)  (2304 + 64 * (j))
#define XB_TOP      3328
#define XB_TOPGEN   3392
#define XCD_BAR_WORDS 3456
#define XB_SPIN_CAP (1u << 18)

__device__ __forceinline__ unsigned xb_ld(unsigned* p)              { return __hip_atomic_load(p, __ATOMIC_RELAXED, __HIP_MEMORY_SCOPE_AGENT); }
__device__ __forceinline__ unsigned xb_add(unsigned* p, unsigned v) { return __hip_atomic_fetch_add(p, v, __ATOMIC_RELAXED, __HIP_MEMORY_SCOPE_AGENT); }
__device__ __forceinline__ unsigned xb_xcc_id() { return (unsigned)__builtin_amdgcn_s_getreg((3 << 11) | 20) & 0xFu; }
#define XB_SPIN(cond, bar) do { unsigned _sp = 0; while (cond) { __builtin_amdgcn_s_sleep(1); \
    if ((++_sp & 255u) == 0u) { if (xb_ld(&(bar)[XB_TMO])) break; if (_sp > XB_SPIN_CAP) { atomicAdd(&(bar)[XB_TMO], 1u); break; } } } } while (0)

struct XcdBarrier {
    unsigned* bar; unsigned x;
    volatile LAS unsigned* st;
};

__device__ __forceinline__ XcdBarrier xcd_barrier_post(unsigned* bar, volatile LAS unsigned* st) {
    XcdBarrier b; b.bar = bar; b.x = xb_xcc_id(); b.st = st;
    if (threadIdx.x == 0) (void)xb_add(&bar[XB_XCNT(b.x)], 1u);
    return b;
}
__device__ __forceinline__ void xcd_barrier_complete(unsigned* bar, unsigned x, unsigned& nloc, unsigned& nx) {
    const unsigned G = gridDim.x * gridDim.y * gridDim.z;
    unsigned sum, cnt, mine, sp = 0u;
    for (;;) {
        sum = 0u; cnt = 0u; mine = 0u;
#pragma unroll
        for (unsigned j = 0; j < 16; ++j) { const unsigned c = xb_ld(&bar[XB_XCNT(j)]); sum += c; cnt += (c > 0u) ? 1u : 0u; mine = (j == x) ? c : mine; }
        if (sum == G) break;
        __builtin_amdgcn_s_sleep(1);
        if ((++sp & 255u) == 0u) { if (xb_ld(&bar[XB_TMO])) break; if (sp > XB_SPIN_CAP) { atomicAdd(&bar[XB_TMO], 1u); break; } }
    }
    nloc = mine > 0u ? mine : 1u; nx = cnt > 0u ? cnt : 1u;
}

__device__ __forceinline__ void xcd_barrier(const XcdBarrier& b) {
    asm volatile("s_waitcnt vmcnt(0)" ::: "memory");
    __syncthreads();
    if (threadIdx.x == 0) {
        unsigned* bar = b.bar;
        __builtin_amdgcn_s_waitcnt(0);
        unsigned nloc = b.st[0], nx = b.st[1];
        if (nloc == 0u) { xcd_barrier_complete(bar, b.x, nloc, nx); b.st[0] = nloc; b.st[1] = nx; }
        const unsigned old = xb_add(&bar[XB_XSUB(b.x)], 1u);
        const unsigned gen = old / nloc;
        if (old + 1u == (gen + 1u) * nloc) {
            __builtin_amdgcn_fence(__ATOMIC_RELEASE, "agent");
            asm volatile("s_waitcnt vmcnt(0)" ::: "memory");
            const unsigned og = xb_add(&bar[XB_TOP], 1u);
            const unsigned tg = og / nx;
            if (og + 1u == (tg + 1u) * nx) xb_add(&bar[XB_TOPGEN], 1u);
            else XB_SPIN(xb_ld(&bar[XB_TOPGEN]) == tg, bar);
            __builtin_amdgcn_fence(__ATOMIC_ACQUIRE, "agent");
            xb_add(&bar[XB_XGEN(b.x)], 1u);
            asm volatile("s_waitcnt vmcnt(0)" ::: "memory");
        } else {
            XB_SPIN(xb_ld(&bar[XB_XGEN(b.x)]) == gen, bar);
            __builtin_amdgcn_fence(__ATOMIC_ACQUIRE, "agent");
            asm volatile("s_waitcnt vmcnt(0)" ::: "memory");
        }
    }
    __syncthreads();
}

namespace pg8 {
constexpr int BM = 256, BK = 64, HALF = 128, HTB = HALF * BK * 2, STAGE_BYTES = 8 * HTB, NXCD = 8, WGM = 8;
__host__ __device__ __forceinline__ int lds_byte(int r, int c) { const int st = (r >> 4) * 2 + (c >> 5), rr = r & 15, cc = c & 31, ob = rr * 64 + cc * 2; return st * 1024 + (ob ^ (((ob >> 9) & 1) << 5)); }
__host__ __device__ __forceinline__ void stage_rc(int b, int& R, int& C) { const int st = b / 1024, sb = b % 1024, swz = sb ^ (((sb >> 9) & 1) << 5); R = (st >> 1) * 16 + swz / 64; C = (st & 1) * 32 + (swz % 64) / 2; }
__host__ __device__ __forceinline__ int perm32(int rho) { const int n = rho >> 4, i = rho & 15; return 8 * (i >> 2) + 4 * n + (i & 3); }

struct Unit { int pm, pn, kt0, nkt, half; };
struct Gemm { const bf16_t* A; const bf16_t* Bt; int lda, ldb, M, N, K; };

struct StaticOrder {
    int nM, nN, nwg, G, c, ktfull, pmS, nS, ktS;
    __device__ void init(int nM_, int nN_, int ktfull_, int G_, int c_, int pmS_ = 0, int ksplit = 0) { nM = nM_; nN = nN_; nwg = nM * nN; G = G_; c = c_; ktfull = ktfull_; pmS = pmS_; nS = nN * ksplit; ktS = ksplit ? ktfull / ksplit : 0; }
    __device__ bool next(int i, Unit& u) const {
        const int L = i * G + c;
        if (L >= nwg) { const int t = L - nwg;
            if (t >= nS) return false;
            u.pm = pmS; u.pn = t % nN; u.kt0 = (t / nN) * ktS; u.nkt = ktS; u.half = 1; return true; }
        int wgid = L; { const int q = nwg / NXCD, r = nwg % NXCD, xcd = wgid % NXCD, off = wgid / NXCD; wgid = (xcd < r ? xcd * (q + 1) : r * (q + 1) + (xcd - r) * q) + off; }
        const int nig = WGM * nN, gid = wgid / nig, fm = gid * WGM, gsz = (nM - fm) < WGM ? (nM - fm) : WGM;
        u.pm = fm + ((wgid % nig) % gsz); u.pn = (wgid % nig) / gsz; u.kt0 = 0; u.nkt = ktfull; u.half = 0; return true;
    }
};

template <class Epi>
__device__ __forceinline__ void gemm_phase(LAS unsigned char* lds, const Gemm g, const StaticOrder& S, const Epi& E) {
    int tid_ = threadIdx.x; asm volatile("" : "+v"(tid_));
    const int tid = tid_, wid = __builtin_amdgcn_readfirstlane(tid >> 6), lane = tid & 63, wr = wid >> 2, wc = wid & 3, fr = lane & 15, fq = lane >> 4;
    unsigned voffA[2], voffB[2];
#pragma unroll
    for (int i = 0; i < 2; ++i) { int R, C; stage_rc(tid * 16 + i * 8192, R, C); const int Rb = (R & ~31) + perm32(R & 31);
        voffA[i] = (unsigned)(R * g.lda + C) * 2u; voffB[i] = (unsigned)(Rb * g.ldb + C) * 2u; }
    const size_t kstep = (size_t)(BK * 2);
    const size_t hstepA = (size_t)HALF * g.lda * 2, hstepB = (size_t)HALF * g.ldb * 2;
    const size_t tstepA = 2 * hstepA, tstepB = 2 * hstepB;
    const unsigned ldsw = (unsigned)wid * 1024u;
    const int aoff = lds_byte(wr * 64 + fr, fq * 8), boff = lds_byte(wc * 32 + fr, fq * 8);
#define PG8_SA(b, h) (((b) * 2 + (h)) * HTB)
#define PG8_SB(b, h) ((4 + (b) * 2 + (h)) * HTB)
#define PG8_STAGE(bufoff, gbase, voff) do { _Pragma("unroll") for (int _i = 0; _i < 2; ++_i) \
        __builtin_amdgcn_global_load_lds((const unsigned*)((const char*)(gbase) + (voff)[_i]), (LAS unsigned*)(lds + (bufoff) + ldsw + _i * 8192), 16, 0, 0); } while (0)
#define PG8_LDA(dst, b, h) do { _Pragma("unroll") for (int m = 0; m < 4; ++m) _Pragma("unroll") for (int k = 0; k < 2; ++k) dst[m][k] = *(const LAS bf16x8*)(lds + PG8_SA(b, h) + aoff + m * 2048 + k * 1024); } while (0)
#define PG8_LDB(dst, b, h) do { _Pragma("unroll") for (int n = 0; n < 2; ++n) _Pragma("unroll") for (int k = 0; k < 2; ++k) dst[n][k] = *(const LAS bf16x8*)(lds + PG8_SB(b, h) + boff + n * 2048 + k * 1024); } while (0)
#define PG8_MMA(ai, bj, At, Bt) do { __builtin_amdgcn_s_setprio(1); _Pragma("unroll") for (int m = 0; m < 4; ++m) _Pragma("unroll") for (int n = 0; n < 2; ++n) _Pragma("unroll") for (int k = 0; k < 2; ++k) \
        acc[ai][bj][m][n] = __builtin_amdgcn_mfma_f32_16x16x32_bf16(Bt[n][k], At[m][k], acc[ai][bj][m][n], 0, 0, 0); __builtin_amdgcn_s_setprio(0); } while (0)
#define PG8_WAIT_V(n) asm volatile("s_waitcnt vmcnt(" #n ")" ::: "memory")
#define PG8_WAIT_L(n) asm volatile("s_waitcnt lgkmcnt(" #n ")" ::: "memory")
#define PG8_BAR __builtin_amdgcn_s_barrier()
#define PG8_SCHED __builtin_amdgcn_sched_barrier(0)
    Unit cur, nxt; int ui = 0;
    if (!S.next(0, cur)) return;
    f32x4 acc[2][2][4][2];
#pragma unroll
    for (int a = 0; a < 2; ++a)
#pragma unroll
        for (int b = 0; b < 2; ++b)
#pragma unroll
            for (int m = 0; m < 4; ++m)
#pragma unroll
                for (int n = 0; n < 2; ++n) acc[a][b][m][n] = (f32x4){0.f, 0.f, 0.f, 0.f};
    bf16x8 At[4][2], B0[2][2], B1[2][2];
    const char* cA = (const char*)g.A + (size_t)cur.pm * tstepA + (size_t)cur.kt0 * kstep; const char* cB = (const char*)g.Bt + (size_t)cur.pn * tstepB + (size_t)cur.kt0 * kstep;
    PG8_STAGE(PG8_SB(0, 0), cB, voffB); PG8_STAGE(PG8_SB(0, 1), cB + hstepB, voffB); PG8_STAGE(PG8_SA(0, 0), cA, voffA); PG8_STAGE(PG8_SA(0, 1), cA + hstepA, voffA);
    if (wr == 1) PG8_BAR;
    PG8_WAIT_V(2); PG8_BAR;
    PG8_STAGE(PG8_SB(1, 0), cB + kstep, voffB); PG8_STAGE(PG8_SA(1, 0), cA + kstep, voffA); PG8_STAGE(PG8_SB(1, 1), cB + hstepB + kstep, voffB);
    PG8_WAIT_V(6); PG8_BAR;
    for (;;) {
        const bool has_next = S.next(ui + 1, nxt);
        const char* nA = has_next ? (const char*)g.A + (size_t)nxt.pm * tstepA + (size_t)nxt.kt0 * kstep : cA; const char* nB = has_next ? (const char*)g.Bt + (size_t)nxt.pn * tstepB + (size_t)nxt.kt0 * kstep : cB;
        const int nt = cur.nkt; const bool full = !cur.half;
        for (int t = 0; t < nt; t += 2) {
            const bool last = (t == nt - 2);
            if constexpr (Epi::HAS_MID) { if (!cur.half && t == (nt >> 1)) E.mid(acc, cur, wr, wc, fr, fq); }
            const char* a1 = cA + (size_t)(t + 1) * kstep;
            const char* a2 = last ? nA : cA + (size_t)(t + 2) * kstep; const char* b2 = last ? nB : cB + (size_t)(t + 2) * kstep;
            const char* a3 = a2 + kstep; const char* b3 = b2 + kstep;
            PG8_LDB(B0, 0, 0); PG8_LDB(B1, 0, 1); PG8_SCHED; PG8_LDA(At, 0, 0); PG8_STAGE(PG8_SA(1, 1), a1 + hstepA, voffA);
            PG8_WAIT_V(8); PG8_WAIT_L(0); PG8_BAR; PG8_MMA(0, 0, At, B0); PG8_MMA(0, 1, At, B1); PG8_BAR; PG8_SCHED;
            if (full) PG8_LDA(At, 0, 1); PG8_STAGE(PG8_SB(0, 0), b2, voffB); PG8_STAGE(PG8_SB(0, 1), b2 + hstepB, voffB); PG8_STAGE(PG8_SA(0, 0), a2, voffA);
            PG8_WAIT_V(8); PG8_WAIT_L(0); PG8_BAR; if (full) { PG8_MMA(1, 0, At, B0); PG8_MMA(1, 1, At, B1); } PG8_BAR; PG8_SCHED;
            PG8_LDB(B0, 1, 0); PG8_LDB(B1, 1, 1); PG8_SCHED; PG8_LDA(At, 1, 0); PG8_STAGE(PG8_SA(0, 1), a2 + hstepA, voffA);
            PG8_WAIT_V(8); PG8_WAIT_L(0); PG8_BAR; PG8_MMA(0, 0, At, B0); PG8_MMA(0, 1, At, B1); PG8_BAR; PG8_SCHED;
            if (full) PG8_LDA(At, 1, 1); PG8_STAGE(PG8_SB(1, 0), b3, voffB); PG8_STAGE(PG8_SB(1, 1), b3 + hstepB, voffB); PG8_STAGE(PG8_SA(1, 0), a3, voffA);
            PG8_WAIT_V(8); PG8_WAIT_L(0); PG8_BAR; if (full) { PG8_MMA(1, 0, At, B0); PG8_MMA(1, 1, At, B1); } PG8_BAR; PG8_SCHED;
        }
        if (wr == 0) PG8_BAR;
        E(acc, cur, wr, wc, fr, fq);
        if (!has_next) break;
#pragma unroll
        for (int a = 0; a < 2; ++a)
#pragma unroll
            for (int b = 0; b < 2; ++b)
#pragma unroll
                for (int m = 0; m < 4; ++m)
#pragma unroll
                    for (int n = 0; n < 2; ++n) acc[a][b][m][n] = (f32x4){0.f, 0.f, 0.f, 0.f};
        cur = nxt; cA = nA; cB = nB; ++ui;
        if (wr == 1) PG8_BAR;
    }
    PG8_WAIT_V(0);
    PG8_BAR;
#undef PG8_SA
#undef PG8_SB
#undef PG8_STAGE
#undef PG8_LDA
#undef PG8_LDB
#undef PG8_MMA
#undef PG8_WAIT_V
#undef PG8_WAIT_L
#undef PG8_BAR
#undef PG8_SCHED
}
}
using pg8::Unit;

__device__ __forceinline__ u32x4 pack8(const f32x4& v0, const f32x4& v1) {
    u32x4 w; w.x = cvt_pk_bf16(v0[0], v0[1]); w.y = cvt_pk_bf16(v0[2], v0[3]); w.z = cvt_pk_bf16(v1[0], v1[1]); w.w = cvt_pk_bf16(v1[2], v1[3]); return w;
}
__device__ __forceinline__ void unpack8(const u32x4& w, f32x4& v0, f32x4& v1) {
    v0 = (f32x4){bflo(w.x), bfhi(w.x), bflo(w.y), bfhi(w.y)}; v1 = (f32x4){bflo(w.z), bfhi(w.z), bflo(w.w), bfhi(w.w)};
}

struct EpiIn {
    static constexpr bool HAS_MID = false;
    bf16_t* qkvu; bf16_t* gate; float* out;
    __device__ __forceinline__ void operator()(const f32x4 (&acc)[2][2][4][2], const Unit& u, int wr, int wc, int fr, int fq) const {
        const int row0 = u.pm * 256 + wr * 64 + fr, cw = wc * 32 + 8 * fq;
        if (u.pn >= 16) {
            bf16_t* base = gate + (size_t)row0 * 4096 + (u.pn - 16) * 128 + cw;
#pragma unroll
            for (int ai = 0; ai < 2; ++ai)
#pragma unroll
                for (int m = 0; m < 4; ++m) { bf16_t* rowp = base + (size_t)(ai * 128 + m * 16) * 4096;
                    f32x4 r0, r1, b0, b1;
#pragma unroll
                    for (int j = 0; j < 4; ++j) { b0[j] = fmaxf(fast_sigmoid(acc[ai][1][m][0][j]), 1e-30f); b1[j] = fmaxf(fast_sigmoid(acc[ai][1][m][1][j]), 1e-30f);
                        r0[j] = fast_sigmoid(acc[ai][0][m][0][j]) * __builtin_amdgcn_rcpf(b0[j]); r1[j] = fast_sigmoid(acc[ai][0][m][1][j]) * __builtin_amdgcn_rcpf(b1[j]); }
                    *(u32x4*)rowp = pack8(r0, r1); *(u32x4*)(rowp + 2048) = pack8(b0, b1); }
        } else {
            const int sec = u.pn >> 2, cc = (u.pn & 3) * 256 + cw;
            bf16_t* base = qkvu + (size_t)sec * MT * 1024 + (size_t)row0 * 1024 + cc;
#pragma unroll
            for (int ai = 0; ai < 2; ++ai)
#pragma unroll
                for (int m = 0; m < 4; ++m) { bf16_t* rowp = base + (size_t)(ai * 128 + m * 16) * 1024;
#pragma unroll
                    for (int bj = 0; bj < 2; ++bj) *(u32x4*)(rowp + bj * 128) = pack8(acc[ai][bj][m][0], acc[ai][bj][m][1]); }
            if (sec >= 2) {
                const size_t offp = (sec == 2) ? OFF_KP : OFF_VP, offs = (sec == 2) ? OFF_KS : OFF_VS;
#pragma unroll
                for (int ai = 0; ai < 2; ++ai)
#pragma unroll
                    for (int m = 0; m < 4; ++m) { const int row = row0 + ai * 128 + m * 16;
                        if (row < MV) { float* o = out + (row < MP ? offp + (size_t)row * 1024 : offs + (size_t)(row - MP) * 1024) + cc;
#pragma unroll
                            for (int bj = 0; bj < 2; ++bj) { *(f32x4*)(o + bj * 128) = acc[ai][bj][m][0]; *(f32x4*)(o + bj * 128 + 4) = acc[ai][bj][m][1]; } } }
            } else if (sec == 0 && ((u.pm & 15) == 15 || u.pm == 64)) {
#pragma unroll
                for (int ai = 0; ai < 2; ++ai)
#pragma unroll
                    for (int m = 0; m < 4; ++m) { const int row = row0 + ai * 128 + m * 16; long off = -1;
                        if (row < MP) { const int t = row & (SEQ - 1); if (t >= SEQ - 15) off = (long)OFF_PP + ((long)(row >> 12) * 15 + (t - (SEQ - 15))) * 1024; }
                        else if (row < MV) { const int t = (row - MP) & 15, b = (row - MP) >> 4; if (t >= 1) off = (long)OFF_PS + ((long)b * 15 + (t - 1)) * 1024; }
                        if (off >= 0) { float* o = out + off + cc;
#pragma unroll
                            for (int bj = 0; bj < 2; ++bj) { *(f32x4*)(o + bj * 128) = acc[ai][bj][m][0]; *(f32x4*)(o + bj * 128 + 4) = acc[ai][bj][m][1]; } } }
            }
        }
    }
};
constexpr int MG_SPLIT = 4, MG_KT = (2048 / 64) / MG_SPLIT;
struct EpiMerged {
    static constexpr bool HAS_MID = true;
    const bf16_t* gate; bf16_t* merged; float* part;
    __device__ __forceinline__ void mid(f32x4 (&acc)[2][2][4][2], const Unit& u, int wr, int wc, int fr, int fq) const {
        int zoff = 0; asm volatile("" : "+v"(zoff));
        const int row0 = u.pm * 256 + wr * 64 + fr + zoff, cc = u.pn * 256 + wc * 32 + 8 * fq;
#pragma unroll
        for (int ai = 0; ai < 2; ++ai) {
            if (ai == 1 && u.half) break;
            u32x4 rw[4][2];
#pragma unroll
            for (int m = 0; m < 4; ++m)
#pragma unroll
                for (int bj = 0; bj < 2; ++bj) rw[m][bj] = *(const u32x4*)(gate + (size_t)(row0 + ai * 128 + m * 16) * 4096 + cc + bj * 128);
#pragma unroll
            for (int m = 0; m < 4; ++m)
#pragma unroll
                for (int bj = 0; bj < 2; ++bj) { f32x4 a0, a1; unpack8(rw[m][bj], a0, a1); acc[ai][bj][m][0] *= a0; acc[ai][bj][m][1] *= a1; }
            __builtin_amdgcn_sched_barrier(0);
        }
    }
    __device__ __forceinline__ void operator()(const f32x4 (&acc)[2][2][4][2], const Unit& u, int wr, int wc, int fr, int fq) const {
        const int row0 = u.pm * 256 + wr * 64 + fr, cc = u.pn * 256 + wc * 32 + 8 * fq;
        if (u.half) {
            float* ps = part + ((size_t)(u.kt0 / MG_KT) * MS + (row0 - MP)) * D + cc;
#pragma unroll
            for (int m = 0; m < 4; ++m)
#pragma unroll
                for (int bj = 0; bj < 2; ++bj) { *(f32x4*)(ps + (size_t)(m * 16) * D + bj * 128) = acc[0][bj][m][0]; *(f32x4*)(ps + (size_t)(m * 16) * D + bj * 128 + 4) = acc[0][bj][m][1]; }
            return; }
#pragma unroll
        for (int ai = 0; ai < 2; ++ai)
#pragma unroll
            for (int m = 0; m < 4; ++m) { const int row = row0 + ai * 128 + m * 16;
                const bf16_t* gp = gate + (size_t)row * 4096 + 2048 + cc; bf16_t* o = merged + (size_t)row * D + cc;
#pragma unroll
                for (int bj = 0; bj < 2; ++bj) { const u32x4 gw = *(const u32x4*)(gp + bj * 128); f32x4 g0, g1; unpack8(gw, g0, g1);
                    *(u32x4*)(o + bj * 128) = pack8(acc[ai][bj][m][0] * g0, acc[ai][bj][m][1] * g1); } }
    }
};
constexpr int OUT_SPLIT = 4, OUT_KT = (D / 64) / OUT_SPLIT;
struct EpiOut {
    static constexpr bool HAS_MID = false;
    const float* xp; const float* xs; float* y; bf16_t* hb; float* ssq; float* part;
    __device__ __forceinline__ void operator()(const f32x4 (&acc)[2][2][4][2], const Unit& u, int wr, int wc, int fr, int fq) const {
        int zoff = 0; asm volatile("" : "+v"(zoff));
        const int row0 = u.pm * 256 + wr * 64 + fr + zoff, cc = u.pn * 256 + wc * 32 + 8 * fq;
        if (u.half) {
            float* ps = part + ((size_t)(u.kt0 / OUT_KT) * MS + (row0 - MP)) * D + cc;
#pragma unroll
            for (int m = 0; m < 4; ++m)
#pragma unroll
                for (int bj = 0; bj < 2; ++bj) { *(f32x4*)(ps + (size_t)(m * 16) * D + bj * 128) = acc[0][bj][m][0]; *(f32x4*)(ps + (size_t)(m * 16) * D + bj * 128 + 4) = acc[0][bj][m][1]; }
            return; }
#pragma unroll
        for (int ai = 0; ai < 2; ++ai) {
            if (ai == 1 && u.half) break;
            f32x4 xv[4][2][2];
#pragma unroll
            for (int m = 0; m < 4; ++m) { const int row = row0 + ai * 128 + m * 16; const bool ok = row < MV;
                const float* xr = (row < MP ? xp + (size_t)row * D : xs + (size_t)(ok ? row - MP : 0) * D) + cc;
#pragma unroll
                for (int bj = 0; bj < 2; ++bj) { xv[m][bj][0] = *(const f32x4*)(xr + bj * 128); xv[m][bj][1] = *(const f32x4*)(xr + bj * 128 + 4); } }
            __builtin_amdgcn_sched_barrier(0);
#pragma unroll
            for (int m = 0; m < 4; ++m) { const int row = row0 + ai * 128 + m * 16; const bool ok = row < MV;
                bf16_t* ob = hb + (size_t)row * D + cc;
                float s = 0.f;
#pragma unroll
                for (int bj = 0; bj < 2; ++bj) { f32x4 h0 = acc[ai][bj][m][0], h1 = acc[ai][bj][m][1];
                    if (ok) { h0 += xv[m][bj][0]; h1 += xv[m][bj][1]; }
                    *(u32x4*)(ob + bj * 128) = pack8(h0, h1);
                    s += (h0[0] * h0[0] + h0[1] * h0[1]) + (h0[2] * h0[2] + h0[3] * h0[3]) + (h1[0] * h1[0] + h1[1] * h1[1]) + (h1[2] * h1[2] + h1[3] * h1[3]); }
                s += __shfl_xor(s, 16); s += __shfl_xor(s, 32);
                if (fq == 0) ssq[(size_t)(u.pn * 4 + wc) * MT + row] = s; }
            __builtin_amdgcn_sched_barrier(0);
        }
    }
};
struct EpiGU {
    static constexpr bool HAS_MID = false;
    const LAS float* tab; bf16_t* hid;
    __device__ __forceinline__ void operator()(const f32x4 (&acc)[2][2][4][2], const Unit& u, int wr, int wc, int fr, int fq) const {
        const int row0 = u.pm * 256 + wr * 64 + fr, cc = u.pn * 128 + wc * 32 + 8 * fq;
#pragma unroll
        for (int ai = 0; ai < 2; ++ai)
#pragma unroll
            for (int m = 0; m < 4; ++m) { const int row = row0 + ai * 128 + m * 16;
                const float sc = tab[(u.half ? 256 : 0) + ((ai * 128 + wr * 64 + m * 16 + fr) & (u.half ? 127 : 255))];
                f32x4 r0, r1;
#pragma unroll
                for (int j = 0; j < 4; ++j) { const float g0 = acc[ai][0][m][0][j] * sc, u0 = acc[ai][1][m][0][j] * sc, g1 = acc[ai][0][m][1][j] * sc, u1 = acc[ai][1][m][1][j] * sc;
                    r0[j] = g0 * fast_sigmoid(g0) * u0; r1[j] = g1 * fast_sigmoid(g1) * u1; }
                *(u32x4*)(hid + (size_t)row * FF + cc) = pack8(r0, r1); }
    }
};
constexpr int DN_SPLIT = 11, DN_KT = (FF / 64) / DN_SPLIT;
struct EpiDown {
    static constexpr bool HAS_MID = false;
    float* y; float* part; const bf16_t* hb; bf16_t* h2b;
    __device__ __forceinline__ void operator()(const f32x4 (&acc)[2][2][4][2], const Unit& u, int wr, int wc, int fr, int fq) const {
        const int row0 = u.pm * 256 + wr * 64 + fr, cc = u.pn * 256 + wc * 32 + 8 * fq;
#pragma unroll
        for (int ai = 0; ai < 2; ++ai)
#pragma unroll
            for (int m = 0; m < 4; ++m) { const int row = row0 + ai * 128 + m * 16;
                if (row < MV) { float* o = y + (size_t)row * D + cc;
                    if (u.half) {
                        float* ps = part + ((size_t)(u.kt0 / DN_KT) * MS + (row - MP)) * D + cc;
#pragma unroll
                        for (int bj = 0; bj < 2; ++bj) { *(f32x4*)(ps + bj * 128) = acc[ai][bj][m][0]; *(f32x4*)(ps + bj * 128 + 4) = acc[ai][bj][m][1]; }
                    } else {
#pragma unroll
                    for (int bj = 0; bj < 2; ++bj) { const u32x4 hw = *(const u32x4*)(hb + (size_t)row * D + cc + bj * 128); f32x4 h0, h1; unpack8(hw, h0, h1);
                        *(u32x4*)(h2b + (size_t)row * D + cc + bj * 128) = pack8(h0 + acc[ai][bj][m][0], h1 + acc[ai][bj][m][1]); } } } }
    }
};

struct EpiWA {
    static constexpr bool HAS_MID = false;
    bf16_t* dst;
    __device__ __forceinline__ void operator()(const f32x4 (&acc)[2][2][4][2], const Unit& u, int wr, int wc, int fr, int fq) const {
        const int row0 = u.pm * 256 + wr * 64 + fr, cc = wc * 32 + 8 * fq;
#pragma unroll
        for (int ai = 0; ai < 2; ++ai)
#pragma unroll
            for (int m = 0; m < 4; ++m) { bf16_t* o = dst + (size_t)(row0 + ai * 128 + m * 16) * 2048 + cc;
#pragma unroll
                for (int bj = 0; bj < 2; ++bj) *(u32x4*)(o + bj * 128) = pack8(acc[ai][bj][m][0], acc[ai][bj][m][1]); }
    }
};

__device__ __forceinline__ void p0_item(const float* W, int N, int k0, int n0, const float* gsc, bf16_t* dst, int ldd, int drow0, int dcol0, LAS float* scr, int lane) {
    const float* wp = W + (size_t)k0 * N + n0 + lane;
    float v[64];
#pragma unroll
    for (int i = 0; i < 64; ++i) v[i] = wp[(size_t)i * N];
    if (gsc) {
#pragma unroll
        for (int i = 0; i < 64; ++i) v[i] *= gsc[k0 + i]; }
#pragma unroll
    for (int i = 0; i < 64; ++i) scr[i * 65 + lane] = v[i];
    asm volatile("s_waitcnt lgkmcnt(0)" ::: "memory");
    const int c = lane & 7;
#pragma unroll
    for (int j = 0; j < 8; ++j) { const int n = (lane >> 3) + 8 * j; const LAS float* s = scr + (8 * c) * 65 + n;
        u32x4 o; o.x = cvt_pk_bf16(s[0 * 65], s[1 * 65]); o.y = cvt_pk_bf16(s[2 * 65], s[3 * 65]); o.z = cvt_pk_bf16(s[4 * 65], s[5 * 65]); o.w = cvt_pk_bf16(s[6 * 65], s[7 * 65]);
        *(u32x4*)(dst + (size_t)(drow0 + n) * ldd + dcol0 + k0 + 8 * c) = o; }
    asm volatile("s_waitcnt lgkmcnt(0)" ::: "memory");
}

struct Params {
    const float *x_prompt, *x_sample, *cache_k, *cache_v, *state_pool, *g_mix, *w_in, *w_pool, *s_pool, *w_branch, *w_out, *g_ffn, *w_gate_up, *w_down, *g_final;
    float* out; unsigned char* ws; int ph_lo, ph_hi;
};

__device__ __forceinline__ void xn_row(const Params& p, int m, int lane);
__device__ __forceinline__ void phase0(const Params& p, LAS unsigned char* lds, int gw, int NGW, int wave, int lane, unsigned xcc) {
    LAS float* scr = (LAS float*)(lds + wave * 16640);
    bf16_t* Wt_in = (bf16_t*)(p.ws + WS_WIN); bf16_t* Wt_br = (bf16_t*)(p.ws + WS_WBR); bf16_t* Wt_out = (bf16_t*)(p.ws + WS_WOUT);
    bf16_t* Wt_gu = (bf16_t*)(p.ws + WS_WGU); bf16_t* Wt_dn = (bf16_t*)(p.ws + WS_WDN); bf16_t* XN = (bf16_t*)(p.ws + WS_XN);
    bf16_t* TMPA = (bf16_t*)(p.ws + WS_TMPA); bf16_t* WPB = (bf16_t*)(p.ws + WS_WPB);
    constexpr int I_IN = (D / 64) * (NIN / 64), I_BR = (D / 64) * (D / 64), I_OUT = (D / 64) * (D / 64), I_GU = (D / 64) * (NGU / 64), I_DN = (FF / 64) * (D / 64);
    constexpr int NITEMS = I_IN + I_BR + I_OUT + I_GU + I_DN;
    unsigned* ctr = (unsigned*)(p.ws + WS_BAR) + 3648 + 64 * (xcc & 7);
    constexpr int NXN = MT / 2;
    for (;;) {
        unsigned kq = 0; if (lane == 0) kq = __hip_atomic_fetch_add(ctr, 1u, __ATOMIC_RELAXED, __HIP_MEMORY_SCOPE_AGENT);
        const int it = 8 * (int)__builtin_amdgcn_readfirstlane(kq) + (int)(xcc & 7);
        if (it >= NITEMS + NXN) break;
        if (it >= NITEMS) { xn_row(p, 2 * (it - NITEMS), lane); xn_row(p, 2 * (it - NITEMS) + 1, lane); continue; }
        int r = it;
        if (r < I_IN) { const int nb = NIN / 64; const int n0 = 64 * (r % nb); int drow = n0;
            if (n0 >= 4096) { const int q = n0 - 4096; drow = q < 2048 ? 4096 + (q / 128) * 256 + (q % 128) : 4096 + ((q - 2048) / 128) * 256 + 128 + ((q - 2048) % 128); }
            p0_item(p.w_in, NIN, 64 * (r / nb), n0, p.g_mix, Wt_in, D, drow, 0, scr, lane); continue; } r -= I_IN;
        if (r < I_BR) { const int nb = D / 64; const int k0 = 64 * (r / nb), n0 = 64 * (r % nb);
            if (k0 < 1024) p0_item(p.w_branch, D, k0, n0, p.s_pool, TMPA, 1024, n0, 0, scr, lane);
            else p0_item(p.w_branch, D, k0, n0, nullptr, Wt_br, 2048, n0, 0, scr, lane);
            continue; } r -= I_BR;
        if (r < I_OUT) { const int nb = D / 64; p0_item(p.w_out, D, 64 * (r / nb), 64 * (r % nb), nullptr, Wt_out, D, 64 * (r % nb), 0, scr, lane); continue; } r -= I_OUT;
        if (r < I_GU) { const int nb = NGU / 64; const int n0 = 64 * (r % nb); const int drow = n0 < FF ? (n0 / 128) * 256 + (n0 % 128) : ((n0 - FF) / 128) * 256 + 128 + ((n0 - FF) % 128);
            p0_item(p.w_gate_up, NGU, 64 * (r / nb), n0, p.g_ffn, Wt_gu, D, drow, 0, scr, lane); continue; } r -= I_GU;
        { const int nb = D / 64; p0_item(p.w_down, D, 64 * (r / nb), 64 * (r % nb), nullptr, Wt_dn, FF, 64 * (r % nb), 0, scr, lane); }
    }
}
__device__ __forceinline__ void xn_row(const Params& p, int m, int lane) {
    bf16_t* XN = (bf16_t*)(p.ws + WS_XN);
    u32x2* o8 = (u32x2*)(XN + (size_t)m * D) + lane;
    if (m >= MV) {
#pragma unroll
        for (int j = 0; j < 8; ++j) o8[64 * j] = (u32x2){0u, 0u};
        return; }
    const f32x4* xr = (const f32x4*)(m < MP ? p.x_prompt + (size_t)m * D : p.x_sample + (size_t)(m - MP) * D) + lane;
    f32x4 v[8]; float s = 0.f;
#pragma unroll
    for (int j = 0; j < 8; ++j) { v[j] = xr[64 * j]; s += (v[j].x * v[j].x + v[j].y * v[j].y) + (v[j].z * v[j].z + v[j].w * v[j].w); }
    const float rs = __builtin_amdgcn_rsqf(wave_sum(s) * (1.0f / D) + EPS);
#pragma unroll
    for (int j = 0; j < 8; ++j) o8[64 * j] = (u32x2){cvt_pk_bf16(v[j].x * rs, v[j].y * rs), cvt_pk_bf16(v[j].z * rs, v[j].w * rs)};
}
__device__ __forceinline__ void phase0b(const Params& p, int gw, int NGW, int lane) {
    bf16_t* WPB = (bf16_t*)(p.ws + WS_WPB);
    for (int i = gw * 64 + lane; i < 4 * 256 * 256 / 8; i += NGW * 64) { const f32x4 a = *(const f32x4*)(p.w_pool + (size_t)i * 8), b = *(const f32x4*)(p.w_pool + (size_t)i * 8 + 4); *(u32x4*)(WPB + (size_t)i * 8) = pack8(a, b); }
    float* ssq = (float*)(p.ws + WS_SSQ);
    for (int i = gw * 64 + lane; i < MT; i += NGW * 64) ssq[i] = 0.f;
}

constexpr int VROW = 320;
__device__ __forceinline__ s16x4 vtr(const LAS unsigned char* p) { typedef short v4i16_t __attribute__((ext_vector_type(4))); return __builtin_bit_cast(s16x4, __builtin_amdgcn_ds_read_tr16_b64_v4i16((LAS v4i16_t*)p)); }
__device__ __forceinline__ bf16x8 cvt8(const f32x4& a, const f32x4& b) { u32x4 w = pack8(a, b); return __builtin_bit_cast(bf16x8, w); }

__device__ __forceinline__ void attn_unit(const Params& p, LAS unsigned char* vl, int unit, int lane) {
    const bf16_t* Ub = (const bf16_t*)(p.ws + WS_QKVU);
    const bf16_t* Qb = Ub + (size_t)MT * 1024; const bf16_t* Kb = Qb + (size_t)MT * 1024; const bf16_t* Vb = Kb + (size_t)MT * 1024;
    bf16_t* AO = (bf16_t*)(p.ws + WS_AO);
    const int n = lane & 31, hh = lane >> 5;
    const bool sample = unit < 64;
    int b, h, qrow0, nblk;
    if (sample) { b = unit >> 3; h = unit & 7; qrow0 = MP + b * DSEQ; nblk = 1 + PAST / 32; }
    else { const int u2 = unit - 64; const int qb = u2 & 127; h = (u2 >> 7) & 7; b = u2 >> 10; qrow0 = b * SEQ + qb * 32; nblk = qb + 1; }
    bf16x8 qf[8];
    { const bf16_t* qp = Qb + (size_t)(qrow0 + n) * 1024 + h * HD + 64 * hh;
#pragma unroll
      for (int kk = 0; kk < 8; ++kk) qf[kk] = *(const bf16x8*)(qp + 8 * kk); }
    f32x16 o[4];
#pragma unroll
    for (int db = 0; db < 4; ++db)
#pragma unroll
        for (int r = 0; r < 16; ++r) o[db][r] = 0.f;
    float R = (sample && n >= DSEQ) ? -1e30f : 0.f;
    const float* ck = p.cache_k + (size_t)b * PAST * 1024 + h * HD; const float* cv = p.cache_v + (size_t)b * PAST * 1024 + h * HD;
    const int vaddr = (4 * hh + ((lane & 15) >> 2)) * VROW + (16 * ((lane >> 4) & 1) + 4 * (lane & 3)) * 2;
    for (int blk = 0; blk < nblk; ++blk) {
        bf16x8 kf[8];
        const bool diag = (blk == 0);
        if (!sample || blk == 0) {
            const int s0 = qrow0 - blk * 32;
            const bf16_t* kp = Kb + (size_t)(s0 + n) * 1024 + h * HD + 64 * hh;
#pragma unroll
            for (int kk = 0; kk < 8; ++kk) kf[kk] = *(const bf16x8*)(kp + 8 * kk);
            const bf16_t* vp = Vb + (size_t)(s0 + (lane >> 4)) * 1024 + h * HD + 8 * (lane & 15);
#pragma unroll
            for (int it = 0; it < 8; ++it) { const u32x4 w = *(const u32x4*)(vp + (size_t)(4 * it) * 1024); *(LAS u32x4*)(vl + (4 * it + (lane >> 4)) * VROW + 16 * (lane & 15)) = w; }
        } else {
            const int s0 = PAST - blk * 32;
            const float* kp = ck + (size_t)(s0 + n) * 1024 + 64 * hh;
#pragma unroll
            for (int kk = 0; kk < 8; ++kk) kf[kk] = cvt8(*(const f32x4*)(kp + 8 * kk), *(const f32x4*)(kp + 8 * kk + 4));
            const float* vp = cv + (size_t)(s0 + (lane >> 4)) * 1024 + 8 * (lane & 15);
#pragma unroll
            for (int it = 0; it < 8; ++it) { const f32x4 a = *(const f32x4*)(vp + (size_t)(4 * it) * 1024), c = *(const f32x4*)(vp + (size_t)(4 * it) * 1024 + 4);
                *(LAS u32x4*)(vl + (4 * it + (lane >> 4)) * VROW + 16 * (lane & 15)) = pack8(a, c); }
        }
        f32x16 st;
#pragma unroll
        for (int r = 0; r < 16; ++r) st[r] = 0.f;
#pragma unroll
        for (int kk = 0; kk < 8; ++kk) st = __builtin_amdgcn_mfma_f32_32x32x16_bf16(kf[kk], qf[kk], st, 0, 0, 0);
        float l1m[16], ls[16];
#pragma unroll
        for (int r = 0; r < 16; ++r) { const int i = (r & 3) + 8 * (r >> 2) + 4 * hh; const bool valid = !diag || (i < n);
            const float z = st[r] * 0.08838834764831845f; const float sp = fmaxf(z, 0.f) + __logf(1.0f + __expf(-fabsf(z)));
            l1m[r] = valid ? -sp : 0.f; ls[r] = valid ? (z - sp) : -1e30f; }
        float gown[4], goth[4];
#pragma unroll
        for (int a = 0; a < 4; ++a) { gown[a] = (l1m[4 * a] + l1m[4 * a + 1]) + (l1m[4 * a + 2] + l1m[4 * a + 3]); goth[a] = __shfl_xor(gown[a], 32); }
        float wv[16]; float tail = R;
#pragma unroll
        for (int a = 3; a >= 0; --a) { float sfx = tail + (hh == 0 ? goth[a] : 0.f);
#pragma unroll
            for (int rr = 3; rr >= 0; --rr) { wv[4 * a + rr] = __expf(ls[4 * a + rr] + sfx); sfx += l1m[4 * a + rr]; }
            tail += gown[a] + goth[a]; }
        R = tail;
        bf16x8 wb[2];
#pragma unroll
        for (int s = 0; s < 2; ++s) wb[s] = cvt8((f32x4){wv[8 * s], wv[8 * s + 1], wv[8 * s + 2], wv[8 * s + 3]}, (f32x4){wv[8 * s + 4], wv[8 * s + 5], wv[8 * s + 6], wv[8 * s + 7]});
        asm volatile("s_waitcnt lgkmcnt(0)" ::: "memory");
#pragma unroll
        for (int db = 0; db < 4; ++db)
#pragma unroll
            for (int s = 0; s < 2; ++s) { const s16x4 lo = vtr(vl + vaddr + (16 * s) * VROW + 64 * db), hi = vtr(vl + vaddr + (16 * s + 8) * VROW + 64 * db);
                const bf16x8 vf = (bf16x8){lo[0], lo[1], lo[2], lo[3], hi[0], hi[1], hi[2], hi[3]};
                o[db] = __builtin_amdgcn_mfma_f32_32x32x16_bf16(vf, wb[s], o[db], 0, 0, 0); }
        asm volatile("s_waitcnt lgkmcnt(0)" ::: "memory");
        if (__all(R < -104.0f)) break;
    }
    if (!sample || n < DSEQ) {
        bf16_t* op = AO + (size_t)(qrow0 + n) * 2048 + 1024 + h * HD + 4 * hh;
#pragma unroll
        for (int db = 0; db < 4; ++db)
#pragma unroll
            for (int a = 0; a < 4; ++a) *(u32x2*)(op + 32 * db + 8 * a) = (u32x2){cvt_pk_bf16(o[db][4 * a], o[db][4 * a + 1]), cvt_pk_bf16(o[db][4 * a + 2], o[db][4 * a + 3])};
    }
}

constexpr int AKROW = 272, AVROW = 288, AKB = 32 * AKROW, AVB = 32 * AVROW, AFLAG = 2 * AKB + 2 * AVB;
constexpr float SB_EXIT = -150.05f;
template <bool DIAG>
__device__ __forceinline__ void sb_block_t(const LAS unsigned char* kl, const LAS unsigned char* vl, int vaddr, const bf16x8 (&qf)[8], f32x16 (&o)[4], float& R, int n, int hh) {
    constexpr float C = 0.08838834764831845f * 1.4426950408889634f;
    f32x16 st;
#pragma unroll
    for (int r = 0; r < 16; ++r) st[r] = 0.f;
    { bf16x8 kf[8];
#pragma unroll
      for (int kk = 0; kk < 8; ++kk) kf[kk] = *(const LAS bf16x8*)(kl + 16 * kk);
#pragma unroll
      for (int kk = 0; kk < 8; ++kk) st = __builtin_amdgcn_mfma_f32_32x32x16_bf16(kf[kk], qf[kk], st, 0, 0, 0); }
    float l1m[16];
#pragma unroll
    for (int r = 0; r < 16; ++r) { const int i = (r & 3) + 8 * (r >> 2) + 4 * hh; const bool valid = !DIAG || (i < n);
        const float Z = st[r] * C; const float sp = fmaxf(Z, 0.f) + __builtin_amdgcn_logf(1.0f + __builtin_amdgcn_exp2f(-fabsf(Z)));
        l1m[r] = valid ? -sp : 0.f; st[r] = valid ? (Z - sp) : -1e30f; }
    float gown[4], goth[4];
#pragma unroll
    for (int a = 0; a < 4; ++a) { gown[a] = (l1m[4 * a] + l1m[4 * a + 1]) + (l1m[4 * a + 2] + l1m[4 * a + 3]); goth[a] = __shfl_xor(gown[a], 32); }
    float tail = R;
#pragma unroll
    for (int a = 3; a >= 0; --a) { float sfx = tail + (hh == 0 ? goth[a] : 0.f);
#pragma unroll
        for (int rr = 3; rr >= 0; --rr) { st[4 * a + rr] = __builtin_amdgcn_exp2f(st[4 * a + rr] + sfx); sfx += l1m[4 * a + rr]; }
        tail += gown[a] + goth[a]; }
    R = tail;
    bf16x8 wb[2];
#pragma unroll
    for (int q = 0; q < 2; ++q) wb[q] = cvt8((f32x4){st[8 * q], st[8 * q + 1], st[8 * q + 2], st[8 * q + 3]}, (f32x4){st[8 * q + 4], st[8 * q + 5], st[8 * q + 6], st[8 * q + 7]});
#pragma unroll
    for (int db = 0; db < 4; ++db)
#pragma unroll
        for (int q = 0; q < 2; ++q) { const s16x4 lo = vtr(vl + vaddr + (16 * q) * AVROW + 64 * db), hi = vtr(vl + vaddr + (16 * q + 8) * AVROW + 64 * db);
            const bf16x8 vf = (bf16x8){lo[0], lo[1], lo[2], lo[3], hi[0], hi[1], hi[2], hi[3]};
            o[db] = __builtin_amdgcn_mfma_f32_32x32x16_bf16(vf, wb[q], o[db], 0, 0, 0); }
}
__device__ __forceinline__ void sb_block(const LAS unsigned char* kl, const LAS unsigned char* vl, int vaddr, const bf16x8 (&qf)[8], f32x16 (&o)[4], float& R, bool diag, int n, int hh) {
    if (diag) sb_block_t<true>(kl, vl, vaddr, qf, o, R, n, hh); else sb_block_t<false>(kl, vl, vaddr, qf, o, R, n, hh);
}
__device__ __forceinline__ void attn_wg_unit(const Params& p, LAS unsigned char* lds, int wgu, int wave, int lane) {
    const bf16_t* Ub = (const bf16_t*)(p.ws + WS_QKVU);
    const bf16_t* Qb = Ub + (size_t)MT * 1024; const bf16_t* Kb = Qb + (size_t)MT * 1024; const bf16_t* Vb = Kb + (size_t)MT * 1024;
    bf16_t* AO = (bf16_t*)(p.ws + WS_AO);
    const int n = lane & 31, hh = lane >> 5;
    const int qg = wgu & 15, h = (wgu >> 4) & 7, b = wgu >> 7;
    const int qtop = qg * 8 + 7, qbw = qg * 8 + wave, qrow0 = b * SEQ + qbw * 32;
    bf16x8 qf[8];
    { const bf16_t* qp = Qb + (size_t)(qrow0 + n) * 1024 + h * HD + 64 * hh;
#pragma unroll
      for (int kk = 0; kk < 8; ++kk) qf[kk] = *(const bf16x8*)(qp + 8 * kk); }
    f32x16 o[4];
#pragma unroll
    for (int db = 0; db < 4; ++db)
#pragma unroll
        for (int r = 0; r < 16; ++r) o[db][r] = 0.f;
    float R = 0.f; bool done = false;
    LAS int* flags = (LAS int*)(lds + AFLAG);
    const int lrow = 4 * wave + (lane >> 4), lch = lane & 15;
    const size_t gbase = ((size_t)b * SEQ + lrow) * 1024 + h * HD + 8 * lch;
    const int vaddr = (4 * hh + ((lane & 15) >> 2)) * AVROW + (16 * ((lane >> 4) & 1) + 4 * (lane & 3)) * 2;
    u32x4 kr = *(const u32x4*)(Kb + gbase + (size_t)qtop * 32 * 1024), vr = *(const u32x4*)(Vb + gbase + (size_t)qtop * 32 * 1024);
    for (int s = 0; s <= qtop; ++s) {
        const int kb = qtop - s, bo = s & 1;
        *(LAS u32x4*)(lds + bo * AKB + lrow * AKROW + 16 * lch) = kr;
        *(LAS u32x4*)(lds + 2 * AKB + bo * AVB + lrow * AVROW + 16 * lch) = vr;
        if (kb > 0) { kr = *(const u32x4*)(Kb + gbase + (size_t)(kb - 1) * 32 * 1024); vr = *(const u32x4*)(Vb + gbase + (size_t)(kb - 1) * 32 * 1024); }
        asm volatile("s_waitcnt lgkmcnt(0)" ::: "memory"); __builtin_amdgcn_s_barrier(); asm volatile("" ::: "memory");
        if (s >= 8) {
            int all = 1;
#pragma unroll
            for (int w = 0; w < 8; ++w) all &= flags[((s - 1) & 1) * 8 + w];
            if (__builtin_amdgcn_readfirstlane(all)) break;
        }
        if (!done && kb <= qbw) {
            sb_block(lds + bo * AKB + n * AKROW + 128 * hh, lds + 2 * AKB + bo * AVB, vaddr, qf, o, R, kb == qbw, n, hh);
            if (__all(R < SB_EXIT)) done = true;
        }
        if (lane == 0) flags[(s & 1) * 8 + wave] = done ? 1 : 0;
    }
    { bf16_t* op = AO + (size_t)(qrow0 + n) * 2048 + 1024 + h * HD + 4 * hh;
#pragma unroll
      for (int db = 0; db < 4; ++db)
#pragma unroll
          for (int a = 0; a < 4; ++a) *(u32x2*)(op + 32 * db + 8 * a) = (u32x2){cvt_pk_bf16(o[db][4 * a], o[db][4 * a + 1]), cvt_pk_bf16(o[db][4 * a + 2], o[db][4 * a + 3])}; }
    asm volatile("s_waitcnt lgkmcnt(0)" ::: "memory"); __builtin_amdgcn_s_barrier(); asm volatile("" ::: "memory");
}

__device__ __forceinline__ void attn_wg_sample(const Params& p, LAS unsigned char* lds, int unit, int wave, int lane) {
    const bf16_t* Ub = (const bf16_t*)(p.ws + WS_QKVU);
    const bf16_t* Qb = Ub + (size_t)MT * 1024; const bf16_t* Kb = Qb + (size_t)MT * 1024; const bf16_t* Vb = Kb + (size_t)MT * 1024;
    bf16_t* AO = (bf16_t*)(p.ws + WS_AO);
    const int n = lane & 31, hh = lane >> 5;
    const int b = unit >> 3, h = unit & 7, qrow0 = MP + b * DSEQ;
    bf16x8 qf[8];
    { const bf16_t* qp = Qb + (size_t)(qrow0 + n) * 1024 + h * HD + 64 * hh;
#pragma unroll
      for (int kk = 0; kk < 8; ++kk) qf[kk] = *(const bf16x8*)(qp + 8 * kk); }
    f32x16 o[4];
#pragma unroll
    for (int db = 0; db < 4; ++db)
#pragma unroll
        for (int r = 0; r < 16; ++r) o[db][r] = 0.f;
    float R = (n >= DSEQ) ? -1e30f : 0.f; bool done = false;
    LAS int* flags = (LAS int*)(lds + AFLAG);
    const int lrow = 4 * wave + (lane >> 4), lch = lane & 15;
    const int vaddr = (4 * hh + ((lane & 15) >> 2)) * AVROW + (16 * ((lane >> 4) & 1) + 4 * (lane & 3)) * 2;
    const float* ck = p.cache_k + (size_t)b * PAST * 1024 + h * HD + 8 * lch; const float* cv = p.cache_v + (size_t)b * PAST * 1024 + h * HD + 8 * lch;
    u32x4 kr = *(const u32x4*)(Kb + (size_t)(qrow0 + lrow) * 1024 + h * HD + 8 * lch), vr = *(const u32x4*)(Vb + (size_t)(qrow0 + lrow) * 1024 + h * HD + 8 * lch);
    constexpr int NSTEP = 1 + PAST / 32;
    for (int s = 0; s < NSTEP; ++s) {
        const int bo = s & 1;
        *(LAS u32x4*)(lds + bo * AKB + lrow * AKROW + 16 * lch) = kr;
        *(LAS u32x4*)(lds + 2 * AKB + bo * AVB + lrow * AVROW + 16 * lch) = vr;
        f32x4 ka0, ka1, va0, va1;
        const bool more = s + 1 < NSTEP;
        if (more) { const size_t po = (size_t)(PAST - 32 * (s + 1) + lrow) * 1024; ka0 = *(const f32x4*)(ck + po); ka1 = *(const f32x4*)(ck + po + 4); va0 = *(const f32x4*)(cv + po); va1 = *(const f32x4*)(cv + po + 4); }
        asm volatile("s_waitcnt lgkmcnt(0)" ::: "memory"); __builtin_amdgcn_s_barrier(); asm volatile("" ::: "memory");
        if (s >= 1) { if (__builtin_amdgcn_readfirstlane(flags[((s - 1) & 1) * 8])) break; }
        if (wave == 0 && !done) {
            sb_block(lds + bo * AKB + n * AKROW + 128 * hh, lds + 2 * AKB + bo * AVB, vaddr, qf, o, R, s == 0, n, hh);
            if (__all(R < SB_EXIT)) done = true;
        }
        if (wave == 0 && lane == 0) flags[(s & 1) * 8] = done ? 1 : 0;
        if (more) { kr = pack8(ka0, ka1); vr = pack8(va0, va1); }
    }
    if (wave == 0 && n < DSEQ) { bf16_t* op = AO + (size_t)(qrow0 + n) * 2048 + 1024 + h * HD + 4 * hh;
#pragma unroll
      for (int db = 0; db < 4; ++db)
#pragma unroll
          for (int a = 0; a < 4; ++a) *(u32x2*)(op + 32 * db + 8 * a) = (u32x2){cvt_pk_bf16(o[db][4 * a], o[db][4 * a + 1]), cvt_pk_bf16(o[db][4 * a + 2], o[db][4 * a + 3])}; }
    asm volatile("s_waitcnt lgkmcnt(0)" ::: "memory"); __builtin_amdgcn_s_barrier(); asm volatile("" ::: "memory");
}

__device__ __forceinline__ void diff_ld(const bf16_t* up, const float* hp, bool prompt, bool hist, int trel, f32x4& a, f32x4& c) {
    a = (f32x4){0.f, 0.f, 0.f, 0.f}; c = a;
    if (trel >= 0 || (prompt && hist)) { const u32x4 v = *(const u32x4*)(up + (long)trel * 1024); unpack8(v, a, c); }
    else if (!prompt) { const float* q = hp + (size_t)(15 + trel) * 1024; a = *(const f32x4*)q; c = *(const f32x4*)(q + 4); }
}
constexpr int N_DIFF_ITEMS = (MV / 32) * 4;
__device__ __forceinline__ void diff_item(const Params& p, int wi, int lane) {
    const bf16_t* Ub = (const bf16_t*)(p.ws + WS_QKVU); bf16_t* AO = (bf16_t*)(p.ws + WS_AO);
    const int g = wi & 3, W = 2 << g, ch = 2 * (wi >> 2) + (lane >> 5), cc = 32 * g + (lane & 31);
    const int m0 = ch * 16; const bool prompt = m0 < MP; const int t0 = prompt ? (m0 & (SEQ - 1)) : PAST; const bool hist = t0 > 0;
    const bf16_t* up = Ub + (size_t)m0 * 1024 + cc * 8;
    const float* hp = p.state_pool + (size_t)(prompt ? 0 : ((m0 - MP) >> 4)) * 15 * 1024 + cc * 8;
    bf16_t* op = AO + (size_t)m0 * 2048 + cc * 8;
    f32x4 s0 = (f32x4){0.f, 0.f, 0.f, 0.f}, s1 = s0;
    for (int j = 1; j < W; ++j) { f32x4 a, c; diff_ld(up, hp, prompt, hist, -j, a, c); s0 += a; s1 += c; }
#pragma unroll 4
    for (int r = 0; r < 16; ++r) {
        f32x4 a, c, da, dc;
        { const u32x4 v = *(const u32x4*)(up + (size_t)r * 1024); unpack8(v, a, c); }
        diff_ld(up, hp, prompt, hist, r - (W - 1), da, dc);
        s0 += a; s1 += c;
        const int t = t0 + r; const float ic = __builtin_amdgcn_rcpf((float)(t + 1 < W ? t + 1 : W));
        *(u32x4*)(op + (size_t)r * 2048) = pack8(s0 * ic - a, s1 * ic - c);
        s0 -= da; s1 -= dc;
    }
}

__global__ void __launch_bounds__(512, 2) fwd_megakernel(Params p) {
    extern __shared__ __attribute__((aligned(16))) unsigned char lds_raw[];
    LAS unsigned char* lds = (LAS unsigned char*)lds_raw;
    const int tid = threadIdx.x, lane = tid & 63, wave = __builtin_amdgcn_readfirstlane(tid >> 6);
    const int G = gridDim.x, bx = blockIdx.x;
    const int vcu = (G % 8 == 0) ? (bx % 8) * (G / 8) + bx / 8 : bx;
    const int gw = vcu * 8 + wave, NGW = G * 8;
    cg::grid_group grid = cg::this_grid();
    volatile LAS unsigned* xst = (volatile LAS unsigned*)(lds + LDS_BYTES - 64);
    if (tid < 2) xst[tid] = 0u;
    __syncthreads();
    XcdBarrier xbar = xcd_barrier_post((unsigned*)(p.ws + WS_BAR), xst);
#define IN(k) (p.ph_lo <= (k) && (k) < p.ph_hi)
#define SEAM(k) do { if (IN(k) && IN((k) + 1)) { if (p.ph_hi > 64) grid.sync();   xcd_barrier(xbar); } STAMP(); } while (0)
    bf16_t* Wt_in = (bf16_t*)(p.ws + WS_WIN); bf16_t* Wt_br = (bf16_t*)(p.ws + WS_WBR); bf16_t* Wt_out = (bf16_t*)(p.ws + WS_WOUT);
    bf16_t* Wt_gu = (bf16_t*)(p.ws + WS_WGU); bf16_t* Wt_dn = (bf16_t*)(p.ws + WS_WDN); bf16_t* XN = (bf16_t*)(p.ws + WS_XN);
    bf16_t* QKVU = (bf16_t*)(p.ws + WS_QKVU); bf16_t* GATE = (bf16_t*)(p.ws + WS_GATE); bf16_t* AO = (bf16_t*)(p.ws + WS_AO);
    bf16_t* MERGED = (bf16_t*)(p.ws + WS_MERGED); bf16_t* HID = (bf16_t*)(p.ws + WS_HID); float* SSQ = (float*)(p.ws + WS_SSQ);
    float* Y = p.out + OFF_Y;
#ifdef PROBE_T
    unsigned long long tstamp[10]; int nst = 0;
#define STAMP() do { tstamp[nst++] = __builtin_amdgcn_s_memrealtime(); } while (0)
#else
#define STAMP() do {} while (0)
#endif
    STAMP();

    if (IN(0)) { phase0(p, lds, gw, NGW, wave, lane, xbar.x);
#ifdef PROBE_T
#endif
        phase0b(p, gw, NGW, lane);
    }
    SEAM(0);
    if (IN(1)) { pg8::Gemm g{XN, Wt_in, D, D, MT, NIN, D}; pg8::StaticOrder S; S.init(64, NIN / 256, D / 64, G, bx, 64, 1); EpiIn E{QKVU, GATE, p.out}; pg8::gemm_phase(lds, g, S, E); }
    SEAM(1);
    if (IN(2)) {
        for (int su = vcu; su < 64; su += G) attn_wg_sample(p, lds, su, wave, lane);
        for (int wu = vcu; wu < 512; wu += G) attn_wg_unit(p, lds, wu, wave, lane);
        for (int wi = gw; wi < N_DIFF_ITEMS; wi += NGW) diff_item(p, __builtin_amdgcn_readfirstlane(wi), lane);
        __syncthreads();
        for (int gq = 0; gq < 4; ++gq) { pg8::Gemm g{(const bf16_t*)(p.ws + WS_TMPA) + gq * 256, (const bf16_t*)(p.ws + WS_WPB) + gq * 65536, 1024, 256, 2048, 256, 256};
            pg8::StaticOrder S; S.init(8, 1, 4, G, (bx + G - 8 * gq) % G); EpiWA E{Wt_br + gq * 256}; pg8::gemm_phase(lds, g, S, E); }
    }
    SEAM(2);
    if (IN(3)) {
        { pg8::Gemm g{AO, Wt_br, 2048, 2048, MT, D, 2048}; pg8::StaticOrder S; S.init(64, 8, 32, G, bx, 64, MG_SPLIT); EpiMerged E{GATE, MERGED, (float*)(p.ws + WS_XN)}; pg8::gemm_phase(lds, g, S, E); }
    }
    if (IN(3) && IN(4)) xcd_barrier(xbar);
    if (IN(3)) {
        for (int r = gw; r < MS; r += NGW) {
            const f32x4* pr = (const f32x4*)((const float*)(p.ws + WS_XN) + (size_t)r * D) + lane;
            const u32x2* gr = (const u32x2*)(GATE + (size_t)(MP + r) * 4096) + lane; u32x2* o8 = (u32x2*)(MERGED + (size_t)(MP + r) * D) + lane;
#pragma unroll
            for (int j = 0; j < 8; ++j) { const size_t cs = (size_t)MS * D / 4;
                const f32x4 a = pr[64 * j] + pr[cs + 64 * j], b = pr[2 * cs + 64 * j] + pr[3 * cs + 64 * j];
                const u32x2 rw = gr[64 * j], bw = gr[512 + 64 * j];
                const f32x4 rr = (f32x4){bflo(rw.x), bfhi(rw.x), bflo(rw.y), bfhi(rw.y)}, gb = (f32x4){bflo(bw.x), bfhi(bw.x), bflo(bw.y), bfhi(bw.y)};
                const f32x4 v = gb * (rr * a + b);
                o8[64 * j] = (u32x2){cvt_pk_bf16(v.x, v.y), cvt_pk_bf16(v.z, v.w)}; }
        }
    }
    SEAM(3);
    if (IN(4)) { pg8::Gemm g{MERGED, Wt_out, D, D, MT, D, D}; pg8::StaticOrder S; S.init(64, 8, 32, G, bx, 64, OUT_SPLIT); EpiOut E{p.x_prompt, p.x_sample, Y, XN, (float*)(p.ws + WS_SSQP), (float*)(p.ws + WS_AO)}; pg8::gemm_phase(lds, g, S, E); }
    if (IN(4) && IN(5)) xcd_barrier(xbar);
    if (IN(4)) {
        for (int r = gw; r < MS; r += NGW) {
            const f32x4* xr = (const f32x4*)(p.x_sample + (size_t)r * D) + lane; const f32x4* pr = (const f32x4*)((const float*)(p.ws + WS_AO) + (size_t)r * D) + lane;
            u32x2* o8 = (u32x2*)(XN + (size_t)(MP + r) * D) + lane; float* sp = (float*)(p.ws + WS_SSQP);
            float sq = 0.f;
#pragma unroll
            for (int j = 0; j < 8; ++j) { f32x4 v = xr[64 * j];
#pragma unroll
                for (int c = 0; c < OUT_SPLIT; ++c) v += pr[(size_t)c * MS * D / 4 + 64 * j];
                sq += (v.x * v.x + v.y * v.y) + (v.z * v.z + v.w * v.w);
                o8[64 * j] = (u32x2){cvt_pk_bf16(v.x, v.y), cvt_pk_bf16(v.z, v.w)}; }
            sq = wave_sum(sq);
            if (lane < 32) sp[(size_t)lane * MT + MP + r] = lane == 0 ? sq : 0.f;
        }
    }
    SEAM(4);
    if (IN(5)) { pg8::Gemm g{XN, Wt_gu, D, D, MT, NGU, D}; pg8::StaticOrder S; S.init(64, NGU / 256, 32, G, bx, 64, 1);
        LAS float* tab = (LAS float*)(lds + 131072);
        { pg8::Unit u0; S.next(0, u0); const float* sp = (const float*)(p.ws + WS_SSQP);
          if (tid < 384) { const int row = tid < 256 ? u0.pm * 256 + tid : MP + (tid - 256); float a = 0.f;
#pragma unroll 8
              for (int k = 0; k < 32; ++k) a += sp[(size_t)k * MT + row];
              tab[tid] = __builtin_amdgcn_rsqf(a * (1.0f / D) + EPS); }
          __syncthreads(); }
        EpiGU E{tab, HID}; pg8::gemm_phase(lds, g, S, E); }
    SEAM(5);
    if (IN(6)) { pg8::Gemm g{HID, Wt_dn, FF, FF, MT, D, FF}; pg8::StaticOrder S; S.init(64, 8, FF / 64, G, bx, 64, DN_SPLIT); EpiDown E{Y, (float*)(p.ws + WS_AO), XN, (bf16_t*)(p.ws + WS_H2B)}; pg8::gemm_phase(lds, g, S, E); }
    SEAM(6);
    if (IN(7)) {
        for (int m = gw; m < MV; m += NGW) {
            f32x4* yr = (f32x4*)(Y + (size_t)m * D) + lane; const f32x4* gf = (const f32x4*)p.g_final + lane;
            f32x4 v[8]; float s = 0.f;
            {
                const u32x2* hr = (const u32x2*)((m < MP ? (const bf16_t*)(p.ws + WS_H2B) : (const bf16_t*)XN) + (size_t)m * D) + lane;
#pragma unroll
                for (int j = 0; j < 8; ++j) { const u32x2 w2 = hr[64 * j]; v[j] = (f32x4){bflo(w2.x), bfhi(w2.x), bflo(w2.y), bfhi(w2.y)}; } }
            if (m >= MP) { const f32x4* pr = (const f32x4*)((const float*)(p.ws + WS_AO) + (size_t)(m - MP) * D) + lane;
                for (int c = 0; c < DN_SPLIT; ++c)
#pragma unroll
                    for (int j = 0; j < 8; ++j) v[j] += pr[(size_t)c * MS * D / 4 + 64 * j]; }
#pragma unroll
            for (int j = 0; j < 8; ++j) s += (v[j].x * v[j].x + v[j].y * v[j].y) + (v[j].z * v[j].z + v[j].w * v[j].w);
            const float rs = __builtin_amdgcn_rsqf(wave_sum(s) * (1.0f / D) + EPS);
#pragma unroll
            for (int j = 0; j < 8; ++j) yr[64 * j] = v[j] * rs * gf[64 * j];
        }
    }
#ifdef PROBE_T
    STAMP();
    if (bx == 0 && tid == 0) {
        const unsigned long long e1 = (unsigned long long)__hip_atomic_load((long long*)(p.ws + WS_SSQ + 512 * 1024), __ATOMIC_RELAXED, __HIP_MEMORY_SCOPE_AGENT);
        const unsigned long long e2 = (unsigned long long)__hip_atomic_load((long long*)(p.ws + WS_SSQ + 512 * 1024 + 256), __ATOMIC_RELAXED, __HIP_MEMORY_SCOPE_AGENT);
        (void)e1; (void)e2;
        const float ta = (float)(tstamp[PROBE_A + 1] - tstamp[PROBE_A]) * 0.01f, tb = (float)(tstamp[PROBE_B + 1] - tstamp[PROBE_B]) * 0.01f;
        asm volatile("s_waitcnt vmcnt(0)" ::: "memory");
        atomicAdd(Y, 4.0f + ta * (1.0f / 256.0f)); atomicAdd(p.out + OFF_PP, 1.5f + tb * (1.0f / 500.0f));
    }
#endif
#undef IN
#undef SEAM
}

extern "C" void kernel_launch(void* const* d_in, const int* in_sizes, int n_in, void* d_out, int out_size, void* d_ws, size_t ws_size, hipStream_t stream) {
    static int grid = 0;
    if (grid == 0) {
        if (n_in != 15 || (size_t)out_size != OUT_TOTAL || ws_size < WS_END) { fprintf(stderr, "kernel_launch: unexpected shapes: n_in %d out %d ws %zu\n", n_in, out_size, ws_size); grid = -1; return; }
        int dev = 0, cus = 0, per_cu = 0;
        hipGetDevice(&dev); hipDeviceGetAttribute(&cus, hipDeviceAttributeMultiprocessorCount, dev);
        hipFuncSetAttribute((const void*)fwd_megakernel, hipFuncAttributeMaxDynamicSharedMemorySize, LDS_BYTES);
        hipOccupancyMaxActiveBlocksPerMultiprocessor(&per_cu, (const void*)fwd_megakernel, 512, LDS_BYTES);
        if (per_cu < 1) { fprintf(stderr, "kernel_launch: occupancy query says %d blocks per CU\n", per_cu); per_cu = 1; }
        (void)hipGetLastError();
        grid = cus;
    }
    if (grid < 0) return;
    Params p{};
    const float** pp = (const float**)&p;
    for (int i = 0; i < 15; ++i) pp[i] = (const float*)d_in[i];
    p.out = (float*)d_out; p.ws = (unsigned char*)d_ws;
#if N_LAUNCH_MODE == 1
    p.ph_lo = 0; p.ph_hi = 8;
    void* args[] = {&p};
    if (hipMemsetAsync((char*)d_ws + WS_BAR, 0, WS_BAR_BYTES, stream) != hipSuccess) fprintf(stderr, "kernel_launch: memset of the barrier words failed\n");
    hipError_t e = hipLaunchCooperativeKernel((const void*)fwd_megakernel, dim3(grid), dim3(512), args, LDS_BYTES, stream);
    if (e != hipSuccess) fprintf(stderr, "cooperative launch failed: %s (grid %d)\n", hipGetErrorString(e), grid);
#else
    for (int ph = 0; ph < 8; ++ph) { p.ph_lo = ph; p.ph_hi = ph + 1; hipLaunchKernelGGL(fwd_megakernel, dim3(grid), dim3(512), LDS_BYTES, stream, p); }
#endif
}
```

```cpp
#include <hip/hip_runtime.h>
#include <hip/hip_cooperative_groups.h>
#include <cstdio>
#include <cstdint>
namespace cg = cooperative_groups;

#define PROBE_A 6
#define PROBE_B 4
#ifndef N_LAUNCH_MODE
#define N_LAUNCH_MODE 1
#endif

#define LAS __attribute__((address_space(3)))
typedef unsigned short bf16_t;
typedef short bf16x8 __attribute__((ext_vector_type(8)));
typedef short s16x4 __attribute__((ext_vector_type(4)));
typedef float f32x4 __attribute__((ext_vector_type(4)));
typedef float f32x16 __attribute__((ext_vector_type(16)));
typedef unsigned u32x4 __attribute__((ext_vector_type(4)));
typedef unsigned u32x2 __attribute__((ext_vector_type(2)));

constexpr int D = 2048, MP = 16384, MS = 128, MV = MP + MS, MT = 16640;
constexpr int SEQ = 4096, DSEQ = 16, PAST = 4096, NH = 8, HD = 128;
constexpr int NIN = 8192, FF = 5632, NGU = 2 * FF, AW = 1024;
constexpr float EPS = 1e-6f;
constexpr size_t OFF_Y = 0, OFF_KP = (size_t)MV * D, OFF_VP = OFF_KP + (size_t)MP * 1024, OFF_PP = OFF_VP + (size_t)MP * 1024,
                 OFF_KS = OFF_PP + 4 * 15 * 1024, OFF_VS = OFF_KS + (size_t)MS * 1024, OFF_PS = OFF_VS + (size_t)MS * 1024, OUT_TOTAL = OFF_PS + 8 * 15 * 1024;
constexpr size_t MiB = 1u << 20;
constexpr size_t WS_SSQ = 0, WS_WIN = 1 * MiB, WS_WBR = 33 * MiB, WS_WOUT = 41 * MiB, WS_WGU = 49 * MiB, WS_WDN = 93 * MiB, WS_XN = 115 * MiB,
                 WS_QKVU = 180 * MiB, WS_GATE = 310 * MiB, WS_AO = 440 * MiB, WS_TMPA = 505 * MiB, WS_WPB = 509 * MiB, WS_SSQP = 510 * MiB, WS_END = 513 * MiB;
constexpr size_t WS_BAR = 768 * 1024, WS_BAR_BYTES = 32768;
constexpr size_t WS_H2B = WS_WIN;
static_assert(WS_H2B + (size_t)MV * D * 2 <= WS_WDN, "h2 overlay");
constexpr size_t WS_MERGED = WS_QKVU;
constexpr size_t WS_HID = WS_QKVU;
static_assert((size_t)MT * FF * 2 <= WS_AO - WS_QKVU, "hid overlay");
constexpr int LDS_BYTES = 147456;

typedef __bf16 bf16x2_t __attribute__((ext_vector_type(2)));
typedef float f32x2_t __attribute__((ext_vector_type(2)));
__device__ __forceinline__ unsigned cvt_pk_bf16(float lo, float hi) { const f32x2_t v = {lo, hi}; return __builtin_bit_cast(unsigned, __builtin_convertvector(v, bf16x2_t)); }
__device__ __forceinline__ float bf2f(unsigned short b) { return __uint_as_float(((unsigned)b) << 16); }
__device__ __forceinline__ float bflo(unsigned w) { return __uint_as_float(w << 16); }
__device__ __forceinline__ float bfhi(unsigned w) { return __uint_as_float(w & 0xffff0000u); }
__device__ __forceinline__ float fast_sigmoid(float x) { return __builtin_amdgcn_rcpf(1.0f + __expf(-x)); }
__device__ __forceinline__ float wave_sum(float v) {
#pragma unroll
    for (int o = 1; o < 64; o <<= 1) v += __shfl_xor(v, o);
    return v;
}

#define XB_TMO      128
#define XB_XCNT(j)  (256  + 64 * (j))
#define XB_XSUB(j)  (1280 + 64 * (j))
#define XB_XGEN(j)  (2304 + 64 * (j))
#define XB_TOP      3328
#define XB_TOPGEN   3392
#define XCD_BAR_WORDS 3456
#define XB_SPIN_CAP (1u << 18)

__device__ __forceinline__ unsigned xb_ld(unsigned* p)              { return __hip_atomic_load(p, __ATOMIC_RELAXED, __HIP_MEMORY_SCOPE_AGENT); }
__device__ __forceinline__ unsigned xb_add(unsigned* p, unsigned v) { return __hip_atomic_fetch_add(p, v, __ATOMIC_RELAXED, __HIP_MEMORY_SCOPE_AGENT); }
__device__ __forceinline__ unsigned xb_xcc_id() { return (unsigned)__builtin_amdgcn_s_getreg((3 << 11) | 20) & 0xFu; }
#define XB_SPIN(cond, bar) do { unsigned _sp = 0; while (cond) { __builtin_amdgcn_s_sleep(1); \
    if ((++_sp & 255u) == 0u) { if (xb_ld(&(bar)[XB_TMO])) break; if (_sp > XB_SPIN_CAP) { atomicAdd(&(bar)[XB_TMO], 1u); break; } } } } while (0)

struct XcdBarrier {
    unsigned* bar; unsigned x;
    volatile LAS unsigned* st;
};

__device__ __forceinline__ XcdBarrier xcd_barrier_post(unsigned* bar, volatile LAS unsigned* st) {
    XcdBarrier b; b.bar = bar; b.x = xb_xcc_id(); b.st = st;
    if (threadIdx.x == 0) (void)xb_add(&bar[XB_XCNT(b.x)], 1u);
    return b;
}
__device__ __forceinline__ void xcd_barrier_complete(unsigned* bar, unsigned x, unsigned& nloc, unsigned& nx) {
    const unsigned G = gridDim.x * gridDim.y * gridDim.z;
    unsigned sum, cnt, mine, sp = 0u;
    for (;;) {
        sum = 0u; cnt = 0u; mine = 0u;
#pragma unroll
        for (unsigned j = 0; j < 16; ++j) { const unsigned c = xb_ld(&bar[XB_XCNT(j)]); sum += c; cnt += (c > 0u) ? 1u : 0u; mine = (j == x) ? c : mine; }
        if (sum == G) break;
        __builtin_amdgcn_s_sleep(1);
        if ((++sp & 255u) == 0u) { if (xb_ld(&bar[XB_TMO])) break; if (sp > XB_SPIN_CAP) { atomicAdd(&bar[XB_TMO], 1u); break; } }
    }
    nloc = mine > 0u ? mine : 1u; nx = cnt > 0u ? cnt : 1u;
}

__device__ __forceinline__ void xcd_barrier(const XcdBarrier& b) {
    asm volatile("s_waitcnt vmcnt(0)" ::: "memory");
    __syncthreads();
    if (threadIdx.x == 0) {
        unsigned* bar = b.bar;
        __builtin_amdgcn_s_waitcnt(0);
        unsigned nloc = b.st[0], nx = b.st[1];
        if (nloc == 0u) { xcd_barrier_complete(bar, b.x, nloc, nx); b.st[0] = nloc; b.st[1] = nx; }
        const unsigned old = xb_add(&bar[XB_XSUB(b.x)], 1u);
        const unsigned gen = old / nloc;
        if (old + 1u == (gen + 1u) * nloc) {
            __builtin_amdgcn_fence(__ATOMIC_RELEASE, "agent");
            asm volatile("s_waitcnt vmcnt(0)" ::: "memory");
            const unsigned og = xb_add(&bar[XB_TOP], 1u);
            const unsigned tg = og / nx;
            if (og + 1u == (tg + 1u) * nx) xb_add(&bar[XB_TOPGEN], 1u);
            else XB_SPIN(xb_ld(&bar[XB_TOPGEN]) == tg, bar);
            __builtin_amdgcn_fence(__ATOMIC_ACQUIRE, "agent");
            xb_add(&bar[XB_XGEN(b.x)], 1u);
            asm volatile("s_waitcnt vmcnt(0)" ::: "memory");
        } else {
            XB_SPIN(xb_ld(&bar[XB_XGEN(b.x)]) == gen, bar);
            __builtin_amdgcn_fence(__ATOMIC_ACQUIRE, "agent");
            asm volatile("s_waitcnt vmcnt(0)" ::: "memory");
        }
    }
    __syncthreads();
}

namespace pg8 {
constexpr int BM = 256, BK = 64, HALF = 128, HTB = HALF * BK * 2, STAGE_BYTES = 8 * HTB, NXCD = 8, WGM = 8;
__host__ __device__ __forceinline__ int lds_byte(int r, int c) { const int st = (r >> 4) * 2 + (c >> 5), rr = r & 15, cc = c & 31, ob = rr * 64 + cc * 2; return st * 1024 + (ob ^ (((ob >> 9) & 1) << 5)); }
__host__ __device__ __forceinline__ void stage_rc(int b, int& R, int& C) { const int st = b / 1024, sb = b % 1024, swz = sb ^ (((sb >> 9) & 1) << 5); R = (st >> 1) * 16 + swz / 64; C = (st & 1) * 32 + (swz % 64) / 2; }
__host__ __device__ __forceinline__ int perm32(int rho) { const int n = rho >> 4, i = rho & 15; return 8 * (i >> 2) + 4 * n + (i & 3); }

struct Unit { int pm, pn, kt0, nkt, half; };
struct Gemm { const bf16_t* A; const bf16_t* Bt; int lda, ldb, M, N, K; };

struct StaticOrder {
    int nM, nN, nwg, G, c, ktfull, pmS, nS, ktS;
    __device__ void init(int nM_, int nN_, int ktfull_, int G_, int c_, int pmS_ = 0, int ksplit = 0) { nM = nM_; nN = nN_; nwg = nM * nN; G = G_; c = c_; ktfull = ktfull_; pmS = pmS_; nS = nN * ksplit; ktS = ksplit ? ktfull / ksplit : 0; }
    __device__ bool next(int i, Unit& u) const {
        const int L = i * G + c;
        if (L >= nwg) { const int t = L - nwg;
            if (t >= nS) return false;
            u.pm = pmS; u.pn = t % nN; u.kt0 = (t / nN) * ktS; u.nkt = ktS; u.half = 1; return true; }
        int wgid = L; { const int q = nwg / NXCD, r = nwg % NXCD, xcd = wgid % NXCD, off = wgid / NXCD; wgid = (xcd < r ? xcd * (q + 1) : r * (q + 1) + (xcd - r) * q) + off; }
        const int nig = WGM * nN, gid = wgid / nig, fm = gid * WGM, gsz = (nM - fm) < WGM ? (nM - fm) : WGM;
        u.pm = fm + ((wgid % nig) % gsz); u.pn = (wgid % nig) / gsz; u.kt0 = 0; u.nkt = ktfull; u.half = 0; return true;
    }
};

template <class Epi>
__device__ __forceinline__ void gemm_phase(LAS unsigned char* lds, const Gemm g, const StaticOrder& S, const Epi& E) {
    int tid_ = threadIdx.x; asm volatile("" : "+v"(tid_));
    const int tid = tid_, wid = __builtin_amdgcn_readfirstlane(tid >> 6), lane = tid & 63, wr = wid >> 2, wc = wid & 3, fr = lane & 15, fq = lane >> 4;
    unsigned voffA[2], voffB[2];
#pragma unroll
    for (int i = 0; i < 2; ++i) { int R, C; stage_rc(tid * 16 + i * 8192, R, C); const int Rb = (R & ~31) + perm32(R & 31);
        voffA[i] = (unsigned)(R * g.lda + C) * 2u; voffB[i] = (unsigned)(Rb * g.ldb + C) * 2u; }
    const size_t kstep = (size_t)(BK * 2);
    const size_t hstepA = (size_t)HALF * g.lda * 2, hstepB = (size_t)HALF * g.ldb * 2;
    const size_t tstepA = 2 * hstepA, tstepB = 2 * hstepB;
    const unsigned ldsw = (unsigned)wid * 1024u;
    const int aoff = lds_byte(wr * 64 + fr, fq * 8), boff = lds_byte(wc * 32 + fr, fq * 8);
#define PG8_SA(b, h) (((b) * 2 + (h)) * HTB)
#define PG8_SB(b, h) ((4 + (b) * 2 + (h)) * HTB)
#define PG8_STAGE(bufoff, gbase, voff) do { _Pragma("unroll") for (int _i = 0; _i < 2; ++_i) \
        __builtin_amdgcn_global_load_lds((const unsigned*)((const char*)(gbase) + (voff)[_i]), (LAS unsigned*)(lds + (bufoff) + ldsw + _i * 8192), 16, 0, 0); } while (0)
#define PG8_LDA(dst, b, h) do { _Pragma("unroll") for (int m = 0; m < 4; ++m) _Pragma("unroll") for (int k = 0; k < 2; ++k) dst[m][k] = *(const LAS bf16x8*)(lds + PG8_SA(b, h) + aoff + m * 2048 + k * 1024); } while (0)
#define PG8_LDB(dst, b, h) do { _Pragma("unroll") for (int n = 0; n < 2; ++n) _Pragma("unroll") for (int k = 0; k < 2; ++k) dst[n][k] = *(const LAS bf16x8*)(lds + PG8_SB(b, h) + boff + n * 2048 + k * 1024); } while (0)
#define PG8_MMA(ai, bj, At, Bt) do { __builtin_amdgcn_s_setprio(1); _Pragma("unroll") for (int m = 0; m < 4; ++m) _Pragma("unroll") for (int n = 0; n < 2; ++n) _Pragma("unroll") for (int k = 0; k < 2; ++k) \
        acc[ai][bj][m][n] = __builtin_amdgcn_mfma_f32_16x16x32_bf16(Bt[n][k], At[m][k], acc[ai][bj][m][n], 0, 0, 0); __builtin_amdgcn_s_setprio(0); } while (0)
#define PG8_WAIT_V(n) asm volatile("s_waitcnt vmcnt(" #n ")" ::: "memory")
#define PG8_WAIT_L(n) asm volatile("s_waitcnt lgkmcnt(" #n ")" ::: "memory")
#define PG8_BAR __builtin_amdgcn_s_barrier()
#define PG8_SCHED __builtin_amdgcn_sched_barrier(0)
    Unit cur, nxt; int ui = 0;
    if (!S.next(0, cur)) return;
    f32x4 acc[2][2][4][2];
#pragma unroll
    for (int a = 0; a < 2; ++a)
#pragma unroll
        for (int b = 0; b < 2; ++b)
#pragma unroll
            for (int m = 0; m < 4; ++m)
#pragma unroll
                for (int n = 0; n < 2; ++n) acc[a][b][m][n] = (f32x4){0.f, 0.f, 0.f, 0.f};
    bf16x8 At[4][2], B0[2][2], B1[2][2];
    const char* cA = (const char*)g.A + (size_t)cur.pm * tstepA + (size_t)cur.kt0 * kstep; const char* cB = (const char*)g.Bt + (size_t)cur.pn * tstepB + (size_t)cur.kt0 * kstep;
    PG8_STAGE(PG8_SB(0, 0), cB, voffB); PG8_STAGE(PG8_SB(0, 1), cB + hstepB, voffB); PG8_STAGE(PG8_SA(0, 0), cA, voffA); PG8_STAGE(PG8_SA(0, 1), cA + hstepA, voffA);
    if (wr == 1) PG8_BAR;
    PG8_WAIT_V(2); PG8_BAR;
    PG8_STAGE(PG8_SB(1, 0), cB + kstep, voffB); PG8_STAGE(PG8_SA(1, 0), cA + kstep, voffA); PG8_STAGE(PG8_SB(1, 1), cB + hstepB + kstep, voffB);
    PG8_WAIT_V(6); PG8_BAR;
    for (;;) {
        const bool has_next = S.next(ui + 1, nxt);
        const char* nA = has_next ? (const char*)g.A + (size_t)nxt.pm * tstepA + (size_t)nxt.kt0 * kstep : cA; const char* nB = has_next ? (const char*)g.Bt + (size_t)nxt.pn * tstepB + (size_t)nxt.kt0 * kstep : cB;
        const int nt = cur.nkt; const bool full = !cur.half;
        for (int t = 0; t < nt; t += 2) {
            const bool last = (t == nt - 2);
            if constexpr (Epi::HAS_MID) { if (!cur.half && t == (nt >> 1)) E.mid(acc, cur, wr, wc, fr, fq); }
            const char* a1 = cA + (size_t)(t + 1) * kstep;
            const char* a2 = last ? nA : cA + (size_t)(t + 2) * kstep; const char* b2 = last ? nB : cB + (size_t)(t + 2) * kstep;
            const char* a3 = a2 + kstep; const char* b3 = b2 + kstep;
            PG8_LDB(B0, 0, 0); PG8_LDB(B1, 0, 1); PG8_SCHED; PG8_LDA(At, 0, 0); PG8_STAGE(PG8_SA(1, 1), a1 + hstepA, voffA);
            PG8_WAIT_V(8); PG8_WAIT_L(0); PG8_BAR; PG8_MMA(0, 0, At, B0); PG8_MMA(0, 1, At, B1); PG8_BAR; PG8_SCHED;
            if (full) PG8_LDA(At, 0, 1); PG8_STAGE(PG8_SB(0, 0), b2, voffB); PG8_STAGE(PG8_SB(0, 1), b2 + hstepB, voffB); PG8_STAGE(PG8_SA(0, 0), a2, voffA);
            PG8_WAIT_V(8); PG8_WAIT_L(0); PG8_BAR; if (full) { PG8_MMA(1, 0, At, B0); PG8_MMA(1, 1, At, B1); } PG8_BAR; PG8_SCHED;
            PG8_LDB(B0, 1, 0); PG8_LDB(B1, 1, 1); PG8_SCHED; PG8_LDA(At, 1, 0); PG8_STAGE(PG8_SA(0, 1), a2 + hstepA, voffA);
            PG8_WAIT_V(8); PG8_WAIT_L(0); PG8_BAR; PG8_MMA(0, 0, At, B0); PG8_MMA(0, 1, At, B1); PG8_BAR; PG8_SCHED;
            if (full) PG8_LDA(At, 1, 1); PG8_STAGE(PG8_SB(1, 0), b3, voffB); PG8_STAGE(PG8_SB(1, 1), b3 + hstepB, voffB); PG8_STAGE(PG8_SA(1, 0), a3, voffA);
            PG8_WAIT_V(8); PG8_WAIT_L(0); PG8_BAR; if (full) { PG8_MMA(1, 0, At, B0); PG8_MMA(1, 1, At, B1); } PG8_BAR; PG8_SCHED;
        }
        if (wr == 0) PG8_BAR;
        E(acc, cur, wr, wc, fr, fq);
        if (!has_next) break;
#pragma unroll
        for (int a = 0; a < 2; ++a)
#pragma unroll
            for (int b = 0; b < 2; ++b)
#pragma unroll
                for (int m = 0; m < 4; ++m)
#pragma unroll
                    for (int n = 0; n < 2; ++n) acc[a][b][m][n] = (f32x4){0.f, 0.f, 0.f, 0.f};
        cur = nxt; cA = nA; cB = nB; ++ui;
        if (wr == 1) PG8_BAR;
    }
    PG8_WAIT_V(0);
    PG8_BAR;
#undef PG8_SA
#undef PG8_SB
#undef PG8_STAGE
#undef PG8_LDA
#undef PG8_LDB
#undef PG8_MMA
#undef PG8_WAIT_V
#undef PG8_WAIT_L
#undef PG8_BAR
#undef PG8_SCHED
}
}
using pg8::Unit;

__device__ __forceinline__ u32x4 pack8(const f32x4& v0, const f32x4& v1) {
    u32x4 w; w.x = cvt_pk_bf16(v0[0], v0[1]); w.y = cvt_pk_bf16(v0[2], v0[3]); w.z = cvt_pk_bf16(v1[0], v1[1]); w.w = cvt_pk_bf16(v1[2], v1[3]); return w;
}
__device__ __forceinline__ void unpack8(const u32x4& w, f32x4& v0, f32x4& v1) {
    v0 = (f32x4){bflo(w.x), bfhi(w.x), bflo(w.y), bfhi(w.y)}; v1 = (f32x4){bflo(w.z), bfhi(w.z), bflo(w.w), bfhi(w.w)};
}

__device__ __forceinline__ int u_row(int row) { return row < MP ? row : MP + ((row - MP) >> 4) * 31 + 15 + ((row - MP) & 15); }
struct EpiIn {
    static constexpr bool HAS_MID = false;
    bf16_t* qkvu; bf16_t* gate; float* out;
    __device__ __forceinline__ void operator()(const f32x4 (&acc)[2][2][4][2], const Unit& u, int wr, int wc, int fr, int fq) const {
        const int row0 = u.pm * 256 + wr * 64 + fr, cw = wc * 32 + 8 * fq;
        if (u.pn >= 16) {
            bf16_t* base = gate + (size_t)row0 * 4096 + (u.pn - 16) * 128 + cw;
#pragma unroll
            for (int ai = 0; ai < 2; ++ai)
#pragma unroll
                for (int m = 0; m < 4; ++m) { bf16_t* rowp = base + (size_t)(ai * 128 + m * 16) * 4096;
                    f32x4 r0, r1, b0, b1;
#pragma unroll
                    for (int j = 0; j < 4; ++j) { b0[j] = fmaxf(fast_sigmoid(acc[ai][1][m][0][j]), 1e-30f); b1[j] = fmaxf(fast_sigmoid(acc[ai][1][m][1][j]), 1e-30f);
                        r0[j] = fast_sigmoid(acc[ai][0][m][0][j]) * __builtin_amdgcn_rcpf(b0[j]); r1[j] = fast_sigmoid(acc[ai][0][m][1][j]) * __builtin_amdgcn_rcpf(b1[j]); }
                    *(u32x4*)rowp = pack8(r0, r1); *(u32x4*)(rowp + 2048) = pack8(b0, b1); }
        } else {
            const int sec = u.pn >> 2, cc = (u.pn & 3) * 256 + cw;
            bf16_t* base = qkvu + (size_t)sec * MT * 1024 + (size_t)row0 * 1024 + cc;
#pragma unroll
            for (int ai = 0; ai < 2; ++ai)
#pragma unroll
                for (int m = 0; m < 4; ++m) { bf16_t* rowp = base + (size_t)(ai * 128 + m * 16) * 1024;
                    if (sec == 0 && u.pm == 64) {
                        const int row = row0 + ai * 128 + m * 16; if (row >= MV) continue;
                        rowp = qkvu + (size_t)u_row(row) * 1024 + cc; }
#pragma unroll
                    for (int bj = 0; bj < 2; ++bj) *(u32x4*)(rowp + bj * 128) = pack8(acc[ai][bj][m][0], acc[ai][bj][m][1]); }
            if (sec >= 2) {
                const size_t offp = (sec == 2) ? OFF_KP : OFF_VP, offs = (sec == 2) ? OFF_KS : OFF_VS;
#pragma unroll
                for (int ai = 0; ai < 2; ++ai)
#pragma unroll
                    for (int m = 0; m < 4; ++m) { const int row = row0 + ai * 128 + m * 16;
                        if (row < MV) { float* o = out + (row < MP ? offp + (size_t)row * 1024 : offs + (size_t)(row - MP) * 1024) + cc;
#pragma unroll
                            for (int bj = 0; bj < 2; ++bj) { *(f32x4*)(o + bj * 128) = acc[ai][bj][m][0]; *(f32x4*)(o + bj * 128 + 4) = acc[ai][bj][m][1]; } } }
            } else if (sec == 0 && ((u.pm & 15) == 15 || u.pm == 64)) {
#pragma unroll
                for (int ai = 0; ai < 2; ++ai)
#pragma unroll
                    for (int m = 0; m < 4; ++m) { const int row = row0 + ai * 128 + m * 16; long off = -1;
                        if (row < MP) { const int t = row & (SEQ - 1); if (t >= SEQ - 15) off = (long)OFF_PP + ((long)(row >> 12) * 15 + (t - (SEQ - 15))) * 1024; }
                        else if (row < MV) { const int t = (row - MP) & 15, b = (row - MP) >> 4; if (t >= 1) off = (long)OFF_PS + ((long)b * 15 + (t - 1)) * 1024; }
                        if (off >= 0) { float* o = out + off + cc;
#pragma unroll
                            for (int bj = 0; bj < 2; ++bj) { *(f32x4*)(o + bj * 128) = acc[ai][bj][m][0]; *(f32x4*)(o + bj * 128 + 4) = acc[ai][bj][m][1]; } } }
            }
        }
    }
};
constexpr int MG_SPLIT = 4, MG_KT = (2048 / 64) / MG_SPLIT;
struct EpiMerged {
    static constexpr bool HAS_MID = true;
    const bf16_t* gate; bf16_t* merged; float* part;
    __device__ __forceinline__ void mid(f32x4 (&acc)[2][2][4][2], const Unit& u, int wr, int wc, int fr, int fq) const {
        int zoff = 0; asm volatile("" : "+v"(zoff));
        const int row0 = u.pm * 256 + wr * 64 + fr + zoff, cc = u.pn * 256 + wc * 32 + 8 * fq;
#pragma unroll
        for (int ai = 0; ai < 2; ++ai) {
            if (ai == 1 && u.half) break;
            u32x4 rw[4][2];
#pragma unroll
            for (int m = 0; m < 4; ++m)
#pragma unroll
                for (int bj = 0; bj < 2; ++bj) rw[m][bj] = *(const u32x4*)(gate + (size_t)(row0 + ai * 128 + m * 16) * 4096 + cc + bj * 128);
#pragma unroll
            for (int m = 0; m < 4; ++m)
#pragma unroll
                for (int bj = 0; bj < 2; ++bj) { f32x4 a0, a1; unpack8(rw[m][bj], a0, a1); acc[ai][bj][m][0] *= a0; acc[ai][bj][m][1] *= a1; }
            __builtin_amdgcn_sched_barrier(0);
        }
    }
    __device__ __forceinline__ void operator()(const f32x4 (&acc)[2][2][4][2], const Unit& u, int wr, int wc, int fr, int fq) const {
        const int row0 = u.pm * 256 + wr * 64 + fr, cc = u.pn * 256 + wc * 32 + 8 * fq;
        if (u.half) {
            float* ps = part + ((size_t)(u.kt0 / MG_KT) * MS + (row0 - MP)) * D + cc;
#pragma unroll
            for (int m = 0; m < 4; ++m)
#pragma unroll
                for (int bj = 0; bj < 2; ++bj) { *(f32x4*)(ps + (size_t)(m * 16) * D + bj * 128) = acc[0][bj][m][0]; *(f32x4*)(ps + (size_t)(m * 16) * D + bj * 128 + 4) = acc[0][bj][m][1]; }
            return; }
#pragma unroll
        for (int ai = 0; ai < 2; ++ai)
#pragma unroll
            for (int m = 0; m < 4; ++m) { const int row = row0 + ai * 128 + m * 16;
                const bf16_t* gp = gate + (size_t)row * 4096 + 2048 + cc; bf16_t* o = merged + (size_t)row * D + cc;
#pragma unroll
                for (int bj = 0; bj < 2; ++bj) { const u32x4 gw = *(const u32x4*)(gp + bj * 128); f32x4 g0, g1; unpack8(gw, g0, g1);
                    *(u32x4*)(o + bj * 128) = pack8(acc[ai][bj][m][0] * g0, acc[ai][bj][m][1] * g1); } }
    }
};
constexpr int OUT_SPLIT = 4, OUT_KT = (D / 64) / OUT_SPLIT;
struct EpiOut {
    static constexpr bool HAS_MID = false;
    const float* xp; const float* xs; float* y; bf16_t* hb; float* ssq; float* part;
    __device__ __forceinline__ void operator()(const f32x4 (&acc)[2][2][4][2], const Unit& u, int wr, int wc, int fr, int fq) const {
        int zoff = 0; asm volatile("" : "+v"(zoff));
        const int row0 = u.pm * 256 + wr * 64 + fr + zoff, cc = u.pn * 256 + wc * 32 + 8 * fq;
        if (u.half) {
            float* ps = part + ((size_t)(u.kt0 / OUT_KT) * MS + (row0 - MP)) * D + cc;
#pragma unroll
            for (int m = 0; m < 4; ++m)
#pragma unroll
                for (int bj = 0; bj < 2; ++bj) { *(f32x4*)(ps + (size_t)(m * 16) * D + bj * 128) = acc[0][bj][m][0]; *(f32x4*)(ps + (size_t)(m * 16) * D + bj * 128 + 4) = acc[0][bj][m][1]; }
            return; }
#pragma unroll
        for (int ai = 0; ai < 2; ++ai) {
            if (ai == 1 && u.half) break;
            f32x4 xv[4][2][2];
#pragma unroll
            for (int m = 0; m < 4; ++m) { const int row = row0 + ai * 128 + m * 16; const bool ok = row < MV;
                const float* xr = (row < MP ? xp + (size_t)row * D : xs + (size_t)(ok ? row - MP : 0) * D) + cc;
#pragma unroll
                for (int bj = 0; bj < 2; ++bj) { xv[m][bj][0] = *(const f32x4*)(xr + bj * 128); xv[m][bj][1] = *(const f32x4*)(xr + bj * 128 + 4); } }
            __builtin_amdgcn_sched_barrier(0);
#pragma unroll
            for (int m = 0; m < 4; ++m) { const int row = row0 + ai * 128 + m * 16; const bool ok = row < MV;
                bf16_t* ob = hb + (size_t)row * D + cc;
                float s = 0.f;
#pragma unroll
                for (int bj = 0; bj < 2; ++bj) { f32x4 h0 = acc[ai][bj][m][0], h1 = acc[ai][bj][m][1];
                    if (ok) { h0 += xv[m][bj][0]; h1 += xv[m][bj][1]; }
                    *(u32x4*)(ob + bj * 128) = pack8(h0, h1);
                    s += (h0[0] * h0[0] + h0[1] * h0[1]) + (h0[2] * h0[2] + h0[3] * h0[3]) + (h1[0] * h1[0] + h1[1] * h1[1]) + (h1[2] * h1[2] + h1[3] * h1[3]); }
                s += __shfl_xor(s, 16); s += __shfl_xor(s, 32);
                if (fq == 0) ssq[(size_t)(u.pn * 4 + wc) * MT + row] = s; }
            __builtin_amdgcn_sched_barrier(0);
        }
    }
};
struct EpiGU {
    static constexpr bool HAS_MID = false;
    const LAS float* tab; bf16_t* hid;
    __device__ __forceinline__ void operator()(const f32x4 (&acc)[2][2][4][2], const Unit& u, int wr, int wc, int fr, int fq) const {
        const int row0 = u.pm * 256 + wr * 64 + fr, cc = u.pn * 128 + wc * 32 + 8 * fq;
#pragma unroll
        for (int ai = 0; ai < 2; ++ai)
#pragma unroll
            for (int m = 0; m < 4; ++m) { const int row = row0 + ai * 128 + m * 16;
                const float sc = tab[(u.half ? 256 : 0) + ((ai * 128 + wr * 64 + m * 16 + fr) & (u.half ? 127 : 255))];
                f32x4 r0, r1;
#pragma unroll
                for (int j = 0; j < 4; ++j) { const float g0 = acc[ai][0][m][0][j] * sc, u0 = acc[ai][1][m][0][j] * sc, g1 = acc[ai][0][m][1][j] * sc, u1 = acc[ai][1][m][1][j] * sc;
                    r0[j] = g0 * fast_sigmoid(g0) * u0; r1[j] = g1 * fast_sigmoid(g1) * u1; }
                *(u32x4*)(hid + (size_t)row * FF + cc) = pack8(r0, r1); }
    }
};
constexpr int DN_SPLIT = 11, DN_KT = (FF / 64) / DN_SPLIT;
struct EpiDown {
    static constexpr bool HAS_MID = false;
    float* y; float* part; const bf16_t* hb; bf16_t* h2b;
    __device__ __forceinline__ void operator()(const f32x4 (&acc)[2][2][4][2], const Unit& u, int wr, int wc, int fr, int fq) const {
        const int row0 = u.pm * 256 + wr * 64 + fr, cc = u.pn * 256 + wc * 32 + 8 * fq;
#pragma unroll
        for (int ai = 0; ai < 2; ++ai)
#pragma unroll
            for (int m = 0; m < 4; ++m) { const int row = row0 + ai * 128 + m * 16;
                if (row < MV) { float* o = y + (size_t)row * D + cc;
                    if (u.half) {
                        float* ps = part + ((size_t)(u.kt0 / DN_KT) * MS + (row - MP)) * D + cc;
#pragma unroll
                        for (int bj = 0; bj < 2; ++bj) { *(f32x4*)(ps + bj * 128) = acc[ai][bj][m][0]; *(f32x4*)(ps + bj * 128 + 4) = acc[ai][bj][m][1]; }
                    } else {
#pragma unroll
                    for (int bj = 0; bj < 2; ++bj) { const u32x4 hw = *(const u32x4*)(hb + (size_t)row * D + cc + bj * 128); f32x4 h0, h1; unpack8(hw, h0, h1);
                        *(u32x4*)(h2b + (size_t)row * D + cc + bj * 128) = pack8(h0 + acc[ai][bj][m][0], h1 + acc[ai][bj][m][1]); } } } }
    }
};

struct EpiWA {
    static constexpr bool HAS_MID = false;
    bf16_t* dst;
    __device__ __forceinline__ void operator()(const f32x4 (&acc)[2][2][4][2], const Unit& u, int wr, int wc, int fr, int fq) const {
        const int row0 = u.pm * 256 + wr * 64 + fr, cc = wc * 32 + 8 * fq;
#pragma unroll
        for (int ai = 0; ai < 2; ++ai)
#pragma unroll
            for (int m = 0; m < 4; ++m) { bf16_t* o = dst + (size_t)(row0 + ai * 128 + m * 16) * 2048 + cc;
#pragma unroll
                for (int bj = 0; bj < 2; ++bj) *(u32x4*)(o + bj * 128) = pack8(acc[ai][bj][m][0], acc[ai][bj][m][1]); }
    }
};

__device__ __forceinline__ void p0_item(const float* W, int N, int k0, int n0, const float* gsc, bf16_t* dst, int ldd, int drow0, int dcol0, LAS float* scr, int lane) {
    const float* wp = W + (size_t)k0 * N + n0 + lane;
    float v[64];
#pragma unroll
    for (int i = 0; i < 64; ++i) v[i] = wp[(size_t)i * N];
    if (gsc) {
#pragma unroll
        for (int i = 0; i < 64; ++i) v[i] *= gsc[k0 + i]; }
#pragma unroll
    for (int i = 0; i < 64; ++i) scr[i * 65 + lane] = v[i];
    asm volatile("s_waitcnt lgkmcnt(0)" ::: "memory");
    const int c = lane & 7;
#pragma unroll
    for (int j = 0; j < 8; ++j) { const int n = (lane >> 3) + 8 * j; const LAS float* s = scr + (8 * c) * 65 + n;
        u32x4 o; o.x = cvt_pk_bf16(s[0 * 65], s[1 * 65]); o.y = cvt_pk_bf16(s[2 * 65], s[3 * 65]); o.z = cvt_pk_bf16(s[4 * 65], s[5 * 65]); o.w = cvt_pk_bf16(s[6 * 65], s[7 * 65]);
        *(u32x4*)(dst + (size_t)(drow0 + n) * ldd + dcol0 + k0 + 8 * c) = o; }
    asm volatile("s_waitcnt lgkmcnt(0)" ::: "memory");
}

struct Params {
    const float *x_prompt, *x_sample, *cache_k, *cache_v, *state_pool, *g_mix, *w_in, *w_pool, *s_pool, *w_branch, *w_out, *g_ffn, *w_gate_up, *w_down, *g_final;
    float* out; unsigned char* ws; int ph_lo, ph_hi;
};

__device__ __forceinline__ void xn_row(const Params& p, int m, int lane);
__device__ __forceinline__ void phase0(const Params& p, LAS unsigned char* lds, int gw, int NGW, int wave, int lane, unsigned xcc) {
    LAS float* scr = (LAS float*)(lds + wave * 16640);
    bf16_t* Wt_in = (bf16_t*)(p.ws + WS_WIN); bf16_t* Wt_br = (bf16_t*)(p.ws + WS_WBR); bf16_t* Wt_out = (bf16_t*)(p.ws + WS_WOUT);
    bf16_t* Wt_gu = (bf16_t*)(p.ws + WS_WGU); bf16_t* Wt_dn = (bf16_t*)(p.ws + WS_WDN); bf16_t* XN = (bf16_t*)(p.ws + WS_XN);
    bf16_t* TMPA = (bf16_t*)(p.ws + WS_TMPA); bf16_t* WPB = (bf16_t*)(p.ws + WS_WPB);
    constexpr int I_IN = (D / 64) * (NIN / 64), I_BR = (D / 64) * (D / 64), I_OUT = (D / 64) * (D / 64), I_GU = (D / 64) * (NGU / 64), I_DN = (FF / 64) * (D / 64);
    constexpr int NITEMS = I_IN + I_BR + I_OUT + I_GU + I_DN;
    unsigned* ctr = (unsigned*)(p.ws + WS_BAR) + 3648 + 64 * (xcc & 7);
    constexpr int NXN = MT / 2;
    for (;;) {
        unsigned kq = 0; if (lane == 0) kq = __hip_atomic_fetch_add(ctr, 1u, __ATOMIC_RELAXED, __HIP_MEMORY_SCOPE_AGENT);
        const int it = 8 * (int)__builtin_amdgcn_readfirstlane(kq) + (int)(xcc & 7);
        if (it >= NITEMS + NXN) break;
        if (it >= NITEMS) { xn_row(p, 2 * (it - NITEMS), lane); xn_row(p, 2 * (it - NITEMS) + 1, lane); continue; }
        int r = it;
        if (r < I_IN) { const int nb = NIN / 64; const int n0 = 64 * (r % nb); int drow = n0;
            if (n0 >= 4096) { const int q = n0 - 4096; drow = q < 2048 ? 4096 + (q / 128) * 256 + (q % 128) : 4096 + ((q - 2048) / 128) * 256 + 128 + ((q - 2048) % 128); }
            p0_item(p.w_in, NIN, 64 * (r / nb), n0, p.g_mix, Wt_in, D, drow, 0, scr, lane); continue; } r -= I_IN;
        if (r < I_BR) { const int nb = D / 64; const int k0 = 64 * (r / nb), n0 = 64 * (r % nb);
            if (k0 < 1024) p0_item(p.w_branch, D, k0, n0, p.s_pool, TMPA, 1024, n0, 0, scr, lane);
            else p0_item(p.w_branch, D, k0, n0, nullptr, Wt_br, 2048, n0, 0, scr, lane);
            continue; } r -= I_BR;
        if (r < I_OUT) { const int nb = D / 64; p0_item(p.w_out, D, 64 * (r / nb), 64 * (r % nb), nullptr, Wt_out, D, 64 * (r % nb), 0, scr, lane); continue; } r -= I_OUT;
        if (r < I_GU) { const int nb = NGU / 64; const int n0 = 64 * (r % nb); const int drow = n0 < FF ? (n0 / 128) * 256 + (n0 % 128) : ((n0 - FF) / 128) * 256 + 128 + ((n0 - FF) % 128);
            p0_item(p.w_gate_up, NGU, 64 * (r / nb), n0, p.g_ffn, Wt_gu, D, drow, 0, scr, lane); continue; } r -= I_GU;
        { const int nb = D / 64; p0_item(p.w_down, D, 64 * (r / nb), 64 * (r % nb), nullptr, Wt_dn, FF, 64 * (r % nb), 0, scr, lane); }
    }
}
__device__ __forceinline__ void xn_row(const Params& p, int m, int lane) {
    bf16_t* XN = (bf16_t*)(p.ws + WS_XN);
    u32x2* o8 = (u32x2*)(XN + (size_t)m * D) + lane;
    if (m >= MV) {
#pragma unroll
        for (int j = 0; j < 8; ++j) o8[64 * j] = (u32x2){0u, 0u};
        return; }
    const f32x4* xr = (const f32x4*)(m < MP ? p.x_prompt + (size_t)m * D : p.x_sample + (size_t)(m - MP) * D) + lane;
    f32x4 v[8]; float s = 0.f;
#pragma unroll
    for (int j = 0; j < 8; ++j) { v[j] = xr[64 * j]; s += (v[j].x * v[j].x + v[j].y * v[j].y) + (v[j].z * v[j].z + v[j].w * v[j].w); }
    const float rs = __builtin_amdgcn_rsqf(wave_sum(s) * (1.0f / D) + EPS);
#pragma unroll
    for (int j = 0; j < 8; ++j) o8[64 * j] = (u32x2){cvt_pk_bf16(v[j].x * rs, v[j].y * rs), cvt_pk_bf16(v[j].z * rs, v[j].w * rs)};
}
__device__ __forceinline__ void phase0b(const Params& p, int gw, int NGW, int lane) {
    bf16_t* WPB = (bf16_t*)(p.ws + WS_WPB);
    { bf16_t* Ub = (bf16_t*)(p.ws + WS_QKVU);
      for (int i = gw * 64 + lane; i < 8 * 15 * 128; i += NGW * 64) { const int rr = i >> 7, c8 = (i & 127) * 8, b = rr / 15, hi = rr % 15;
          const float* sp = p.state_pool + (size_t)rr * 1024 + c8; *(u32x4*)(Ub + (size_t)(MP + 31 * b + hi) * 1024 + c8) = pack8(*(const f32x4*)sp, *(const f32x4*)(sp + 4)); } }
    for (int i = gw * 64 + lane; i < 4 * 256 * 256 / 8; i += NGW * 64) { const f32x4 a = *(const f32x4*)(p.w_pool + (size_t)i * 8), b = *(const f32x4*)(p.w_pool + (size_t)i * 8 + 4); *(u32x4*)(WPB + (size_t)i * 8) = pack8(a, b); }
    float* ssq = (float*)(p.ws + WS_SSQ);
    for (int i = gw * 64 + lane; i < MT; i += NGW * 64) ssq[i] = 0.f;
}

constexpr int VROW = 320;
__device__ __forceinline__ s16x4 vtr(const LAS unsigned char* p) { typedef short v4i16_t __attribute__((ext_vector_type(4))); return __builtin_bit_cast(s16x4, __builtin_amdgcn_ds_read_tr16_b64_v4i16((LAS v4i16_t*)p)); }
__device__ __forceinline__ bf16x8 cvt8(const f32x4& a, const f32x4& b) { u32x4 w = pack8(a, b); return __builtin_bit_cast(bf16x8, w); }

__device__ __forceinline__ void attn_unit(const Params& p, LAS unsigned char* vl, int unit, int lane) {
    const bf16_t* Ub = (const bf16_t*)(p.ws + WS_QKVU);
    const bf16_t* Qb = Ub + (size_t)MT * 1024; const bf16_t* Kb = Qb + (size_t)MT * 1024; const bf16_t* Vb = Kb + (size_t)MT * 1024;
    bf16_t* AO = (bf16_t*)(p.ws + WS_AO);
    const int n = lane & 31, hh = lane >> 5;
    const bool sample = unit < 64;
    int b, h, qrow0, nblk;
    if (sample) { b = unit >> 3; h = unit & 7; qrow0 = MP + b * DSEQ; nblk = 1 + PAST / 32; }
    else { const int u2 = unit - 64; const int qb = u2 & 127; h = (u2 >> 7) & 7; b = u2 >> 10; qrow0 = b * SEQ + qb * 32; nblk = qb + 1; }
    bf16x8 qf[8];
    { const bf16_t* qp = Qb + (size_t)(qrow0 + n) * 1024 + h * HD + 64 * hh;
#pragma unroll
      for (int kk = 0; kk < 8; ++kk) qf[kk] = *(const bf16x8*)(qp + 8 * kk); }
    f32x16 o[4];
#pragma unroll
    for (int db = 0; db < 4; ++db)
#pragma unroll
        for (int r = 0; r < 16; ++r) o[db][r] = 0.f;
    float R = (sample && n >= DSEQ) ? -1e30f : 0.f;
    const float* ck = p.cache_k + (size_t)b * PAST * 1024 + h * HD; const float* cv = p.cache_v + (size_t)b * PAST * 1024 + h * HD;
    const int vaddr = (4 * hh + ((lane & 15) >> 2)) * VROW + (16 * ((lane >> 4) & 1) + 4 * (lane & 3)) * 2;
    for (int blk = 0; blk < nblk; ++blk) {
        bf16x8 kf[8];
        const bool diag = (blk == 0);
        if (!sample || blk == 0) {
            const int s0 = qrow0 - blk * 32;
            const bf16_t* kp = Kb + (size_t)(s0 + n) * 1024 + h * HD + 64 * hh;
#pragma unroll
            for (int kk = 0; kk < 8; ++kk) kf[kk] = *(const bf16x8*)(kp + 8 * kk);
            const bf16_t* vp = Vb + (size_t)(s0 + (lane >> 4)) * 1024 + h * HD + 8 * (lane & 15);
#pragma unroll
            for (int it = 0; it < 8; ++it) { const u32x4 w = *(const u32x4*)(vp + (size_t)(4 * it) * 1024); *(LAS u32x4*)(vl + (4 * it + (lane >> 4)) * VROW + 16 * (lane & 15)) = w; }
        } else {
            const int s0 = PAST - blk * 32;
            const float* kp = ck + (size_t)(s0 + n) * 1024 + 64 * hh;
#pragma unroll
            for (int kk = 0; kk < 8; ++kk) kf[kk] = cvt8(*(const f32x4*)(kp + 8 * kk), *(const f32x4*)(kp + 8 * kk + 4));
            const float* vp = cv + (size_t)(s0 + (lane >> 4)) * 1024 + 8 * (lane & 15);
#pragma unroll
            for (int it = 0; it < 8; ++it) { const f32x4 a = *(const f32x4*)(vp + (size_t)(4 * it) * 1024), c = *(const f32x4*)(vp + (size_t)(4 * it) * 1024 + 4);
                *(LAS u32x4*)(vl + (4 * it + (lane >> 4)) * VROW + 16 * (lane & 15)) = pack8(a, c); }
        }
        f32x16 st;
#pragma unroll
        for (int r = 0; r < 16; ++r) st[r] = 0.f;
#pragma unroll
        for (int kk = 0; kk < 8; ++kk) st = __builtin_amdgcn_mfma_f32_32x32x16_bf16(kf[kk], qf[kk], st, 0, 0, 0);
        float l1m[16], ls[16];
#pragma unroll
        for (int r = 0; r < 16; ++r) { const int i = (r & 3) + 8 * (r >> 2) + 4 * hh; const bool valid = !diag || (i < n);
            const float z = st[r] * 0.08838834764831845f; const float sp = fmaxf(z, 0.f) + __logf(1.0f + __expf(-fabsf(z)));
            l1m[r] = valid ? -sp : 0.f; ls[r] = valid ? (z - sp) : -1e30f; }
        float gown[4], goth[4];
#pragma unroll
        for (int a = 0; a < 4; ++a) { gown[a] = (l1m[4 * a] + l1m[4 * a + 1]) + (l1m[4 * a + 2] + l1m[4 * a + 3]); goth[a] = __shfl_xor(gown[a], 32); }
        float wv[16]; float tail = R;
#pragma unroll
        for (int a = 3; a >= 0; --a) { float sfx = tail + (hh == 0 ? goth[a] : 0.f);
#pragma unroll
            for (int rr = 3; rr >= 0; --rr) { wv[4 * a + rr] = __expf(ls[4 * a + rr] + sfx); sfx += l1m[4 * a + rr]; }
            tail += gown[a] + goth[a]; }
        R = tail;
        bf16x8 wb[2];
#pragma unroll
        for (int s = 0; s < 2; ++s) wb[s] = cvt8((f32x4){wv[8 * s], wv[8 * s + 1], wv[8 * s + 2], wv[8 * s + 3]}, (f32x4){wv[8 * s + 4], wv[8 * s + 5], wv[8 * s + 6], wv[8 * s + 7]});
        asm volatile("s_waitcnt lgkmcnt(0)" ::: "memory");
#pragma unroll
        for (int db = 0; db < 4; ++db)
#pragma unroll
            for (int s = 0; s < 2; ++s) { const s16x4 lo = vtr(vl + vaddr + (16 * s) * VROW + 64 * db), hi = vtr(vl + vaddr + (16 * s + 8) * VROW + 64 * db);
                const bf16x8 vf = (bf16x8){lo[0], lo[1], lo[2], lo[3], hi[0], hi[1], hi[2], hi[3]};
                o[db] = __builtin_amdgcn_mfma_f32_32x32x16_bf16(vf, wb[s], o[db], 0, 0, 0); }
        asm volatile("s_waitcnt lgkmcnt(0)" ::: "memory");
        if (__all(R < -104.0f)) break;
    }
    if (!sample || n < DSEQ) {
        bf16_t* op = AO + (size_t)(qrow0 + n) * 2048 + 1024 + h * HD + 4 * hh;
#pragma unroll
        for (int db = 0; db < 4; ++db)
#pragma unroll
            for (int a = 0; a < 4; ++a) *(u32x2*)(op + 32 * db + 8 * a) = (u32x2){cvt_pk_bf16(o[db][4 * a], o[db][4 * a + 1]), cvt_pk_bf16(o[db][4 * a + 2], o[db][4 * a + 3])};
    }
}

constexpr int AKROW = 272, AVROW = 288, AKB = 32 * AKROW, AVB = 32 * AVROW, AFLAG = 2 * AKB + 2 * AVB;
constexpr float SB_EXIT = -150.05f;
template <bool DIAG>
__device__ __forceinline__ void sb_block_t(const LAS unsigned char* kl, const LAS unsigned char* vl, int vaddr, const bf16x8 (&qf)[8], f32x16 (&o)[4], float& R, int n, int hh) {
    constexpr float C = 0.08838834764831845f * 1.4426950408889634f;
    f32x16 st;
#pragma unroll
    for (int r = 0; r < 16; ++r) st[r] = 0.f;
    { bf16x8 kf[8];
#pragma unroll
      for (int kk = 0; kk < 8; ++kk) kf[kk] = *(const LAS bf16x8*)(kl + 16 * kk);
#pragma unroll
      for (int kk = 0; kk < 8; ++kk) st = __builtin_amdgcn_mfma_f32_32x32x16_bf16(kf[kk], qf[kk], st, 0, 0, 0); }
    float l1m[16];
#pragma unroll
    for (int r = 0; r < 16; ++r) { const int i = (r & 3) + 8 * (r >> 2) + 4 * hh; const bool valid = !DIAG || (i < n);
        const float Z = st[r] * C; const float sp = fmaxf(Z, 0.f) + __builtin_amdgcn_logf(1.0f + __builtin_amdgcn_exp2f(-fabsf(Z)));
        l1m[r] = valid ? -sp : 0.f; st[r] = valid ? (Z - sp) : -1e30f; }
    float gown[4], goth[4];
#pragma unroll
    for (int a = 0; a < 4; ++a) { gown[a] = (l1m[4 * a] + l1m[4 * a + 1]) + (l1m[4 * a + 2] + l1m[4 * a + 3]); goth[a] = __shfl_xor(gown[a], 32); }
    float tail = R;
#pragma unroll
    for (int a = 3; a >= 0; --a) { float sfx = tail + (hh == 0 ? goth[a] : 0.f);
#pragma unroll
        for (int rr = 3; rr >= 0; --rr) { st[4 * a + rr] = __builtin_amdgcn_exp2f(st[4 * a + rr] + sfx); sfx += l1m[4 * a + rr]; }
        tail += gown[a] + goth[a]; }
    R = tail;
    bf16x8 wb[2];
#pragma unroll
    for (int q = 0; q < 2; ++q) wb[q] = cvt8((f32x4){st[8 * q], st[8 * q + 1], st[8 * q + 2], st[8 * q + 3]}, (f32x4){st[8 * q + 4], st[8 * q + 5], st[8 * q + 6], st[8 * q + 7]});
#pragma unroll
    for (int db = 0; db < 4; ++db)
#pragma unroll
        for (int q = 0; q < 2; ++q) { const s16x4 lo = vtr(vl + vaddr + (16 * q) * AVROW + 64 * db), hi = vtr(vl + vaddr + (16 * q + 8) * AVROW + 64 * db);
            const bf16x8 vf = (bf16x8){lo[0], lo[1], lo[2], lo[3], hi[0], hi[1], hi[2], hi[3]};
            o[db] = __builtin_amdgcn_mfma_f32_32x32x16_bf16(vf, wb[q], o[db], 0, 0, 0); }
}
__device__ __forceinline__ void sb_block(const LAS unsigned char* kl, const LAS unsigned char* vl, int vaddr, const bf16x8 (&qf)[8], f32x16 (&o)[4], float& R, bool diag, int n, int hh) {
    if (diag) sb_block_t<true>(kl, vl, vaddr, qf, o, R, n, hh); else sb_block_t<false>(kl, vl, vaddr, qf, o, R, n, hh);
}
__device__ __forceinline__ void attn_wg_unit(const Params& p, LAS unsigned char* lds, int wgu, int wave, int lane) {
    const bf16_t* Ub = (const bf16_t*)(p.ws + WS_QKVU);
    const bf16_t* Qb = Ub + (size_t)MT * 1024; const bf16_t* Kb = Qb + (size_t)MT * 1024; const bf16_t* Vb = Kb + (size_t)MT * 1024;
    bf16_t* AO = (bf16_t*)(p.ws + WS_AO);
    const int n = lane & 31, hh = lane >> 5;
    const int qg = wgu & 15, h = (wgu >> 4) & 7, b = wgu >> 7;
    const int qtop = qg * 8 + 7, qbw = qg * 8 + wave, qrow0 = b * SEQ + qbw * 32;
    bf16x8 qf[8];
    { const bf16_t* qp = Qb + (size_t)(qrow0 + n) * 1024 + h * HD + 64 * hh;
#pragma unroll
      for (int kk = 0; kk < 8; ++kk) qf[kk] = *(const bf16x8*)(qp + 8 * kk); }
    f32x16 o[4];
#pragma unroll
    for (int db = 0; db < 4; ++db)
#pragma unroll
        for (int r = 0; r < 16; ++r) o[db][r] = 0.f;
    float R = 0.f; bool done = false;
    LAS int* flags = (LAS int*)(lds + AFLAG);
    const int lrow = 4 * wave + (lane >> 4), lch = lane & 15;
    const size_t gbase = ((size_t)b * SEQ + lrow) * 1024 + h * HD + 8 * lch;
    const int vaddr = (4 * hh + ((lane & 15) >> 2)) * AVROW + (16 * ((lane >> 4) & 1) + 4 * (lane & 3)) * 2;
    u32x4 kr = *(const u32x4*)(Kb + gbase + (size_t)qtop * 32 * 1024), vr = *(const u32x4*)(Vb + gbase + (size_t)qtop * 32 * 1024);
    for (int s = 0; s <= qtop; ++s) {
        const int kb = qtop - s, bo = s & 1;
        *(LAS u32x4*)(lds + bo * AKB + lrow * AKROW + 16 * lch) = kr;
        *(LAS u32x4*)(lds + 2 * AKB + bo * AVB + lrow * AVROW + 16 * lch) = vr;
        if (kb > 0) { kr = *(const u32x4*)(Kb + gbase + (size_t)(kb - 1) * 32 * 1024); vr = *(const u32x4*)(Vb + gbase + (size_t)(kb - 1) * 32 * 1024); }
        asm volatile("s_waitcnt lgkmcnt(0)" ::: "memory"); __builtin_amdgcn_s_barrier(); asm volatile("" ::: "memory");
        if (s >= 8) {
            int all = 1;
#pragma unroll
            for (int w = 0; w < 8; ++w) all &= flags[((s - 1) & 1) * 8 + w];
            if (__builtin_amdgcn_readfirstlane(all)) break;
        }
        if (!done && kb <= qbw) {
            sb_block(lds + bo * AKB + n * AKROW + 128 * hh, lds + 2 * AKB + bo * AVB, vaddr, qf, o, R, kb == qbw, n, hh);
            if (__all(R < SB_EXIT)) done = true;
        }
        if (lane == 0) flags[(s & 1) * 8 + wave] = done ? 1 : 0;
    }
    { bf16_t* op = AO + (size_t)(qrow0 + n) * 2048 + 1024 + h * HD + 4 * hh;
#pragma unroll
      for (int db = 0; db < 4; ++db)
#pragma unroll
          for (int a = 0; a < 4; ++a) *(u32x2*)(op + 32 * db + 8 * a) = (u32x2){cvt_pk_bf16(o[db][4 * a], o[db][4 * a + 1]), cvt_pk_bf16(o[db][4 * a + 2], o[db][4 * a + 3])}; }
    asm volatile("s_waitcnt lgkmcnt(0)" ::: "memory"); __builtin_amdgcn_s_barrier(); asm volatile("" ::: "memory");
}

__device__ __forceinline__ void attn_wg_sample(const Params& p, LAS unsigned char* lds, int unit, int wave, int lane) {
    const bf16_t* Ub = (const bf16_t*)(p.ws + WS_QKVU);
    const bf16_t* Qb = Ub + (size_t)MT * 1024; const bf16_t* Kb = Qb + (size_t)MT * 1024; const bf16_t* Vb = Kb + (size_t)MT * 1024;
    bf16_t* AO = (bf16_t*)(p.ws + WS_AO);
    const int n = lane & 31, hh = lane >> 5;
    const int b = unit >> 3, h = unit & 7, qrow0 = MP + b * DSEQ;
    bf16x8 qf[8];
    { const bf16_t* qp = Qb + (size_t)(qrow0 + n) * 1024 + h * HD + 64 * hh;
#pragma unroll
      for (int kk = 0; kk < 8; ++kk) qf[kk] = *(const bf16x8*)(qp + 8 * kk); }
    f32x16 o[4];
#pragma unroll
    for (int db = 0; db < 4; ++db)
#pragma unroll
        for (int r = 0; r < 16; ++r) o[db][r] = 0.f;
    float R = (n >= DSEQ) ? -1e30f : 0.f; bool done = false;
    LAS int* flags = (LAS int*)(lds + AFLAG);
    const int lrow = 4 * wave + (lane >> 4), lch = lane & 15;
    const int vaddr = (4 * hh + ((lane & 15) >> 2)) * AVROW + (16 * ((lane >> 4) & 1) + 4 * (lane & 3)) * 2;
    const float* ck = p.cache_k + (size_t)b * PAST * 1024 + h * HD + 8 * lch; const float* cv = p.cache_v + (size_t)b * PAST * 1024 + h * HD + 8 * lch;
    u32x4 kr = *(const u32x4*)(Kb + (size_t)(qrow0 + lrow) * 1024 + h * HD + 8 * lch), vr = *(const u32x4*)(Vb + (size_t)(qrow0 + lrow) * 1024 + h * HD + 8 * lch);
    constexpr int NSTEP = 1 + PAST / 32;
    for (int s = 0; s < NSTEP; ++s) {
        const int bo = s & 1;
        *(LAS u32x4*)(lds + bo * AKB + lrow * AKROW + 16 * lch) = kr;
        *(LAS u32x4*)(lds + 2 * AKB + bo * AVB + lrow * AVROW + 16 * lch) = vr;
        f32x4 ka0, ka1, va0, va1;
        const bool more = s + 1 < NSTEP;
        if (more) { const size_t po = (size_t)(PAST - 32 * (s + 1) + lrow) * 1024; ka0 = *(const f32x4*)(ck + po); ka1 = *(const f32x4*)(ck + po + 4); va0 = *(const f32x4*)(cv + po); va1 = *(const f32x4*)(cv + po + 4); }
        asm volatile("s_waitcnt lgkmcnt(0)" ::: "memory"); __builtin_amdgcn_s_barrier(); asm volatile("" ::: "memory");
        if (s >= 1) { if (__builtin_amdgcn_readfirstlane(flags[((s - 1) & 1) * 8])) break; }
        if (wave == 0 && !done) {
            sb_block(lds + bo * AKB + n * AKROW + 128 * hh, lds + 2 * AKB + bo * AVB, vaddr, qf, o, R, s == 0, n, hh);
            if (__all(R < SB_EXIT)) done = true;
        }
        if (wave == 0 && lane == 0) flags[(s & 1) * 8] = done ? 1 : 0;
        if (more) { kr = pack8(ka0, ka1); vr = pack8(va0, va1); }
    }
    if (wave == 0 && n < DSEQ) { bf16_t* op = AO + (size_t)(qrow0 + n) * 2048 + 1024 + h * HD + 4 * hh;
#pragma unroll
      for (int db = 0; db < 4; ++db)
#pragma unroll
          for (int a = 0; a < 4; ++a) *(u32x2*)(op + 32 * db + 8 * a) = (u32x2){cvt_pk_bf16(o[db][4 * a], o[db][4 * a + 1]), cvt_pk_bf16(o[db][4 * a + 2], o[db][4 * a + 3])}; }
    asm volatile("s_waitcnt lgkmcnt(0)" ::: "memory"); __builtin_amdgcn_s_barrier(); asm volatile("" ::: "memory");
}

constexpr int N_DIFF_ITEMS = (MV / 32) * 4;
__device__ __forceinline__ void diff_item(const Params& p, int wi, int lane) {
    const bf16_t* Ub = (const bf16_t*)(p.ws + WS_QKVU); bf16_t* AO = (bf16_t*)(p.ws + WS_AO);
    const int g = wi & 3, W = 2 << g, ch = 2 * (wi >> 2) + (lane >> 5), cc = 32 * g + (lane & 31);
    const int m0 = ch * 16; const bool prompt = m0 < MP; const int t0 = prompt ? (m0 & (SEQ - 1)) : PAST; const bool hist = prompt ? (t0 > 0) : true;
    const bf16_t* up = Ub + (size_t)u_row(m0) * 1024 + cc * 8;
    bf16_t* op = AO + (size_t)m0 * 2048 + cc * 8;
    u32x4 nw[16], od[16];
#pragma unroll
    for (int r = 0; r < 16; ++r) nw[r] = *(const u32x4*)(up + (size_t)r * 1024);
#pragma unroll
    for (int r = 0; r < 16; ++r) { const int trel = r - (W - 1); const bool ex = trel >= 0 || hist; const u32x4 v = *(const u32x4*)(up + (long)(ex ? trel : 0) * 1024); od[r] = ex ? v : (u32x4){0u, 0u, 0u, 0u}; }
    f32x4 s0 = (f32x4){0.f, 0.f, 0.f, 0.f}, s1 = s0;
#pragma unroll
    for (int r = 0; r < 15; ++r) { f32x4 a, c; unpack8(od[r], a, c); const float k = r < W - 1 ? 1.f : 0.f; s0 += a * k; s1 += c * k; }
#pragma unroll
    for (int r = 0; r < 16; ++r) {
        f32x4 a, c, da, dc; unpack8(nw[r], a, c); unpack8(od[r], da, dc);
        s0 += a; s1 += c;
        const int t = t0 + r; const float ic = __builtin_amdgcn_rcpf((float)(t + 1 < W ? t + 1 : W));
        *(u32x4*)(op + (size_t)r * 2048) = pack8(s0 * ic - a, s1 * ic - c);
        s0 -= da; s1 -= dc;
    }
}

__global__ void __launch_bounds__(512, 2) fwd_megakernel(Params p) {
    extern __shared__ __attribute__((aligned(16))) unsigned char lds_raw[];
    LAS unsigned char* lds = (LAS unsigned char*)lds_raw;
    const int tid = threadIdx.x, lane = tid & 63, wave = __builtin_amdgcn_readfirstlane(tid >> 6);
    const int G = gridDim.x, bx = blockIdx.x;
    const int vcu = (G % 8 == 0) ? (bx % 8) * (G / 8) + bx / 8 : bx;
    const int gw = vcu * 8 + wave, NGW = G * 8;
    cg::grid_group grid = cg::this_grid();
    volatile LAS unsigned* xst = (volatile LAS unsigned*)(lds + LDS_BYTES - 64);
    if (tid < 2) xst[tid] = 0u;
    __syncthreads();
    XcdBarrier xbar = xcd_barrier_post((unsigned*)(p.ws + WS_BAR), xst);
#define IN(k) (p.ph_lo <= (k) && (k) < p.ph_hi)
#define SEAM(k) do { if (IN(k) && IN((k) + 1)) { if (p.ph_hi > 64) grid.sync();   xcd_barrier(xbar); } STAMP(); } while (0)
    bf16_t* Wt_in = (bf16_t*)(p.ws + WS_WIN); bf16_t* Wt_br = (bf16_t*)(p.ws + WS_WBR); bf16_t* Wt_out = (bf16_t*)(p.ws + WS_WOUT);
    bf16_t* Wt_gu = (bf16_t*)(p.ws + WS_WGU); bf16_t* Wt_dn = (bf16_t*)(p.ws + WS_WDN); bf16_t* XN = (bf16_t*)(p.ws + WS_XN);
    bf16_t* QKVU = (bf16_t*)(p.ws + WS_QKVU); bf16_t* GATE = (bf16_t*)(p.ws + WS_GATE); bf16_t* AO = (bf16_t*)(p.ws + WS_AO);
    bf16_t* MERGED = (bf16_t*)(p.ws + WS_MERGED); bf16_t* HID = (bf16_t*)(p.ws + WS_HID); float* SSQ = (float*)(p.ws + WS_SSQ);
    float* Y = p.out + OFF_Y;
#ifdef PROBE_T
    unsigned long long tstamp[10]; int nst = 0;
#define STAMP() do { tstamp[nst++] = __builtin_amdgcn_s_memrealtime(); } while (0)
#else
#define STAMP() do {} while (0)
#endif
    STAMP();

    if (IN(0)) { phase0(p, lds, gw, NGW, wave, lane, xbar.x);
#ifdef PROBE_T
#endif
        phase0b(p, gw, NGW, lane);
    }
    SEAM(0);
    if (IN(1)) { pg8::Gemm g{XN, Wt_in, D, D, MT, NIN, D}; pg8::StaticOrder S; S.init(64, NIN / 256, D / 64, G, bx, 64, 1); EpiIn E{QKVU, GATE, p.out}; pg8::gemm_phase(lds, g, S, E); }
    SEAM(1);
    if (IN(2)) {
        for (int su = vcu; su < 64; su += G) attn_wg_sample(p, lds, su, wave, lane);
        for (int wu = vcu; wu < 512; wu += G) attn_wg_unit(p, lds, wu, wave, lane);
        for (int wi = gw; wi < N_DIFF_ITEMS; wi += NGW) diff_item(p, __builtin_amdgcn_readfirstlane(wi), lane);
        __syncthreads();
        for (int gq = 0; gq < 4; ++gq) { pg8::Gemm g{(const bf16_t*)(p.ws + WS_TMPA) + gq * 256, (const bf16_t*)(p.ws + WS_WPB) + gq * 65536, 1024, 256, 2048, 256, 256};
            pg8::StaticOrder S; S.init(8, 1, 4, G, (bx + G - 8 * gq) % G); EpiWA E{Wt_br + gq * 256}; pg8::gemm_phase(lds, g, S, E); }
    }
    SEAM(2);
    if (IN(3)) {
        { pg8::Gemm g{AO, Wt_br, 2048, 2048, MT, D, 2048}; pg8::StaticOrder S; S.init(64, 8, 32, G, bx, 64, MG_SPLIT); EpiMerged E{GATE, MERGED, (float*)(p.ws + WS_XN)}; pg8::gemm_phase(lds, g, S, E); }
    }
    if (IN(3) && IN(4)) xcd_barrier(xbar);
    if (IN(3)) {
        for (int r = gw; r < MS; r += NGW) {
            const f32x4* pr = (const f32x4*)((const float*)(p.ws + WS_XN) + (size_t)r * D) + lane;
            const u32x2* gr = (const u32x2*)(GATE + (size_t)(MP + r) * 4096) + lane; u32x2* o8 = (u32x2*)(MERGED + (size_t)(MP + r) * D) + lane;
#pragma unroll
            for (int j = 0; j < 8; ++j) { const size_t cs = (size_t)MS * D / 4;
                const f32x4 a = pr[64 * j] + pr[cs + 64 * j], b = pr[2 * cs + 64 * j] + pr[3 * cs + 64 * j];
                const u32x2 rw = gr[64 * j], bw = gr[512 + 64 * j];
                const f32x4 rr = (f32x4){bflo(rw.x), bfhi(rw.x), bflo(rw.y), bfhi(rw.y)}, gb = (f32x4){bflo(bw.x), bfhi(bw.x), bflo(bw.y), bfhi(bw.y)};
                const f32x4 v = gb * (rr * a + b);
                o8[64 * j] = (u32x2){cvt_pk_bf16(v.x, v.y), cvt_pk_bf16(v.z, v.w)}; }
        }
    }
    SEAM(3);
    if (IN(4)) { pg8::Gemm g{MERGED, Wt_out, D, D, MT, D, D}; pg8::StaticOrder S; S.init(64, 8, 32, G, bx, 64, OUT_SPLIT); EpiOut E{p.x_prompt, p.x_sample, Y, XN, (float*)(p.ws + WS_SSQP), (float*)(p.ws + WS_AO)}; pg8::gemm_phase(lds, g, S, E); }
    if (IN(4) && IN(5)) xcd_barrier(xbar);
    if (IN(4)) {
        for (int r = gw; r < MS; r += NGW) {
            const f32x4* xr = (const f32x4*)(p.x_sample + (size_t)r * D) + lane; const f32x4* pr = (const f32x4*)((const float*)(p.ws + WS_AO) + (size_t)r * D) + lane;
            u32x2* o8 = (u32x2*)(XN + (size_t)(MP + r) * D) + lane; float* sp = (float*)(p.ws + WS_SSQP);
            float sq = 0.f;
#pragma unroll
            for (int j = 0; j < 8; ++j) { f32x4 v = xr[64 * j];
#pragma unroll
                for (int c = 0; c < OUT_SPLIT; ++c) v += pr[(size_t)c * MS * D / 4 + 64 * j];
                sq += (v.x * v.x + v.y * v.y) + (v.z * v.z + v.w * v.w);
                o8[64 * j] = (u32x2){cvt_pk_bf16(v.x, v.y), cvt_pk_bf16(v.z, v.w)}; }
            sq = wave_sum(sq);
            if (lane < 32) sp[(size_t)lane * MT + MP + r] = lane == 0 ? sq : 0.f;
        }
    }
    SEAM(4);
    if (IN(5)) { pg8::Gemm g{XN, Wt_gu, D, D, MT, NGU, D}; pg8::StaticOrder S; S.init(64, NGU / 256, 32, G, bx, 64, 1);
        LAS float* tab = (LAS float*)(lds + 131072);
        { pg8::Unit u0; S.next(0, u0); const float* sp = (const float*)(p.ws + WS_SSQP);
          if (tid < 384) { const int row = tid < 256 ? u0.pm * 256 + tid : MP + (tid - 256); float a = 0.f;
#pragma unroll 8
              for (int k = 0; k < 32; ++k) a += sp[(size_t)k * MT + row];
              tab[tid] = __builtin_amdgcn_rsqf(a * (1.0f / D) + EPS); }
          __syncthreads(); }
        EpiGU E{tab, HID}; pg8::gemm_phase(lds, g, S, E); }
    SEAM(5);
    if (IN(6)) { pg8::Gemm g{HID, Wt_dn, FF, FF, MT, D, FF}; pg8::StaticOrder S; S.init(64, 8, FF / 64, G, bx, 64, DN_SPLIT); EpiDown E{Y, (float*)(p.ws + WS_AO), XN, (bf16_t*)(p.ws + WS_H2B)}; pg8::gemm_phase(lds, g, S, E); }
    SEAM(6);
    if (IN(7)) {
        for (int m = gw; m < MV; m += NGW) {
            f32x4* yr = (f32x4*)(Y + (size_t)m * D) + lane; const f32x4* gf = (const f32x4*)p.g_final + lane;
            f32x4 v[8]; float s = 0.f;
            {
                const u32x2* hr = (const u32x2*)((m < MP ? (const bf16_t*)(p.ws + WS_H2B) : (const bf16_t*)XN) + (size_t)m * D) + lane;
#pragma unroll
                for (int j = 0; j < 8; ++j) { const u32x2 w2 = hr[64 * j]; v[j] = (f32x4){bflo(w2.x), bfhi(w2.x), bflo(w2.y), bfhi(w2.y)}; } }
            if (m >= MP) { const f32x4* pr = (const f32x4*)((const float*)(p.ws + WS_AO) + (size_t)(m - MP) * D) + lane;
                for (int c = 0; c < DN_SPLIT; ++c)
#pragma unroll
                    for (int j = 0; j < 8; ++j) v[j] += pr[(size_t)c * MS * D / 4 + 64 * j]; }
#pragma unroll
            for (int j = 0; j < 8; ++j) s += (v[j].x * v[j].x + v[j].y * v[j].y) + (v[j].z * v[j].z + v[j].w * v[j].w);
            const float rs = __builtin_amdgcn_rsqf(wave_sum(s) * (1.0f / D) + EPS);
#pragma unroll
            for (int j = 0; j < 8; ++j) yr[64 * j] = v[j] * rs * gf[64 * j];
        }
    }
#ifdef PROBE_T
    STAMP();
    if (bx == 0 && tid == 0) {
        const unsigned long long e1 = (unsigned long long)__hip_atomic_load((long long*)(p.ws + WS_SSQ + 512 * 1024), __ATOMIC_RELAXED, __HIP_MEMORY_SCOPE_AGENT);
        const unsigned long long e2 = (unsigned long long)__hip_atomic_load((long long*)(p.ws + WS_SSQ + 512 * 1024 + 256), __ATOMIC_RELAXED, __HIP_MEMORY_SCOPE_AGENT);
        (void)e1; (void)e2;
        const float ta = (float)(tstamp[PROBE_A + 1] - tstamp[PROBE_A]) * 0.01f, tb = (float)(tstamp[PROBE_B + 1] - tstamp[PROBE_B]) * 0.01f;
        asm volatile("s_waitcnt vmcnt(0)" ::: "memory");
        atomicAdd(Y, 4.0f + ta * (1.0f / 256.0f)); atomicAdd(p.out + OFF_PP, 1.5f + tb * (1.0f / 500.0f));
    }
#endif
#undef IN
#undef SEAM
}

extern "C" void kernel_launch(void* const* d_in, const int* in_sizes, int n_in, void* d_out, int out_size, void* d_ws, size_t ws_size, hipStream_t stream) {
    static int grid = 0;
    if (grid == 0) {
        if (n_in != 15 || (size_t)out_size != OUT_TOTAL || ws_size < WS_END) { fprintf(stderr, "kernel_launch: unexpected shapes: n_in %d out %d ws %zu\n", n_in, out_size, ws_size); grid = -1; return; }
        int dev = 0, cus = 0, per_cu = 0;
        hipGetDevice(&dev); hipDeviceGetAttribute(&cus, hipDeviceAttributeMultiprocessorCount, dev);
        hipFuncSetAttribute((const void*)fwd_megakernel, hipFuncAttributeMaxDynamicSharedMemorySize, LDS_BYTES);
        hipOccupancyMaxActiveBlocksPerMultiprocessor(&per_cu, (const void*)fwd_megakernel, 512, LDS_BYTES);
        if (per_cu < 1) { fprintf(stderr, "kernel_launch: occupancy query says %d blocks per CU\n", per_cu); per_cu = 1; }
        (void)hipGetLastError();
        grid = cus;
    }
    if (grid < 0) return;
    Params p{};
    const float** pp = (const float**)&p;
    for (int i = 0; i < 15; ++i) pp[i] = (const float*)d_in[i];
    p.out = (float*)d_out; p.ws = (unsigned char*)d_ws;
#if N_LAUNCH_MODE == 1
    p.ph_lo = 0; p.ph_hi = 8;
    void* args[] = {&p};
    if (hipMemsetAsync((char*)d_ws + WS_BAR, 0, WS_BAR_BYTES, stream) != hipSuccess) fprintf(stderr, "kernel_launch: memset of the barrier words failed\n");
    hipError_t e = hipLaunchCooperativeKernel((const void*)fwd_megakernel, dim3(grid), dim3(512), args, LDS_BYTES, stream);
    if (e != hipSuccess) fprintf(stderr, "cooperative launch failed: %s (grid %d)\n", hipGetErrorString(e), grid);
#else
    for (int ph = 0; ph < 8; ++ph) { p.ph_lo = ph; p.ph_hi = ph + 1; hipLaunchKernelGGL(fwd_megakernel, dim3(grid), dim3(512), LDS_BYTES, stream, p); }
#endif
}
```
